# Optimizing an MI355X kernel written in HIP

```python
import math
import jax, jax.numpy as jnp
from jax import lax
import numpy as np

D_MODEL = 1024
BATCH = 2
SEQ = 8192
DEPTH = 4

ATTN_HEAD_DIM = 64
ATTN_HEADS = D_MODEL // 256
ATTN_V_DIM = 2 * ATTN_HEAD_DIM
ATTN_QK_WIDTH = ATTN_HEADS * 2 * ATTN_HEAD_DIM
ATTN_V_WIDTH = ATTN_HEADS * ATTN_V_DIM
Q_BLOCK = 128
ROPE_THETA = 10000.0

SSM_GROUP_CH = 16
SSM_GROUPS = D_MODEL // 32
SSM_WIDTH = SSM_GROUPS * SSM_GROUP_CH
SSM_STATE = 64
SSM_DT_MIN = 1e-3
SSM_DT_MAX = 1e-1

N_BRANCHES = 2
OFF_K = ATTN_QK_WIDTH
OFF_V = OFF_K + ATTN_QK_WIDTH
OFF_U = OFF_V + ATTN_V_WIDTH
OFF_G = OFF_U + SSM_WIDTH
IN_WIDTH = OFF_G + N_BRANCHES * D_MODEL

D_FF = 256 * ((8 * D_MODEL // 3 + 255) // 256)
N_EXPERTS = 8
TOP_K = 2
MOE_BLOCK = 256
RMS_EPS = 1e-6

kernel_name = "hybrid_diffattn_s5_moe_encoder"


def rms_norm(x, g):
    xf = x.astype(jnp.float32)
    y = xf * lax.rsqrt(jnp.mean(xf * xf, axis=-1, keepdims=True) + RMS_EPS)
    return (y * g.astype(jnp.float32)).astype(x.dtype)


def rotary(x, positions):
    half = ATTN_HEAD_DIM // 2
    inv_freq = 1.0 / (ROPE_THETA ** (jnp.arange(half, dtype=jnp.float32) / half))
    ang = positions.astype(jnp.float32)[:, None] * inv_freq[None, :]
    cos = jnp.cos(ang)[:, None, None, :]
    sin = jnp.sin(ang)[:, None, None, :]
    xf = x.astype(jnp.float32)
    x1, x2 = xf[..., :half], xf[..., half:]
    return jnp.concatenate([x1 * cos - x2 * sin, x2 * cos + x1 * sin], axis=-1).astype(x.dtype)


def diff_attention(q, k, v, lam):
    bsz, seq = q.shape[0], q.shape[1]
    n_blocks = seq // Q_BLOCK
    scale = ATTN_HEAD_DIM ** -0.5
    qb = jnp.moveaxis(q.reshape(bsz, n_blocks, Q_BLOCK, ATTN_HEADS, 2, ATTN_HEAD_DIM), 1, 0)

    def one_block(q_blk):
        s = jnp.einsum('bqhcd,bkhcd->bhcqk', q_blk, k,
                       preferred_element_type=jnp.float32) * scale
        p = jax.nn.softmax(s, axis=-1)
        w = p[:, :, 0] - lam * p[:, :, 1]
        return jnp.einsum('bhqk,bkhe->bqhe', w.astype(v.dtype), v)

    o = lax.map(one_block, qb)
    return jnp.moveaxis(o, 0, 1).reshape(bsz, seq, ATTN_HEADS, ATTN_V_DIM)


def _linear_recurrence_combine(left, right):
    a_l, b_l = left
    a_r, b_r = right
    return a_r * a_l, a_r * b_l + b_r


def s5_bidirectional(u, lam_re, lam_im, log_dt, b_re, b_im, c_re, c_im, d_skip):
    bsz, seq, _ = u.shape
    uf = u.astype(jnp.float32).reshape(bsz, seq, SSM_GROUPS, SSM_GROUP_CH)
    uc = uf.astype(jnp.complex64)
    y = uf * d_skip.astype(jnp.float32).reshape(SSM_GROUPS, SSM_GROUP_CH)
    for direction in range(2):
        lam = lax.complex(lam_re[direction].astype(jnp.float32),
                          lam_im[direction].astype(jnp.float32))
        dt = jnp.exp(log_dt[direction].astype(jnp.float32))[:, None]
        a_bar = jnp.exp(lam * dt)
        b_mat = lax.complex(b_re[direction].astype(jnp.float32),
                            b_im[direction].astype(jnp.float32))
        b_bar = ((a_bar - 1.0) / lam)[..., None] * b_mat
        bu = jnp.einsum('gph,bsgh->bsgp', b_bar, uc)
        a_seq = jnp.broadcast_to(a_bar, bu.shape)
        _, states = lax.associative_scan(_linear_recurrence_combine, (a_seq, bu),
                                         reverse=(direction == 1), axis=1)
        c_mat = lax.complex(c_re[direction].astype(jnp.float32),
                            c_im[direction].astype(jnp.float32))
        y = y + jnp.real(jnp.einsum('ghp,bsgp->bsgh', c_mat, states))
    return y.reshape(bsz, seq, SSM_WIDTH)


def swiglu(h, w1, w3, w2):
    return (jax.nn.silu(h @ w1) * (h @ w3)) @ w2


def moe_swiglu(h, w_router, w1, w3, w2):
    bsz, seq, d = h.shape
    t = h.reshape(-1, d)
    n_tok = t.shape[0]
    logits = jnp.dot(t, w_router, preferred_element_type=jnp.float32)
    top_logit, top_idx = lax.top_k(logits, TOP_K)
    gate = jax.nn.softmax(top_logit, axis=-1)
    n_assign = n_tok * TOP_K
    flat_e = top_idx.reshape(-1)
    order = jnp.argsort(flat_e)
    sorted_e = flat_e[order]
    sorted_tok = order // TOP_K
    sorted_gate = gate.reshape(-1)[order]
    counts = jnp.bincount(flat_e, length=N_EXPERTS)
    padded = (counts + MOE_BLOCK - 1) // MOE_BLOCK * MOE_BLOCK
    pad_end = jnp.cumsum(padded)
    pad_start = pad_end - padded
    grp_start = jnp.cumsum(counts) - counts
    dest = pad_start[sorted_e] + jnp.arange(n_assign) - grp_start[sorted_e]
    n_slots = ((n_assign + MOE_BLOCK - 1) // MOE_BLOCK) * MOE_BLOCK + N_EXPERTS * MOE_BLOCK
    slot_tok = jnp.zeros((n_slots,), jnp.int32).at[dest].set(sorted_tok.astype(jnp.int32))
    slot_gate = jnp.zeros((n_slots,), jnp.float32).at[dest].set(sorted_gate)
    n_blocks = n_slots // MOE_BLOCK
    block_start = jnp.arange(n_blocks) * MOE_BLOCK
    block_exp = jnp.minimum(jnp.searchsorted(pad_end, block_start, side='right'), N_EXPERTS - 1)
    xb = t[slot_tok].reshape(n_blocks, MOE_BLOCK, d)

    def expert_block(args):
        x_blk, e = args
        return (jax.nn.silu(x_blk @ w1[e]) * (x_blk @ w3[e])) @ w2[e]

    yb = lax.map(expert_block, (xb, block_exp)).reshape(n_slots, d)
    y = jnp.zeros_like(t).at[slot_tok].add(yb * slot_gate[:, None].astype(yb.dtype))
    return y.reshape(bsz, seq, d)


def setup_inputs(seed: int = 0) -> dict:
    key = jax.random.key(seed)
    ks = iter(jax.random.split(key, 40))
    f32 = jnp.float32
    n_dense = (DEPTH + 1) // 2
    n_moe = DEPTH // 2

    def nrm(shape, scale):
        return jax.random.normal(next(ks), shape, f32) * scale

    def gain(shape):
        return 1.0 + nrm(shape, 0.02)

    ssm_p = (DEPTH, 2, SSM_GROUPS, SSM_STATE)
    n_idx = jnp.arange(SSM_STATE, dtype=f32)
    return {
        "x": nrm((BATCH, SEQ, D_MODEL), 1.0),
        "norm_mix": gain((DEPTH, D_MODEL)),
        "w_in": nrm((DEPTH, D_MODEL, IN_WIDTH), D_MODEL ** -0.5),
        "attn_lambda": nrm((DEPTH, 4, ATTN_HEAD_DIM), 0.1),
        "attn_subln": gain((DEPTH, ATTN_V_DIM)),
        "ssm_lam_re": -0.5 + nrm(ssm_p, 0.01),
        "ssm_lam_im": math.pi * n_idx + nrm(ssm_p, 0.01),
        "ssm_log_dt": jax.random.uniform(next(ks), (DEPTH, 2, SSM_GROUPS), f32,
                                         math.log(SSM_DT_MIN), math.log(SSM_DT_MAX)),
        "ssm_b_re": nrm((DEPTH, 2, SSM_GROUPS, SSM_STATE, SSM_GROUP_CH), (2 * SSM_GROUP_CH) ** -0.5),
        "ssm_b_im": nrm((DEPTH, 2, SSM_GROUPS, SSM_STATE, SSM_GROUP_CH), (2 * SSM_GROUP_CH) ** -0.5),
        "ssm_c_re": nrm((DEPTH, 2, SSM_GROUPS, SSM_GROUP_CH, SSM_STATE), (2 * SSM_STATE) ** -0.5),
        "ssm_c_im": nrm((DEPTH, 2, SSM_GROUPS, SSM_GROUP_CH, SSM_STATE), (2 * SSM_STATE) ** -0.5),
        "ssm_d": nrm((DEPTH, SSM_WIDTH), 1.0),
        "w_glu": nrm((DEPTH, SSM_WIDTH, SSM_WIDTH), SSM_WIDTH ** -0.5),
        "w_branch": nrm((DEPTH, N_BRANCHES, ATTN_V_WIDTH, D_MODEL), ATTN_V_WIDTH ** -0.5),
        "w_out": nrm((DEPTH, D_MODEL, D_MODEL), D_MODEL ** -0.5),
        "norm_ffn": gain((DEPTH, D_MODEL)),
        "ffn_w1": nrm((n_dense, D_MODEL, D_FF), D_MODEL ** -0.5),
        "ffn_w3": nrm((n_dense, D_MODEL, D_FF), D_MODEL ** -0.5),
        "ffn_w2": nrm((n_dense, D_FF, D_MODEL), D_FF ** -0.5),
        "moe_router": nrm((n_moe, D_MODEL, N_EXPERTS), D_MODEL ** -0.5),
        "moe_w1": nrm((n_moe, N_EXPERTS, D_MODEL, D_FF), D_MODEL ** -0.5),
        "moe_w3": nrm((n_moe, N_EXPERTS, D_MODEL, D_FF), D_MODEL ** -0.5),
        "moe_w2": nrm((n_moe, N_EXPERTS, D_FF, D_MODEL), D_FF ** -0.5),
        "norm_final": gain((D_MODEL,)),
    }


def reference(x, norm_mix, w_in, attn_lambda, attn_subln, ssm_lam_re, ssm_lam_im, ssm_log_dt,
              ssm_b_re, ssm_b_im, ssm_c_re, ssm_c_im, ssm_d, w_glu, w_branch, w_out, norm_ffn,
              ffn_w1, ffn_w3, ffn_w2, moe_router, moe_w1, moe_w3, moe_w2, norm_final):
    bsz, seq, _ = x.shape
    positions = jnp.arange(seq, dtype=jnp.int32)
    for layer in range(DEPTH):
        xn = rms_norm(x, norm_mix[layer])
        proj = xn @ w_in[layer]
        q = proj[..., :OFF_K].reshape(bsz, seq, ATTN_HEADS, 2, ATTN_HEAD_DIM)
        k = proj[..., OFF_K:OFF_V].reshape(bsz, seq, ATTN_HEADS, 2, ATTN_HEAD_DIM)
        v = proj[..., OFF_V:OFF_U].reshape(bsz, seq, ATTN_HEADS, ATTN_V_DIM)
        u = proj[..., OFF_U:OFF_G]
        gates = jax.nn.sigmoid(proj[..., OFF_G:].astype(jnp.float32)).reshape(
            bsz, seq, N_BRANCHES, D_MODEL)

        q = rotary(q, positions)
        k = rotary(k, positions)
        lam_init = 0.8 - 0.6 * math.exp(-0.3 * layer)
        lp = attn_lambda[layer].astype(jnp.float32)
        lam = jnp.exp(jnp.sum(lp[0] * lp[1])) - jnp.exp(jnp.sum(lp[2] * lp[3])) + lam_init
        a = diff_attention(q, k, v, lam)
        a = (rms_norm(a, attn_subln[layer]) * (1.0 - lam_init)).reshape(bsz, seq, ATTN_V_WIDTH)

        s = s5_bidirectional(u, ssm_lam_re[layer], ssm_lam_im[layer], ssm_log_dt[layer],
                             ssm_b_re[layer], ssm_b_im[layer], ssm_c_re[layer], ssm_c_im[layer],
                             ssm_d[layer]).astype(x.dtype)
        s = jax.nn.gelu(s, approximate=False)
        s = s * jax.nn.sigmoid(s @ w_glu[layer])

        merged = (gates[:, :, 0] * (a @ w_branch[layer, 0])
                  + gates[:, :, 1] * (s @ w_branch[layer, 1])).astype(x.dtype)
        x = x + merged @ w_out[layer]

        hn = rms_norm(x, norm_ffn[layer])
        if layer % 2 == 0:
            i = layer // 2
            f = swiglu(hn, ffn_w1[i], ffn_w3[i], ffn_w2[i])
        else:
            i = layer // 2
            f = moe_swiglu(hn, moe_router[i], moe_w1[i], moe_w3[i], moe_w2[i])
        x = x + f.astype(x.dtype)
    return rms_norm(x, norm_final)
```

```cpp
#include <hip/hip_runtime.h>
#include <cstdio>
#include <cstdint>
#include <cmath>

constexpr int D_MODEL = 1024, BATCH = 2, SEQ = 8192, DEPTH = 4, NTOK = BATCH * SEQ;
constexpr int NHEAD = 4, HD = 64, VD = 128;
constexpr int SSM_G = 32, SSM_CH = 16, SSM_P = 64, SSM_W = 512;
constexpr int IN_W = 4096, OFF_K = 512, OFF_V = 1024, OFF_U = 1536, OFF_G = 2048;
constexpr int D_FF = 2816, N_EXP = 8;
constexpr float RMS_EPS = 1e-6f;
constexpr int CHL = 16;
constexpr int NCH = SEQ / CHL;

typedef unsigned short bf16;
typedef float f32x4 __attribute__((ext_vector_type(4)));

constexpr size_t MiB = 1u << 20;
constexpr size_t WS_CTL = 0;
constexpr size_t WS_WEIGHTS = 1 * MiB;
constexpr size_t WS_XN = 267 * MiB;
constexpr size_t WS_R1 = WS_XN + 32 * MiB;
constexpr size_t WS_Q = WS_R1, WS_K = WS_Q + 16 * MiB, WS_V = WS_K + 16 * MiB, WS_G = WS_V + 16 * MiB;
constexpr size_t WS_AY = WS_G + 64 * MiB, WS_XLOC = WS_AY + 32 * MiB, WS_AS2 = WS_XLOC + 32 * MiB;
constexpr size_t WS_H = WS_R1;
constexpr size_t WS_R2 = WS_R1 + 208 * MiB;
constexpr size_t WS_SACT = WS_R2, WS_MERGED = WS_SACT + 16 * MiB, WS_O1 = WS_MERGED + 32 * MiB;
constexpr size_t WS_ROUTE = WS_R2 + 80 * MiB;
constexpr size_t WS_PART = WS_ROUTE + 1 * MiB;
constexpr size_t WS_PS = WS_PART + 48 * MiB;
constexpr size_t WS_END = WS_PS + 1 * MiB;

__device__ __forceinline__ float bf2f(bf16 v) { return __uint_as_float(((unsigned)v) << 16); }
__device__ __forceinline__ bf16 f2bf(float f) { unsigned u = __float_as_uint(f); return (bf16)((u + 0x7fffu + ((u >> 16) & 1u)) >> 16); }
__device__ __forceinline__ float wave_sum(float v) {
#pragma unroll
    for (int o = 1; o < 64; o <<= 1) v += __shfl_xor(v, o);
    return v;
}
__device__ __forceinline__ float sigmoidf_(float x) { return 1.f / (1.f + __expf(-x)); }
__host__ __device__ __forceinline__ int qk_pos(int d) { const int j = d & 31, n = d >> 5; return 32 * (j >> 4) + 8 * ((j & 15) >> 2) + 4 * n + (j & 3); }
__device__ __forceinline__ size_t q_index(int b, int h, int c, int s, int d) { return ((((size_t)b * NHEAD + h) * 2 + c) * SEQ + s) * HD + qk_pos(d); }
__device__ __forceinline__ size_t v_index(int b, int h, int s, int e) { return (((size_t)b * NHEAD + h) * SEQ + s) * VD + e; }
__device__ __forceinline__ size_t ay_index(int g, int b, int s, int hh) { return (((size_t)g * (BATCH * NCH)) + b * NCH + (s / CHL)) * 512 + (s % CHL) * SSM_CH + hh; }

__global__ __launch_bounds__(256) void k_norm(const float* __restrict__ x, const float* __restrict__ g, bf16* __restrict__ xn,
                                             const float* __restrict__ wr, int* __restrict__ top_e, float* __restrict__ top_g) {
    const int lane = threadIdx.x & 63, row = blockIdx.x * 4 + (threadIdx.x >> 6);
    const f32x4* xr = (const f32x4*)(x + (size_t)row * D_MODEL) + lane;
    f32x4 v[4]; float s = 0.f;
#pragma unroll
    for (int j = 0; j < 4; ++j) { v[j] = xr[64 * j]; s += (v[j].x * v[j].x + v[j].y * v[j].y) + (v[j].z * v[j].z + v[j].w * v[j].w); }
    const float rstd = rsqrtf(wave_sum(s) * (1.f / D_MODEL) + RMS_EPS);
    float lg[N_EXP];
#pragma unroll
    for (int e = 0; e < N_EXP; ++e) lg[e] = 0.f;
#pragma unroll
    for (int j = 0; j < 4; ++j) {
        const f32x4 gg = ((const f32x4*)g)[64 * j + lane];
        v[j].x *= rstd * gg.x; v[j].y *= rstd * gg.y; v[j].z *= rstd * gg.z; v[j].w *= rstd * gg.w;
        unsigned long long o = (unsigned long long)f2bf(v[j].x) | ((unsigned long long)f2bf(v[j].y) << 16) | ((unsigned long long)f2bf(v[j].z) << 32) | ((unsigned long long)f2bf(v[j].w) << 48);
        ((unsigned long long*)(xn + (size_t)row * D_MODEL))[64 * j + lane] = o;
        if (wr) {
            const int k0 = (64 * j + lane) * 4;
#pragma unroll
            for (int e = 0; e < N_EXP; ++e) lg[e] += v[j].x * wr[(k0 + 0) * N_EXP + e] + v[j].y * wr[(k0 + 1) * N_EXP + e] + v[j].z * wr[(k0 + 2) * N_EXP + e] + v[j].w * wr[(k0 + 3) * N_EXP + e];
        }
    }
    if (wr) {
#pragma unroll
        for (int e = 0; e < N_EXP; ++e) lg[e] = wave_sum(lg[e]);
        int e0 = 0; float l0 = lg[0];
#pragma unroll
        for (int e = 1; e < N_EXP; ++e) if (lg[e] > l0) { l0 = lg[e]; e0 = e; }
        int e1 = -1; float l1 = -3.4e38f;
#pragma unroll
        for (int e = 0; e < N_EXP; ++e) if (e != e0 && lg[e] > l1) { l1 = lg[e]; e1 = e; }
        const float p1 = __expf(l1 - l0), inv = 1.f / (1.f + p1);
        if (lane == 0) { top_e[row * 2] = e0; top_e[row * 2 + 1] = e1; top_g[row * 2] = inv; top_g[row * 2 + 1] = p1 * inv; }
    }
}

__global__ __launch_bounds__(256) void k_final_norm(float* __restrict__ x, const float* __restrict__ g) {
    const int lane = threadIdx.x & 63, row = blockIdx.x * 4 + (threadIdx.x >> 6);
    f32x4* xr = (f32x4*)(x + (size_t)row * D_MODEL) + lane;
    f32x4 v[4]; float s = 0.f;
#pragma unroll
    for (int j = 0; j < 4; ++j) { v[j] = xr[64 * j]; s += (v[j].x * v[j].x + v[j].y * v[j].y) + (v[j].z * v[j].z + v[j].w * v[j].w); }
    const float rstd = rsqrtf(wave_sum(s) * (1.f / D_MODEL) + RMS_EPS);
#pragma unroll
    for (int j = 0; j < 4; ++j) { const f32x4 gg = ((const f32x4*)g)[64 * j + lane]; f32x4 o = {v[j].x * rstd * gg.x, v[j].y * rstd * gg.y, v[j].z * rstd * gg.z, v[j].w * rstd * gg.w}; xr[64 * j] = o; }
}

template <class Epi, bool DUAL>
__global__ __launch_bounds__(256) void k_ngemm(const bf16* __restrict__ A, int lda, const float* __restrict__ W, const float* __restrict__ W2, int ldw, int K, Epi epi) {
    __shared__ float As[16][132];
    __shared__ float Bs[16][128];
    __shared__ float Bs2[DUAL ? 16 : 1][128];
    const int tid = threadIdx.x, tx = tid & 15, ty = tid >> 4;
    const int m0 = blockIdx.y * 128, n0 = blockIdx.x * 128;
    float acc[8][8], acc2[DUAL ? 8 : 1][8];
#pragma unroll
    for (int i = 0; i < 8; ++i)
#pragma unroll
        for (int j = 0; j < 8; ++j) { acc[i][j] = 0.f; if (DUAL) acc2[i][j] = 0.f; }
    const int ar = tid >> 1, ak = (tid & 1) * 8;
    const int bk = tid >> 4, bn = (tid & 15) * 8;
    for (int k0 = 0; k0 < K; k0 += 16) {
        const uint4 av = *(const uint4*)(A + (size_t)(m0 + ar) * lda + k0 + ak);
        const unsigned aw[4] = {av.x, av.y, av.z, av.w};
#pragma unroll
        for (int q = 0; q < 4; ++q) { As[ak + 2 * q][ar] = __uint_as_float(aw[q] << 16); As[ak + 2 * q + 1][ar] = __uint_as_float(aw[q] & 0xffff0000u); }
        const f32x4 b0 = *(const f32x4*)(W + (size_t)(k0 + bk) * ldw + n0 + bn), b1 = *(const f32x4*)(W + (size_t)(k0 + bk) * ldw + n0 + bn + 4);
        *(f32x4*)&Bs[bk][bn] = b0; *(f32x4*)&Bs[bk][bn + 4] = b1;
        if (DUAL) { const f32x4 c0 = *(const f32x4*)(W2 + (size_t)(k0 + bk) * ldw + n0 + bn), c1 = *(const f32x4*)(W2 + (size_t)(k0 + bk) * ldw + n0 + bn + 4);
            *(f32x4*)&Bs2[bk][bn] = c0; *(f32x4*)&Bs2[bk][bn + 4] = c1; }
        __syncthreads();
#pragma unroll
        for (int k = 0; k < 16; ++k) {
            float a[8], b[8], b2[8];
#pragma unroll
            for (int i = 0; i < 8; ++i) a[i] = As[k][ty * 8 + i];
#pragma unroll
            for (int j = 0; j < 8; ++j) { b[j] = Bs[k][tx * 2 + (j & 1) + 32 * (j >> 1)]; if (DUAL) b2[j] = Bs2[k][tx * 2 + (j & 1) + 32 * (j >> 1)]; }
#pragma unroll
            for (int i = 0; i < 8; ++i)
#pragma unroll
                for (int j = 0; j < 8; ++j) { acc[i][j] += a[i] * b[j]; if (DUAL) acc2[i][j] += a[i] * b2[j]; }
        }
        __syncthreads();
    }
#pragma unroll
    for (int i = 0; i < 8; ++i) { if constexpr (DUAL) epi.row2(m0 + ty * 8 + i, n0, tx, acc[i], acc2[i]); else epi.row(m0 + ty * 8 + i, n0, tx, acc[i]); }
}
#define NG_COL(n0, tx, jj) ((n0) + (tx) * 2 + ((jj) & 1) + 32 * ((jj) >> 1))

struct NEpiInProj {
    bf16 *Q, *Kb, *V, *AY, *G;
    __device__ void row(int m, int n0, int tx, const float (&a)[8]) const {
        const int b = m / SEQ, s = m % SEQ;
        if (n0 < OFF_V) {
            bf16* dst = n0 < OFF_K ? Q : Kb; const int h = (n0 % 512) / 128;
#pragma unroll
            for (int c = 0; c < 2; ++c)
#pragma unroll
                for (int e = 0; e < 2; ++e) {
                    const int j = tx * 2 + e;
                    const float x1 = a[c * 4 + e], x2 = a[c * 4 + 2 + e];
                    const double ang = (double)s * pow(10000.0, -(double)j / 32.0);
                    const float sn = (float)sin(ang), cs = (float)cos(ang);
                    dst[q_index(b, h, c, s, j)] = f2bf(x1 * cs - x2 * sn);
                    dst[q_index(b, h, c, s, j + 32)] = f2bf(x2 * cs + x1 * sn);
                }
        } else {
#pragma unroll
            for (int jj = 0; jj < 8; ++jj) {
                const int n = NG_COL(n0, tx, jj);
                if (n < OFF_U) { const int h = (n - OFF_V) / VD, e = (n - OFF_V) % VD; V[v_index(b, h, s, e)] = f2bf(a[jj]); }
                else if (n < OFF_G) { const int g = (n - OFF_U) / SSM_CH, hh = (n - OFF_U) % SSM_CH; AY[ay_index(g, b, s, hh)] = f2bf(a[jj]); }
                else G[(size_t)m * 2048 + (n - OFF_G)] = f2bf(sigmoidf_(a[jj]));
            }
        }
    }
};
struct NEpiGlu {
    const bf16* SACT; bf16* AS2;
    __device__ void row(int m, int n0, int tx, const float (&a)[8]) const {
#pragma unroll
        for (int jj = 0; jj < 8; ++jj) { const int n = NG_COL(n0, tx, jj); AS2[(size_t)m * 1024 + 512 + n] = f2bf(bf2f(SACT[(size_t)m * 512 + n]) * sigmoidf_(a[jj])); }
    }
};
struct NEpiBranch {
    const bf16* G; float* TMP; bf16* MERGED; int second, pad;
    __device__ void row(int m, int n0, int tx, const float (&a)[8]) const {
#pragma unroll
        for (int jj = 0; jj < 8; ++jj) { const int n = NG_COL(n0, tx, jj);
            if (!second) TMP[(size_t)m * 1024 + n] = bf2f(G[(size_t)m * 2048 + n]) * a[jj];
            else MERGED[(size_t)m * 1024 + n] = f2bf(TMP[(size_t)m * 1024 + n] + bf2f(G[(size_t)m * 2048 + 1024 + n]) * a[jj]); }
    }
};
struct NEpiRes {
    float* X; const int* top_e; const float* top_g; int e, pad;
    __device__ void row(int m, int n0, int tx, const float (&a)[8]) const {
        float gt = 1.f;
        if (top_e) { gt = 0.f; if (top_e[m * 2] == e) gt = top_g[m * 2]; else if (top_e[m * 2 + 1] == e) gt = top_g[m * 2 + 1]; if (gt == 0.f) return; }
#pragma unroll
        for (int jj = 0; jj < 8; ++jj) { const int n = NG_COL(n0, tx, jj); X[(size_t)m * 1024 + n] += gt * a[jj]; }
    }
};
struct NEpiSwiglu {
    bf16* H;
    __device__ void row2(int m, int n0, int tx, const float (&a)[8], const float (&b)[8]) const {
#pragma unroll
        for (int jj = 0; jj < 8; ++jj) { const int n = NG_COL(n0, tx, jj); H[(size_t)m * D_FF + n] = f2bf(a[jj] * sigmoidf_(a[jj]) * b[jj]); }
    }
};

__global__ __launch_bounds__(128) void k_nattn(const bf16* __restrict__ Q, const bf16* __restrict__ Kb, const bf16* __restrict__ V, bf16* __restrict__ AS2,
                                              const float* __restrict__ lam_p, const float* __restrict__ subln, float lam_init) {
    __shared__ float Ks[32][64];
    __shared__ float Vs[32][128];
    __shared__ float ssq[2][64];
    const int tid = threadIdx.x, r = tid & 63, vh = tid >> 6;
    const int b = blockIdx.z, h = blockIdx.y, s = blockIdx.x * 64 + r;
    float d01 = 0.f, d23 = 0.f;
    for (int i = 0; i < HD; ++i) { d01 += lam_p[i] * lam_p[HD + i]; d23 += lam_p[2 * HD + i] * lam_p[3 * HD + i]; }
    const float lam = __expf(d01) - __expf(d23) + lam_init;
    float res[64];
#pragma unroll
    for (int e = 0; e < 64; ++e) res[e] = 0.f;
    for (int c = 0; c < 2; ++c) {
        float q[64], o[64];
        const bf16* qp = Q + ((((size_t)b * NHEAD + h) * 2 + c) * SEQ + s) * HD;
#pragma unroll
        for (int d = 0; d < 64; ++d) { q[d] = bf2f(qp[d]) * 0.125f; o[d] = 0.f; }
        float mx = -1e30f, l = 0.f;
        const bf16* kp = Kb + ((((size_t)b * NHEAD + h) * 2 + c) * SEQ) * HD;
        const bf16* vp = V + (((size_t)b * NHEAD + h) * SEQ) * VD;
        for (int k0 = 0; k0 < SEQ; k0 += 32) {
            __syncthreads();
            for (int i = tid; i < 32 * 64; i += 128) Ks[i / 64][i % 64] = bf2f(kp[(size_t)k0 * HD + i]);
            for (int i = tid; i < 32 * 128; i += 128) Vs[i / 128][i % 128] = bf2f(vp[(size_t)k0 * VD + i]);
            __syncthreads();
            float sc[32]; float tm = mx;
#pragma unroll
            for (int j = 0; j < 32; ++j) { float a = 0.f;
#pragma unroll
                for (int d = 0; d < 64; ++d) a += q[d] * Ks[j][d];
                sc[j] = a; tm = fmaxf(tm, a); }
            const float alpha = __expf(mx - tm); mx = tm; l *= alpha;
#pragma unroll
            for (int e = 0; e < 64; ++e) o[e] *= alpha;
#pragma unroll
            for (int j = 0; j < 32; ++j) { const float p = __expf(sc[j] - mx); l += p;
#pragma unroll
                for (int e = 0; e < 64; ++e) o[e] += p * Vs[j][vh * 64 + e]; }
        }
        const float il = (c == 0 ? 1.f : -lam) / l;
#pragma unroll
        for (int e = 0; e < 64; ++e) res[e] += o[e] * il;
    }
    float sq = 0.f;
#pragma unroll
    for (int e = 0; e < 64; ++e) sq += res[e] * res[e];
    ssq[vh][r] = sq;
    __syncthreads();
    const float rstd = rsqrtf((ssq[0][r] + ssq[1][r]) * (1.f / VD) + RMS_EPS) * (1.f - lam_init);
    bf16* op = AS2 + (size_t)(b * SEQ + s) * 1024 + h * VD + vh * 64;
#pragma unroll
    for (int e = 0; e < 64; ++e) op[e] = f2bf(res[e] * rstd * subln[vh * 64 + e]);
}

__global__ __launch_bounds__(64) void k_nssm(const bf16* __restrict__ AY, float* __restrict__ Y, bf16* __restrict__ SACT,
                                            const float* __restrict__ lam_re, const float* __restrict__ lam_im, const float* __restrict__ log_dt,
                                            const float* __restrict__ b_re, const float* __restrict__ b_im, const float* __restrict__ c_re, const float* __restrict__ c_im,
                                            const float* __restrict__ dsk) {
    const int p = threadIdx.x, g = blockIdx.x % SSM_G, b = blockIdx.x / SSM_G;
    for (int dir = 0; dir < 2; ++dir) {
        const size_t pi = ((size_t)dir * SSM_G + g) * SSM_P + p;
        const float lr = lam_re[pi], li = lam_im[pi], dt = __expf(log_dt[dir * SSM_G + g]);
        const float er = expf(lr * dt); float sn, cs; sincosf(li * dt, &sn, &cs);
        const float ar = er * cs, ai = er * sn;
        const float nr = ar - 1.f, ni = ai, den = lr * lr + li * li;
        const float fr = (nr * lr + ni * li) / den, fi = (ni * lr - nr * li) / den;
        float bbr[16], bbi[16], cr[16], ci[16];
#pragma unroll
        for (int hh = 0; hh < 16; ++hh) { const float br = b_re[pi * 16 + hh], bi = b_im[pi * 16 + hh]; bbr[hh] = fr * br - fi * bi; bbi[hh] = fr * bi + fi * br;
            const size_t cidx = (((size_t)dir * SSM_G + g) * SSM_CH + hh) * SSM_P + p; cr[hh] = c_re[cidx]; ci[hh] = c_im[cidx]; }
        float xr = 0.f, xi = 0.f;
        for (int step = 0; step < SEQ; ++step) {
            const int s = dir == 0 ? step : SEQ - 1 - step;
            const bf16* up = AY + ay_index(g, b, s, 0);
            float u[16];
#pragma unroll
            for (int hh = 0; hh < 16; ++hh) u[hh] = bf2f(up[hh]);
            float br = 0.f, bi = 0.f;
#pragma unroll
            for (int hh = 0; hh < 16; ++hh) { br += bbr[hh] * u[hh]; bi += bbi[hh] * u[hh]; }
            const float nxr = ar * xr - ai * xi + br, nxi = ar * xi + ai * xr + bi; xr = nxr; xi = nxi;
            float mine = 0.f;
#pragma unroll
            for (int hh = 0; hh < 16; ++hh) { const float t = wave_sum(cr[hh] * xr - ci[hh] * xi); if (p == hh) mine = t; }
            if (p < 16) {
                const size_t yi = (size_t)(b * SEQ + s) * SSM_W + g * SSM_CH + p;
                if (dir == 0) Y[yi] = u[p] * dsk[g * SSM_CH + p] + mine;
                else { const float y = Y[yi] + mine; SACT[yi] = f2bf(0.5f * y * (1.f + erff(y * 0.70710678118654752f))); }
            }
        }
    }
}


#define GAS __attribute__((address_space(1)))
#define LAS __attribute__((address_space(3)))
namespace pg8 {
#define PG8_LAS __attribute__((address_space(3)))
typedef unsigned short bf16_t;
typedef short bf16x8 __attribute__((ext_vector_type(8)));
typedef float f32x4 __attribute__((ext_vector_type(4)));
typedef unsigned u32x4 __attribute__((ext_vector_type(4)));
constexpr int BM = 256, BK = 64, HALF = 128, HTB = HALF * BK * 2  , STAGE_BYTES = 8 * HTB, NXCD = 8, WGM = 8;

__host__ __device__ __forceinline__ int lds_byte(int r, int c) { const int st = (r >> 4) * 2 + (c >> 5), rr = r & 15, cc = c & 31, ob = rr * 64 + cc * 2; return st * 1024 + (ob ^ (((ob >> 9) & 1) << 5)); }
__host__ __device__ __forceinline__ void stage_rc(int b, int& R, int& C) { const int st = b / 1024, sb = b % 1024, swz = sb ^ (((sb >> 9) & 1) << 5); R = (st >> 1) * 16 + swz / 64; C = (st & 1) * 32 + (swz % 64) / 2; }
__host__ __device__ __forceinline__ int perm32(int rho) { const int n = rho >> 4, i = rho & 15; return 8 * (i >> 2) + 4 * n + (i & 3); }

struct Unit { int pm, pn; int ko = 0, aux = 0, nk = 0; };
struct Gemm { const bf16_t* A; const bf16_t* Bt; };

struct StaticOrder {
    int nM, nN, nwg, G, c;
    __host__ __device__ void init(int M, int N, int G_, int c_) { nM = M / BM; nN = N / BM; nwg = nM * nN; G = G_; c = c_; }
    __host__ __device__ void map(int L, Unit& u) const {
        int wgid = L; { const int q = nwg / NXCD, r = nwg % NXCD, xcd = wgid % NXCD, off = wgid / NXCD; wgid = (xcd < r ? xcd * (q + 1) : r * (q + 1) + (xcd - r) * q) + off; }
        const int nig = WGM * nN, gid = wgid / nig, fm = gid * WGM, gsz = (nM - fm) < WGM ? (nM - fm) : WGM;
        u.pm = fm + ((wgid % nig) % gsz); u.pn = (wgid % nig) / gsz;
    }
    __host__ __device__ bool next(int i, Unit& u) const {
        const long L = (long)i * G + c; if (L >= nwg) return false;
        map((int)L, u); return true;
    }
    __device__ __forceinline__ void a_ready(const Unit&) const {}
    __device__ __forceinline__ void done(const Unit&) const {}
};


template <int NM, int NN> struct StaticOrderT {
    int c;
    __device__ __forceinline__ bool next(int i, Unit& u) const {
        constexpr int nwg = NM * NN, q = nwg / NXCD, r = nwg % NXCD; const int L = i * 256 + c; if (L >= nwg) return false;
        int wgid = L; { const int xcd = wgid % NXCD, off = wgid / NXCD; wgid = (xcd < r ? xcd * (q + 1) : r * (q + 1) + (xcd - r) * q) + off; }
        constexpr int nig = WGM * NN; const int gid = wgid / nig, fm = gid * WGM, gsz = (NM - fm) < WGM ? (NM - fm) : WGM;
        u.pm = fm + ((wgid % nig) % gsz); u.pn = (wgid % nig) / gsz; return true;
    }
    __device__ __forceinline__ void a_ready(const Unit&) const {}
    __device__ __forceinline__ void done(const Unit&) const {}
};
typedef __bf16 bf16x2_cv __attribute__((ext_vector_type(2))); typedef float f32x2_cv __attribute__((ext_vector_type(2)));
__device__ __forceinline__ unsigned cvt_pk_bf16(float lo, float hi) { const bf16x2_cv r = __builtin_convertvector((f32x2_cv){lo, hi}, bf16x2_cv); return __builtin_bit_cast(unsigned, r); }
typedef float f32x2 __attribute__((ext_vector_type(2)));
__device__ __forceinline__ f32x2 gelu_pk(f32x2 v) {
    const f32x2 av = __builtin_elementwise_abs(v), d = av * 0.2316418882f + 1.0f;
    f32x2 t; t.x = __builtin_amdgcn_rcpf(d.x); t.y = __builtin_amdgcn_rcpf(d.y);
    f32x2 q = t * 0.5307027145f + (-0.7265760135f); q = q * t + 0.7107068705f; q = q * t + (-0.142248368f); q = q * t + 0.127414796f; q = q * t;
    const f32x2 s = (v * v) * (-0.72134752044f);
    f32x2 e; e.x = __builtin_amdgcn_exp2f(s.x); e.y = __builtin_amdgcn_exp2f(s.y);
    const f32x2 m = v * (q * e), r = v - m;
    f32x2 o; o.x = v.x < 0.f ? m.x : r.x; o.y = v.y < 0.f ? m.y : r.y; return o;
}

template <class Epi, class Sched, int LDA, int LDB, int KK, bool ALIGN_EPI = true, bool SP2 = true>
__device__ __forceinline__ void gemm_phase(PG8_LAS unsigned char* lds, const Gemm g, const Sched& S, const Epi& E) {
    int tid_l = threadIdx.x; asm volatile("" : "+v"(tid_l));
    const int tid = tid_l, wid = __builtin_amdgcn_readfirstlane(tid >> 6), lane = tid & 63, wr = wid >> 2, wc = wid & 3, fr = lane & 15, fq = lane >> 4;
    static_assert(KK % 128 == 0, "K multiple of 128");
    unsigned voffA[2], voffB[2];
#pragma unroll
    for (int i = 0; i < 2; ++i) { int R, C; stage_rc(tid * 16 + i * 8192, R, C); const int Rb = Epi::PERM ? ((R & ~31) + perm32(R & 31)) : R;
        voffA[i] = (unsigned)(R * LDA + C) * 2u; voffB[i] = (unsigned)(Rb * LDB + C) * 2u; }
    constexpr size_t kstep = (size_t)(BK * 2);
    constexpr size_t hstepA = (size_t)HALF * LDA * 2, hstepB = (size_t)HALF * LDB * 2;
    constexpr size_t tstepA = 2 * hstepA, tstepB = 2 * hstepB;
    const unsigned ldsw = (unsigned)wid * 1024u;
    const int aoff = lds_byte(wr * 64 + fr, fq * 8), boff = lds_byte(wc * 32 + fr, fq * 8);
#define PG8_SA(b, h) (((b) * 2 + (h)) * HTB)
#define PG8_SB(b, h) ((4 + (b) * 2 + (h)) * HTB)
#define PG8_STAGE(bufoff, gbase, voff) do { _Pragma("unroll") for (int _i = 0; _i < 2; ++_i) \
        __builtin_amdgcn_global_load_lds((const unsigned*)((const char*)(gbase) + (voff)[_i]), (PG8_LAS unsigned*)(lds + (bufoff) + ldsw + _i * 8192), 16, 0, 0); } while (0)
#define PG8_LDA(dst, b, h) do { _Pragma("unroll") for (int m = 0; m < 4; ++m) _Pragma("unroll") for (int k = 0; k < 2; ++k) dst[m][k] = *(const PG8_LAS bf16x8*)(lds + PG8_SA(b, h) + aoff + m * 2048 + k * 1024); } while (0)
#define PG8_LDB(dst, b, h) do { _Pragma("unroll") for (int n = 0; n < 2; ++n) _Pragma("unroll") for (int k = 0; k < 2; ++k) dst[n][k] = *(const PG8_LAS bf16x8*)(lds + PG8_SB(b, h) + boff + n * 2048 + k * 1024); } while (0)
#define PG8_MMA(ai, bj, At, Bt) do { __builtin_amdgcn_s_setprio(1); _Pragma("unroll") for (int m = 0; m < 4; ++m) _Pragma("unroll") for (int n = 0; n < 2; ++n) _Pragma("unroll") for (int k = 0; k < 2; ++k) \
        acc[ai][bj][m][n] = __builtin_amdgcn_mfma_f32_16x16x32_bf16(Bt[n][k], At[m][k], acc[ai][bj][m][n], 0, 0, 0); __builtin_amdgcn_s_setprio(0); } while (0)
#define PG8_WAIT_V(n) asm volatile("s_waitcnt vmcnt(" #n ")" ::: "memory")
#define PG8_WAIT_L(n) asm volatile("s_waitcnt lgkmcnt(" #n ")" ::: "memory")
#define PG8_BAR __builtin_amdgcn_s_barrier()
#define PG8_SCHED __builtin_amdgcn_sched_barrier(0)
    Unit cur, nxt; int ui = 0;
    if (!S.next(0, cur)) return;
    f32x4 acc[2][2][4][2];
#pragma unroll
    for (int a = 0; a < 2; ++a)
#pragma unroll
        for (int b = 0; b < 2; ++b)
#pragma unroll
            for (int m = 0; m < 4; ++m)
#pragma unroll
                for (int n = 0; n < 2; ++n) acc[a][b][m][n] = (f32x4){0.f, 0.f, 0.f, 0.f};
    bf16x8 At[4][2], B0[2][2], B1[2][2];
    const char* cA = (const char*)g.A + (size_t)cur.pm * tstepA + cur.ko; const char* cB = (const char*)g.Bt + (size_t)cur.pn * tstepB + cur.ko;
    S.a_ready(cur);
    if constexpr (SP2) {
        PG8_STAGE(PG8_SB(0, 0), cB, voffB); PG8_STAGE(PG8_SB(0, 1), cB + hstepB, voffB); PG8_STAGE(PG8_SA(0, 0), cA, voffA); PG8_STAGE(PG8_SA(0, 1), cA + hstepA, voffA);
        if (wr == 1) PG8_BAR;
        PG8_WAIT_V(2); PG8_BAR;
        PG8_STAGE(PG8_SB(1, 0), cB + kstep, voffB); PG8_STAGE(PG8_SA(1, 0), cA + kstep, voffA); PG8_STAGE(PG8_SB(1, 1), cB + hstepB + kstep, voffB);
        PG8_WAIT_V(6); PG8_BAR;
    } else {
        PG8_STAGE(PG8_SB(0, 0), cB, voffB); PG8_STAGE(PG8_SA(0, 0), cA, voffA); PG8_STAGE(PG8_SB(0, 1), cB + hstepB, voffB); PG8_STAGE(PG8_SA(0, 1), cA + hstepA, voffA);
        if (wr == 1) PG8_BAR;
        PG8_WAIT_V(4); PG8_BAR;
        PG8_STAGE(PG8_SB(1, 0), cB + kstep, voffB); PG8_STAGE(PG8_SA(1, 0), cA + kstep, voffA); PG8_STAGE(PG8_SB(1, 1), cB + hstepB + kstep, voffB);
        PG8_WAIT_V(6); PG8_BAR;
    }
    for (;;) {
        const bool has_next = S.next(ui + 1, nxt);
        const char* nA = has_next ? (const char*)g.A + (size_t)nxt.pm * tstepA + nxt.ko : cA; const char* nB = has_next ? (const char*)g.Bt + (size_t)nxt.pn * tstepB + nxt.ko : cB;
        const int nt = KK > 0 ? KK / BK : cur.nk;
        for (int t = 0; t < nt; t += 2) {
            if constexpr (Epi::MIDHOOK) { if (t == nt / 2) E.mid(acc, cur, wr, wc, fr, fq); }
            const bool last = (t == nt - 2);
            const char* a1 = cA + (size_t)(t + 1) * kstep;
            const char* a2 = last ? nA : cA + (size_t)(t + 2) * kstep; const char* b2 = last ? nB : cB + (size_t)(t + 2) * kstep;
            const char* a3 = a2 + kstep; const char* b3 = b2 + kstep;
            if (last && has_next) S.a_ready(nxt);
            if constexpr (SP2) {
            PG8_LDB(B0, 0, 0); PG8_LDB(B1, 0, 1); PG8_SCHED; PG8_LDA(At, 0, 0); PG8_STAGE(PG8_SA(1, 1), a1 + hstepA, voffA);
            PG8_WAIT_V(8); PG8_WAIT_L(0); PG8_BAR; PG8_MMA(0, 0, At, B0); PG8_MMA(0, 1, At, B1); PG8_BAR; PG8_SCHED;
            PG8_LDA(At, 0, 1); PG8_STAGE(PG8_SB(0, 0), b2, voffB); PG8_STAGE(PG8_SB(0, 1), b2 + hstepB, voffB); PG8_STAGE(PG8_SA(0, 0), a2, voffA);
            PG8_WAIT_V(8); PG8_WAIT_L(0); PG8_BAR; PG8_MMA(1, 0, At, B0); PG8_MMA(1, 1, At, B1); PG8_BAR; PG8_SCHED;
            PG8_LDB(B0, 1, 0); PG8_LDB(B1, 1, 1); PG8_SCHED; PG8_LDA(At, 1, 0); PG8_STAGE(PG8_SA(0, 1), a2 + hstepA, voffA);
            PG8_WAIT_V(8); PG8_WAIT_L(0); PG8_BAR; PG8_MMA(0, 0, At, B0); PG8_MMA(0, 1, At, B1); PG8_BAR; PG8_SCHED;
            PG8_LDA(At, 1, 1); PG8_STAGE(PG8_SB(1, 0), b3, voffB); PG8_STAGE(PG8_SB(1, 1), b3 + hstepB, voffB); PG8_STAGE(PG8_SA(1, 0), a3, voffA);
            PG8_WAIT_V(8); PG8_WAIT_L(0); PG8_BAR; PG8_MMA(1, 0, At, B0); PG8_MMA(1, 1, At, B1); PG8_BAR; PG8_SCHED;
            } else {
            PG8_LDB(B0, 0, 0); PG8_SCHED; PG8_LDA(At, 0, 0); PG8_STAGE(PG8_SA(1, 1), a1 + hstepA, voffA);
            PG8_WAIT_L(8); PG8_BAR; PG8_WAIT_L(0); PG8_MMA(0, 0, At, B0); PG8_BAR; PG8_SCHED;
            PG8_LDB(B1, 0, 1); PG8_STAGE(PG8_SB(0, 0), b2, voffB);
            PG8_BAR; PG8_WAIT_L(0); PG8_MMA(0, 1, At, B1); PG8_BAR;
            PG8_LDA(At, 0, 1); PG8_STAGE(PG8_SA(0, 0), a2, voffA);
            PG8_BAR; PG8_WAIT_L(0); PG8_MMA(1, 0, At, B0); PG8_BAR; PG8_SCHED;
            PG8_STAGE(PG8_SB(0, 1), b2 + hstepB, voffB);
            PG8_WAIT_V(6); PG8_BAR; PG8_MMA(1, 1, At, B1); PG8_BAR;
            PG8_LDB(B0, 1, 0); PG8_SCHED; PG8_LDA(At, 1, 0); PG8_STAGE(PG8_SA(0, 1), a2 + hstepA, voffA);
            PG8_WAIT_L(8); PG8_BAR; PG8_WAIT_L(0); PG8_MMA(0, 0, At, B0); PG8_BAR; PG8_SCHED;
            PG8_LDB(B1, 1, 1); PG8_STAGE(PG8_SB(1, 0), b3, voffB);
            PG8_BAR; PG8_WAIT_L(0); PG8_MMA(0, 1, At, B1); PG8_BAR;
            PG8_LDA(At, 1, 1); PG8_STAGE(PG8_SA(1, 0), a3, voffA);
            PG8_BAR; PG8_WAIT_L(0); PG8_MMA(1, 0, At, B0); PG8_BAR; PG8_SCHED;
            PG8_STAGE(PG8_SB(1, 1), b3 + hstepB, voffB);
            PG8_WAIT_V(6); PG8_BAR; PG8_MMA(1, 1, At, B1); PG8_BAR;
            }
        }
        if constexpr (ALIGN_EPI) { if (wr == 0) PG8_BAR; }
        if constexpr (!Epi::AFTER_DRAIN) { E(acc, cur, wr, wc, fr, fq); S.done(cur); }
        if (!has_next) break;
#pragma unroll
        for (int a = 0; a < 2; ++a)
#pragma unroll
            for (int b = 0; b < 2; ++b)
#pragma unroll
                for (int m = 0; m < 4; ++m)
#pragma unroll
                    for (int n = 0; n < 2; ++n) acc[a][b][m][n] = (f32x4){0.f, 0.f, 0.f, 0.f};
        cur = nxt; cA = nA; cB = nB; ++ui;
        if constexpr (ALIGN_EPI) { if (wr == 1) PG8_BAR; }
    }
    PG8_WAIT_V(0);
    if constexpr (!ALIGN_EPI) { if (wr == 0) PG8_BAR; }
    PG8_BAR;
    if constexpr (Epi::AFTER_DRAIN) { E.fused(acc, cur, wr, wc, fr, fq, lds, wid, lane); S.done(cur); }
#undef PG8_SA
#undef PG8_SB
#undef PG8_STAGE
#undef PG8_LDA
#undef PG8_LDB
#undef PG8_MMA
#undef PG8_WAIT_V
#undef PG8_WAIT_L
#undef PG8_BAR
#undef PG8_SCHED
}
}
namespace pg8 {
__device__ __forceinline__ u32x4 pack8(const f32x4 a, const f32x4 b) { u32x4 w; w.x = cvt_pk_bf16(a[0], a[1]); w.y = cvt_pk_bf16(a[2], a[3]); w.z = cvt_pk_bf16(b[0], b[1]); w.w = cvt_pk_bf16(b[2], b[3]); return w; }
__device__ __forceinline__ void unpack8(const u32x4 w, f32x4& a, f32x4& b) {
    a[0] = __uint_as_float(w.x << 16); a[1] = __uint_as_float(w.x & 0xffff0000u); a[2] = __uint_as_float(w.y << 16); a[3] = __uint_as_float(w.y & 0xffff0000u);
    b[0] = __uint_as_float(w.z << 16); b[1] = __uint_as_float(w.z & 0xffff0000u); b[2] = __uint_as_float(w.w << 16); b[3] = __uint_as_float(w.w & 0xffff0000u); }
__device__ __forceinline__ float fsig(float x) { return __builtin_amdgcn_rcpf(1.f + __builtin_amdgcn_exp2f(-1.4426950408889634f * x)); }
__device__ __forceinline__ f32x4 fsig4(const f32x4 v) { f32x4 r; r[0] = fsig(v[0]); r[1] = fsig(v[1]); r[2] = fsig(v[2]); r[3] = fsig(v[3]); return r; }
__device__ __forceinline__ f32x4 gelu4(const f32x4 v) { const f32x2 a = gelu_pk((f32x2){v[0], v[1]}), b = gelu_pk((f32x2){v[2], v[3]}); return (f32x4){a.x, a.y, b.x, b.y}; }

struct SsmOrder {
    int G, c;
    __device__ bool next(int i, Unit& u) const { const int L = i * G + c; if (L >= 128) return false; u.pm = L; u.pn = L >> 2; return true; }
    __device__ __forceinline__ void a_ready(const Unit&) const {}
    __device__ __forceinline__ void done(const Unit&) const {}
};
struct MoeOrder {
    StaticOrder so; int pe0, pe1, pe2, pe3, pe4, pe5, pe6; int nN; int maxr;
    __device__ bool next(int i, Unit& u) const {
        if (i >= maxr || !so.next(i, u)) return false;
        const int r0 = u.pm * 256; const int e = (pe0 <= r0) + (pe1 <= r0) + (pe2 <= r0) + (pe3 <= r0) + (pe4 <= r0) + (pe5 <= r0) + (pe6 <= r0);
        u.pn += e * nN; return true; }
    __device__ __forceinline__ void a_ready(const Unit&) const {}
    __device__ __forceinline__ void done(const Unit&) const {}
};

struct MoeSplitOrder {
    int c, tile0, nsub, eoff;
    int pe0, pe1, pe2, pe3, pe4, pe5, pe6; int nN;
    __device__ bool next(int i, Unit& u) const {
        const int q = i * 256 + c; if (q >= nsub) return false;
        const int j = q / 6, ks = q - j * 6;
        u.pm = tile0 + (j >> 2);
        const int r0 = u.pm * 256; const int e = (pe0 <= r0) + (pe1 <= r0) + (pe2 <= r0) + (pe3 <= r0) + (pe4 <= r0) + (pe5 <= r0) + (pe6 <= r0);
        u.pn = (j & 3) + e * nN; u.ko = (ks < 4 ? ks * 8 : 32 + (ks - 4) * 6) * 128; u.nk = ks < 4 ? 8 : 6; u.aux = q; return true; }
    __device__ __forceinline__ void a_ready(const Unit&) const {}
    __device__ __forceinline__ void done(const Unit&) const {}
};

#define EPI_ROWS(u) const int rowb = (u).pm * BM + wr * 64 + fr
template <bool RS> struct EpiInProjT {
    static constexpr bool PERM = true, AFTER_DRAIN = false, MIDHOOK = false;
    bf16_t *Q, *Kb, *V, *AY, *G; const float *COS, *SIN; const PG8_LAS float* RSTD;
    __device__ __forceinline__ void operator()(const f32x4 (&acc_)[2][2][4][2], const Unit& u, int wr, int wc, int fr, int fq) const {
        EPI_ROWS(u); const int pn = u.pn;
#pragma unroll
        for (int ai = 0; ai < 2; ++ai)
#pragma unroll
            for (int m = 0; m < 4; ++m) {
                f32x4 c_[2][2];
                { const float rs = RS ? RSTD[ai * HALF + wr * 64 + m * 16 + fr] : 1.f;
#pragma unroll
                  for (int bj = 0; bj < 2; ++bj) { c_[bj][0] = RS ? acc_[ai][bj][m][0] * rs : acc_[ai][bj][m][0]; c_[bj][1] = RS ? acc_[ai][bj][m][1] * rs : acc_[ai][bj][m][1]; } }
                const int row = rowb + ai * HALF + m * 16, b = row >> 13, s = row & 8191;
                if (pn < 4) {
                    bf16_t* dst = pn < 2 ? Q : Kb; const int c = wc >> 1, jb = 16 * (wc & 1) + 4 * fq;
                    const f32x4 cs = *(const f32x4*)(COS + s * 32 + jb), sn = *(const f32x4*)(SIN + s * 32 + jb);
#pragma unroll
                    for (int bj = 0; bj < 2; ++bj) { const int h = 2 * (pn & 1) + bj; const f32x4 x1 = c_[bj][0], x2 = c_[bj][1];
                        *(u32x4*)(dst + ((((size_t)b * 4 + h) * 2 + c) * 8192 + s) * 64 + 32 * (wc & 1) + 8 * fq) = pack8(x1 * cs - x2 * sn, x2 * cs + x1 * sn); }
                } else if (pn < 6) {
#pragma unroll
                    for (int bj = 0; bj < 2; ++bj) { const int h = 2 * (pn - 4) + bj;
                        *(u32x4*)(V + (((size_t)b * 4 + h) * 8192 + s) * 128 + 32 * wc + 8 * fq) = pack8(c_[bj][0], c_[bj][1]); }
                } else if (pn < 8) {
#pragma unroll
                    for (int bj = 0; bj < 2; ++bj) { const int ucol = 256 * (pn - 6) + 128 * bj + 32 * wc + 8 * fq, g = ucol >> 4, hh0 = ucol & 15;
                        *(u32x4*)(AY + ((size_t)g * 1024 + b * 512 + (s >> 4)) * 512 + (s & 15) * 16 + hh0) = pack8(c_[bj][0], c_[bj][1]); }
                } else {
#pragma unroll
                    for (int bj = 0; bj < 2; ++bj) { const int gcol = 256 * (pn - 8) + 128 * bj + 32 * wc + 8 * fq;
                        *(u32x4*)(G + (size_t)row * 2048 + gcol) = pack8(fsig4(c_[bj][0]), fsig4(c_[bj][1])); }
                }
            }
    }
};
typedef EpiInProjT<false> EpiInProj;
struct EpiXloc {
    static constexpr bool PERM = true, AFTER_DRAIN = false, MIDHOOK = false;
    float* XLOC;
    __device__ __forceinline__ void operator()(const f32x4 (&acc)[2][2][4][2], const Unit& u, int wr, int wc, int fr, int fq) const {
        EPI_ROWS(u);
#pragma unroll
        for (int ai = 0; ai < 2; ++ai)
#pragma unroll
            for (int m = 0; m < 4; ++m)
#pragma unroll
                for (int bj = 0; bj < 2; ++bj) { float* p = XLOC + (size_t)(rowb + ai * HALF + m * 16) * 256 + bj * HALF + 32 * wc + 8 * fq;
                    *(f32x4*)p = acc[ai][bj][m][0]; *(f32x4*)(p + 4) = acc[ai][bj][m][1]; }
    }
};
struct EpiY {
    static constexpr bool PERM = true, AFTER_DRAIN = false, MIDHOOK = false;
    bf16_t* SACT;
    __device__ __forceinline__ void operator()(const f32x4 (&acc)[2][2][4][2], const Unit& u, int wr, int wc, int fr, int fq) const {
        EPI_ROWS(u);
#pragma unroll
        for (int ai = 0; ai < 2; ++ai)
#pragma unroll
            for (int m = 0; m < 4; ++m) { const int R = rowb + ai * HALF + m * 16, g = R >> 10, bc = R & 1023;
#pragma unroll
                for (int bj = 0; bj < 2; ++bj) { const int col0 = bj * HALF + 32 * wc + 8 * fq, i = col0 >> 4, hh0 = col0 & 15;
                    *(u32x4*)(SACT + (size_t)(bc * 16 + i) * 512 + g * 16 + hh0) = pack8(gelu4(acc[ai][bj][m][0]), gelu4(acc[ai][bj][m][1])); } }
    }
};
struct EpiGlu {
    static constexpr bool PERM = true, AFTER_DRAIN = false, MIDHOOK = false;
    const bf16_t* SACT; bf16_t* AS2;
    __device__ __forceinline__ void operator()(const f32x4 (&acc)[2][2][4][2], const Unit& u, int wr, int wc, int fr, int fq) const {
        EPI_ROWS(u);
#pragma unroll
        for (int ai = 0; ai < 2; ++ai)
#pragma unroll
            for (int m = 0; m < 4; ++m) { const int row = rowb + ai * HALF + m * 16;
#pragma unroll
                for (int bj = 0; bj < 2; ++bj) { const int col0 = u.pn * BM + bj * HALF + 32 * wc + 8 * fq;
                    f32x4 s0, s1; unpack8(*(const u32x4*)(SACT + (size_t)row * 512 + col0), s0, s1);
                    *(u32x4*)(AS2 + (size_t)row * 1024 + 512 + col0) = pack8(s0 * fsig4(acc[ai][bj][m][0]), s1 * fsig4(acc[ai][bj][m][1])); } }
    }
};
struct EpiBranch {
    static constexpr bool PERM = true, AFTER_DRAIN = false, MIDHOOK = true;
    const bf16_t* G; bf16_t* MERGED;
    __device__ __forceinline__ void mid(f32x4 (&acc)[2][2][4][2], const Unit& u, int wr, int wc, int fr, int fq) const {
        asm volatile("" : "+v"(fr), "+v"(fq));
        EPI_ROWS(u);
#pragma unroll
        for (int ai = 0; ai < 2; ++ai)
#pragma unroll
            for (int m = 0; m < 4; ++m) { const int row = rowb + ai * HALF + m * 16;
#pragma unroll
                for (int bj = 0; bj < 2; ++bj) { const int col0 = u.pn * BM + bj * HALF + 32 * wc + 8 * fq;
                    f32x4 a0, a1, b0, b1; unpack8(*(const u32x4*)(G + (size_t)row * 2048 + col0), a0, a1); unpack8(*(const u32x4*)(G + (size_t)row * 2048 + 1024 + col0), b0, b1);
#pragma unroll
                    for (int e = 0; e < 4; ++e) { acc[ai][bj][m][0][e] *= a0[e] * __builtin_amdgcn_rcpf(b0[e]); acc[ai][bj][m][1][e] *= a1[e] * __builtin_amdgcn_rcpf(b1[e]); } }
                asm volatile("" ::: "memory"); }
    }
    __device__ __forceinline__ void operator()(const f32x4 (&acc)[2][2][4][2], const Unit& u, int wr, int wc, int fr, int fq) const {
        EPI_ROWS(u);
#pragma unroll
        for (int ai = 0; ai < 2; ++ai)
#pragma unroll
            for (int m = 0; m < 4; ++m) { const int row = rowb + ai * HALF + m * 16;
#pragma unroll
                for (int bj = 0; bj < 2; ++bj) { const int col0 = u.pn * BM + bj * HALF + 32 * wc + 8 * fq;
                    f32x4 b0, b1; unpack8(*(const u32x4*)(G + (size_t)row * 2048 + 1024 + col0), b0, b1);
                    *(u32x4*)(MERGED + (size_t)row * 1024 + col0) = pack8(acc[ai][bj][m][0] * b0, acc[ai][bj][m][1] * b1); } }
    }
};
struct EpiRes {
    static constexpr bool PERM = true, AFTER_DRAIN = false, MIDHOOK = false;
    const float* SRC; float* X;
    __device__ __forceinline__ void operator()(const f32x4 (&acc)[2][2][4][2], const Unit& u, int wr, int wc, int fr, int fq) const {
        EPI_ROWS(u);
#pragma unroll
        for (int ai = 0; ai < 2; ++ai)
#pragma unroll
            for (int m = 0; m < 4; ++m) { const int row = rowb + ai * HALF + m * 16;
#pragma unroll
                for (int bj = 0; bj < 2; ++bj) { const size_t o = (size_t)row * 1024 + u.pn * BM + bj * HALF + 32 * wc + 8 * fq;
                    const f32x4 s0 = *(const f32x4*)(SRC + o), s1 = *(const f32x4*)(SRC + o + 4);
                    *(f32x4*)(X + o) = s0 + acc[ai][bj][m][0]; *(f32x4*)(X + o + 4) = s1 + acc[ai][bj][m][1]; } }
    }
};
template <bool RS> struct EpiSwigluT {
    static constexpr bool PERM = true, AFTER_DRAIN = false, MIDHOOK = false;
    bf16_t* H; int nN; const PG8_LAS float* RSTD;
    __device__ __forceinline__ void operator()(const f32x4 (&acc)[2][2][4][2], const Unit& u, int wr, int wc, int fr, int fq) const {
        EPI_ROWS(u); const int col0 = 128 * (u.pn % nN) + 32 * wc + 8 * fq;
#pragma unroll
        for (int ai = 0; ai < 2; ++ai)
#pragma unroll
            for (int m = 0; m < 4; ++m) { const int row = rowb + ai * HALF + m * 16;
                const float rs = RS ? RSTD[ai * HALF + wr * 64 + m * 16 + fr] : 1.f;
                const f32x4 a0 = RS ? acc[ai][0][m][0] * rs : acc[ai][0][m][0], a1 = RS ? acc[ai][0][m][1] * rs : acc[ai][0][m][1];
                const f32x4 b0 = RS ? acc[ai][1][m][0] * rs : acc[ai][1][m][0], b1 = RS ? acc[ai][1][m][1] * rs : acc[ai][1][m][1];
                *(u32x4*)(H + (size_t)row * 2816 + col0) = pack8(a0 * fsig4(a0) * b0, a1 * fsig4(a1) * b1); }
    }
};
typedef EpiSwigluT<false> EpiSwiglu;
struct EpiResN {
    static constexpr bool PERM = true, AFTER_DRAIN = false, MIDHOOK = false;
    const float* SRC; float* X; bf16_t* XN; float* PS;
    __device__ __forceinline__ void operator()(const f32x4 (&acc)[2][2][4][2], const Unit& u, int wr, int wc, int fr, int fq) const {
        EPI_ROWS(u);
#pragma unroll
        for (int ai = 0; ai < 2; ++ai)
#pragma unroll
            for (int m = 0; m < 4; ++m) { const int row = rowb + ai * HALF + m * 16; float ss = 0.f;
#pragma unroll
                for (int bj = 0; bj < 2; ++bj) { const size_t o = (size_t)row * 1024 + u.pn * BM + bj * HALF + 32 * wc + 8 * fq;
                    const f32x4 s0 = *(const f32x4*)(SRC + o), s1 = *(const f32x4*)(SRC + o + 4);
                    const f32x4 y0 = s0 + acc[ai][bj][m][0], y1 = s1 + acc[ai][bj][m][1];
                    *(f32x4*)(X + o) = y0; *(f32x4*)(X + o + 4) = y1; *(u32x4*)(XN + o) = pack8(y0, y1);
                    ss += (y0[0] * y0[0] + y0[1] * y0[1]) + (y0[2] * y0[2] + y0[3] * y0[3]) + (y1[0] * y1[0] + y1[1] * y1[1]) + (y1[2] * y1[2] + y1[3] * y1[3]); }
                { auto r = __builtin_amdgcn_permlane16_swap(__float_as_uint(ss), __float_as_uint(ss), false, false); ss = __uint_as_float(r[0]) + __uint_as_float(r[1]); }
                { auto r = __builtin_amdgcn_permlane32_swap(__float_as_uint(ss), __float_as_uint(ss), false, false); ss = __uint_as_float(r[0]) + __uint_as_float(r[1]); }
                if (fq == 0) PS[(size_t)(u.pn * 4 + wc) * 16384 + row] = ss; }
    }
};
struct EpiMoeDown {
    static constexpr bool PERM = true, AFTER_DRAIN = false, MIDHOOK = false;
    bf16_t* YS;
    __device__ __forceinline__ void operator()(const f32x4 (&acc)[2][2][4][2], const Unit& u, int wr, int wc, int fr, int fq) const {
        EPI_ROWS(u);
#pragma unroll
        for (int ai = 0; ai < 2; ++ai)
#pragma unroll
            for (int m = 0; m < 4; ++m) { const int row = rowb + ai * HALF + m * 16;
#pragma unroll
                for (int bj = 0; bj < 2; ++bj)
                    *(u32x4*)(YS + (size_t)row * 1024 + (u.pn & 3) * BM + bj * HALF + 32 * wc + 8 * fq) = pack8(acc[ai][bj][m][0], acc[ai][bj][m][1]); }
    }
};
struct EpiMoeDownPart {
    static constexpr bool PERM = true, AFTER_DRAIN = false, MIDHOOK = false;
    float* P;
    __device__ __forceinline__ void operator()(const f32x4 (&acc)[2][2][4][2], const Unit& u, int wr, int wc, int fr, int fq) const {
        float* base = P + (size_t)u.aux * 65536 + (size_t)(wr * 64 + fr) * 256 + 32 * wc + 8 * fq;
#pragma unroll
        for (int ai = 0; ai < 2; ++ai)
#pragma unroll
            for (int m = 0; m < 4; ++m)
#pragma unroll
                for (int bj = 0; bj < 2; ++bj) { float* d = base + (ai * HALF + m * 16) * 256 + bj * HALF;
                    *(f32x4*)d = acc[ai][bj][m][0]; *(f32x4*)(d + 4) = acc[ai][bj][m][1]; }
    }
};
#undef EPI_ROWS
}
#define XB_TMO      128
#define XB_XCNT(j)  (256  + 64 * (j))
#define XB_XSUB(j)  (1280 + 64 * (j))
#define XB_XGEN(j)  (2304 + 64 * (j))
#define XB_TOP      3328
#define XB_TOPGEN   3392
#define XCD_BAR_WORDS 3456
#define XB_SPIN_CAP (1u << 18)

__device__ __forceinline__ unsigned xb_ld(unsigned* p)              { return __hip_atomic_load(p, __ATOMIC_RELAXED, __HIP_MEMORY_SCOPE_AGENT); }
__device__ __forceinline__ unsigned xb_add(unsigned* p, unsigned v) { return __hip_atomic_fetch_add(p, v, __ATOMIC_RELAXED, __HIP_MEMORY_SCOPE_AGENT); }
__device__ __forceinline__ unsigned xb_xcc_id() { return (unsigned)__builtin_amdgcn_s_getreg((3 << 11) | 20) & 0xFu; }
#define XB_SPIN(cond, bar) do { unsigned _sp = 0; while (cond) { __builtin_amdgcn_s_sleep(1); \
    if ((++_sp & 255u) == 0u) { if (xb_ld(&(bar)[XB_TMO])) break; if (_sp > XB_SPIN_CAP) { atomicAdd(&(bar)[XB_TMO], 1u); break; } } } } while (0)

struct XcdBarrier {
    unsigned* bar; unsigned x;
    volatile LAS unsigned* st;
};

__device__ __forceinline__ XcdBarrier xcd_barrier_post(unsigned* bar, volatile LAS unsigned* st) {
    XcdBarrier b; b.bar = bar; b.x = xb_xcc_id(); b.st = st;
    if (threadIdx.x == 0) (void)xb_add(&bar[XB_XCNT(b.x)], 1u);
    return b;
}
__device__ __forceinline__ void xcd_barrier_complete(unsigned* bar, unsigned x, unsigned& nloc, unsigned& nx) {
    const unsigned G = gridDim.x * gridDim.y * gridDim.z;
    unsigned sum, cnt, mine, sp = 0u;
    for (;;) {
        sum = 0u; cnt = 0u; mine = 0u;
#pragma unroll
        for (unsigned j = 0; j < 16; ++j) { const unsigned c = xb_ld(&bar[XB_XCNT(j)]); sum += c; cnt += (c > 0u) ? 1u : 0u; mine = (j == x) ? c : mine; }
        if (sum == G) break;
        __builtin_amdgcn_s_sleep(1);
        if ((++sp & 255u) == 0u) { if (xb_ld(&bar[XB_TMO])) break; if (sp > XB_SPIN_CAP) { atomicAdd(&bar[XB_TMO], 1u); break; } }
    }
    nloc = mine > 0u ? mine : 1u; nx = cnt > 0u ? cnt : 1u;
}

__device__ __forceinline__ void xcd_barrier(const XcdBarrier& b) {
    asm volatile("s_waitcnt vmcnt(0)" ::: "memory");
    __syncthreads();
    if (threadIdx.x == 0) {
        unsigned* bar = b.bar;
        __builtin_amdgcn_s_waitcnt(0);
        unsigned nloc = b.st[0], nx = b.st[1];
        if (nloc == 0u) { xcd_barrier_complete(bar, b.x, nloc, nx); b.st[0] = nloc; b.st[1] = nx; }
        const unsigned old = xb_add(&bar[XB_XSUB(b.x)], 1u);
        const unsigned gen = old / nloc;
        if (old + 1u == (gen + 1u) * nloc) {
            __builtin_amdgcn_fence(__ATOMIC_RELEASE, "agent");
            asm volatile("s_waitcnt vmcnt(0)" ::: "memory");
            const unsigned og = xb_add(&bar[XB_TOP], 1u);
            const unsigned tg = og / nx;
            if (og + 1u == (tg + 1u) * nx) xb_add(&bar[XB_TOPGEN], 1u);
            else XB_SPIN(xb_ld(&bar[XB_TOPGEN]) == tg, bar);
            __builtin_amdgcn_fence(__ATOMIC_ACQUIRE, "agent");
            xb_add(&bar[XB_XGEN(b.x)], 1u);
            asm volatile("s_waitcnt vmcnt(0)" ::: "memory");
        } else {
            XB_SPIN(xb_ld(&bar[XB_XGEN(b.x)]) == gen, bar);
            __builtin_amdgcn_fence(__ATOMIC_ACQUIRE, "agent");
            asm volatile("s_waitcnt vmcnt(0)" ::: "memory");
        }
    }
    __syncthreads();
}

namespace att {
using bf16x8 = __attribute__((ext_vector_type(8))) short;
using s16x4  = __attribute__((ext_vector_type(4))) short;
using f32x16 = __attribute__((ext_vector_type(16))) float;
using u32x4  = __attribute__((ext_vector_type(4))) unsigned;
constexpr int NW = 8, QBLK = 32, KVBLK = 64;
constexpr float SCALE = 0.125f;
constexpr int SHM_V = KVBLK * 128 * 2, SHM_K = KVBLK * 64 * 2, SHM_ATTN = 4 * SHM_V + 4 * SHM_K + NW * 64 * 4;
#define KSWZ64(row, colB) ((row) * 128 + ((colB) ^ ((((row) >> 1) & 7) << 4)))
#define SBAR() __builtin_amdgcn_sched_barrier(0)
__device__ __forceinline__ int crow(int r, int hi) { return (r & 3) + 8 * (r >> 2) + 4 * hi; }
typedef __bf16 bf16x2_cv __attribute__((ext_vector_type(2))); typedef float f32x2_cv __attribute__((ext_vector_type(2)));
__device__ __forceinline__ unsigned cvtpk(float lo, float hi) { const bf16x2_cv r = __builtin_convertvector((f32x2_cv){lo, hi}, bf16x2_cv); return __builtin_bit_cast(unsigned, r); }
__device__ __forceinline__ void partialSM(f32x16& p0, f32x16& p1, float mb) {
  constexpr float C = SCALE * 1.4426950408889634f;
#pragma unroll
  for (int r = 0; r < 16; ++r) p0[r] = fmaf(p0[r], C, -mb);
#pragma unroll
  for (int r = 0; r < 16; ++r) p1[r] = fmaf(p1[r], C, -mb);
#pragma unroll
  for (int r = 0; r < 16; ++r) p0[r] = __builtin_amdgcn_exp2f(p0[r]);
}
__device__ __forceinline__ void finishSM(f32x16& p0, f32x16& p1, float& l_reg, bf16x8& pa0, bf16x8& pa1, bf16x8& pa2, bf16x8& pa3) {
#pragma unroll
  for (int r = 0; r < 16; ++r) p1[r] = __builtin_amdgcn_exp2f(p1[r]);
  float ps0 = 0.f;
#pragma unroll
  for (int r = 0; r < 16; ++r) ps0 += p0[r];
#pragma unroll
  for (int r = 0; r < 16; ++r) ps0 += p1[r];
  l_reg += ps0;
#define PK4(P, BASE, OUT) do { unsigned a0 = cvtpk(P[BASE + 0], P[BASE + 1]), a1 = cvtpk(P[BASE + 2], P[BASE + 3]);   \
    unsigned b0 = cvtpk(P[BASE + 4], P[BASE + 5]), b1 = cvtpk(P[BASE + 6], P[BASE + 7]);                              \
    u32x4 w = {a0, a1, b0, b1}; OUT = *reinterpret_cast<bf16x8*>(&w); } while (0)
  PK4(p0, 0, pa0); PK4(p0, 8, pa1); PK4(p1, 0, pa2); PK4(p1, 8, pa3);
#undef PK4
}
template <int OFF> __device__ __forceinline__ bf16x8 k_read(int ka) { bf16x8 r; asm volatile("ds_read_b128 %0, %1 offset:%2" : "=&v"(r) : "v"(ka), "i"(OFF) : "memory"); return r; }
__device__ __forceinline__ void qkt(f32x16& p0, f32x16& p1, const char* Ks, const bf16x8* qr, int r32, int hi) {
  p0 = f32x16{}; p1 = f32x16{};
  const int sw = (r32 >> 1) & 7, base = (int)(uintptr_t)Ks + r32 * 128;
  const int a0 = base + (((0 + hi) ^ sw) << 4), a1 = base + (((2 + hi) ^ sw) << 4), a2 = base + (((4 + hi) ^ sw) << 4), a3 = base + (((6 + hi) ^ sw) << 4);
  const bf16x8 k00 = k_read<0>(a0), k01 = k_read<4096>(a0), k10 = k_read<0>(a1), k11 = k_read<4096>(a1), k20 = k_read<0>(a2), k21 = k_read<4096>(a2), k30 = k_read<0>(a3), k31 = k_read<4096>(a3);
  asm volatile("s_waitcnt lgkmcnt(0)" ::: "memory"); SBAR();
  p0 = __builtin_amdgcn_mfma_f32_32x32x16_bf16(k00, qr[0], p0, 0, 0, 0); p1 = __builtin_amdgcn_mfma_f32_32x32x16_bf16(k01, qr[0], p1, 0, 0, 0);
  p0 = __builtin_amdgcn_mfma_f32_32x32x16_bf16(k10, qr[1], p0, 0, 0, 0); p1 = __builtin_amdgcn_mfma_f32_32x32x16_bf16(k11, qr[1], p1, 0, 0, 0);
  p0 = __builtin_amdgcn_mfma_f32_32x32x16_bf16(k20, qr[2], p0, 0, 0, 0); p1 = __builtin_amdgcn_mfma_f32_32x32x16_bf16(k21, qr[2], p1, 0, 0, 0);
  p0 = __builtin_amdgcn_mfma_f32_32x32x16_bf16(k30, qr[3], p0, 0, 0, 0); p1 = __builtin_amdgcn_mfma_f32_32x32x16_bf16(k31, qr[3], p1, 0, 0, 0);
}
__device__ __forceinline__ int v_st(int k, int c) { const int kk = k; return ((kk >> 3) * 4 + (c >> 5)) * 512 + ((kk & 7) * 32 + (c & 31)) * 2; }
__device__ __forceinline__ int v_rd_base(int lane) { return ((lane & 3) << 3) | (((lane >> 2) & 3) << 6) | (((lane >> 4) & 1) << 5) | (((lane >> 5) & 1) << 8); }
constexpr int v_rd_off(int d0, int ks, int half) { return d0 * 512 + ks * 4096 + half * 2048; }
template <int OFF> __device__ __forceinline__ s16x4 tr_read(int vb) {
  s16x4 r; asm volatile("ds_read_b64_tr_b16 %0, %1 offset:%2" : "=&v"(r) : "v"(vb), "i"(OFF) : "memory"); return r;
}
template <int D0> __device__ __forceinline__ void pv_one(f32x16& od, int vb, bf16x8 pa0, bf16x8 pa1, bf16x8 pa2, bf16x8 pa3) {
  const s16x4 l0 = tr_read<v_rd_off(D0, 0, 0)>(vb), h0 = tr_read<v_rd_off(D0, 0, 1)>(vb), l1 = tr_read<v_rd_off(D0, 1, 0)>(vb), h1 = tr_read<v_rd_off(D0, 1, 1)>(vb);
  const s16x4 l2 = tr_read<v_rd_off(D0, 2, 0)>(vb), h2 = tr_read<v_rd_off(D0, 2, 1)>(vb), l3 = tr_read<v_rd_off(D0, 3, 0)>(vb), h3 = tr_read<v_rd_off(D0, 3, 1)>(vb);
  asm volatile("s_waitcnt lgkmcnt(0)" ::: "memory"); SBAR();
#define PK(L, H) (bf16x8){L[0], L[1], L[2], L[3], H[0], H[1], H[2], H[3]}
  od = __builtin_amdgcn_mfma_f32_32x32x16_bf16(pa0, PK(l0, h0), od, 0, 0, 0);
  od = __builtin_amdgcn_mfma_f32_32x32x16_bf16(pa1, PK(l1, h1), od, 0, 0, 0);
  od = __builtin_amdgcn_mfma_f32_32x32x16_bf16(pa2, PK(l2, h2), od, 0, 0, 0);
  od = __builtin_amdgcn_mfma_f32_32x32x16_bf16(pa3, PK(l3, h3), od, 0, 0, 0);
#undef PK
}
__device__ __forceinline__ void pv_d0(f32x16* o, int vb, bf16x8 pa0, bf16x8 pa1, bf16x8 pa2, bf16x8 pa3) {
  pv_one<0>(o[0], vb, pa0, pa1, pa2, pa3); pv_one<1>(o[1], vb, pa0, pa1, pa2, pa3); pv_one<2>(o[2], vb, pa0, pa1, pa2, pa3); pv_one<3>(o[3], vb, pa0, pa1, pa2, pa3);
}

__device__ __forceinline__ void diff_attn_unit(const unsigned short* __restrict__ Qh, const unsigned short* __restrict__ Kh, const unsigned short* __restrict__ Vh, int i0,
                                               const unsigned* __restrict__ kmax2, float* __restrict__ O1s, unsigned short* __restrict__ OUT, const float* __restrict__ subln, float lam, float oml, char* lds) {
  constexpr int SEQL = 8192, NT = SEQL / KVBLK;
  char* V_lds = lds; char* K_lds = lds + 4 * SHM_V;
  for (int c = 0; c < 2; ++c) {
    int tid_l = threadIdx.x; asm volatile("" : "+v"(tid_l));
    const int tid = tid_l, wid = __builtin_amdgcn_readfirstlane(tid >> 6), lane = tid & 63, r32 = lane & 31, hi = lane >> 5;
    const int sr = tid >> 4, sc = (tid & 15) * 8, vst0 = v_st(sr, sc), vst1 = v_st(32 + sr, sc);
    const int kr = tid >> 3, kcb = (tid & 7) * 16, kst = KSWZ64(kr, kcb);
    const int vb0 = (int)(uintptr_t)V_lds + v_rd_base(lane);
    const unsigned short* Kc = Kh + (size_t)c * SEQL * 64;
    float l_reg = 0; f32x16 o[4] = {}; bf16x8 qr[4];
    const unsigned short* Qw = Qh + (size_t)c * SEQL * 64 + (size_t)(i0 + wid * QBLK + r32) * 64 + hi * 8;
#pragma unroll
    for (int d0 = 0; d0 < 4; ++d0) qr[d0] = *reinterpret_cast<const bf16x8*>(Qw + d0 * 16);
    float mb;
    { float q2 = 0.f;
#pragma unroll
      for (int d0 = 0; d0 < 4; ++d0)
#pragma unroll
        for (int e = 0; e < 8; ++e) { const float qv = __uint_as_float(((unsigned)(unsigned short)qr[d0][e]) << 16); q2 = fmaf(qv, qv, q2); }
      { auto rr = __builtin_amdgcn_permlane32_swap(__float_as_uint(q2), __float_as_uint(q2), false, false); q2 = __uint_as_float(rr[0]) + __uint_as_float(rr[1]); }
      mb = sqrtf(q2 * __uint_as_float(kmax2[c])) * (SCALE * 1.4426950408889634f); }
    struct { bf16x8 vs0, vs1, ks0; } sr_[3];
#define SLOAD(i, k0) do { sr_[i].vs0 = *reinterpret_cast<const bf16x8*>(&Vh[(size_t)((k0) + sr) * 128 + sc]); sr_[i].vs1 = *reinterpret_cast<const bf16x8*>(&Vh[(size_t)((k0) + 32 + sr) * 128 + sc]); \
    sr_[i].ks0 = *reinterpret_cast<const bf16x8*>(&Kc[(size_t)((k0) + kr) * 64 + (tid & 7) * 8]); } while (0)
#define SWRITE(b, i) do { *(bf16x8*)(V_lds + (b) * SHM_V + vst0) = sr_[i].vs0; *(bf16x8*)(V_lds + (b) * SHM_V + vst1) = sr_[i].vs1; \
    *(bf16x8*)(K_lds + (b) * SHM_K + kst) = sr_[i].ks0; } while (0)
#define LBAR() do { asm volatile("s_waitcnt lgkmcnt(0)" ::: "memory"); __builtin_amdgcn_s_barrier(); asm volatile("" ::: "memory"); } while (0)
    f32x16 pA0, pA1, pB0, pB1; bf16x8 pa0, pa1, pa2, pa3;
    __syncthreads();
    SLOAD(0, 0); SLOAD(1, KVBLK); SLOAD(2, 2 * KVBLK); SWRITE(0, 0); SWRITE(1, 1); SWRITE(2, 2); __syncthreads();
    qkt(pA0, pA1, K_lds, qr, r32, hi); partialSM(pA0, pA1, mb);
    if (wid >= 4) { __builtin_amdgcn_s_setprio(1); LBAR(); }
    for (int j = 1; j + 1 < NT; j += 2) {
      SLOAD(0, (j + 2) * KVBLK);
      SBAR(); qkt(pB0, pB1, K_lds + (j & 3) * SHM_K, qr, r32, hi);
      finishSM(pA0, pA1, l_reg, pa0, pa1, pa2, pa3); SBAR();
      LBAR();
      pv_d0(o, vb0 + ((j - 1) & 3) * SHM_V, pa0, pa1, pa2, pa3); SBAR(); partialSM(pB0, pB1, mb); SBAR();
      SWRITE((j + 2) & 3, 0);
      LBAR();
      if (j + 3 < NT) SLOAD(0, (j + 3) * KVBLK);
      SBAR(); qkt(pA0, pA1, K_lds + ((j + 1) & 3) * SHM_K, qr, r32, hi);
      finishSM(pB0, pB1, l_reg, pa0, pa1, pa2, pa3); SBAR();
      LBAR();
      pv_d0(o, vb0 + (j & 3) * SHM_V, pa0, pa1, pa2, pa3); SBAR(); partialSM(pA0, pA1, mb); SBAR();
      if (j + 3 < NT) SWRITE((j + 3) & 3, 0);
      LBAR();
    }
    SBAR(); qkt(pB0, pB1, K_lds + ((NT - 1) & 3) * SHM_K, qr, r32, hi);
    finishSM(pA0, pA1, l_reg, pa0, pa1, pa2, pa3); SBAR();
    pv_d0(o, vb0 + ((NT - 2) & 3) * SHM_V, pa0, pa1, pa2, pa3); partialSM(pB0, pB1, mb);
    finishSM(pB0, pB1, l_reg, pa0, pa1, pa2, pa3); SBAR();
    pv_d0(o, vb0 + ((NT - 1) & 3) * SHM_V, pa0, pa1, pa2, pa3);
    if (wid < 4) LBAR();
    __builtin_amdgcn_s_setprio(0);
    { auto rr = __builtin_amdgcn_permlane32_swap(__float_as_uint(l_reg), __float_as_uint(l_reg), false, false); l_reg = __uint_as_float(rr[0]) + __uint_as_float(rr[1]); }
    { int t2 = threadIdx.x; asm volatile("" : "+v"(t2));
      const int wid2 = __builtin_amdgcn_readfirstlane(t2 >> 6), lane2 = t2 & 63, r322 = lane2 & 31, hi2 = lane2 >> 5;
      float* li_l = (float*)(lds + 4 * SHM_V + 4 * SHM_K) + wid2 * 64;
      if (hi2 == 0) li_l[r322] = l_reg; asm volatile("s_waitcnt lgkmcnt(0)" ::: "memory");
      float* O1w = O1s + (size_t)c * 32768 + (size_t)wid2 * 4096 + lane2;
#pragma unroll
      for (int r = 0; r < 16; ++r) { const float rl = __builtin_amdgcn_rcpf(li_l[crow(r, hi2)]);
#pragma unroll
        for (int d0 = 0; d0 < 4; ++d0) O1w[(d0 * 16 + r) * 64] = o[d0][r] * rl; } }
#undef SLOAD
#undef SWRITE
#undef LBAR
  }
  {
    int t3 = threadIdx.x; asm volatile("" : "+v"(t3));
    const int wid = __builtin_amdgcn_readfirstlane(t3 >> 6), lane = t3 & 63, r32 = lane & 31, hi = lane >> 5;
    const float* Ow = O1s + (size_t)wid * 4096 + lane;
    float sg[4];
#pragma unroll
    for (int d0 = 0; d0 < 4; ++d0) sg[d0] = subln[d0 * 32 + r32] * oml;
#pragma unroll 4
    for (int r = 0; r < 16; ++r) {
      float v[4], ss = 0.f;
#pragma unroll
      for (int d0 = 0; d0 < 4; ++d0) { v[d0] = Ow[(d0 * 16 + r) * 64] - lam * Ow[32768 + (d0 * 16 + r) * 64]; ss += v[d0] * v[d0]; }
#pragma unroll
      for (int of = 1; of < 32; of <<= 1) ss += __int_as_float(__builtin_amdgcn_ds_bpermute((lane ^ of) << 2, __float_as_int(ss)));
      const float rstd = rsqrtf(ss * (1.f / 128.f) + 1e-6f);
      unsigned short* op = OUT + (size_t)(wid * QBLK + crow(r, hi)) * 1024 + r32;
#pragma unroll
      for (int d0 = 0; d0 < 4; ++d0) { const float y = v[d0] * rstd * sg[d0]; unsigned u = __float_as_uint(y); op[d0 * 32] = (unsigned short)((u + 0x7fffu + ((u >> 16) & 1u)) >> 16); }
    }
  }
}
}
constexpr int NWAVES = 8;
constexpr int RING_OFF = 0, RING_BYTES = 131072;
constexpr int LDSCTL_OFF = RING_BYTES, MISC_OFF = LDSCTL_OFF + 320;
constexpr int LDS_BYTES = 147456;
constexpr int RSTD_OFF = LDSCTL_OFF + 8192;
constexpr int CW_BAR = 4096;
constexpr int CW_KMAX = 8448;
constexpr int CW_CNT = 8192;
constexpr int CW_BLKCNT = 10240;
constexpr int CW_SPLT = 9216;
constexpr size_t CTL_ZERO_BYTES = 64 * 1024;
constexpr int PH_PRO = 0, PH_L0 = 1, PH_PER_LAYER = 12, PH_FINAL = PH_L0 + DEPTH * PH_PER_LAYER, PH_END = PH_FINAL + 1;
enum { P_NORM1 = 0, P_INPROJ, P_XLOC, P_SCAN, P_MIX, P_GLU, P_BRANCH, P_OUT, P_NORM2, P_ASSIGN, P_UP, P_DOWN };

struct Args {
    const float* in[25]; float* out; unsigned char* ws;
    double inv_freq[32];
    int ph_lo, ph_hi, sub, pad;
};

typedef const __attribute__((address_space(4))) Args* ArgsP;
__device__ __forceinline__ ArgsP get_args() { ArgsP p = (ArgsP)__builtin_amdgcn_kernarg_segment_ptr(); asm volatile("" : "+s"(p)); return p; }
#define LDS_WAIT() asm volatile("s_waitcnt lgkmcnt(0)" ::: "memory")
#define VM_WAIT() asm volatile("s_waitcnt vmcnt(0)" ::: "memory")
typedef unsigned v4u __attribute__((ext_vector_type(4)));
__device__ __forceinline__ unsigned pk2(float lo, float hi) { return (unsigned)f2bf(lo) | ((unsigned)f2bf(hi) << 16); }

template <class RowMap>
__device__ __forceinline__ void transpose_item(const float* __restrict__ W, int N, bf16* __restrict__ WT, int ldt, int koff, LAS float* scr, int item, int lane, const RowMap& rm, const float* __restrict__ gk = nullptr) {
    const int nblk = N / 32, kb = item / nblk, nb = item % nblk, k0 = 64 * kb, n0 = 32 * nb;
    float wv[32];
    const float* wp = W + (size_t)(k0 + (lane >> 5)) * N + n0 + (lane & 31);
#pragma unroll
    for (int i = 0; i < 32; ++i) wv[i] = wp[(size_t)(2 * i) * N];
#pragma unroll
    for (int i = 0; i < 32; ++i) scr[(2 * i + (lane >> 5)) * 33 + (lane & 31)] = wv[i];
    LDS_WAIT(); asm volatile("" ::: "memory");
    const int c = lane & 7;
    f32x4 g0 = {1.f, 1.f, 1.f, 1.f}, g1 = g0;
    if (gk) { g0 = *(const f32x4*)(gk + k0 + 8 * c); g1 = *(const f32x4*)(gk + k0 + 8 * c + 4); }
#pragma unroll
    for (int j = 0; j < 4; ++j) { const int n = (lane >> 3) + 8 * j; const LAS float* s = scr + (8 * c) * 33 + n;
        v4u o; o.x = pk2(s[0 * 33] * g0.x, s[1 * 33] * g0.y); o.y = pk2(s[2 * 33] * g0.z, s[3 * 33] * g0.w); o.z = pk2(s[4 * 33] * g1.x, s[5 * 33] * g1.y); o.w = pk2(s[6 * 33] * g1.z, s[7 * 33] * g1.w);
        *(v4u*)(WT + (size_t)rm(n0 + n) * ldt + koff + k0 + 8 * c) = o; }
    LDS_WAIT(); asm volatile("" ::: "memory");
}
struct RmId { __device__ __forceinline__ int operator()(int n) const { return n; } };
struct RmInProj { __device__ __forceinline__ int operator()(int n) const { return n < 1024 ? (n & ~63) + qk_pos(n & 63) : n; } };
struct RmGlu13 { int half; __device__ __forceinline__ int operator()(int n) const { return (n >> 7) * 256 + half * 128 + (n & 127); } };
struct TItem { const float* src; bf16* dst; int N, ldt, koff, map, k0, n0; };
__device__ __forceinline__ void t_setkn(TItem& t, int item) { const int nblk = t.N / 32; t.k0 = 64 * (item / nblk); t.n0 = 32 * (item % nblk); }
__device__ __forceinline__ void t_load(const TItem& t, int lane, float (&wv)[32]) {
    const float* wp = t.src + (size_t)(t.k0 + (lane >> 5)) * t.N + t.n0 + (lane & 31);
#pragma unroll
    for (int i = 0; i < 32; ++i) wv[i] = wp[(size_t)(2 * i) * t.N];
}
__device__ __forceinline__ void t_store(const TItem& t, int lane, const float (&wv)[32], LAS float* scr) {
#pragma unroll
    for (int i = 0; i < 32; ++i) scr[(2 * i + (lane >> 5)) * 33 + (lane & 31)] = wv[i];
    LDS_WAIT(); asm volatile("" ::: "memory");
    const int c = lane & 7;
#pragma unroll
    for (int j = 0; j < 4; ++j) { const int n = (lane >> 3) + 8 * j; const LAS float* q = scr + (8 * c) * 33 + n; const int nn = t.n0 + n;
        const int row = t.map == 0 ? nn : (t.map == 1 ? (nn < 1024 ? (nn & ~63) + qk_pos(nn & 63) : nn) : (nn >> 7) * 256 + (t.map - 2) * 128 + (nn & 127));
        v4u o; o.x = pk2(q[0 * 33], q[1 * 33]); o.y = pk2(q[2 * 33], q[3 * 33]); o.z = pk2(q[4 * 33], q[5 * 33]); o.w = pk2(q[6 * 33], q[7 * 33]);
        *(v4u*)(t.dst + (size_t)row * t.ldt + t.koff + t.k0 + 8 * c) = o; }
    LDS_WAIT(); asm volatile("" ::: "memory");
}
#define T_SWEEP(first, step, total, DEC) do { int it_ = (first); if (it_ < (total)) { TItem ta_, tb_; float va_[32], vb_[32]; DEC(it_, ta_); t_load(ta_, lane, va_); \
    for (;;) { const int i2_ = it_ + (step); const bool h2_ = i2_ < (total); if (h2_) { DEC(i2_, tb_); t_load(tb_, lane, vb_); } t_store(ta_, lane, va_, scr); if (!h2_) break; \
               it_ = i2_ + (step); const bool h3_ = it_ < (total); if (h3_) { DEC(it_, ta_); t_load(ta_, lane, va_); } t_store(tb_, lane, vb_, scr); if (!h3_) break; } } } while (0)

constexpr size_t WO_IN = 0, WO_GLU = WO_IN + 32 * MiB, WO_BR = WO_GLU + 2 * MiB, WO_OUT = WO_BR + 8 * MiB, WO_F13 = WO_OUT + 8 * MiB, WO_F2 = WO_F13 + 22 * MiB,
                 WO_M13 = WO_F2 + 11 * MiB, WO_M2 = WO_M13 + 88 * MiB, WO_BY = WO_M2 + 44 * MiB, WO_BX = WO_BY + 32 * MiB, WO_ROT = WO_BX + 16 * MiB, WO_END = WO_ROT + 2 * MiB;
static_assert(WS_WEIGHTS + WO_END <= WS_XN, "weights region");

__device__ __forceinline__ int ltid() { int t = threadIdx.x; asm volatile("" : "+v"(t)); return t; }
#define PHASE_IDS const int tid = ltid(), lane = tid & 63, wave = __builtin_amdgcn_readfirstlane(tid >> 6); (void)lane; (void)wave
struct Frame {
    LAS unsigned char* lds; int vcu, G, bx;
};
__device__ __forceinline__ Frame make_frame(LAS unsigned char* lds) {
    Frame F; F.lds = lds; int G = gridDim.x, bx = blockIdx.x; asm volatile("" : "+s"(G), "+s"(bx));
    F.G = G; F.bx = bx; F.vcu = (G % 8 == 0) ? (bx % 8) * (G / 8) + bx / 8 : bx; return F;
}
__device__ __forceinline__ float shx(float v, int o, int lane) { return __int_as_float(__builtin_amdgcn_ds_bpermute((lane ^ o) << 2, __float_as_int(v))); }
#define WS_DPP(v, ctrl) ((v) + __int_as_float(__builtin_amdgcn_mov_dpp(__float_as_int(v), (ctrl), 0xf, 0xf, true)))
__device__ __forceinline__ float wave_sum_l(float v, int lane) {
    (void)lane;
    v = WS_DPP(v, 0xB1);
    v = WS_DPP(v, 0x4E);
    v = WS_DPP(v, 0x141);
    v = WS_DPP(v, 0x140);
    { auto r = __builtin_amdgcn_permlane16_swap(__float_as_uint(v), __float_as_uint(v), false, false); v = __uint_as_float(r[0]) + __uint_as_float(r[1]); }
    { auto r = __builtin_amdgcn_permlane32_swap(__float_as_uint(v), __float_as_uint(v), false, false); v = __uint_as_float(r[0]) + __uint_as_float(r[1]); }
    return v;
}

__device__ __forceinline__ void ssm_gen_item(const Frame& F, ArgsP A, int item) {
    unsigned char* ws = A->ws;
    PHASE_IDS; const int layer = item >> 5, g = item & 31;
    LAS float* L = (LAS float*)(F.lds);
    LAS float* apr = L;
    LAS float* api = apr + 2 * 17 * 64;
    LAS float* bbr = api + 2 * 17 * 64;
    LAS float* bbi = bbr + 2 * 64 * 16;
    LAS float* cr = bbi + 2 * 64 * 16;
    LAS float* ci = cr + 2 * 16 * 64;
    LAS float* Kt = ci + 2 * 16 * 64;
    LAS float* ff = Kt + 2 * 16 * 256;
    LAS float* apj = ff + 2 * 64 * 2;
    const float* lam_re = A->in[5] + (size_t)layer * 2 * SSM_G * SSM_P; const float* lam_im = A->in[6] + (size_t)layer * 2 * SSM_G * SSM_P; const float* log_dt = A->in[7] + layer * 2 * SSM_G;
    const float* b_re = A->in[8] + (size_t)layer * 2 * SSM_G * SSM_P * 16; const float* b_im = A->in[9] + (size_t)layer * 2 * SSM_G * SSM_P * 16;
    const float* c_re = A->in[10] + (size_t)layer * 2 * SSM_G * 16 * SSM_P; const float* c_im = A->in[11] + (size_t)layer * 2 * SSM_G * 16 * SSM_P;
    const float* dsk = A->in[12] + layer * SSM_W + g * 16;
    {
        const int d = (tid >> 6) & 1, p = tid & 63, jq = tid >> 7; const size_t pi = ((size_t)d * SSM_G + g) * SSM_P + p;
        const float lr = lam_re[pi], li = lam_im[pi], dt = expf(log_dt[d * SSM_G + g]);
        for (int j = jq; j <= 16; j += 4) { const float er = expf((float)j * lr * dt); float sn, cs; sincosf((float)j * li * dt, &sn, &cs); const float ar_ = er * cs, ai_ = er * sn;
            apr[(d * 17 + j) * 64 + p] = ar_; api[(d * 17 + j) * 64 + p] = ai_;
            if (j < 16) { apj[((d * 64 + p) * 16 + j) * 2] = ar_; apj[((d * 64 + p) * 16 + j) * 2 + 1] = ai_; }
            if (j == 1) { const float nr = ar_ - 1.f, ni = ai_, den = lr * lr + li * li;
                ff[(d * 64 + p) * 2] = (nr * lr + ni * li) / den; ff[(d * 64 + p) * 2 + 1] = (ni * lr - nr * li) / den; } }
    }
    __syncthreads();
    for (int e = tid; e < 2048; e += 512) {
        const int d = e >> 10, p = (e >> 4) & 63, hh = e & 15; const size_t bi_ = (((size_t)d * SSM_G + g) * SSM_P + p) * 16 + hh;
        const float br = b_re[bi_], bi = b_im[bi_], fr = ff[(d * 64 + p) * 2], fi = ff[(d * 64 + p) * 2 + 1];
        bbr[e] = fr * br - fi * bi; bbi[e] = fr * bi + fi * br;
        const int h2 = (e >> 6) & 15, p2 = e & 63; const size_t ci_ = (((size_t)d * SSM_G + g) * 16 + h2) * SSM_P + p2;
        cr[e] = c_re[ci_]; ci[e] = c_im[ci_];
    }
    __syncthreads();
    {
        const int d = tid >> 8, h = (tid >> 4) & 15, h2 = tid & 15;
        float sj[16];
#pragma unroll
        for (int j = 0; j < 16; ++j) sj[j] = 0.f;
        for (int p = 0; p < 64; ++p) {
            const float c_r = cr[(d * 16 + h) * 64 + p], c_i = ci[(d * 16 + h) * 64 + p], b_r = bbr[(d * 64 + p) * 16 + h2], b_i = bbi[(d * 64 + p) * 16 + h2];
            const float t_r = c_r * b_r - c_i * b_i, t_i = c_r * b_i + c_i * b_r;
            const LAS f32x4* ap = (const LAS f32x4*)(apj + (d * 64 + p) * 32);
#pragma unroll
            for (int q = 0; q < 8; ++q) { const f32x4 a = ap[q]; sj[2 * q] += t_r * a.x - t_i * a.y; sj[2 * q + 1] += t_r * a.z - t_i * a.w; }
        }
#pragma unroll
        for (int j = 0; j < 16; ++j) Kt[(d * 16 + j) * 256 + h * 16 + h2] = sj[j];
    }
    __syncthreads();
    bf16* BY = (bf16*)(ws + WS_WEIGHTS + WO_BY) + ((size_t)layer * 32 + g) * 256 * 512;
    bf16* BX = (bf16*)(ws + WS_WEIGHTS + WO_BX) + ((size_t)layer * 32 + g) * 256 * 256;
    for (int e8 = tid; e8 < 256 * 64; e8 += 512) {
        const int n = e8 >> 6, k0 = (e8 & 63) * 8, i = n >> 4, h = n & 15; float v[8];
        if (k0 < 256) { const int i2 = k0 >> 4, h20 = k0 & 15;
#pragma unroll
            for (int q = 0; q < 8; ++q) { const int h2 = h20 + q; float t = 0.f;
                if (i >= i2) t += Kt[(0 * 16 + (i - i2)) * 256 + h * 16 + h2];
                if (i2 >= i) t += Kt[(1 * 16 + (i2 - i)) * 256 + h * 16 + h2];
                if (i == i2 && h == h2) t += dsk[h];
                v[q] = t; }
        } else { const int kk = k0 - 256, d = kk >> 7, im = (kk >> 6) & 1, p0 = kk & 63, j = d == 0 ? i + 1 : 16 - i;
#pragma unroll
            for (int q = 0; q < 8; ++q) { const int p = p0 + q; const float c_r = cr[(d * 16 + h) * 64 + p], c_i = ci[(d * 16 + h) * 64 + p], a_r = apr[(d * 17 + j) * 64 + p], a_i = api[(d * 17 + j) * 64 + p];
                v[q] = im ? -(c_r * a_i + c_i * a_r) : (c_r * a_r - c_i * a_i); } }
        v4u o; o.x = pk2(v[0], v[1]); o.y = pk2(v[2], v[3]); o.z = pk2(v[4], v[5]); o.w = pk2(v[6], v[7]);
        *(v4u*)(BY + (size_t)n * 512 + k0) = o;
    }
    for (int e8 = tid; e8 < 256 * 32; e8 += 512) {
        const int n = e8 >> 5, k0 = (e8 & 31) * 8, d = n >> 7, im = (n >> 6) & 1, p = n & 63, i2 = k0 >> 4, h20 = k0 & 15, j = d == 0 ? 15 - i2 : i2;
        const float a_r = apr[(d * 17 + j) * 64 + p], a_i = api[(d * 17 + j) * 64 + p]; float v[8];
#pragma unroll
        for (int q = 0; q < 8; ++q) { const float b_r = bbr[(d * 64 + p) * 16 + h20 + q], b_i = bbi[(d * 64 + p) * 16 + h20 + q]; v[q] = im ? (a_r * b_i + a_i * b_r) : (a_r * b_r - a_i * b_i); }
        v4u o; o.x = pk2(v[0], v[1]); o.y = pk2(v[2], v[3]); o.z = pk2(v[4], v[5]); o.w = pk2(v[6], v[7]);
        *(v4u*)(BX + (size_t)n * 256 + k0) = o;
    }
    __syncthreads();
}

__device__ __forceinline__ void prologue_phase(const Frame& F, ArgsP A) {
    unsigned char* ws = A->ws;
    PHASE_IDS;
    __syncthreads();
    for (int it = F.bx; it < DEPTH * SSM_G; it += F.G) ssm_gen_item(F, A, it);
    { float* COS = (float*)(ws + WS_WEIGHTS + WO_ROT); float* SIN = COS + SEQ * 32;
      for (int e = F.bx * 512 + tid; e < SEQ * 32; e += F.G * 512) { const int s = e >> 5, j = e & 31;
          double r = (double)s * A->inv_freq[j] * 0.15915494309189533577; r -= floor(r); const float th = (float)(r * 6.283185307179586477);
          float sn, cs; sincosf(th, &sn, &cs); COS[e] = cs; SIN[e] = sn; } }
    LAS float* scr = (LAS float*)(F.lds + wave * 16384);
    const int gw = F.vcu * NWAVES + wave, NGW = F.G * NWAVES;
    unsigned char* wb = ws + WS_WEIGHTS;
    constexpr int I_IN = 16 * 128, I_GLU = 8 * 16, I_BR = 8 * 32, I_OUT = 16 * 32, I_LAYER = I_IN + I_GLU + 2 * I_BR + I_OUT;
    constexpr int I_13 = 16 * 88, I_2 = 44 * 32, I_FFN = 2 * I_13 + I_2;
    constexpr int N_ITEMS = DEPTH * I_LAYER + 2 * I_FFN, POOL_A = (N_ITEMS * 99 / 100) & ~7;
    const bool split = F.G == 256; const int hw = (F.bx - 128) * NWAVES + wave;
    for (int k = 0;; ++k) {
        int it;
        if (!split) { it = gw + k * NGW; if (it >= N_ITEMS) break; }
        else if (F.bx >= 128) { const int a = hw + k * 128 * NWAVES; if (a < POOL_A) it = a; else { const int nA = (POOL_A - hw + 128 * NWAVES - 1) / (128 * NWAVES); it = POOL_A + gw + (k - nA) * NGW; if (it >= N_ITEMS) break; } }
        else { it = POOL_A + gw + k * NGW; if (it >= N_ITEMS) break; }
        int r = it;
        if (r < DEPTH * I_LAYER) {
            const int l = r / I_LAYER; r -= l * I_LAYER;
            if (r < I_IN) { transpose_item(A->in[2] + (size_t)l * 1024 * 4096, 4096, (bf16*)(wb + WO_IN) + (size_t)l * 4096 * 1024, 1024, 0, scr, r, lane, RmInProj{}, (l & 1) ? A->in[1] + l * D_MODEL : nullptr); continue; } r -= I_IN;
            if (r < I_GLU) { transpose_item(A->in[13] + (size_t)l * 512 * 512, 512, (bf16*)(wb + WO_GLU) + (size_t)l * 512 * 512, 512, 0, scr, r, lane, RmId{}); continue; } r -= I_GLU;
            if (r < 2 * I_BR) { const int br = r / I_BR; r -= br * I_BR;
                transpose_item(A->in[14] + ((size_t)l * 2 + br) * 512 * 1024, 1024, (bf16*)(wb + WO_BR) + (size_t)l * 1024 * 1024, 1024, br * 512, scr, r, lane, RmId{}); continue; } r -= 2 * I_BR;
            transpose_item(A->in[15] + (size_t)l * 1024 * 1024, 1024, (bf16*)(wb + WO_OUT) + (size_t)l * 1024 * 1024, 1024, 0, scr, r, lane, RmId{});
        } else {
            r -= DEPTH * I_LAYER; const int i = r / I_FFN; r -= i * I_FFN;
            bf16* F13 = (bf16*)(wb + WO_F13) + (size_t)i * 5632 * 1024; bf16* F2 = (bf16*)(wb + WO_F2) + (size_t)i * 1024 * 2816;
            if (r < I_13) { transpose_item(A->in[17] + (size_t)i * 1024 * 2816, 2816, F13, 1024, 0, scr, r, lane, RmGlu13{0}, A->in[16] + (2 * i) * D_MODEL); continue; } r -= I_13;
            if (r < I_13) { transpose_item(A->in[18] + (size_t)i * 1024 * 2816, 2816, F13, 1024, 0, scr, r, lane, RmGlu13{1}, A->in[16] + (2 * i) * D_MODEL); continue; } r -= I_13;
            transpose_item(A->in[19] + (size_t)i * 2816 * 1024, 1024, F2, 2816, 0, scr, r, lane, RmId{});
        }
    }
}
constexpr int MOE_EARLY = 4864;
__device__ __forceinline__ void moe_cvt(const Frame& F, ArgsP A, int i, int part) {
    unsigned char* ws = A->ws;
    PHASE_IDS;
    LAS float* scr = (LAS float*)(F.lds + 40960 + wave * 8704);
    const bool early = part < 2 && F.G == 256;
    if (part < 2 && !early) return;
    const int gw = early ? part * MOE_EARLY + (F.bx - 128) * NWAVES + wave : (F.G == 256 ? 2 * MOE_EARLY : 0) + F.vcu * NWAVES + wave, NGW = early ? 128 * NWAVES : F.G * NWAVES;
    const int itend = early ? (part + 1) * MOE_EARLY : 8 * (2 * 16 * 88 + 44 * 32);
    unsigned char* wb = ws + WS_WEIGHTS;
    constexpr int I_13 = 16 * 88, I_2 = 44 * 32, I_E = 2 * I_13 + I_2;
#define MOE_DEC(it, t) do { const int e_ = (it) / I_E; int r_ = (it) - e_ * I_E; const size_t wo_ = ((size_t)i * N_EXP + e_); \
        if (r_ < 2 * I_13) { const int h_ = r_ >= I_13; r_ -= h_ * I_13; (t).src = A->in[21 + h_] + wo_ * 1024 * 2816; (t).N = 2816; (t).dst = (bf16*)(wb + WO_M13) + (size_t)e_ * 5632 * 1024; (t).ldt = 1024; (t).koff = 0; (t).map = 2 + h_; } \
        else { r_ -= 2 * I_13; (t).src = A->in[23] + wo_ * 2816 * 1024; (t).N = 1024; (t).dst = (bf16*)(wb + WO_M2) + (size_t)e_ * 1024 * 2816; (t).ldt = 2816; (t).koff = 0; (t).map = 0; } \
        t_setkn((t), r_); } while (0)
    T_SWEEP(gw, NGW, itend, MOE_DEC);
#undef MOE_DEC
}

template <bool COMBINE, bool ROUTER, bool FINAL>
__device__ __forceinline__ void norm_phase(const Frame& F, const float* __restrict__ SRC, float* __restrict__ X, const float* __restrict__ gain, bf16* __restrict__ XN,
                                           const bf16* __restrict__ YS, const int* __restrict__ slot_prev, const float* __restrict__ gate_prev, const unsigned* __restrict__ SPLT, const float* __restrict__ PART,
                                           const float* __restrict__ wr, unsigned* __restrict__ cnt, int* __restrict__ asg_e, int* __restrict__ asg_pos, float* __restrict__ asg_g) {
    PHASE_IDS;
    LAS float* wrl = (LAS float*)F.lds;
    LAS int* rinfo = (LAS int*)(F.lds + 32768 + 64);
    LAS int* lcnt = (LAS int*)(F.lds + 32768 + 64 + 512);
    LAS float* rg = (LAS float*)(F.lds + 32768 + 64 + 1024);
    if (ROUTER) { for (int e = tid; e < 8192; e += 512) wrl[(e & 7) * 1024 + (e >> 3)] = wr[e]; __syncthreads(); }
    const int rpb = NTOK / F.G;
    f32x4 gg4[4], vn[4];
#pragma unroll
    for (int j = 0; j < 4; ++j) gg4[j] = ((const f32x4*)gain)[64 * j + lane];
    if (wave < rpb) { const f32x4* xr = (const f32x4*)(SRC + (size_t)(F.vcu * rpb + wave) * D_MODEL) + lane;
#pragma unroll
        for (int j = 0; j < 4; ++j) vn[j] = xr[64 * j]; }
    for (int rr = wave; rr < rpb; rr += NWAVES) {
        const int row = F.vcu * rpb + rr;
        f32x4 v[4]; float s = 0.f;
#pragma unroll
        for (int j = 0; j < 4; ++j) v[j] = vn[j];
        if (rr + NWAVES < rpb) { const f32x4* xr = (const f32x4*)(SRC + (size_t)(row + NWAVES) * D_MODEL) + lane;
#pragma unroll
            for (int j = 0; j < 4; ++j) vn[j] = xr[64 * j]; }
        if (COMBINE) {
            const int s0 = slot_prev[row * 2], s1 = slot_prev[row * 2 + 1]; const float g0 = gate_prev[row * 2], g1 = gate_prev[row * 2 + 1];
            const unsigned long long* y0 = (const unsigned long long*)(YS + (size_t)s0 * 1024) + lane; const unsigned long long* y1 = (const unsigned long long*)(YS + (size_t)s1 * 1024) + lane;
            const unsigned t0 = SPLT[s0 >> 8], t1 = SPLT[s1 >> 8];
            f32x4 ta[4] = {{0.f, 0.f, 0.f, 0.f}, {0.f, 0.f, 0.f, 0.f}, {0.f, 0.f, 0.f, 0.f}, {0.f, 0.f, 0.f, 0.f}}, tb[4] = {{0.f, 0.f, 0.f, 0.f}, {0.f, 0.f, 0.f, 0.f}, {0.f, 0.f, 0.f, 0.f}, {0.f, 0.f, 0.f, 0.f}};
            if (t0 != 0u) { const f32x4* pp = (const f32x4*)(PART + (size_t)(t0 - 1) * 24 * 65536 + (size_t)(s0 & 255) * 256) + lane;
#pragma unroll
                for (int j = 0; j < 4; ++j) { ta[j] = pp[(size_t)(j * 6) * 16384];
#pragma unroll
                    for (int ks = 1; ks < 6; ++ks) ta[j] += pp[(size_t)(j * 6 + ks) * 16384]; } }
            if (t1 != 0u) { const f32x4* pp = (const f32x4*)(PART + (size_t)(t1 - 1) * 24 * 65536 + (size_t)(s1 & 255) * 256) + lane;
#pragma unroll
                for (int j = 0; j < 4; ++j) { tb[j] = pp[(size_t)(j * 6) * 16384];
#pragma unroll
                    for (int ks = 1; ks < 6; ++ks) tb[j] += pp[(size_t)(j * 6 + ks) * 16384]; } }
#pragma unroll
            for (int j = 0; j < 4; ++j) { const unsigned long long a = y0[64 * j], b = y1[64 * j];
                f32x4 ya = {__uint_as_float((unsigned)(a << 16)), __uint_as_float((unsigned)a & 0xffff0000u), __uint_as_float((unsigned)(a >> 32) << 16), __uint_as_float((unsigned)(a >> 32) & 0xffff0000u)};
                f32x4 yb = {__uint_as_float((unsigned)(b << 16)), __uint_as_float((unsigned)b & 0xffff0000u), __uint_as_float((unsigned)(b >> 32) << 16), __uint_as_float((unsigned)(b >> 32) & 0xffff0000u)};
                if (t0 != 0u) ya = ta[j];
                if (t1 != 0u) yb = tb[j];
                v[j] += g0 * ya + g1 * yb;
                if (!FINAL) ((f32x4*)(X + (size_t)row * D_MODEL) + lane)[64 * j] = v[j]; }
        }
#pragma unroll
        for (int j = 0; j < 4; ++j) s += (v[j].x * v[j].x + v[j].y * v[j].y) + (v[j].z * v[j].z + v[j].w * v[j].w);
        const float rstd = rsqrtf(wave_sum_l(s, lane) * (1.f / D_MODEL) + RMS_EPS);
        float lg[8];
#pragma unroll
        for (int e = 0; e < 8; ++e) lg[e] = 0.f;
#pragma unroll
        for (int j = 0; j < 4; ++j) {
            const f32x4 gg = gg4[j];
            v[j].x *= rstd * gg.x; v[j].y *= rstd * gg.y; v[j].z *= rstd * gg.z; v[j].w *= rstd * gg.w;
            if (FINAL) ((f32x4*)(X + (size_t)row * D_MODEL) + lane)[64 * j] = v[j];
            else ((unsigned long long*)(XN + (size_t)row * D_MODEL))[64 * j + lane] = (unsigned long long)pk2(v[j].x, v[j].y) | ((unsigned long long)pk2(v[j].z, v[j].w) << 32);
            if (ROUTER) {
#pragma unroll
                for (int e = 0; e < 8; ++e) { const f32x4 w = *(const LAS f32x4*)(wrl + e * 1024 + (64 * j + lane) * 4); lg[e] += (v[j].x * w.x + v[j].y * w.y) + (v[j].z * w.z + v[j].w * w.w); } }
        }
        if (ROUTER) {
#pragma unroll
            for (int e = 0; e < 8; ++e) lg[e] = wave_sum_l(lg[e], lane);
            int e0 = 0; float l0 = lg[0];
#pragma unroll
            for (int e = 1; e < 8; ++e) if (lg[e] > l0) { l0 = lg[e]; e0 = e; }
            int e1 = -1; float l1 = -3.4e38f;
#pragma unroll
            for (int e = 0; e < 8; ++e) if (e != e0 && lg[e] > l1) { l1 = lg[e]; e1 = e; }
            const float p1 = __expf(l1 - l0), inv = 1.f / (1.f + p1);
            if (lane == 0) { rinfo[rr * 2] = e0; rinfo[rr * 2 + 1] = e1; rg[rr * 2] = inv; rg[rr * 2 + 1] = p1 * inv; }
        }
    }
    if (ROUTER) {
        __syncthreads();
        const int nW = (rpb * 2) >> 6;
        int e_my = 0, lp = 0;
        if (wave < nW) { e_my = rinfo[wave * 64 + lane]; unsigned long long mine = 0ull;
#pragma unroll
            for (int q = 0; q < 8; ++q) { const unsigned long long m = __ballot(e_my == q); mine = (e_my == q) ? m : mine; if (lane == 0) lcnt[wave * 8 + q] = __popcll(m); }
            lp = (int)__builtin_amdgcn_mbcnt_hi((unsigned)(mine >> 32), __builtin_amdgcn_mbcnt_lo((unsigned)mine, 0u)); }
        __syncthreads();
        if (wave < nW) { for (int w2 = 0; w2 < wave; ++w2) lp += lcnt[w2 * 8 + e_my];
            const int a = wave * 64 + lane, row2 = F.vcu * rpb * 2 + a; asg_e[row2] = e_my; asg_pos[row2] = lp; asg_g[row2] = rg[a]; }
        if (tid >= 256 && tid < 264) { const int e = tid - 256; int c = 0; for (int w2 = 0; w2 < nW; ++w2) c += lcnt[w2 * 8 + e]; cnt[F.vcu * 8 + e] = (unsigned)c; }
    }
}

__device__ __forceinline__ void rstd_prep(const Frame& F, const float* __restrict__ PS, int pm) {
    PHASE_IDS;
    LAS float* rs = (LAS float*)(F.lds + RSTD_OFF);
    if (tid < 256) { const float* q = PS + pm * 256 + tid; float s = 0.f;
#pragma unroll
        for (int i = 0; i < 16; ++i) s += q[(size_t)i * NTOK];
        rs[tid] = rsqrtf(s * (1.f / D_MODEL) + RMS_EPS); }
    __syncthreads();
}
struct MoeLayout { int ps[8]; int pe[8]; int nblk; };
template <class P> __device__ __forceinline__ MoeLayout moe_layout(P cnt) {
    MoeLayout L; int acc = 0;
#pragma unroll
    for (int e = 0; e < 8; ++e) { const int c = (int)cnt[e]; L.ps[e] = acc; acc += (c + 255) & ~255; L.pe[e] = acc; }
    L.nblk = acc >> 8; return L;
}
__device__ __forceinline__ void assign_phase(const Frame& F, const unsigned* blkcnt, unsigned* cnt, const int* asg_e, const int* asg_pos, int* slot_of, const bf16* XN, bf16* XB, unsigned* splt) {
    PHASE_IDS;
    LAS int* lt = (LAS int*)F.lds;
    if (tid < 16) lt[tid] = 0;
    __syncthreads();
    int tot = 0, pre = 0;
    if (tid < 128) { const int e = tid & 7, h = tid >> 3;
#pragma unroll
        for (int k = 0; k < 16; ++k) { const int b = h * 16 + k; const int c = b < F.G ? (int)blkcnt[b * 8 + e] : 0; tot += c; pre += (b < F.vcu) ? c : 0; } }
    const int rpb = NTOK / F.G;
    if (rpb == 64) {
        int ee[16], pp[16]; v4u d0[16], d1[16];
#pragma unroll
        for (int k = 0; k < 16; ++k) { const int ga = F.vcu * 128 + wave + 8 * k; ee[k] = asg_e[ga]; pp[k] = asg_pos[ga];
            const v4u* src = (const v4u*)(XN + (size_t)(ga >> 1) * 1024) + lane; d0[k] = src[0]; d1[k] = src[64]; }
        if (tid < 128) { const int e = tid & 7; __hip_atomic_fetch_add(&lt[e], tot, __ATOMIC_RELAXED, __HIP_MEMORY_SCOPE_WORKGROUP); __hip_atomic_fetch_add(&lt[8 + e], pre, __ATOMIC_RELAXED, __HIP_MEMORY_SCOPE_WORKGROUP); }
        __syncthreads();
        const MoeLayout L = moe_layout(lt);
        if (F.bx == 0) {
            if (tid < 8) cnt[tid] = (unsigned)lt[tid];
            const int tile0 = ((L.nblk * 4) >> 8) * 64;
            if (tid < L.nblk - tile0) splt[tile0 + tid] = (unsigned)(tid + 1);
        }
#pragma unroll
        for (int k = 0; k < 16; ++k) { const int ga = F.vcu * 128 + wave + 8 * k, e = ee[k];
            int ps = L.ps[0], pr = lt[8];
#pragma unroll
            for (int q = 1; q < 8; ++q) { ps = (e == q) ? L.ps[q] : ps; pr = (e == q) ? lt[8 + q] : pr; }
            const int dest = ps + pr + pp[k];
            if (lane == 0) slot_of[ga] = dest;
            v4u* dst = (v4u*)(XB + (size_t)dest * 1024) + lane; dst[0] = d0[k]; dst[64] = d1[k]; }
        return;
    }
    if (tid < 128) { const int e = tid & 7; __hip_atomic_fetch_add(&lt[e], tot, __ATOMIC_RELAXED, __HIP_MEMORY_SCOPE_WORKGROUP); __hip_atomic_fetch_add(&lt[8 + e], pre, __ATOMIC_RELAXED, __HIP_MEMORY_SCOPE_WORKGROUP); }
    __syncthreads();
    if (F.bx == 0 && tid < 8) cnt[tid] = (unsigned)lt[tid];
    const MoeLayout L = moe_layout(lt);
    if (F.bx == 0) {
        const int tile0 = ((L.nblk * 4) >> 8) * 64;
        if (tid < L.nblk - tile0) splt[tile0 + tid] = (unsigned)(tid + 1);
    }
    for (int a = wave; a < rpb * 2; a += NWAVES) {
        const int ga = F.vcu * rpb * 2 + a, tok = ga >> 1, e = asg_e[ga];
        int ps = L.ps[0];
#pragma unroll
        for (int q = 1; q < 8; ++q) ps = (e == q) ? L.ps[q] : ps;
        int pr = lt[8];
#pragma unroll
        for (int q = 1; q < 8; ++q) pr = (e == q) ? lt[8 + q] : pr;
        const int dest = ps + pr + asg_pos[ga];
        if (lane == 0) slot_of[ga] = dest;
        const v4u* src = (const v4u*)(XN + (size_t)tok * 1024) + lane; v4u* dst = (v4u*)(XB + (size_t)dest * 1024) + lane;
        dst[0] = src[0]; dst[64] = src[64];
    }
}

__device__ __forceinline__ void scan_phase(const Frame& F, ArgsP A, int layer, const float* __restrict__ XLOC, bf16* __restrict__ AY) {
    PHASE_IDS;
    LAS float* S = (LAS float*)F.lds;
    for (int it = F.vcu; it < 256; it += F.G) {
        const int b = it >> 7, g = (it >> 2) & 31, d = (it >> 1) & 1, ph = it & 1, pp = tid & 31, seg = tid >> 5, p = ph * 32 + pp;
        const size_t pi = ((size_t)layer * 2 + d) * SSM_G * SSM_P + (size_t)g * SSM_P + p;
        const float lr = A->in[5][pi], li = A->in[6][pi], dt = expf(A->in[7][(layer * 2 + d) * SSM_G + g]);
        const float er = expf(16.f * lr * dt); float sn, cs; sincosf(16.f * li * dt, &sn, &cs);
        const float ar = er * cs, ai = er * sn;
        float Ar = ar, Ai = ai;
#pragma unroll
        for (int q = 0; q < 5; ++q) { const float t = Ar * Ar - Ai * Ai; Ai = 2.f * Ar * Ai; Ar = t; }
        const int c0 = d == 0 ? seg * 32 : 511 - seg * 32, cstep = d == 0 ? 1 : -1;
        const float* xl = XLOC + ((size_t)g * 1024 + b * 512 + c0) * 256 + d * 128 + p; const long xs = (long)cstep * 256;
        float sr = 0.f, si = 0.f;
        float xrv[32], xiv[32];
#pragma unroll
        for (int k = 0; k < 32; ++k) { xrv[k] = xl[k * xs]; xiv[k] = xl[k * xs + 64]; }
#pragma unroll
        for (int k = 0; k < 32; ++k) { const float t = ar * sr - ai * si + xrv[k]; si = ar * si + ai * sr + xiv[k]; sr = t; }
        S[(seg * 32 + pp) * 2] = sr; S[(seg * 32 + pp) * 2 + 1] = si;
        __syncthreads();
        float cr_ = 0.f, ci_ = 0.f;
        for (int s2 = 0; s2 < seg; ++s2) { const float t = Ar * cr_ - Ai * ci_ + S[(s2 * 32 + pp) * 2]; ci_ = Ar * ci_ + Ai * cr_ + S[(s2 * 32 + pp) * 2 + 1]; cr_ = t; }
        bf16* ay = AY + ((size_t)g * 1024 + b * 512 + c0) * 512 + 256 + d * 128 + p; const long ys = (long)cstep * 512;
#pragma unroll
        for (int k = 0; k < 32; ++k) { const float xr = xrv[k], xi = xiv[k];
            {
              const float pr = __int_as_float(__builtin_amdgcn_mov_dpp(__float_as_int(cr_), 0xB1, 0xf, 0xf, true)), pi = __int_as_float(__builtin_amdgcn_mov_dpp(__float_as_int(ci_), 0xB1, 0xf, 0xf, true));
              const bool odd = (pp & 1) != 0;
              *(unsigned*)(ay + k * ys + (odd ? 63 : 0)) = odd ? pk2(pi, ci_) : pk2(cr_, pr); }
            const float t = ar * cr_ - ai * ci_ + xr; ci_ = ar * ci_ + ai * cr_ + xi; cr_ = t; }
        __syncthreads();
    }
}

__device__ __forceinline__ void kmax_phase(const Frame& F, const bf16* __restrict__ Kb, unsigned* __restrict__ KMAX) {
    PHASE_IDS;
    const int nw = F.G > 128 ? F.G - 128 : F.G, w0 = F.G > 128 ? F.bx - 128 : F.bx;
    if (w0 < 0) return;
    for (int it = w0; it < 128; it += nw) {
        const int slab = it >> 3; const bf16* base = Kb + ((size_t)slab * 8192 + (size_t)(it & 7) * 1024 + wave * 128) * 64;
        float mx = 0.f;
#pragma unroll 4
        for (int i = 0; i < 16; ++i) { const v4u v = *(const v4u*)(base + (size_t)(i * 8 + (lane >> 3)) * 64 + (lane & 7) * 8); float q = 0.f;
            const unsigned w[4] = {v.x, v.y, v.z, v.w};
#pragma unroll
            for (int e = 0; e < 4; ++e) { const float a = __uint_as_float(w[e] << 16), b2 = __uint_as_float(w[e] & 0xffff0000u); q = fmaf(a, a, q); q = fmaf(b2, b2, q); }
            q += shx(q, 1, lane); q += shx(q, 2, lane); q += shx(q, 4, lane); mx = fmaxf(mx, q); }
#pragma unroll
        for (int o = 8; o < 64; o <<= 1) mx = fmaxf(mx, shx(mx, o, lane));
        if (lane == 0) __hip_atomic_fetch_max(KMAX + slab, __float_as_uint(mx), __ATOMIC_RELAXED, __HIP_MEMORY_SCOPE_AGENT);
    }
}
#ifndef PHASE_MASK
#define PHASE_MASK 0xffffffu
#endif
#define PMB(b) ((PHASE_MASK >> (b)) & 1u)
#ifndef REP_MASK
#define REP_MASK 0u
#endif
#ifndef REP_N
#define REP_N 1
#endif
#define RPT(b, cond) for (int rep_ = 0; rep_ < 1 + (((REP_MASK >> (b)) & 1u) && (cond) ? REP_N : 0); ++rep_)
#define SITE ArgsP ap = get_args(); unsigned char* ws = ap->ws; unsigned char* wb = ws + WS_WEIGHTS; (void)wb; const Frame F = make_frame((LAS unsigned char*)lds); (void)F
__device__ __forceinline__ bool in_range(int k) { ArgsP a = get_args(); const int lo = a->ph_lo, hi = a->ph_hi; return lo <= k && k < hi; }
__global__ void __launch_bounds__(NWAVES * 64, 2) mk_fwd(Args args_unused) {
    extern __shared__ __attribute__((aligned(16))) unsigned char lds[];
    volatile LAS unsigned* MISC = (volatile LAS unsigned*)((LAS unsigned char*)lds + MISC_OFF);
    for (int u = threadIdx.x; u < (LDS_BYTES - LDSCTL_OFF) / 4; u += NWAVES * 64) ((LAS unsigned*)((LAS unsigned char*)lds + LDSCTL_OFF))[u] = 0u;
    __syncthreads();
    { SITE; if ((ap->ph_hi - ap->ph_lo) > 1) (void)xcd_barrier_post((unsigned*)(ws + WS_CTL) + CW_BAR, MISC + 8); }
#define IN(k) in_range((k))
#define SUB() (get_args()->sub)
#define SEAM(k) do { if (IN(k) && IN((k) + 1)) { ArgsP ap_ = get_args(); XcdBarrier b_; b_.bar = (unsigned*)(ap_->ws + WS_CTL) + CW_BAR; b_.x = xb_xcc_id(); \
        b_.st = (volatile LAS unsigned*)((LAS unsigned char*)lds + MISC_OFF) + 8; xcd_barrier(b_); } } while (0)

    RPT(0, true) if (PMB(0) && IN(PH_PRO)) { SITE; prologue_phase(F, ap); }
    SEAM(PH_PRO);

    for (int l = 0; l < DEPTH; ++l) {
        const int pb = PH_L0 + l * PH_PER_LAYER, moe = l & 1, i = l >> 1;
        const bool fold1 = (l & 1) != 0;
        RPT(1, l != 2) if (!fold1 && PMB(1) && IN(pb + P_NORM1)) {
            SITE; float* X = ap->out; bf16* XN = (bf16*)(ws + WS_XN);
            const float* gain = ap->in[1] + l * D_MODEL;
            if (l == 0) norm_phase<false, false, false>(F, ap->in[0], X, gain, XN, nullptr, nullptr, nullptr, nullptr, nullptr, nullptr, nullptr, nullptr, nullptr, nullptr);
            else if (l == 2 && ((SUB() & 4) != 0)) { const int* sp = (const int*)(ws + WS_ROUTE) + 3 * 32768; const float* gp = (const float*)(ws + WS_ROUTE) + 2 * 32768;
                norm_phase<true, false, false>(F, X, X, gain, XN, (const bf16*)(ws + WS_R2), sp, gp, (const unsigned*)(ws + WS_CTL) + CW_SPLT, (const float*)(ws + WS_PART), nullptr, nullptr, nullptr, nullptr, nullptr); }
            else norm_phase<false, false, false>(F, X, X, gain, XN, nullptr, nullptr, nullptr, nullptr, nullptr, nullptr, nullptr, nullptr, nullptr, nullptr);
        }
        if (!fold1) SEAM(pb + P_NORM1);
        RPT(2, true) if (PMB(2) && IN(pb + P_INPROJ)) {
            SITE;
            pg8::Gemm g{(const bf16*)(ws + WS_XN), (const bf16*)(wb + WO_IN) + (size_t)l * 4096 * 1024}; pg8::StaticOrderT<64, 16> S{F.bx};
            const float* COS = (const float*)(wb + WO_ROT);
            if (fold1) { pg8::Unit u0; S.next(0, u0); rstd_prep(F, (const float*)(ws + WS_PS), u0.pm);
                pg8::EpiInProjT<true> E{(bf16*)(ws + WS_Q), (bf16*)(ws + WS_K), (bf16*)(ws + WS_V), (bf16*)(ws + WS_AY), (bf16*)(ws + WS_G), COS, COS + SEQ * 32, (const LAS float*)(F.lds + RSTD_OFF)};
                pg8::gemm_phase<pg8::EpiInProjT<true>, pg8::StaticOrderT<64, 16>, 1024, 1024, 1024>(F.lds + RING_OFF, g, S, E); }
            else { pg8::EpiInProj E{(bf16*)(ws + WS_Q), (bf16*)(ws + WS_K), (bf16*)(ws + WS_V), (bf16*)(ws + WS_AY), (bf16*)(ws + WS_G), COS, COS + SEQ * 32, nullptr};
                pg8::gemm_phase<pg8::EpiInProj, pg8::StaticOrderT<64, 16>, 1024, 1024, 1024>(F.lds + RING_OFF, g, S, E); }
        }
        SEAM(pb + P_INPROJ);
        RPT(3, true) if (PMB(3) && IN(pb + P_XLOC)) {
            SITE;
            pg8::Gemm g{(const bf16*)(ws + WS_AY), (const bf16*)(wb + WO_BX) + (size_t)l * 32 * 256 * 256}; pg8::SsmOrder S{F.G, F.bx};
            pg8::EpiXloc E{(float*)(ws + WS_XLOC)};
            pg8::gemm_phase<pg8::EpiXloc, pg8::SsmOrder, 512, 256, 256>(F.lds + RING_OFF, g, S, E);
            kmax_phase(F, (const bf16*)(ws + WS_K), (unsigned*)(ws + WS_CTL) + CW_KMAX + 16 * l);
        }
        SEAM(pb + P_XLOC);
        RPT(4, true) if (PMB(4) && IN(pb + P_SCAN)) { SITE; scan_phase(F, ap, l, (const float*)(ws + WS_XLOC), (bf16*)(ws + WS_AY)); }
        SEAM(pb + P_SCAN);
        if (IN(pb + P_MIX)) {
            RPT(5, true) if (PMB(5) && (SUB() & 1)) {
                SITE;
                pg8::Gemm g{(const bf16*)(ws + WS_AY), (const bf16*)(wb + WO_BY) + (size_t)l * 32 * 256 * 512}; pg8::SsmOrder S{F.G, F.bx};
                pg8::EpiY E{(bf16*)(ws + WS_SACT)};
                pg8::gemm_phase<pg8::EpiY, pg8::SsmOrder, 512, 512, 512>(F.lds + RING_OFF, g, S, E);
            }
            if ((SUB() & 8) && (SUB() & 2)) { SITE; if (F.bx >= 128) moe_cvt(F, ap, i, l & 1); }
            RPT(6, true) if (PMB(6) && (SUB() & 2)) {
                SITE;
                const float* lp = ap->in[3] + l * 4 * HD; float d01 = 0.f, d23 = 0.f;
                for (int q = 0; q < HD; ++q) { d01 += lp[q] * lp[HD + q]; d23 += lp[2 * HD + q] * lp[3 * HD + q]; }
                const float lam_init = 0.8f - 0.6f * __expf(-0.3f * (float)l), lam = __expf(d01) - __expf(d23) + lam_init;
                const bf16* Q = (const bf16*)(ws + WS_Q); const bf16* Kb = (const bf16*)(ws + WS_K); const bf16* V = (const bf16*)(ws + WS_V);
                float* O1 = (float*)(ws + WS_MERGED);
                bf16* AS2 = (bf16*)(ws + WS_AS2);
                for (int u = F.vcu; u < 256; u += F.G) {
                    const int bh = u >> 5, qb = u & 31, b = bh >> 2, h = bh & 3;
                    att::diff_attn_unit(Q + (size_t)bh * 2 * SEQ * 64, Kb + (size_t)bh * 2 * SEQ * 64, V + (size_t)bh * SEQ * 128, qb * 256,
                                        (const unsigned*)(ws + WS_CTL) + CW_KMAX + 16 * l + bh * 2, O1 + (size_t)u * 65536, AS2 + ((size_t)b * SEQ + qb * 256) * 1024 + h * 128, ap->in[4] + l * VD, lam, 1.f - lam_init, (char*)lds + RING_OFF);
                    __syncthreads();
                }
            }
        }
        SEAM(pb + P_MIX);
        RPT(7, true) if (PMB(7) && IN(pb + P_GLU)) {
            SITE;
            pg8::Gemm g{(const bf16*)(ws + WS_SACT), (const bf16*)(wb + WO_GLU) + (size_t)l * 512 * 512}; pg8::StaticOrderT<64, 2> S{F.bx};
            pg8::EpiGlu E{(const bf16*)(ws + WS_SACT), (bf16*)(ws + WS_AS2)};
            pg8::gemm_phase<pg8::EpiGlu, pg8::StaticOrderT<64, 2>, 512, 512, 512>(F.lds + RING_OFF, g, S, E);
        }
        SEAM(pb + P_GLU);
        RPT(8, true) if (PMB(8) && IN(pb + P_BRANCH)) {
            SITE;
            pg8::Gemm g{(const bf16*)(ws + WS_AS2), (const bf16*)(wb + WO_BR) + (size_t)l * 1024 * 1024}; pg8::StaticOrderT<64, 4> S{F.bx};
            pg8::EpiBranch E{(const bf16*)(ws + WS_G), (bf16*)(ws + WS_MERGED)};
            pg8::gemm_phase<pg8::EpiBranch, pg8::StaticOrderT<64, 4>, 1024, 1024, 1024>(F.lds + RING_OFF, g, S, E);
        }
        SEAM(pb + P_BRANCH);
        RPT(9, l == 0) if (PMB(9) && IN(pb + P_OUT)) {
            SITE; float* X = ap->out;
            pg8::Gemm g{(const bf16*)(ws + WS_MERGED), (const bf16*)(wb + WO_OUT) + (size_t)l * 1024 * 1024}; pg8::StaticOrderT<64, 4> S{F.bx};
            if (!moe) { pg8::EpiResN E{l == 0 ? ap->in[0] : X, X, (bf16*)(ws + WS_XN), (float*)(ws + WS_PS)};
                pg8::gemm_phase<pg8::EpiResN, pg8::StaticOrderT<64, 4>, 1024, 1024, 1024>(F.lds + RING_OFF, g, S, E); }
            else { pg8::EpiRes E{X, X};
                pg8::gemm_phase<pg8::EpiRes, pg8::StaticOrderT<64, 4>, 1024, 1024, 1024>(F.lds + RING_OFF, g, S, E); }
        }
        SEAM(pb + P_OUT);
        RPT(10, false) if (moe && PMB(10) && IN(pb + P_NORM2)) {
            SITE; float* X = ap->out; bf16* XN = (bf16*)(ws + WS_XN);
            const float* gain = ap->in[16] + l * D_MODEL;
            if (moe) { int* asg_e = (int*)(ws + WS_ROUTE + (size_t)i * 512 * 1024); int* asg_pos = asg_e + 32768; float* asg_g = (float*)(asg_pos + 32768);
                       norm_phase<false, true, false>(F, X, X, gain, XN, nullptr, nullptr, nullptr, nullptr, nullptr, ap->in[20] + (size_t)i * D_MODEL * N_EXP, (unsigned*)(ws + WS_CTL) + CW_BLKCNT + 2048 * i, asg_e, asg_pos, asg_g);
                       RPT(17, true) { if (SUB() & 8) moe_cvt(F, ap, i, 2); } }
            else norm_phase<false, false, false>(F, X, X, gain, XN, nullptr, nullptr, nullptr, nullptr, nullptr, nullptr, nullptr, nullptr, nullptr, nullptr);
        }
        if (moe) SEAM(pb + P_NORM2);
        if (!moe) {
            RPT(11, true) if (PMB(11) && IN(pb + P_UP)) {
                SITE;
                pg8::Gemm g{(const bf16*)(ws + WS_XN), (const bf16*)(wb + WO_F13) + (size_t)i * 5632 * 1024}; pg8::StaticOrderT<64, 22> S{F.bx};
                { pg8::Unit u0; S.next(0, u0); rstd_prep(F, (const float*)(ws + WS_PS), u0.pm); }
                pg8::EpiSwigluT<true> E{(bf16*)(ws + WS_H), 22, (const LAS float*)(F.lds + RSTD_OFF)};
                pg8::gemm_phase<pg8::EpiSwigluT<true>, pg8::StaticOrderT<64, 22>, 1024, 1024, 1024>(F.lds + RING_OFF, g, S, E);
            }
            SEAM(pb + P_UP);
            if (PMB(12) && IN(pb + P_DOWN)) {
                SITE; float* X = ap->out;
                pg8::Gemm g{(const bf16*)(ws + WS_H), (const bf16*)(wb + WO_F2) + (size_t)i * 1024 * 2816}; pg8::StaticOrderT<64, 4> S{F.bx};
                pg8::EpiResN E{X, X, (bf16*)(ws + WS_XN), (float*)(ws + WS_PS)};
                pg8::gemm_phase<pg8::EpiResN, pg8::StaticOrderT<64, 4>, 2816, 2816, 2816>(F.lds + RING_OFF, g, S, E);
            }
            SEAM(pb + P_DOWN);
        } else {
            RPT(13, true) if (PMB(13) && IN(pb + P_ASSIGN)) {
                SITE; int* asg_e = (int*)(ws + WS_ROUTE + (size_t)i * 512 * 1024);
                assign_phase(F, (const unsigned*)(ws + WS_CTL) + CW_BLKCNT + 2048 * i, (unsigned*)(ws + WS_CTL) + CW_CNT + 64 * i, asg_e, asg_e + 32768, asg_e + 3 * 32768, (const bf16*)(ws + WS_XN), (bf16*)(ws + WS_R2), (unsigned*)(ws + WS_CTL) + CW_SPLT + 256 * i);
            }
            SEAM(pb + P_ASSIGN);
            RPT(14, true) if (PMB(14) && IN(pb + P_UP)) {
                SITE;
                const MoeLayout L = moe_layout((const unsigned*)(ws + WS_CTL) + CW_CNT + 64 * i);
                pg8::Gemm g{(const bf16*)(ws + WS_R2), (const bf16*)(wb + WO_M13)};
                pg8::MoeOrder S; S.so.init(L.nblk * 256, 5632, F.G, F.bx); S.pe0 = L.pe[0]; S.pe1 = L.pe[1]; S.pe2 = L.pe[2]; S.pe3 = L.pe[3]; S.pe4 = L.pe[4]; S.pe5 = L.pe[5]; S.pe6 = L.pe[6]; S.nN = 22; S.maxr = 1 << 20;
                pg8::EpiSwiglu E{(bf16*)(ws + WS_H), 22, nullptr};
                pg8::gemm_phase<pg8::EpiSwiglu, pg8::MoeOrder, 1024, 1024, 1024>(F.lds + RING_OFF, g, S, E);
            }
            SEAM(pb + P_UP);
            RPT(15, true) if (PMB(15) && IN(pb + P_DOWN)) {
                SITE;
                const MoeLayout L = moe_layout((const unsigned*)(ws + WS_CTL) + CW_CNT + 64 * i);
                pg8::Gemm g{(const bf16*)(ws + WS_H), (const bf16*)(wb + WO_M2)};
                const int tile0 = ((L.nblk * 4) >> 8) * 64;
                pg8::MoeOrder S; S.so.init(tile0 * 256, 1024, F.G, F.bx); S.pe0 = L.pe[0]; S.pe1 = L.pe[1]; S.pe2 = L.pe[2]; S.pe3 = L.pe[3]; S.pe4 = L.pe[4]; S.pe5 = L.pe[5]; S.pe6 = L.pe[6]; S.nN = 4; S.maxr = 1 << 20;
                pg8::EpiMoeDown E{(bf16*)(ws + WS_R2)};
                pg8::gemm_phase<pg8::EpiMoeDown, pg8::MoeOrder, 2816, 2816, 2816>(F.lds + RING_OFF, g, S, E);
                pg8::MoeSplitOrder T; T.c = F.bx; T.tile0 = tile0; T.nsub = (L.nblk - tile0) * 24; T.eoff = 0; T.pe0 = S.pe0; T.pe1 = S.pe1; T.pe2 = S.pe2; T.pe3 = S.pe3; T.pe4 = S.pe4; T.pe5 = S.pe5; T.pe6 = S.pe6; T.nN = 4;
                pg8::EpiMoeDownPart EP{(float*)(ws + WS_PART)};
                pg8::gemm_phase<pg8::EpiMoeDownPart, pg8::MoeSplitOrder, 2816, 2816, 0>(F.lds + RING_OFF, g, T, EP);
            }
            SEAM(pb + P_DOWN);
        }
    }
    if (PMB(16) && IN(PH_FINAL)) {
        SITE; float* X = ap->out;
        if (((SUB() & 4) != 0)) { const int* sp = (const int*)(ws + WS_ROUTE + 512 * 1024) + 3 * 32768; const float* gp = (const float*)(ws + WS_ROUTE + 512 * 1024) + 2 * 32768;
            norm_phase<true, false, true>(F, X, X, ap->in[24], nullptr, (const bf16*)(ws + WS_R2), sp, gp, (const unsigned*)(ws + WS_CTL) + CW_SPLT + 256, (const float*)(ws + WS_PART), nullptr, nullptr, nullptr, nullptr, nullptr); }
        else norm_phase<false, false, true>(F, X, X, ap->in[24], nullptr, nullptr, nullptr, nullptr, nullptr, nullptr, nullptr, nullptr, nullptr, nullptr, nullptr);
    }
#undef IN
#undef SEAM
}
#ifndef OPT_MASK
#define OPT_MASK 0x37f
#endif
#ifndef ONE_LAUNCH
#define ONE_LAUNCH 1
#endif
static void launch_mk(Args& a, int lo, int hi, int sub, int grid, hipStream_t stream) {
    a.ph_lo = lo; a.ph_hi = hi; a.sub = sub;
    hipLaunchKernelGGL(mk_fwd, dim3(grid), dim3(NWAVES * 64), LDS_BYTES, stream, a);
}
extern "C" void kernel_launch(void* const* d_in, const int* in_sizes, int n_in, void* d_out, int out_size, void* d_ws, size_t ws_size, hipStream_t stream) {
    static int grid = 0;
    if (grid == 0) {
        if (n_in != 25 || out_size != NTOK * D_MODEL || ws_size < WS_END + 64 * MiB) { fprintf(stderr, "kernel_launch: unexpected shapes n_in %d out %d ws %zu (need %zu)\n", n_in, out_size, ws_size, (size_t)(WS_END + 64 * MiB)); grid = -1; return; }
        int dev = 0, cus = 0;
        if (hipGetDevice(&dev) != hipSuccess || hipDeviceGetAttribute(&cus, hipDeviceAttributeMultiprocessorCount, dev) != hipSuccess) { grid = -1; return; }
        if (hipFuncSetAttribute((const void*)mk_fwd, hipFuncAttributeMaxDynamicSharedMemorySize, LDS_BYTES) != hipSuccess) { fprintf(stderr, "kernel_launch: hipFuncSetAttribute failed\n"); grid = -1; return; }
        int per_cu = 0;
        if (hipOccupancyMaxActiveBlocksPerMultiprocessor(&per_cu, (const void*)mk_fwd, NWAVES * 64, LDS_BYTES) != hipSuccess || per_cu < 1) fprintf(stderr, "kernel_launch: occupancy query reports %d\n", per_cu);
        (void)hipGetLastError();
        grid = cus;
        if (grid != 256) fprintf(stderr, "kernel_launch: %d CUs (built for 256)\n", grid);
    }
    if (grid < 0) return;
    const float* x_in = (const float*)d_in[0]; const float* norm_mix = (const float*)d_in[1]; const float* w_in = (const float*)d_in[2];
    const float* attn_lambda = (const float*)d_in[3]; const float* attn_subln = (const float*)d_in[4];
    const float* ssm_lam_re = (const float*)d_in[5]; const float* ssm_lam_im = (const float*)d_in[6]; const float* ssm_log_dt = (const float*)d_in[7];
    const float* ssm_b_re = (const float*)d_in[8]; const float* ssm_b_im = (const float*)d_in[9]; const float* ssm_c_re = (const float*)d_in[10]; const float* ssm_c_im = (const float*)d_in[11];
    const float* ssm_d = (const float*)d_in[12]; const float* w_glu = (const float*)d_in[13]; const float* w_branch = (const float*)d_in[14]; const float* w_out = (const float*)d_in[15];
    const float* norm_ffn = (const float*)d_in[16]; const float* ffn_w1 = (const float*)d_in[17]; const float* ffn_w3 = (const float*)d_in[18]; const float* ffn_w2 = (const float*)d_in[19];
    const float* moe_router = (const float*)d_in[20]; const float* moe_w1 = (const float*)d_in[21]; const float* moe_w3 = (const float*)d_in[22]; const float* moe_w2 = (const float*)d_in[23];
    const float* norm_final = (const float*)d_in[24];
    unsigned char* ws = (unsigned char*)d_ws; float* X = (float*)d_out;
    bf16* XN = (bf16*)(ws + WS_XN); bf16* Q = (bf16*)(ws + WS_Q); bf16* Kb = (bf16*)(ws + WS_K); bf16* V = (bf16*)(ws + WS_V); bf16* G = (bf16*)(ws + WS_G);
    bf16* AY = (bf16*)(ws + WS_AY); float* XLOC = (float*)(ws + WS_XLOC); bf16* AS2 = (bf16*)(ws + WS_AS2); bf16* H = (bf16*)(ws + WS_H);
    bf16* SACT = (bf16*)(ws + WS_SACT); bf16* MERGED = (bf16*)(ws + WS_MERGED);
    float* TMP = (float*)(ws + WS_END);
    if (hipMemsetAsync(ws + WS_CTL, 0, CTL_ZERO_BYTES, stream) != hipSuccess) { fprintf(stderr, "kernel_launch: memset failed\n"); return; }
    Args a{};
    for (int i = 0; i < 25; ++i) a.in[i] = (const float*)d_in[i];
    a.out = X; a.ws = ws;
    for (int j = 0; j < 32; ++j) a.inv_freq[j] = pow(10000.0, -(double)j / 32.0);
    constexpr int OM = OPT_MASK;
    if (ONE_LAUNCH) { launch_mk(a, 0, PH_END, 1 | 2 | 4 | 8, grid, stream); return; }
    constexpr bool o_norm = OM & 1, o_inproj = OM & 2, o_ssm = OM & 4, o_attn = OM & 8, o_glu = OM & 16, o_branch = OM & 32, o_out = OM & 64, o_ffn = OM & 256, o_moe = OM & 512;
    static_assert(!o_moe || o_norm, "optimized MoE needs the optimized norms");
    const int sub_c = o_moe ? 4 : 0;
    (void)hipMemcpyAsync(X, x_in, (size_t)NTOK * D_MODEL * 4, hipMemcpyDeviceToDevice, stream);
    if (OM & ~1) launch_mk(a, PH_PRO, PH_PRO + 1, 0, grid, stream);
    for (int layer = 0; layer < DEPTH; ++layer) {
        const int pb = PH_L0 + layer * PH_PER_LAYER, i = layer / 2;
        const float lam_init = 0.8f - 0.6f * expf(-0.3f * (float)layer);
        if (o_norm) launch_mk(a, pb + P_NORM1, pb + P_NORM1 + 1, sub_c, grid, stream);
        else k_norm<<<NTOK / 4, 256, 0, stream>>>(X, norm_mix + layer * D_MODEL, XN, nullptr, nullptr, nullptr);
        if (o_inproj) launch_mk(a, pb + P_INPROJ, pb + P_INPROJ + 1, 0, grid, stream);
        else { NEpiInProj e{Q, Kb, V, AY, G};
          k_ngemm<NEpiInProj, false><<<dim3(IN_W / 128, NTOK / 128), 256, 0, stream>>>(XN, D_MODEL, w_in + (size_t)layer * D_MODEL * IN_W, nullptr, IN_W, D_MODEL, e); }
        if (o_ssm) { launch_mk(a, pb + P_XLOC, pb + P_XLOC + 1, 0, grid, stream); launch_mk(a, pb + P_SCAN, pb + P_SCAN + 1, 0, grid, stream); launch_mk(a, pb + P_MIX, pb + P_MIX + 1, 1, grid, stream); }
        else { const size_t po = (size_t)layer * 2 * SSM_G * SSM_P;
          k_nssm<<<BATCH * SSM_G, 64, 0, stream>>>(AY, XLOC, SACT, ssm_lam_re + po, ssm_lam_im + po, ssm_log_dt + layer * 2 * SSM_G,
                                                   ssm_b_re + po * 16, ssm_b_im + po * 16, ssm_c_re + po * 16, ssm_c_im + po * 16, ssm_d + layer * SSM_W); }
        if (o_attn) launch_mk(a, pb + P_MIX, pb + P_MIX + 1, 2, grid, stream);
        else k_nattn<<<dim3(SEQ / 64, NHEAD, BATCH), 128, 0, stream>>>(Q, Kb, V, AS2, attn_lambda + layer * 4 * HD, attn_subln + layer * VD, lam_init);
        if (o_glu) launch_mk(a, pb + P_GLU, pb + P_GLU + 1, 0, grid, stream);
        else { NEpiGlu e{SACT, AS2};
          k_ngemm<NEpiGlu, false><<<dim3(SSM_W / 128, NTOK / 128), 256, 0, stream>>>(SACT, SSM_W, w_glu + (size_t)layer * SSM_W * SSM_W, nullptr, SSM_W, SSM_W, e); }
        if (o_branch) launch_mk(a, pb + P_BRANCH, pb + P_BRANCH + 1, 0, grid, stream);
        else { NEpiBranch e0{G, TMP, MERGED, 0, 0}, e1{G, TMP, MERGED, 1, 0};
            const float* wbp = w_branch + (size_t)layer * 2 * 512 * 1024;
            k_ngemm<NEpiBranch, false><<<dim3(1024 / 128, NTOK / 128), 256, 0, stream>>>(AS2, 1024, wbp, nullptr, 1024, 512, e0);
            k_ngemm<NEpiBranch, false><<<dim3(1024 / 128, NTOK / 128), 256, 0, stream>>>(AS2 + 512, 1024, wbp + 512 * 1024, nullptr, 1024, 512, e1); }
        if (o_out) launch_mk(a, pb + P_OUT, pb + P_OUT + 1, 0, grid, stream);
        else { NEpiRes e{X, nullptr, nullptr, 0, 0};
          k_ngemm<NEpiRes, false><<<dim3(1024 / 128, NTOK / 128), 256, 0, stream>>>(MERGED, 1024, w_out + (size_t)layer * 1024 * 1024, nullptr, 1024, 1024, e); }
        int* asg_e = (int*)(ws + WS_ROUTE + (size_t)i * 512 * 1024); float* asg_g = (float*)(asg_e + 2 * 32768);
        if (layer % 2 == 0) {
            if (o_norm) launch_mk(a, pb + P_NORM2, pb + P_NORM2 + 1, 0, grid, stream);
            else k_norm<<<NTOK / 4, 256, 0, stream>>>(X, norm_ffn + layer * D_MODEL, XN, nullptr, nullptr, nullptr);
            if (o_ffn) { launch_mk(a, pb + P_UP, pb + P_UP + 1, 0, grid, stream); launch_mk(a, pb + P_DOWN, pb + P_DOWN + 1, 0, grid, stream); }
            else {
              { NEpiSwiglu e{H};
                k_ngemm<NEpiSwiglu, true><<<dim3(D_FF / 128, NTOK / 128), 256, 0, stream>>>(XN, D_MODEL, ffn_w1 + (size_t)i * D_MODEL * D_FF, ffn_w3 + (size_t)i * D_MODEL * D_FF, D_FF, D_MODEL, e); }
              { NEpiRes e{X, nullptr, nullptr, 0, 0};
                k_ngemm<NEpiRes, false><<<dim3(1024 / 128, NTOK / 128), 256, 0, stream>>>(H, D_FF, ffn_w2 + (size_t)i * D_FF * D_MODEL, nullptr, D_MODEL, D_FF, e); }
            }
        } else {
            if (o_norm) launch_mk(a, pb + P_NORM2, pb + P_NORM2 + 1, o_moe ? 8 : 0, grid, stream);
            else k_norm<<<NTOK / 4, 256, 0, stream>>>(X, norm_ffn + layer * D_MODEL, XN, moe_router + (size_t)i * D_MODEL * N_EXP, asg_e, asg_g);
            if (o_moe) { launch_mk(a, pb + P_ASSIGN, pb + P_ASSIGN + 1, 0, grid, stream); launch_mk(a, pb + P_UP, pb + P_UP + 1, 0, grid, stream); launch_mk(a, pb + P_DOWN, pb + P_DOWN + 1, 0, grid, stream); }
            else for (int ex = 0; ex < N_EXP; ++ex) {
                const size_t wo = ((size_t)i * N_EXP + ex) * D_MODEL * D_FF;
                { NEpiSwiglu e{H};
                  k_ngemm<NEpiSwiglu, true><<<dim3(D_FF / 128, NTOK / 128), 256, 0, stream>>>(XN, D_MODEL, moe_w1 + wo, moe_w3 + wo, D_FF, D_MODEL, e); }
                { NEpiRes e{X, asg_e, asg_g, ex, 0};
                  k_ngemm<NEpiRes, false><<<dim3(1024 / 128, NTOK / 128), 256, 0, stream>>>(H, D_FF, moe_w2 + wo, nullptr, D_MODEL, D_FF, e); }
            }
        }
    }
    if (o_norm) launch_mk(a, PH_FINAL, PH_FINAL + 1, sub_c, grid, stream);
    else k_final_norm<<<NTOK / 4, 256, 0, stream>>>(X, norm_final);
}
```

```cpp
#include <hip/hip_runtime.h>
#include <cstdio>
#include <cstdint>
#include <cmath>

constexpr int D_MODEL = 1024, BATCH = 2, SEQ = 8192, DEPTH = 4, NTOK = BATCH * SEQ;
constexpr int NHEAD = 4, HD = 64, VD = 128;
constexpr int SSM_G = 32, SSM_CH = 16, SSM_P = 64, SSM_W = 512;
constexpr int IN_W = 4096, OFF_K = 512, OFF_V = 1024, OFF_U = 1536, OFF_G = 2048;
constexpr int D_FF = 2816, N_EXP = 8;
constexpr float RMS_EPS = 1e-6f;
constexpr int CHL = 16;
constexpr int NCH = SEQ / CHL;

typedef unsigned short bf16;
typedef float f32x4 __attribute__((ext_vector_type(4)));

constexpr size_t MiB = 1u << 20;
constexpr size_t WS_CTL = 0;
constexpr size_t WS_WEIGHTS = 1 * MiB;
constexpr size_t WS_XN = 267 * MiB;
constexpr size_t WS_R1 = WS_XN + 32 * MiB;
constexpr size_t WS_Q = WS_R1, WS_K = WS_Q + 16 * MiB, WS_V = WS_K + 16 * MiB, WS_G = WS_V + 16 * MiB;
constexpr size_t WS_AY = WS_G + 64 * MiB, WS_XLOC = WS_AY + 32 * MiB, WS_AS2 = WS_XLOC + 32 * MiB;
constexpr size_t WS_H = WS_R1;
constexpr size_t WS_R2 = WS_R1 + 208 * MiB;
constexpr size_t WS_SACT = WS_R2, WS_MERGED = WS_SACT + 16 * MiB, WS_O1 = WS_MERGED + 32 * MiB;
constexpr size_t WS_ROUTE = WS_R2 + 80 * MiB;
constexpr size_t WS_PART = WS_ROUTE + 1 * MiB;
constexpr size_t WS_PS = WS_PART + 48 * MiB;
constexpr size_t WS_END = WS_PS + 1 * MiB;

__device__ __forceinline__ float bf2f(bf16 v) { return __uint_as_float(((unsigned)v) << 16); }
__device__ __forceinline__ bf16 f2bf(float f) { unsigned u = __float_as_uint(f); return (bf16)((u + 0x7fffu + ((u >> 16) & 1u)) >> 16); }
__device__ __forceinline__ float wave_sum(float v) {
#pragma unroll
    for (int o = 1; o < 64; o <<= 1) v += __shfl_xor(v, o);
    return v;
}
__device__ __forceinline__ float sigmoidf_(float x) { return 1.f / (1.f + __expf(-x)); }
__host__ __device__ __forceinline__ int qk_pos(int d) { const int j = d & 31, n = d >> 5; return 32 * (j >> 4) + 8 * ((j & 15) >> 2) + 4 * n + (j & 3); }
__device__ __forceinline__ size_t q_index(int b, int h, int c, int s, int d) { return ((((size_t)b * NHEAD + h) * 2 + c) * SEQ + s) * HD + qk_pos(d); }
__device__ __forceinline__ size_t v_index(int b, int h, int s, int e) { return (((size_t)b * NHEAD + h) * SEQ + s) * VD + e; }
__device__ __forceinline__ size_t ay_index(int g, int b, int s, int hh) { return (((size_t)g * (BATCH * NCH)) + b * NCH + (s / CHL)) * 512 + (s % CHL) * SSM_CH + hh; }

__global__ __launch_bounds__(256) void k_norm(const float* __restrict__ x, const float* __restrict__ g, bf16* __restrict__ xn,
                                             const float* __restrict__ wr, int* __restrict__ top_e, float* __restrict__ top_g) {
    const int lane = threadIdx.x & 63, row = blockIdx.x * 4 + (threadIdx.x >> 6);
    const f32x4* xr = (const f32x4*)(x + (size_t)row * D_MODEL) + lane;
    f32x4 v[4]; float s = 0.f;
#pragma unroll
    for (int j = 0; j < 4; ++j) { v[j] = xr[64 * j]; s += (v[j].x * v[j].x + v[j].y * v[j].y) + (v[j].z * v[j].z + v[j].w * v[j].w); }
    const float rstd = rsqrtf(wave_sum(s) * (1.f / D_MODEL) + RMS_EPS);
    float lg[N_EXP];
#pragma unroll
    for (int e = 0; e < N_EXP; ++e) lg[e] = 0.f;
#pragma unroll
    for (int j = 0; j < 4; ++j) {
        const f32x4 gg = ((const f32x4*)g)[64 * j + lane];
        v[j].x *= rstd * gg.x; v[j].y *= rstd * gg.y; v[j].z *= rstd * gg.z; v[j].w *= rstd * gg.w;
        unsigned long long o = (unsigned long long)f2bf(v[j].x) | ((unsigned long long)f2bf(v[j].y) << 16) | ((unsigned long long)f2bf(v[j].z) << 32) | ((unsigned long long)f2bf(v[j].w) << 48);
        ((unsigned long long*)(xn + (size_t)row * D_MODEL))[64 * j + lane] = o;
        if (wr) {
            const int k0 = (64 * j + lane) * 4;
#pragma unroll
            for (int e = 0; e < N_EXP; ++e) lg[e] += v[j].x * wr[(k0 + 0) * N_EXP + e] + v[j].y * wr[(k0 + 1) * N_EXP + e] + v[j].z * wr[(k0 + 2) * N_EXP + e] + v[j].w * wr[(k0 + 3) * N_EXP + e];
        }
    }
    if (wr) {
#pragma unroll
        for (int e = 0; e < N_EXP; ++e) lg[e] = wave_sum(lg[e]);
        int e0 = 0; float l0 = lg[0];
#pragma unroll
        for (int e = 1; e < N_EXP; ++e) if (lg[e] > l0) { l0 = lg[e]; e0 = e; }
        int e1 = -1; float l1 = -3.4e38f;
#pragma unroll
        for (int e = 0; e < N_EXP; ++e) if (e != e0 && lg[e] > l1) { l1 = lg[e]; e1 = e; }
        const float p1 = __expf(l1 - l0), inv = 1.f / (1.f + p1);
        if (lane == 0) { top_e[row * 2] = e0; top_e[row * 2 + 1] = e1; top_g[row * 2] = inv; top_g[row * 2 + 1] = p1 * inv; }
    }
}

__global__ __launch_bounds__(256) void k_final_norm(float* __restrict__ x, const float* __restrict__ g) {
    const int lane = threadIdx.x & 63, row = blockIdx.x * 4 + (threadIdx.x >> 6);
    f32x4* xr = (f32x4*)(x + (size_t)row * D_MODEL) + lane;
    f32x4 v[4]; float s = 0.f;
#pragma unroll
    for (int j = 0; j < 4; ++j) { v[j] = xr[64 * j]; s += (v[j].x * v[j].x + v[j].y * v[j].y) + (v[j].z * v[j].z + v[j].w * v[j].w); }
    const float rstd = rsqrtf(wave_sum(s) * (1.f / D_MODEL) + RMS_EPS);
#pragma unroll
    for (int j = 0; j < 4; ++j) { const f32x4 gg = ((const f32x4*)g)[64 * j + lane]; f32x4 o = {v[j].x * rstd * gg.x, v[j].y * rstd * gg.y, v[j].z * rstd * gg.z, v[j].w * rstd * gg.w}; xr[64 * j] = o; }
}

template <class Epi, bool DUAL>
__global__ __launch_bounds__(256) void k_ngemm(const bf16* __restrict__ A, int lda, const float* __restrict__ W, const float* __restrict__ W2, int ldw, int K, Epi epi) {
    __shared__ float As[16][132];
    __shared__ float Bs[16][128];
    __shared__ float Bs2[DUAL ? 16 : 1][128];
    const int tid = threadIdx.x, tx = tid & 15, ty = tid >> 4;
    const int m0 = blockIdx.y * 128, n0 = blockIdx.x * 128;
    float acc[8][8], acc2[DUAL ? 8 : 1][8];
#pragma unroll
    for (int i = 0; i < 8; ++i)
#pragma unroll
        for (int j = 0; j < 8; ++j) { acc[i][j] = 0.f; if (DUAL) acc2[i][j] = 0.f; }
    const int ar = tid >> 1, ak = (tid & 1) * 8;
    const int bk = tid >> 4, bn = (tid & 15) * 8;
    for (int k0 = 0; k0 < K; k0 += 16) {
        const uint4 av = *(const uint4*)(A + (size_t)(m0 + ar) * lda + k0 + ak);
        const unsigned aw[4] = {av.x, av.y, av.z, av.w};
#pragma unroll
        for (int q = 0; q < 4; ++q) { As[ak + 2 * q][ar] = __uint_as_float(aw[q] << 16); As[ak + 2 * q + 1][ar] = __uint_as_float(aw[q] & 0xffff0000u); }
        const f32x4 b0 = *(const f32x4*)(W + (size_t)(k0 + bk) * ldw + n0 + bn), b1 = *(const f32x4*)(W + (size_t)(k0 + bk) * ldw + n0 + bn + 4);
        *(f32x4*)&Bs[bk][bn] = b0; *(f32x4*)&Bs[bk][bn + 4] = b1;
        if (DUAL) { const f32x4 c0 = *(const f32x4*)(W2 + (size_t)(k0 + bk) * ldw + n0 + bn), c1 = *(const f32x4*)(W2 + (size_t)(k0 + bk) * ldw + n0 + bn + 4);
            *(f32x4*)&Bs2[bk][bn] = c0; *(f32x4*)&Bs2[bk][bn + 4] = c1; }
        __syncthreads();
#pragma unroll
        for (int k = 0; k < 16; ++k) {
            float a[8], b[8], b2[8];
#pragma unroll
            for (int i = 0; i < 8; ++i) a[i] = As[k][ty * 8 + i];
#pragma unroll
            for (int j = 0; j < 8; ++j) { b[j] = Bs[k][tx * 2 + (j & 1) + 32 * (j >> 1)]; if (DUAL) b2[j] = Bs2[k][tx * 2 + (j & 1) + 32 * (j >> 1)]; }
#pragma unroll
            for (int i = 0; i < 8; ++i)
#pragma unroll
                for (int j = 0; j < 8; ++j) { acc[i][j] += a[i] * b[j]; if (DUAL) acc2[i][j] += a[i] * b2[j]; }
        }
        __syncthreads();
    }
#pragma unroll
    for (int i = 0; i < 8; ++i) { if constexpr (DUAL) epi.row2(m0 + ty * 8 + i, n0, tx, acc[i], acc2[i]); else epi.row(m0 + ty * 8 + i, n0, tx, acc[i]); }
}
#define NG_COL(n0, tx, jj) ((n0) + (tx) * 2 + ((jj) & 1) + 32 * ((jj) >> 1))

struct NEpiInProj {
    bf16 *Q, *Kb, *V, *AY, *G;
    __device__ void row(int m, int n0, int tx, const float (&a)[8]) const {
        const int b = m / SEQ, s = m % SEQ;
        if (n0 < OFF_V) {
            bf16* dst = n0 < OFF_K ? Q : Kb; const int h = (n0 % 512) / 128;
#pragma unroll
            for (int c = 0; c < 2; ++c)
#pragma unroll
                for (int e = 0; e < 2; ++e) {
                    const int j = tx * 2 + e;
                    const float x1 = a[c * 4 + e], x2 = a[c * 4 + 2 + e];
                    const double ang = (double)s * pow(10000.0, -(double)j / 32.0);
                    const float sn = (float)sin(ang), cs = (float)cos(ang);
                    dst[q_index(b, h, c, s, j)] = f2bf(x1 * cs - x2 * sn);
                    dst[q_index(b, h, c, s, j + 32)] = f2bf(x2 * cs + x1 * sn);
                }
        } else {
#pragma unroll
            for (int jj = 0; jj < 8; ++jj) {
                const int n = NG_COL(n0, tx, jj);
                if (n < OFF_U) { const int h = (n - OFF_V) / VD, e = (n - OFF_V) % VD; V[v_index(b, h, s, e)] = f2bf(a[jj]); }
                else if (n < OFF_G) { const int g = (n - OFF_U) / SSM_CH, hh = (n - OFF_U) % SSM_CH; AY[ay_index(g, b, s, hh)] = f2bf(a[jj]); }
                else G[(size_t)m * 2048 + (n - OFF_G)] = f2bf(sigmoidf_(a[jj]));
            }
        }
    }
};
struct NEpiGlu {
    const bf16* SACT; bf16* AS2;
    __device__ void row(int m, int n0, int tx, const float (&a)[8]) const {
#pragma unroll
        for (int jj = 0; jj < 8; ++jj) { const int n = NG_COL(n0, tx, jj); AS2[(size_t)m * 1024 + 512 + n] = f2bf(bf2f(SACT[(size_t)m * 512 + n]) * sigmoidf_(a[jj])); }
    }
};
struct NEpiBranch {
    const bf16* G; float* TMP; bf16* MERGED; int second, pad;
    __device__ void row(int m, int n0, int tx, const float (&a)[8]) const {
#pragma unroll
        for (int jj = 0; jj < 8; ++jj) { const int n = NG_COL(n0, tx, jj);
            if (!second) TMP[(size_t)m * 1024 + n] = bf2f(G[(size_t)m * 2048 + n]) * a[jj];
            else MERGED[(size_t)m * 1024 + n] = f2bf(TMP[(size_t)m * 1024 + n] + bf2f(G[(size_t)m * 2048 + 1024 + n]) * a[jj]); }
    }
};
struct NEpiRes {
    float* X; const int* top_e; const float* top_g; int e, pad;
    __device__ void row(int m, int n0, int tx, const float (&a)[8]) const {
        float gt = 1.f;
        if (top_e) { gt = 0.f; if (top_e[m * 2] == e) gt = top_g[m * 2]; else if (top_e[m * 2 + 1] == e) gt = top_g[m * 2 + 1]; if (gt == 0.f) return; }
#pragma unroll
        for (int jj = 0; jj < 8; ++jj) { const int n = NG_COL(n0, tx, jj); X[(size_t)m * 1024 + n] += gt * a[jj]; }
    }
};
struct NEpiSwiglu {
    bf16* H;
    __device__ void row2(int m, int n0, int tx, const float (&a)[8], const float (&b)[8]) const {
#pragma unroll
        for (int jj = 0; jj < 8; ++jj) { const int n = NG_COL(n0, tx, jj); H[(size_t)m * D_FF + n] = f2bf(a[jj] * sigmoidf_(a[jj]) * b[jj]); }
    }
};

__global__ __launch_bounds__(128) void k_nattn(const bf16* __restrict__ Q, const bf16* __restrict__ Kb, const bf16* __restrict__ V, bf16* __restrict__ AS2,
                                              const float* __restrict__ lam_p, const float* __restrict__ subln, float lam_init) {
    __shared__ float Ks[32][64];
    __shared__ float Vs[32][128];
    __shared__ float ssq[2][64];
    const int tid = threadIdx.x, r = tid & 63, vh = tid >> 6;
    const int b = blockIdx.z, h = blockIdx.y, s = blockIdx.x * 64 + r;
    float d01 = 0.f, d23 = 0.f;
    for (int i = 0; i < HD; ++i) { d01 += lam_p[i] * lam_p[HD + i]; d23 += lam_p[2 * HD + i] * lam_p[3 * HD + i]; }
    const float lam = __expf(d01) - __expf(d23) + lam_init;
    float res[64];
#pragma unroll
    for (int e = 0; e < 64; ++e) res[e] = 0.f;
    for (int c = 0; c < 2; ++c) {
        float q[64], o[64];
        const bf16* qp = Q + ((((size_t)b * NHEAD + h) * 2 + c) * SEQ + s) * HD;
#pragma unroll
        for (int d = 0; d < 64; ++d) { q[d] = bf2f(qp[d]) * 0.125f; o[d] = 0.f; }
        float mx = -1e30f, l = 0.f;
        const bf16* kp = Kb + ((((size_t)b * NHEAD + h) * 2 + c) * SEQ) * HD;
        const bf16* vp = V + (((size_t)b * NHEAD + h) * SEQ) * VD;
        for (int k0 = 0; k0 < SEQ; k0 += 32) {
            __syncthreads();
            for (int i = tid; i < 32 * 64; i += 128) Ks[i / 64][i % 64] = bf2f(kp[(size_t)k0 * HD + i]);
            for (int i = tid; i < 32 * 128; i += 128) Vs[i / 128][i % 128] = bf2f(vp[(size_t)k0 * VD + i]);
            __syncthreads();
            float sc[32]; float tm = mx;
#pragma unroll
            for (int j = 0; j < 32; ++j) { float a = 0.f;
#pragma unroll
                for (int d = 0; d < 64; ++d) a += q[d] * Ks[j][d];
                sc[j] = a; tm = fmaxf(tm, a); }
            const float alpha = __expf(mx - tm); mx = tm; l *= alpha;
#pragma unroll
            for (int e = 0; e < 64; ++e) o[e] *= alpha;
#pragma unroll
            for (int j = 0; j < 32; ++j) { const float p = __expf(sc[j] - mx); l += p;
#pragma unroll
                for (int e = 0; e < 64; ++e) o[e] += p * Vs[j][vh * 64 + e]; }
        }
        const float il = (c == 0 ? 1.f : -lam) / l;
#pragma unroll
        for (int e = 0; e < 64; ++e) res[e] += o[e] * il;
    }
    float sq = 0.f;
#pragma unroll
    for (int e = 0; e < 64; ++e) sq += res[e] * res[e];
    ssq[vh][r] = sq;
    __syncthreads();
    const float rstd = rsqrtf((ssq[0][r] + ssq[1][r]) * (1.f / VD) + RMS_EPS) * (1.f - lam_init);
    bf16* op = AS2 + (size_t)(b * SEQ + s) * 1024 + h * VD + vh * 64;
#pragma unroll
    for (int e = 0; e < 64; ++e) op[e] = f2bf(res[e] * rstd * subln[vh * 64 + e]);
}

__global__ __launch_bounds__(64) void k_nssm(const bf16* __restrict__ AY, float* __restrict__ Y, bf16* __restrict__ SACT,
                                            const float* __restrict__ lam_re, const float* __restrict__ lam_im, const float* __restrict__ log_dt,
                                            const float* __restrict__ b_re, const float* __restrict__ b_im, const float* __restrict__ c_re, const float* __restrict__ c_im,
                                            const float* __restrict__ dsk) {
    const int p = threadIdx.x, g = blockIdx.x % SSM_G, b = blockIdx.x / SSM_G;
    for (int dir = 0; dir < 2; ++dir) {
        const size_t pi = ((size_t)dir * SSM_G + g) * SSM_P + p;
        const float lr = lam_re[pi], li = lam_im[pi], dt = __expf(log_dt[dir * SSM_G + g]);
        const float er = expf(lr * dt); float sn, cs; sincosf(li * dt, &sn, &cs);
        const float ar = er * cs, ai = er * sn;
        const float nr = ar - 1.f, ni = ai, den = lr * lr + li * li;
        const float fr = (nr * lr + ni * li) / den, fi = (ni * lr - nr * li) / den;
        float bbr[16], bbi[16], cr[16], ci[16];
#pragma unroll
        for (int hh = 0; hh < 16; ++hh) { const float br = b_re[pi * 16 + hh], bi = b_im[pi * 16 + hh]; bbr[hh] = fr * br - fi * bi; bbi[hh] = fr * bi + fi * br;
            const size_t cidx = (((size_t)dir * SSM_G + g) * SSM_CH + hh) * SSM_P + p; cr[hh] = c_re[cidx]; ci[hh] = c_im[cidx]; }
        float xr = 0.f, xi = 0.f;
        for (int step = 0; step < SEQ; ++step) {
            const int s = dir == 0 ? step : SEQ - 1 - step;
            const bf16* up = AY + ay_index(g, b, s, 0);
            float u[16];
#pragma unroll
            for (int hh = 0; hh < 16; ++hh) u[hh] = bf2f(up[hh]);
            float br = 0.f, bi = 0.f;
#pragma unroll
            for (int hh = 0; hh < 16; ++hh) { br += bbr[hh] * u[hh]; bi += bbi[hh] * u[hh]; }
            const float nxr = ar * xr - ai * xi + br, nxi = ar * xi + ai * xr + bi; xr = nxr; xi = nxi;
            float mine = 0.f;
#pragma unroll
            for (int hh = 0; hh < 16; ++hh) { const float t = wave_sum(cr[hh] * xr - ci[hh] * xi); if (p == hh) mine = t; }
            if (p < 16) {
                const size_t yi = (size_t)(b * SEQ + s) * SSM_W + g * SSM_CH + p;
                if (dir == 0) Y[yi] = u[p] * dsk[g * SSM_CH + p] + mine;
                else { const float y = Y[yi] + mine; SACT[yi] = f2bf(0.5f * y * (1.f + erff(y * 0.70710678118654752f))); }
            }
        }
    }
}


#define GAS __attribute__((address_space(1)))
#define LAS __attribute__((address_space(3)))
namespace pg8 {
#define PG8_LAS __attribute__((address_space(3)))
typedef unsigned short bf16_t;
typedef short bf16x8 __attribute__((ext_vector_type(8)));
typedef float f32x4 __attribute__((ext_vector_type(4)));
typedef unsigned u32x4 __attribute__((ext_vector_type(4)));
constexpr int BM = 256, BK = 64, HALF = 128, HTB = HALF * BK * 2  , STAGE_BYTES = 8 * HTB, NXCD = 8, WGM = 8;

__host__ __device__ __forceinline__ int lds_byte(int r, int c) { const int st = (r >> 4) * 2 + (c >> 5), rr = r & 15, cc = c & 31, ob = rr * 64 + cc * 2; return st * 1024 + (ob ^ (((ob >> 9) & 1) << 5)); }
__host__ __device__ __forceinline__ void stage_rc(int b, int& R, int& C) { const int st = b / 1024, sb = b % 1024, swz = sb ^ (((sb >> 9) & 1) << 5); R = (st >> 1) * 16 + swz / 64; C = (st & 1) * 32 + (swz % 64) / 2; }
__host__ __device__ __forceinline__ int perm32(int rho) { const int n = rho >> 4, i = rho & 15; return 8 * (i >> 2) + 4 * n + (i & 3); }

struct Unit { int pm, pn; int ko = 0, aux = 0, nk = 0; };
struct Gemm { const bf16_t* A; const bf16_t* Bt; };

struct StaticOrder {
    int nM, nN, nwg, G, c;
    __host__ __device__ void init(int M, int N, int G_, int c_) { nM = M / BM; nN = N / BM; nwg = nM * nN; G = G_; c = c_; }
    __host__ __device__ void map(int L, Unit& u) const {
        int wgid = L; { const int q = nwg / NXCD, r = nwg % NXCD, xcd = wgid % NXCD, off = wgid / NXCD; wgid = (xcd < r ? xcd * (q + 1) : r * (q + 1) + (xcd - r) * q) + off; }
        const int nig = WGM * nN, gid = wgid / nig, fm = gid * WGM, gsz = (nM - fm) < WGM ? (nM - fm) : WGM;
        u.pm = fm + ((wgid % nig) % gsz); u.pn = (wgid % nig) / gsz;
    }
    __host__ __device__ bool next(int i, Unit& u) const {
        const long L = (long)i * G + c; if (L >= nwg) return false;
        map((int)L, u); return true;
    }
    __device__ __forceinline__ void a_ready(const Unit&) const {}
    __device__ __forceinline__ void done(const Unit&) const {}
};


template <int NM, int NN> struct StaticOrderT {
    int c;
    __device__ __forceinline__ bool next(int i, Unit& u) const {
        constexpr int nwg = NM * NN, q = nwg / NXCD, r = nwg % NXCD; const int L = i * 256 + c; if (L >= nwg) return false;
        int wgid = L; { const int xcd = wgid % NXCD, off = wgid / NXCD; wgid = (xcd < r ? xcd * (q + 1) : r * (q + 1) + (xcd - r) * q) + off; }
        constexpr int nig = WGM * NN; const int gid = wgid / nig, fm = gid * WGM, gsz = (NM - fm) < WGM ? (NM - fm) : WGM;
        u.pm = fm + ((wgid % nig) % gsz); u.pn = (wgid % nig) / gsz; return true;
    }
    __device__ __forceinline__ void a_ready(const Unit&) const {}
    __device__ __forceinline__ void done(const Unit&) const {}
};
typedef __bf16 bf16x2_cv __attribute__((ext_vector_type(2))); typedef float f32x2_cv __attribute__((ext_vector_type(2)));
__device__ __forceinline__ unsigned cvt_pk_bf16(float lo, float hi) { const bf16x2_cv r = __builtin_convertvector((f32x2_cv){lo, hi}, bf16x2_cv); return __builtin_bit_cast(unsigned, r); }
typedef float f32x2 __attribute__((ext_vector_type(2)));
__device__ __forceinline__ f32x2 gelu_pk(f32x2 v) {
    const f32x2 av = __builtin_elementwise_abs(v), d = av * 0.2316418882f + 1.0f;
    f32x2 t; t.x = __builtin_amdgcn_rcpf(d.x); t.y = __builtin_amdgcn_rcpf(d.y);
    f32x2 q = t * 0.5307027145f + (-0.7265760135f); q = q * t + 0.7107068705f; q = q * t + (-0.142248368f); q = q * t + 0.127414796f; q = q * t;
    const f32x2 s = (v * v) * (-0.72134752044f);
    f32x2 e; e.x = __builtin_amdgcn_exp2f(s.x); e.y = __builtin_amdgcn_exp2f(s.y);
    const f32x2 m = v * (q * e), r = v - m;
    f32x2 o; o.x = v.x < 0.f ? m.x : r.x; o.y = v.y < 0.f ? m.y : r.y; return o;
}

template <class Epi, class Sched, int LDA, int LDB, int KK, bool ALIGN_EPI = true, bool SP2 = true>
__device__ __forceinline__ void gemm_phase(PG8_LAS unsigned char* lds, const Gemm g, const Sched& S, const Epi& E) {
    int tid_l = threadIdx.x; asm volatile("" : "+v"(tid_l));
    const int tid = tid_l, wid = __builtin_amdgcn_readfirstlane(tid >> 6), lane = tid & 63, wr = wid >> 2, wc = wid & 3, fr = lane & 15, fq = lane >> 4;
    static_assert(KK % 128 == 0, "K multiple of 128");
    unsigned voffA[2], voffB[2];
#pragma unroll
    for (int i = 0; i < 2; ++i) { int R, C; stage_rc(tid * 16 + i * 8192, R, C); const int Rb = Epi::PERM ? ((R & ~31) + perm32(R & 31)) : R;
        voffA[i] = (unsigned)(R * LDA + C) * 2u; voffB[i] = (unsigned)(Rb * LDB + C) * 2u; }
    constexpr size_t kstep = (size_t)(BK * 2);
    constexpr size_t hstepA = (size_t)HALF * LDA * 2, hstepB = (size_t)HALF * LDB * 2;
    constexpr size_t tstepA = 2 * hstepA, tstepB = 2 * hstepB;
    const unsigned ldsw = (unsigned)wid * 1024u;
    const int aoff = lds_byte(wr * 64 + fr, fq * 8), boff = lds_byte(wc * 32 + fr, fq * 8);
#define PG8_SA(b, h) (((b) * 2 + (h)) * HTB)
#define PG8_SB(b, h) ((4 + (b) * 2 + (h)) * HTB)
#define PG8_STAGE(bufoff, gbase, voff) do { _Pragma("unroll") for (int _i = 0; _i < 2; ++_i) \
        __builtin_amdgcn_global_load_lds((const unsigned*)((const char*)(gbase) + (voff)[_i]), (PG8_LAS unsigned*)(lds + (bufoff) + ldsw + _i * 8192), 16, 0, 0); } while (0)
#define PG8_LDA(dst, b, h) do { _Pragma("unroll") for (int m = 0; m < 4; ++m) _Pragma("unroll") for (int k = 0; k < 2; ++k) dst[m][k] = *(const PG8_LAS bf16x8*)(lds + PG8_SA(b, h) + aoff + m * 2048 + k * 1024); } while (0)
#define PG8_LDB(dst, b, h) do { _Pragma("unroll") for (int n = 0; n < 2; ++n) _Pragma("unroll") for (int k = 0; k < 2; ++k) dst[n][k] = *(const PG8_LAS bf16x8*)(lds + PG8_SB(b, h) + boff + n * 2048 + k * 1024); } while (0)
#define PG8_MMA(ai, bj, At, Bt) do { __builtin_amdgcn_s_setprio(1); _Pragma("unroll") for (int m = 0; m < 4; ++m) _Pragma("unroll") for (int n = 0; n < 2; ++n) _Pragma("unroll") for (int k = 0; k < 2; ++k) \
        acc[ai][bj][m][n] = __builtin_amdgcn_mfma_f32_16x16x32_bf16(Bt[n][k], At[m][k], acc[ai][bj][m][n], 0, 0, 0); __builtin_amdgcn_s_setprio(0); } while (0)
#define PG8_WAIT_V(n) asm volatile("s_waitcnt vmcnt(" #n ")" ::: "memory")
#define PG8_WAIT_L(n) asm volatile("s_waitcnt lgkmcnt(" #n ")" ::: "memory")
#define PG8_BAR __builtin_amdgcn_s_barrier()
#define PG8_SCHED __builtin_amdgcn_sched_barrier(0)
    Unit cur, nxt; int ui = 0;
    if (!S.next(0, cur)) return;
    f32x4 acc[2][2][4][2];
#pragma unroll
    for (int a = 0; a < 2; ++a)
#pragma unroll
        for (int b = 0; b < 2; ++b)
#pragma unroll
            for (int m = 0; m < 4; ++m)
#pragma unroll
                for (int n = 0; n < 2; ++n) acc[a][b][m][n] = (f32x4){0.f, 0.f, 0.f, 0.f};
    bf16x8 At[4][2], B0[2][2], B1[2][2];
    const char* cA = (const char*)g.A + (size_t)cur.pm * tstepA + cur.ko; const char* cB = (const char*)g.Bt + (size_t)cur.pn * tstepB + cur.ko;
    S.a_ready(cur);
    if constexpr (SP2) {
        PG8_STAGE(PG8_SB(0, 0), cB, voffB); PG8_STAGE(PG8_SB(0, 1), cB + hstepB, voffB); PG8_STAGE(PG8_SA(0, 0), cA, voffA); PG8_STAGE(PG8_SA(0, 1), cA + hstepA, voffA);
        if (wr == 1) PG8_BAR;
        PG8_WAIT_V(2); PG8_BAR;
        PG8_STAGE(PG8_SB(1, 0), cB + kstep, voffB); PG8_STAGE(PG8_SA(1, 0), cA + kstep, voffA); PG8_STAGE(PG8_SB(1, 1), cB + hstepB + kstep, voffB);
        PG8_WAIT_V(6); PG8_BAR;
    } else {
        PG8_STAGE(PG8_SB(0, 0), cB, voffB); PG8_STAGE(PG8_SA(0, 0), cA, voffA); PG8_STAGE(PG8_SB(0, 1), cB + hstepB, voffB); PG8_STAGE(PG8_SA(0, 1), cA + hstepA, voffA);
        if (wr == 1) PG8_BAR;
        PG8_WAIT_V(4); PG8_BAR;
        PG8_STAGE(PG8_SB(1, 0), cB + kstep, voffB); PG8_STAGE(PG8_SA(1, 0), cA + kstep, voffA); PG8_STAGE(PG8_SB(1, 1), cB + hstepB + kstep, voffB);
        PG8_WAIT_V(6); PG8_BAR;
    }
    for (;;) {
        const bool has_next = S.next(ui + 1, nxt);
        const char* nA = has_next ? (const char*)g.A + (size_t)nxt.pm * tstepA + nxt.ko : cA; const char* nB = has_next ? (const char*)g.Bt + (size_t)nxt.pn * tstepB + nxt.ko : cB;
        const int nt = KK > 0 ? KK / BK : cur.nk;
        for (int t = 0; t < nt; t += 2) {
            if constexpr (Epi::MIDHOOK) { if (t == nt / 2) E.mid(acc, cur, wr, wc, fr, fq); }
            const bool last = (t == nt - 2);
            const char* a1 = cA + (size_t)(t + 1) * kstep;
            const char* a2 = last ? nA : cA + (size_t)(t + 2) * kstep; const char* b2 = last ? nB : cB + (size_t)(t + 2) * kstep;
            const char* a3 = a2 + kstep; const char* b3 = b2 + kstep;
            if (last && has_next) S.a_ready(nxt);
            if constexpr (SP2) {
            PG8_LDB(B0, 0, 0); PG8_LDB(B1, 0, 1); PG8_SCHED; PG8_LDA(At, 0, 0); PG8_STAGE(PG8_SA(1, 1), a1 + hstepA, voffA);
            PG8_WAIT_V(8); PG8_WAIT_L(0); PG8_BAR; PG8_MMA(0, 0, At, B0); PG8_MMA(0, 1, At, B1); PG8_BAR; PG8_SCHED;
            PG8_LDA(At, 0, 1); PG8_STAGE(PG8_SB(0, 0), b2, voffB); PG8_STAGE(PG8_SB(0, 1), b2 + hstepB, voffB); PG8_STAGE(PG8_SA(0, 0), a2, voffA);
            PG8_WAIT_V(8); PG8_WAIT_L(0); PG8_BAR; PG8_MMA(1, 0, At, B0); PG8_MMA(1, 1, At, B1); PG8_BAR; PG8_SCHED;
            PG8_LDB(B0, 1, 0); PG8_LDB(B1, 1, 1); PG8_SCHED; PG8_LDA(At, 1, 0); PG8_STAGE(PG8_SA(0, 1), a2 + hstepA, voffA);
            PG8_WAIT_V(8); PG8_WAIT_L(0); PG8_BAR; PG8_MMA(0, 0, At, B0); PG8_MMA(0, 1, At, B1); PG8_BAR; PG8_SCHED;
            PG8_LDA(At, 1, 1); PG8_STAGE(PG8_SB(1, 0), b3, voffB); PG8_STAGE(PG8_SB(1, 1), b3 + hstepB, voffB); PG8_STAGE(PG8_SA(1, 0), a3, voffA);
            PG8_WAIT_V(8); PG8_WAIT_L(0); PG8_BAR; PG8_MMA(1, 0, At, B0); PG8_MMA(1, 1, At, B1); PG8_BAR; PG8_SCHED;
            } else {
            PG8_LDB(B0, 0, 0); PG8_SCHED; PG8_LDA(At, 0, 0); PG8_STAGE(PG8_SA(1, 1), a1 + hstepA, voffA);
            PG8_WAIT_L(8); PG8_BAR; PG8_WAIT_L(0); PG8_MMA(0, 0, At, B0); PG8_BAR; PG8_SCHED;
            PG8_LDB(B1, 0, 1); PG8_STAGE(PG8_SB(0, 0), b2, voffB);
            PG8_BAR; PG8_WAIT_L(0); PG8_MMA(0, 1, At, B1); PG8_BAR;
            PG8_LDA(At, 0, 1); PG8_STAGE(PG8_SA(0, 0), a2, voffA);
            PG8_BAR; PG8_WAIT_L(0); PG8_MMA(1, 0, At, B0); PG8_BAR; PG8_SCHED;
            PG8_STAGE(PG8_SB(0, 1), b2 + hstepB, voffB);
            PG8_WAIT_V(6); PG8_BAR; PG8_MMA(1, 1, At, B1); PG8_BAR;
            PG8_LDB(B0, 1, 0); PG8_SCHED; PG8_LDA(At, 1, 0); PG8_STAGE(PG8_SA(0, 1), a2 + hstepA, voffA);
            PG8_WAIT_L(8); PG8_BAR; PG8_WAIT_L(0); PG8_MMA(0, 0, At, B0); PG8_BAR; PG8_SCHED;
            PG8_LDB(B1, 1, 1); PG8_STAGE(PG8_SB(1, 0), b3, voffB);
            PG8_BAR; PG8_WAIT_L(0); PG8_MMA(0, 1, At, B1); PG8_BAR;
            PG8_LDA(At, 1, 1); PG8_STAGE(PG8_SA(1, 0), a3, voffA);
            PG8_BAR; PG8_WAIT_L(0); PG8_MMA(1, 0, At, B0); PG8_BAR; PG8_SCHED;
            PG8_STAGE(PG8_SB(1, 1), b3 + hstepB, voffB);
            PG8_WAIT_V(6); PG8_BAR; PG8_MMA(1, 1, At, B1); PG8_BAR;
            }
        }
        if constexpr (ALIGN_EPI) { if (wr == 0) PG8_BAR; }
        if constexpr (!Epi::AFTER_DRAIN) { E(acc, cur, wr, wc, fr, fq); S.done(cur); }
        if (!has_next) break;
#pragma unroll
        for (int a = 0; a < 2; ++a)
#pragma unroll
            for (int b = 0; b < 2; ++b)
#pragma unroll
                for (int m = 0; m < 4; ++m)
#pragma unroll
                    for (int n = 0; n < 2; ++n) acc[a][b][m][n] = (f32x4){0.f, 0.f, 0.f, 0.f};
        cur = nxt; cA = nA; cB = nB; ++ui;
        if constexpr (ALIGN_EPI) { if (wr == 1) PG8_BAR; }
    }
    PG8_WAIT_V(0);
    if constexpr (!ALIGN_EPI) { if (wr == 0) PG8_BAR; }
    PG8_BAR;
    if constexpr (Epi::AFTER_DRAIN) { E.fused(acc, cur, wr, wc, fr, fq, lds, wid, lane); S.done(cur); }
#undef PG8_SA
#undef PG8_SB
#undef PG8_STAGE
#undef PG8_LDA
#undef PG8_LDB
#undef PG8_MMA
#undef PG8_WAIT_V
#undef PG8_WAIT_L
#undef PG8_BAR
#undef PG8_SCHED
}
}
namespace pg8 {
__device__ __forceinline__ u32x4 pack8(const f32x4 a, const f32x4 b) { u32x4 w; w.x = cvt_pk_bf16(a[0], a[1]); w.y = cvt_pk_bf16(a[2], a[3]); w.z = cvt_pk_bf16(b[0], b[1]); w.w = cvt_pk_bf16(b[2], b[3]); return w; }
__device__ __forceinline__ void unpack8(const u32x4 w, f32x4& a, f32x4& b) {
    a[0] = __uint_as_float(w.x << 16); a[1] = __uint_as_float(w.x & 0xffff0000u); a[2] = __uint_as_float(w.y << 16); a[3] = __uint_as_float(w.y & 0xffff0000u);
    b[0] = __uint_as_float(w.z << 16); b[1] = __uint_as_float(w.z & 0xffff0000u); b[2] = __uint_as_float(w.w << 16); b[3] = __uint_as_float(w.w & 0xffff0000u); }
__device__ __forceinline__ float fsig(float x) { return __builtin_amdgcn_rcpf(1.f + __builtin_amdgcn_exp2f(-1.4426950408889634f * x)); }
__device__ __forceinline__ f32x4 fsig4(const f32x4 v) { f32x4 r; r[0] = fsig(v[0]); r[1] = fsig(v[1]); r[2] = fsig(v[2]); r[3] = fsig(v[3]); return r; }
__device__ __forceinline__ f32x4 gelu4(const f32x4 v) { const f32x2 a = gelu_pk((f32x2){v[0], v[1]}), b = gelu_pk((f32x2){v[2], v[3]}); return (f32x4){a.x, a.y, b.x, b.y}; }

struct SsmOrder {
    int G, c;
    __device__ bool next(int i, Unit& u) const { const int L = i * G + c; if (L >= 128) return false; u.pm = L; u.pn = L >> 2; return true; }
    __device__ __forceinline__ void a_ready(const Unit&) const {}
    __device__ __forceinline__ void done(const Unit&) const {}
};
struct MoeOrder {
    StaticOrder so; int pe0, pe1, pe2, pe3, pe4, pe5, pe6; int nN; int maxr;
    __device__ bool next(int i, Unit& u) const {
        if (i >= maxr || !so.next(i, u)) return false;
        const int r0 = u.pm * 256; const int e = (pe0 <= r0) + (pe1 <= r0) + (pe2 <= r0) + (pe3 <= r0) + (pe4 <= r0) + (pe5 <= r0) + (pe6 <= r0);
        u.pn += e * nN; return true; }
    __device__ __forceinline__ void a_ready(const Unit&) const {}
    __device__ __forceinline__ void done(const Unit&) const {}
};

struct MoeSplitOrder {
    int c, tile0, nsub, eoff;
    int pe0, pe1, pe2, pe3, pe4, pe5, pe6; int nN;
    __device__ bool next(int i, Unit& u) const {
        const int q = i * 256 + c; if (q >= nsub) return false;
        const int j = q / 6, ks = q - j * 6;
        u.pm = tile0 + (j >> 2);
        const int r0 = u.pm * 256; const int e = (pe0 <= r0) + (pe1 <= r0) + (pe2 <= r0) + (pe3 <= r0) + (pe4 <= r0) + (pe5 <= r0) + (pe6 <= r0);
        u.pn = (j & 3) + e * nN; u.ko = (ks < 4 ? ks * 8 : 32 + (ks - 4) * 6) * 128; u.nk = ks < 4 ? 8 : 6; u.aux = q; return true; }
    __device__ __forceinline__ void a_ready(const Unit&) const {}
    __device__ __forceinline__ void done(const Unit&) const {}
};

#define EPI_ROWS(u) const int rowb = (u).pm * BM + wr * 64 + fr
template <bool RS> struct EpiInProjT {
    static constexpr bool PERM = true, AFTER_DRAIN = false, MIDHOOK = false;
    bf16_t *Q, *Kb, *V, *AY, *G; const float *COS, *SIN; const PG8_LAS float* RSTD;
    __device__ __forceinline__ void operator()(const f32x4 (&acc_)[2][2][4][2], const Unit& u, int wr, int wc, int fr, int fq) const {
        EPI_ROWS(u); const int pn = u.pn;
#pragma unroll
        for (int ai = 0; ai < 2; ++ai)
#pragma unroll
            for (int m = 0; m < 4; ++m) {
                f32x4 c_[2][2];
                { const float rs = RS ? RSTD[ai * HALF + wr * 64 + m * 16 + fr] : 1.f;
#pragma unroll
                  for (int bj = 0; bj < 2; ++bj) { c_[bj][0] = RS ? acc_[ai][bj][m][0] * rs : acc_[ai][bj][m][0]; c_[bj][1] = RS ? acc_[ai][bj][m][1] * rs : acc_[ai][bj][m][1]; } }
                const int row = rowb + ai * HALF + m * 16, b = row >> 13, s = row & 8191;
                if (pn < 4) {
                    bf16_t* dst = pn < 2 ? Q : Kb; const int c = wc >> 1, jb = 16 * (wc & 1) + 4 * fq;
                    const f32x4 cs = *(const f32x4*)(COS + s * 32 + jb), sn = *(const f32x4*)(SIN + s * 32 + jb);
#pragma unroll
                    for (int bj = 0; bj < 2; ++bj) { const int h = 2 * (pn & 1) + bj; const f32x4 x1 = c_[bj][0], x2 = c_[bj][1];
                        *(u32x4*)(dst + ((((size_t)b * 4 + h) * 2 + c) * 8192 + s) * 64 + 32 * (wc & 1) + 8 * fq) = pack8(x1 * cs - x2 * sn, x2 * cs + x1 * sn); }
                } else if (pn < 6) {
#pragma unroll
                    for (int bj = 0; bj < 2; ++bj) { const int h = 2 * (pn - 4) + bj;
                        *(u32x4*)(V + (((size_t)b * 4 + h) * 8192 + s) * 128 + 32 * wc + 8 * fq) = pack8(c_[bj][0], c_[bj][1]); }
                } else if (pn < 8) {
#pragma unroll
                    for (int bj = 0; bj < 2; ++bj) { const int ucol = 256 * (pn - 6) + 128 * bj + 32 * wc + 8 * fq, g = ucol >> 4, hh0 = ucol & 15;
                        *(u32x4*)(AY + ((size_t)g * 1024 + b * 512 + (s >> 4)) * 512 + (s & 15) * 16 + hh0) = pack8(c_[bj][0], c_[bj][1]); }
                } else {
#pragma unroll
                    for (int bj = 0; bj < 2; ++bj) { const int gcol = 256 * (pn - 8) + 128 * bj + 32 * wc + 8 * fq;
                        *(u32x4*)(G + (size_t)row * 2048 + gcol) = pack8(fsig4(c_[bj][0]), fsig4(c_[bj][1])); }
                }
            }
    }
};
typedef EpiInProjT<false> EpiInProj;
struct EpiXloc {
    static constexpr bool PERM = true, AFTER_DRAIN = false, MIDHOOK = false;
    float* XLOC;
    __device__ __forceinline__ void operator()(const f32x4 (&acc)[2][2][4][2], const Unit& u, int wr, int wc, int fr, int fq) const {
        EPI_ROWS(u);
#pragma unroll
        for (int ai = 0; ai < 2; ++ai)
#pragma unroll
            for (int m = 0; m < 4; ++m)
#pragma unroll
                for (int bj = 0; bj < 2; ++bj) { float* p = XLOC + (size_t)(rowb + ai * HALF + m * 16) * 256 + bj * HALF + 32 * wc + 8 * fq;
                    *(f32x4*)p = acc[ai][bj][m][0]; *(f32x4*)(p + 4) = acc[ai][bj][m][1]; }
    }
};
struct EpiY {
    static constexpr bool PERM = true, AFTER_DRAIN = false, MIDHOOK = false;
    bf16_t* SACT;
    __device__ __forceinline__ void operator()(const f32x4 (&acc)[2][2][4][2], const Unit& u, int wr, int wc, int fr, int fq) const {
        EPI_ROWS(u);
#pragma unroll
        for (int ai = 0; ai < 2; ++ai)
#pragma unroll
            for (int m = 0; m < 4; ++m) { const int R = rowb + ai * HALF + m * 16, g = R >> 10, bc = R & 1023;
#pragma unroll
                for (int bj = 0; bj < 2; ++bj) { const int col0 = bj * HALF + 32 * wc + 8 * fq, i = col0 >> 4, hh0 = col0 & 15;
                    *(u32x4*)(SACT + (size_t)(bc * 16 + i) * 512 + g * 16 + hh0) = pack8(gelu4(acc[ai][bj][m][0]), gelu4(acc[ai][bj][m][1])); } }
    }
};
struct EpiGlu {
    static constexpr bool PERM = true, AFTER_DRAIN = false, MIDHOOK = false;
    const bf16_t* SACT; bf16_t* AS2;
    __device__ __forceinline__ void operator()(const f32x4 (&acc)[2][2][4][2], const Unit& u, int wr, int wc, int fr, int fq) const {
        EPI_ROWS(u);
#pragma unroll
        for (int ai = 0; ai < 2; ++ai)
#pragma unroll
            for (int m = 0; m < 4; ++m) { const int row = rowb + ai * HALF + m * 16;
#pragma unroll
                for (int bj = 0; bj < 2; ++bj) { const int col0 = u.pn * BM + bj * HALF + 32 * wc + 8 * fq;
                    f32x4 s0, s1; unpack8(*(const u32x4*)(SACT + (size_t)row * 512 + col0), s0, s1);
                    *(u32x4*)(AS2 + (size_t)row * 1024 + 512 + col0) = pack8(s0 * fsig4(acc[ai][bj][m][0]), s1 * fsig4(acc[ai][bj][m][1])); } }
    }
};
struct EpiBranch {
    static constexpr bool PERM = true, AFTER_DRAIN = false, MIDHOOK = true;
    const bf16_t* G; bf16_t* MERGED;
    __device__ __forceinline__ void mid(f32x4 (&acc)[2][2][4][2], const Unit& u, int wr, int wc, int fr, int fq) const {
        asm volatile("" : "+v"(fr), "+v"(fq));
        EPI_ROWS(u);
#pragma unroll
        for (int ai = 0; ai < 2; ++ai)
#pragma unroll
            for (int m = 0; m < 4; ++m) { const int row = rowb + ai * HALF + m * 16;
#pragma unroll
                for (int bj = 0; bj < 2; ++bj) { const int col0 = u.pn * BM + bj * HALF + 32 * wc + 8 * fq;
                    f32x4 a0, a1, b0, b1; unpack8(*(const u32x4*)(G + (size_t)row * 2048 + col0), a0, a1); unpack8(*(const u32x4*)(G + (size_t)row * 2048 + 1024 + col0), b0, b1);
#pragma unroll
                    for (int e = 0; e < 4; ++e) { acc[ai][bj][m][0][e] *= a0[e] * __builtin_amdgcn_rcpf(b0[e]); acc[ai][bj][m][1][e] *= a1[e] * __builtin_amdgcn_rcpf(b1[e]); } }
                asm volatile("" ::: "memory"); }
    }
    __device__ __forceinline__ void operator()(const f32x4 (&acc)[2][2][4][2], const Unit& u, int wr, int wc, int fr, int fq) const {
        EPI_ROWS(u);
#pragma unroll
        for (int ai = 0; ai < 2; ++ai)
#pragma unroll
            for (int m = 0; m < 4; ++m) { const int row = rowb + ai * HALF + m * 16;
#pragma unroll
                for (int bj = 0; bj < 2; ++bj) { const int col0 = u.pn * BM + bj * HALF + 32 * wc + 8 * fq;
                    f32x4 b0, b1; unpack8(*(const u32x4*)(G + (size_t)row * 2048 + 1024 + col0), b0, b1);
                    *(u32x4*)(MERGED + (size_t)row * 1024 + col0) = pack8(acc[ai][bj][m][0] * b0, acc[ai][bj][m][1] * b1); } }
    }
};
struct EpiRes {
    static constexpr bool PERM = true, AFTER_DRAIN = false, MIDHOOK = false;
    const float* SRC; float* X;
    __device__ __forceinline__ void operator()(const f32x4 (&acc)[2][2][4][2], const Unit& u, int wr, int wc, int fr, int fq) const {
        EPI_ROWS(u);
#pragma unroll
        for (int ai = 0; ai < 2; ++ai)
#pragma unroll
            for (int m = 0; m < 4; ++m) { const int row = rowb + ai * HALF + m * 16;
#pragma unroll
                for (int bj = 0; bj < 2; ++bj) { const size_t o = (size_t)row * 1024 + u.pn * BM + bj * HALF + 32 * wc + 8 * fq;
                    const f32x4 s0 = *(const f32x4*)(SRC + o), s1 = *(const f32x4*)(SRC + o + 4);
                    *(f32x4*)(X + o) = s0 + acc[ai][bj][m][0]; *(f32x4*)(X + o + 4) = s1 + acc[ai][bj][m][1]; } }
    }
};
template <bool RS> struct EpiSwigluT {
    static constexpr bool PERM = true, AFTER_DRAIN = false, MIDHOOK = false;
    bf16_t* H; int nN; const PG8_LAS float* RSTD;
    __device__ __forceinline__ void operator()(const f32x4 (&acc)[2][2][4][2], const Unit& u, int wr, int wc, int fr, int fq) const {
        EPI_ROWS(u); const int col0 = 128 * (u.pn % nN) + 32 * wc + 8 * fq;
#pragma unroll
        for (int ai = 0; ai < 2; ++ai)
#pragma unroll
            for (int m = 0; m < 4; ++m) { const int row = rowb + ai * HALF + m * 16;
                const float rs = RS ? RSTD[ai * HALF + wr * 64 + m * 16 + fr] : 1.f;
                const f32x4 a0 = RS ? acc[ai][0][m][0] * rs : acc[ai][0][m][0], a1 = RS ? acc[ai][0][m][1] * rs : acc[ai][0][m][1];
                const f32x4 b0 = RS ? acc[ai][1][m][0] * rs : acc[ai][1][m][0], b1 = RS ? acc[ai][1][m][1] * rs : acc[ai][1][m][1];
                *(u32x4*)(H + (size_t)row * 2816 + col0) = pack8(a0 * fsig4(a0) * b0, a1 * fsig4(a1) * b1); }
    }
};
typedef EpiSwigluT<false> EpiSwiglu;
struct EpiResN {
    static constexpr bool PERM = true, AFTER_DRAIN = false, MIDHOOK = false;
    const float* SRC; float* X; bf16_t* XN; float* PS;
    __device__ __forceinline__ void operator()(const f32x4 (&acc)[2][2][4][2], const Unit& u, int wr, int wc, int fr, int fq) const {
        EPI_ROWS(u);
#pragma unroll
        for (int ai = 0; ai < 2; ++ai)
#pragma unroll
            for (int m = 0; m < 4; ++m) { const int row = rowb + ai * HALF + m * 16; float ss = 0.f;
#pragma unroll
                for (int bj = 0; bj < 2; ++bj) { const size_t o = (size_t)row * 1024 + u.pn * BM + bj * HALF + 32 * wc + 8 * fq;
                    const f32x4 s0 = *(const f32x4*)(SRC + o), s1 = *(const f32x4*)(SRC + o + 4);
                    const f32x4 y0 = s0 + acc[ai][bj][m][0], y1 = s1 + acc[ai][bj][m][1];
                    *(f32x4*)(X + o) = y0; *(f32x4*)(X + o + 4) = y1; *(u32x4*)(XN + o) = pack8(y0, y1);
                    ss += (y0[0] * y0[0] + y0[1] * y0[1]) + (y0[2] * y0[2] + y0[3] * y0[3]) + (y1[0] * y1[0] + y1[1] * y1[1]) + (y1[2] * y1[2] + y1[3] * y1[3]); }
                { auto r = __builtin_amdgcn_permlane16_swap(__float_as_uint(ss), __float_as_uint(ss), false, false); ss = __uint_as_float(r[0]) + __uint_as_float(r[1]); }
                { auto r = __builtin_amdgcn_permlane32_swap(__float_as_uint(ss), __float_as_uint(ss), false, false); ss = __uint_as_float(r[0]) + __uint_as_float(r[1]); }
                if (fq == 0) PS[(size_t)(u.pn * 4 + wc) * 16384 + row] = ss; }
    }
};
struct EpiMoeDown {
    static constexpr bool PERM = true, AFTER_DRAIN = false, MIDHOOK = false;
    bf16_t* YS;
    __device__ __forceinline__ void operator()(const f32x4 (&acc)[2][2][4][2], const Unit& u, int wr, int wc, int fr, int fq) const {
        EPI_ROWS(u);
#pragma unroll
        for (int ai = 0; ai < 2; ++ai)
#pragma unroll
            for (int m = 0; m < 4; ++m) { const int row = rowb + ai * HALF + m * 16;
#pragma unroll
                for (int bj = 0; bj < 2; ++bj)
                    *(u32x4*)(YS + (size_t)row * 1024 + (u.pn & 3) * BM + bj * HALF + 32 * wc + 8 * fq) = pack8(acc[ai][bj][m][0], acc[ai][bj][m][1]); }
    }
};
struct EpiMoeDownPart {
    static constexpr bool PERM = true, AFTER_DRAIN = false, MIDHOOK = false;
    float* P;
    __device__ __forceinline__ void operator()(const f32x4 (&acc)[2][2][4][2], const Unit& u, int wr, int wc, int fr, int fq) const {
        float* base = P + (size_t)u.aux * 65536 + (size_t)(wr * 64 + fr) * 256 + 32 * wc + 8 * fq;
#pragma unroll
        for (int ai = 0; ai < 2; ++ai)
#pragma unroll
            for (int m = 0; m < 4; ++m)
#pragma unroll
                for (int bj = 0; bj < 2; ++bj) { float* d = base + (ai * HALF + m * 16) * 256 + bj * HALF;
                    *(f32x4*)d = acc[ai][bj][m][0]; *(f32x4*)(d + 4) = acc[ai][bj][m][1]; }
    }
};
#undef EPI_ROWS
}
#define XB_TMO      128
#define XB_XCNT(j)  (256  + 64 * (j))
#define XB_XSUB(j)  (1280 + 64 * (j))
#define XB_XGEN(j)  (2304 + 64 * (j))
#define XB_TOP      3328
#define XB_TOPGEN   3392
#define XCD_BAR_WORDS 3456
#define XB_SPIN_CAP (1u << 18)

__device__ __forceinline__ unsigned xb_ld(unsigned* p)              { return __hip_atomic_load(p, __ATOMIC_RELAXED, __HIP_MEMORY_SCOPE_AGENT); }
__device__ __forceinline__ unsigned xb_add(unsigned* p, unsigned v) { return __hip_atomic_fetch_add(p, v, __ATOMIC_RELAXED, __HIP_MEMORY_SCOPE_AGENT); }
__device__ __forceinline__ unsigned xb_xcc_id() { return (unsigned)__builtin_amdgcn_s_getreg((3 << 11) | 20) & 0xFu; }
#define XB_SPIN(cond, bar) do { unsigned _sp = 0; while (cond) { __builtin_amdgcn_s_sleep(1); \
    if ((++_sp & 255u) == 0u) { if (xb_ld(&(bar)[XB_TMO])) break; if (_sp > XB_SPIN_CAP) { atomicAdd(&(bar)[XB_TMO], 1u); break; } } } } while (0)

struct XcdBarrier {
    unsigned* bar; unsigned x;
    volatile LAS unsigned* st;
};

__device__ __forceinline__ XcdBarrier xcd_barrier_post(unsigned* bar, volatile LAS unsigned* st) {
    XcdBarrier b; b.bar = bar; b.x = xb_xcc_id(); b.st = st;
    if (threadIdx.x == 0) (void)xb_add(&bar[XB_XCNT(b.x)], 1u);
    return b;
}
__device__ __forceinline__ void xcd_barrier_complete(unsigned* bar, unsigned x, unsigned& nloc, unsigned& nx) {
    const unsigned G = gridDim.x * gridDim.y * gridDim.z;
    unsigned sum, cnt, mine, sp = 0u;
    for (;;) {
        sum = 0u; cnt = 0u; mine = 0u;
#pragma unroll
        for (unsigned j = 0; j < 16; ++j) { const unsigned c = xb_ld(&bar[XB_XCNT(j)]); sum += c; cnt += (c > 0u) ? 1u : 0u; mine = (j == x) ? c : mine; }
        if (sum == G) break;
        __builtin_amdgcn_s_sleep(1);
        if ((++sp & 255u) == 0u) { if (xb_ld(&bar[XB_TMO])) break; if (sp > XB_SPIN_CAP) { atomicAdd(&bar[XB_TMO], 1u); break; } }
    }
    nloc = mine > 0u ? mine : 1u; nx = cnt > 0u ? cnt : 1u;
}

__device__ __forceinline__ void xcd_barrier(const XcdBarrier& b) {
    asm volatile("s_waitcnt vmcnt(0)" ::: "memory");
    __syncthreads();
    if (threadIdx.x == 0) {
        unsigned* bar = b.bar;
        __builtin_amdgcn_s_waitcnt(0);
        unsigned nloc = b.st[0], nx = b.st[1];
        if (nloc == 0u) { xcd_barrier_complete(bar, b.x, nloc, nx); b.st[0] = nloc; b.st[1] = nx; }
        const unsigned old = xb_add(&bar[XB_XSUB(b.x)], 1u);
        const unsigned gen = old / nloc;
        if (old + 1u == (gen + 1u) * nloc) {
            __builtin_amdgcn_fence(__ATOMIC_RELEASE, "agent");
            asm volatile("s_waitcnt vmcnt(0)" ::: "memory");
            const unsigned og = xb_add(&bar[XB_TOP], 1u);
            const unsigned tg = og / nx;
            if (og + 1u == (tg + 1u) * nx) xb_add(&bar[XB_TOPGEN], 1u);
            else XB_SPIN(xb_ld(&bar[XB_TOPGEN]) == tg, bar);
            __builtin_amdgcn_fence(__ATOMIC_ACQUIRE, "agent");
            xb_add(&bar[XB_XGEN(b.x)], 1u);
            asm volatile("s_waitcnt vmcnt(0)" ::: "memory");
        } else {
            XB_SPIN(xb_ld(&bar[XB_XGEN(b.x)]) == gen, bar);
            __builtin_amdgcn_fence(__ATOMIC_ACQUIRE, "agent");
            asm volatile("s_waitcnt vmcnt(0)" ::: "memory");
        }
    }
    __syncthreads();
}

namespace att {
using bf16x8 = __attribute__((ext_vector_type(8))) short;
using s16x4  = __attribute__((ext_vector_type(4))) short;
using f32x16 = __attribute__((ext_vector_type(16))) float;
using u32x4  = __attribute__((ext_vector_type(4))) unsigned;
constexpr int NW = 8, QBLK = 32, KVBLK = 64;
constexpr float SCALE = 0.125f;
constexpr int SHM_V = KVBLK * 128 * 2, SHM_K = KVBLK * 64 * 2, SHM_ATTN = 4 * SHM_V + 4 * SHM_K + NW * 64 * 4;
#define KSWZ64(row, colB) ((row) * 128 + ((colB) ^ ((((row) >> 1) & 7) << 4)))
#define SBAR() __builtin_amdgcn_sched_barrier(0)
__device__ __forceinline__ int crow(int r, int hi) { return (r & 3) + 8 * (r >> 2) + 4 * hi; }
typedef __bf16 bf16x2_cv __attribute__((ext_vector_type(2))); typedef float f32x2_cv __attribute__((ext_vector_type(2)));
__device__ __forceinline__ unsigned cvtpk(float lo, float hi) { const bf16x2_cv r = __builtin_convertvector((f32x2_cv){lo, hi}, bf16x2_cv); return __builtin_bit_cast(unsigned, r); }
__device__ __forceinline__ void partialSM(f32x16& p0, f32x16& p1, float mb) {
  constexpr float C = SCALE * 1.4426950408889634f;
#pragma unroll
  for (int r = 0; r < 16; ++r) p0[r] = fmaf(p0[r], C, -mb);
#pragma unroll
  for (int r = 0; r < 16; ++r) p1[r] = fmaf(p1[r], C, -mb);
#pragma unroll
  for (int r = 0; r < 16; ++r) p0[r] = __builtin_amdgcn_exp2f(p0[r]);
}
__device__ __forceinline__ void finishSM(f32x16& p0, f32x16& p1, float& l_reg, bf16x8& pa0, bf16x8& pa1, bf16x8& pa2, bf16x8& pa3) {
#pragma unroll
  for (int r = 0; r < 16; ++r) p1[r] = __builtin_amdgcn_exp2f(p1[r]);
  typedef __bf16 bf2_t __attribute__((ext_vector_type(2)));
  const bf2_t one2 = {(__bf16)1.0f, (__bf16)1.0f};
  float ps0 = 0.f, ps1 = 0.f;
#define DOT1(acc, w) acc = __builtin_amdgcn_fdot2_f32_bf16(__builtin_bit_cast(bf2_t, (unsigned)(w)), one2, acc, false)
#define PK4(P, BASE, OUT) do { unsigned a0 = cvtpk(P[BASE + 0], P[BASE + 1]), a1 = cvtpk(P[BASE + 2], P[BASE + 3]);   \
    unsigned b0 = cvtpk(P[BASE + 4], P[BASE + 5]), b1 = cvtpk(P[BASE + 6], P[BASE + 7]);                              \
    DOT1(ps0, a0); DOT1(ps1, a1); DOT1(ps0, b0); DOT1(ps1, b1);                                                       \
    u32x4 w = {a0, a1, b0, b1}; OUT = *reinterpret_cast<bf16x8*>(&w); } while (0)
  PK4(p0, 0, pa0); PK4(p0, 8, pa1); PK4(p1, 0, pa2); PK4(p1, 8, pa3);
  l_reg += ps0 + ps1;
#undef DOT1
#undef PK4
}
template <int OFF> __device__ __forceinline__ bf16x8 k_read(int ka) { bf16x8 r; asm volatile("ds_read_b128 %0, %1 offset:%2" : "=&v"(r) : "v"(ka), "i"(OFF) : "memory"); return r; }
__device__ __forceinline__ void qkt(f32x16& p0, f32x16& p1, const char* Ks, const bf16x8* qr, int r32, int hi) {
  p0 = f32x16{}; p1 = f32x16{};
  const int sw = (r32 >> 1) & 7, base = (int)(uintptr_t)Ks + r32 * 128;
  const int a0 = base + (((0 + hi) ^ sw) << 4), a1 = base + (((2 + hi) ^ sw) << 4), a2 = base + (((4 + hi) ^ sw) << 4), a3 = base + (((6 + hi) ^ sw) << 4);
  const bf16x8 k00 = k_read<0>(a0), k01 = k_read<4096>(a0), k10 = k_read<0>(a1), k11 = k_read<4096>(a1), k20 = k_read<0>(a2), k21 = k_read<4096>(a2), k30 = k_read<0>(a3), k31 = k_read<4096>(a3);
  asm volatile("s_waitcnt lgkmcnt(0)" ::: "memory"); SBAR();
  p0 = __builtin_amdgcn_mfma_f32_32x32x16_bf16(k00, qr[0], p0, 0, 0, 0); p1 = __builtin_amdgcn_mfma_f32_32x32x16_bf16(k01, qr[0], p1, 0, 0, 0);
  p0 = __builtin_amdgcn_mfma_f32_32x32x16_bf16(k10, qr[1], p0, 0, 0, 0); p1 = __builtin_amdgcn_mfma_f32_32x32x16_bf16(k11, qr[1], p1, 0, 0, 0);
  p0 = __builtin_amdgcn_mfma_f32_32x32x16_bf16(k20, qr[2], p0, 0, 0, 0); p1 = __builtin_amdgcn_mfma_f32_32x32x16_bf16(k21, qr[2], p1, 0, 0, 0);
  p0 = __builtin_amdgcn_mfma_f32_32x32x16_bf16(k30, qr[3], p0, 0, 0, 0); p1 = __builtin_amdgcn_mfma_f32_32x32x16_bf16(k31, qr[3], p1, 0, 0, 0);
}
__device__ __forceinline__ int v_st(int k, int c) { const int kk = k; return ((kk >> 3) * 4 + (c >> 5)) * 512 + ((kk & 7) * 32 + (c & 31)) * 2; }
__device__ __forceinline__ int v_rd_base(int lane) { return ((lane & 3) << 3) | (((lane >> 2) & 3) << 6) | (((lane >> 4) & 1) << 5) | (((lane >> 5) & 1) << 8); }
constexpr int v_rd_off(int d0, int ks, int half) { return d0 * 512 + ks * 4096 + half * 2048; }
template <int OFF> __device__ __forceinline__ s16x4 tr_read(int vb) {
  s16x4 r; asm volatile("ds_read_b64_tr_b16 %0, %1 offset:%2" : "=&v"(r) : "v"(vb), "i"(OFF) : "memory"); return r;
}
template <int D0> __device__ __forceinline__ void pv_one(f32x16& od, int vb, bf16x8 pa0, bf16x8 pa1, bf16x8 pa2, bf16x8 pa3) {
  const s16x4 l0 = tr_read<v_rd_off(D0, 0, 0)>(vb), h0 = tr_read<v_rd_off(D0, 0, 1)>(vb), l1 = tr_read<v_rd_off(D0, 1, 0)>(vb), h1 = tr_read<v_rd_off(D0, 1, 1)>(vb);
  const s16x4 l2 = tr_read<v_rd_off(D0, 2, 0)>(vb), h2 = tr_read<v_rd_off(D0, 2, 1)>(vb), l3 = tr_read<v_rd_off(D0, 3, 0)>(vb), h3 = tr_read<v_rd_off(D0, 3, 1)>(vb);
  asm volatile("s_waitcnt lgkmcnt(0)" ::: "memory"); SBAR();
#define PK(L, H) (bf16x8){L[0], L[1], L[2], L[3], H[0], H[1], H[2], H[3]}
  od = __builtin_amdgcn_mfma_f32_32x32x16_bf16(pa0, PK(l0, h0), od, 0, 0, 0);
  od = __builtin_amdgcn_mfma_f32_32x32x16_bf16(pa1, PK(l1, h1), od, 0, 0, 0);
  od = __builtin_amdgcn_mfma_f32_32x32x16_bf16(pa2, PK(l2, h2), od, 0, 0, 0);
  od = __builtin_amdgcn_mfma_f32_32x32x16_bf16(pa3, PK(l3, h3), od, 0, 0, 0);
#undef PK
}
__device__ __forceinline__ void pv_d0(f32x16* o, int vb, bf16x8 pa0, bf16x8 pa1, bf16x8 pa2, bf16x8 pa3) {
  pv_one<0>(o[0], vb, pa0, pa1, pa2, pa3); pv_one<1>(o[1], vb, pa0, pa1, pa2, pa3); pv_one<2>(o[2], vb, pa0, pa1, pa2, pa3); pv_one<3>(o[3], vb, pa0, pa1, pa2, pa3);
}

__device__ __forceinline__ void diff_attn_unit(const unsigned short* __restrict__ Qh, const unsigned short* __restrict__ Kh, const unsigned short* __restrict__ Vh, int i0,
                                               const unsigned* __restrict__ kmax2, float* __restrict__ O1s, unsigned short* __restrict__ OUT, const float* __restrict__ subln, float lam, float oml, char* lds) {
  constexpr int SEQL = 8192, NT = SEQL / KVBLK;
  char* V_lds = lds; char* K_lds = lds + 4 * SHM_V;
  for (int c = 0; c < 2; ++c) {
    int tid_l = threadIdx.x; asm volatile("" : "+v"(tid_l));
    const int tid = tid_l, wid = __builtin_amdgcn_readfirstlane(tid >> 6), lane = tid & 63, r32 = lane & 31, hi = lane >> 5;
    const int sr = tid >> 4, sc = (tid & 15) * 8, vst0 = v_st(sr, sc), vst1 = v_st(32 + sr, sc);
    const int kr = tid >> 3, kcb = (tid & 7) * 16, kst = KSWZ64(kr, kcb);
    const int vb0 = (int)(uintptr_t)V_lds + v_rd_base(lane);
    const unsigned short* Kc = Kh + (size_t)c * SEQL * 64;
    float l_reg = 0; f32x16 o[4] = {}; bf16x8 qr[4];
    const unsigned short* Qw = Qh + (size_t)c * SEQL * 64 + (size_t)(i0 + wid * QBLK + r32) * 64 + hi * 8;
#pragma unroll
    for (int d0 = 0; d0 < 4; ++d0) qr[d0] = *reinterpret_cast<const bf16x8*>(Qw + d0 * 16);
    float mb;
    { float q2 = 0.f;
#pragma unroll
      for (int d0 = 0; d0 < 4; ++d0)
#pragma unroll
        for (int e = 0; e < 8; ++e) { const float qv = __uint_as_float(((unsigned)(unsigned short)qr[d0][e]) << 16); q2 = fmaf(qv, qv, q2); }
      { auto rr = __builtin_amdgcn_permlane32_swap(__float_as_uint(q2), __float_as_uint(q2), false, false); q2 = __uint_as_float(rr[0]) + __uint_as_float(rr[1]); }
      mb = sqrtf(q2 * __uint_as_float(kmax2[c])) * (SCALE * 1.4426950408889634f); }
    struct { bf16x8 vs0, vs1, ks0; } sr_[3];
#define SLOAD(i, k0) do { sr_[i].vs0 = *reinterpret_cast<const bf16x8*>(&Vh[(size_t)((k0) + sr) * 128 + sc]); sr_[i].vs1 = *reinterpret_cast<const bf16x8*>(&Vh[(size_t)((k0) + 32 + sr) * 128 + sc]); \
    sr_[i].ks0 = *reinterpret_cast<const bf16x8*>(&Kc[(size_t)((k0) + kr) * 64 + (tid & 7) * 8]); } while (0)
#define SWRITE(b, i) do { *(bf16x8*)(V_lds + (b) * SHM_V + vst0) = sr_[i].vs0; *(bf16x8*)(V_lds + (b) * SHM_V + vst1) = sr_[i].vs1; \
    *(bf16x8*)(K_lds + (b) * SHM_K + kst) = sr_[i].ks0; } while (0)
#define LBAR() do { asm volatile("s_waitcnt lgkmcnt(0)" ::: "memory"); __builtin_amdgcn_s_barrier(); asm volatile("" ::: "memory"); } while (0)
    f32x16 pA0, pA1, pB0, pB1; bf16x8 pa0, pa1, pa2, pa3;
    __syncthreads();
    SLOAD(0, 0); SLOAD(1, KVBLK); SLOAD(2, 2 * KVBLK); SWRITE(0, 0); SWRITE(1, 1); SWRITE(2, 2); __syncthreads();
    qkt(pA0, pA1, K_lds, qr, r32, hi); partialSM(pA0, pA1, mb);
    if (wid >= 4) { __builtin_amdgcn_s_setprio(1); LBAR(); }
    for (int j = 1; j + 1 < NT; j += 2) {
      SLOAD(0, (j + 2) * KVBLK);
      SBAR(); qkt(pB0, pB1, K_lds + (j & 3) * SHM_K, qr, r32, hi);
      finishSM(pA0, pA1, l_reg, pa0, pa1, pa2, pa3); SBAR();
      LBAR();
      pv_d0(o, vb0 + ((j - 1) & 3) * SHM_V, pa0, pa1, pa2, pa3); SBAR(); partialSM(pB0, pB1, mb); SBAR();
      SWRITE((j + 2) & 3, 0);
      LBAR();
      if (j + 3 < NT) SLOAD(0, (j + 3) * KVBLK);
      SBAR(); qkt(pA0, pA1, K_lds + ((j + 1) & 3) * SHM_K, qr, r32, hi);
      finishSM(pB0, pB1, l_reg, pa0, pa1, pa2, pa3); SBAR();
      LBAR();
      pv_d0(o, vb0 + (j & 3) * SHM_V, pa0, pa1, pa2, pa3); SBAR(); partialSM(pA0, pA1, mb); SBAR();
      if (j + 3 < NT) SWRITE((j + 3) & 3, 0);
      LBAR();
    }
    SBAR(); qkt(pB0, pB1, K_lds + ((NT - 1) & 3) * SHM_K, qr, r32, hi);
    finishSM(pA0, pA1, l_reg, pa0, pa1, pa2, pa3); SBAR();
    pv_d0(o, vb0 + ((NT - 2) & 3) * SHM_V, pa0, pa1, pa2, pa3); partialSM(pB0, pB1, mb);
    finishSM(pB0, pB1, l_reg, pa0, pa1, pa2, pa3); SBAR();
    pv_d0(o, vb0 + ((NT - 1) & 3) * SHM_V, pa0, pa1, pa2, pa3);
    if (wid < 4) LBAR();
    __builtin_amdgcn_s_setprio(0);
    { auto rr = __builtin_amdgcn_permlane32_swap(__float_as_uint(l_reg), __float_as_uint(l_reg), false, false); l_reg = __uint_as_float(rr[0]) + __uint_as_float(rr[1]); }
    { int t2 = threadIdx.x; asm volatile("" : "+v"(t2));
      const int wid2 = __builtin_amdgcn_readfirstlane(t2 >> 6), lane2 = t2 & 63, r322 = lane2 & 31, hi2 = lane2 >> 5;
      float* li_l = (float*)(lds + 4 * SHM_V + 4 * SHM_K) + wid2 * 64;
      if (hi2 == 0) li_l[r322] = l_reg; asm volatile("s_waitcnt lgkmcnt(0)" ::: "memory");
      float* O1w = O1s + (size_t)c * 32768 + (size_t)wid2 * 4096 + lane2;
#pragma unroll
      for (int r = 0; r < 16; ++r) { const float rl = __builtin_amdgcn_rcpf(li_l[crow(r, hi2)]);
#pragma unroll
        for (int d0 = 0; d0 < 4; ++d0) O1w[(d0 * 16 + r) * 64] = o[d0][r] * rl; } }
#undef SLOAD
#undef SWRITE
#undef LBAR
  }
  {
    int t3 = threadIdx.x; asm volatile("" : "+v"(t3));
    const int wid = __builtin_amdgcn_readfirstlane(t3 >> 6), lane = t3 & 63, r32 = lane & 31, hi = lane >> 5;
    const float* Ow = O1s + (size_t)wid * 4096 + lane;
    float sg[4];
#pragma unroll
    for (int d0 = 0; d0 < 4; ++d0) sg[d0] = subln[d0 * 32 + r32] * oml;
#pragma unroll 4
    for (int r = 0; r < 16; ++r) {
      float v[4], ss = 0.f;
#pragma unroll
      for (int d0 = 0; d0 < 4; ++d0) { v[d0] = Ow[(d0 * 16 + r) * 64] - lam * Ow[32768 + (d0 * 16 + r) * 64]; ss += v[d0] * v[d0]; }
#pragma unroll
      for (int of = 1; of < 32; of <<= 1) ss += __int_as_float(__builtin_amdgcn_ds_bpermute((lane ^ of) << 2, __float_as_int(ss)));
      const float rstd = rsqrtf(ss * (1.f / 128.f) + 1e-6f);
      unsigned short* op = OUT + (size_t)(wid * QBLK + crow(r, hi)) * 1024 + r32;
#pragma unroll
      for (int d0 = 0; d0 < 4; ++d0) { const float y = v[d0] * rstd * sg[d0]; unsigned u = __float_as_uint(y); op[d0 * 32] = (unsigned short)((u + 0x7fffu + ((u >> 16) & 1u)) >> 16); }
    }
  }
}
}
constexpr int NWAVES = 8;
constexpr int RING_OFF = 0, RING_BYTES = 131072;
constexpr int LDSCTL_OFF = RING_BYTES, MISC_OFF = LDSCTL_OFF + 320;
constexpr int LDS_BYTES = 147456;
constexpr int RSTD_OFF = LDSCTL_OFF + 8192;
constexpr int CW_BAR = 4096;
constexpr int CW_KMAX = 8448;
constexpr int CW_CNT = 8192;
constexpr int CW_BLKCNT = 10240;
constexpr int CW_SPLT = 9216;
constexpr size_t CTL_ZERO_BYTES = 64 * 1024;
constexpr int PH_PRO = 0, PH_L0 = 1, PH_PER_LAYER = 12, PH_FINAL = PH_L0 + DEPTH * PH_PER_LAYER, PH_END = PH_FINAL + 1;
enum { P_NORM1 = 0, P_INPROJ, P_XLOC, P_SCAN, P_MIX, P_GLU, P_BRANCH, P_OUT, P_NORM2, P_ASSIGN, P_UP, P_DOWN };

struct Args {
    const float* in[25]; float* out; unsigned char* ws;
    double inv_freq[32];
    int ph_lo, ph_hi, sub, pad;
};

typedef const __attribute__((address_space(4))) Args* ArgsP;
__device__ __forceinline__ ArgsP get_args() { ArgsP p = (ArgsP)__builtin_amdgcn_kernarg_segment_ptr(); asm volatile("" : "+s"(p)); return p; }
#define LDS_WAIT() asm volatile("s_waitcnt lgkmcnt(0)" ::: "memory")
#define VM_WAIT() asm volatile("s_waitcnt vmcnt(0)" ::: "memory")
typedef unsigned v4u __attribute__((ext_vector_type(4)));
__device__ __forceinline__ unsigned pk2(float lo, float hi) { return (unsigned)f2bf(lo) | ((unsigned)f2bf(hi) << 16); }

template <class RowMap>
__device__ __forceinline__ void transpose_item(const float* __restrict__ W, int N, bf16* __restrict__ WT, int ldt, int koff, LAS float* scr, int item, int lane, const RowMap& rm, const float* __restrict__ gk = nullptr) {
    const int nblk = N / 32, kb = item / nblk, nb = item % nblk, k0 = 64 * kb, n0 = 32 * nb;
    float wv[32];
    const float* wp = W + (size_t)(k0 + (lane >> 5)) * N + n0 + (lane & 31);
#pragma unroll
    for (int i = 0; i < 32; ++i) wv[i] = wp[(size_t)(2 * i) * N];
#pragma unroll
    for (int i = 0; i < 32; ++i) scr[(2 * i + (lane >> 5)) * 33 + (lane & 31)] = wv[i];
    LDS_WAIT(); asm volatile("" ::: "memory");
    const int c = lane & 7;
    f32x4 g0 = {1.f, 1.f, 1.f, 1.f}, g1 = g0;
    if (gk) { g0 = *(const f32x4*)(gk + k0 + 8 * c); g1 = *(const f32x4*)(gk + k0 + 8 * c + 4); }
#pragma unroll
    for (int j = 0; j < 4; ++j) { const int n = (lane >> 3) + 8 * j; const LAS float* s = scr + (8 * c) * 33 + n;
        v4u o; o.x = pk2(s[0 * 33] * g0.x, s[1 * 33] * g0.y); o.y = pk2(s[2 * 33] * g0.z, s[3 * 33] * g0.w); o.z = pk2(s[4 * 33] * g1.x, s[5 * 33] * g1.y); o.w = pk2(s[6 * 33] * g1.z, s[7 * 33] * g1.w);
        *(v4u*)(WT + (size_t)rm(n0 + n) * ldt + koff + k0 + 8 * c) = o; }
    LDS_WAIT(); asm volatile("" ::: "memory");
}
struct RmId { __device__ __forceinline__ int operator()(int n) const { return n; } };
struct RmInProj { __device__ __forceinline__ int operator()(int n) const { return n < 1024 ? (n & ~63) + qk_pos(n & 63) : n; } };
struct RmGlu13 { int half; __device__ __forceinline__ int operator()(int n) const { return (n >> 7) * 256 + half * 128 + (n & 127); } };
struct TItem { const float* src; bf16* dst; int N, ldt, koff, map, k0, n0; };
__device__ __forceinline__ void t_setkn(TItem& t, int item) { const int nblk = t.N / 32; t.k0 = 64 * (item / nblk); t.n0 = 32 * (item % nblk); }
__device__ __forceinline__ void t_load(const TItem& t, int lane, float (&wv)[32]) {
    const float* wp = t.src + (size_t)(t.k0 + (lane >> 5)) * t.N + t.n0 + (lane & 31);
#pragma unroll
    for (int i = 0; i < 32; ++i) wv[i] = wp[(size_t)(2 * i) * t.N];
}
__device__ __forceinline__ void t_store(const TItem& t, int lane, const float (&wv)[32], LAS float* scr) {
#pragma unroll
    for (int i = 0; i < 32; ++i) scr[(2 * i + (lane >> 5)) * 33 + (lane & 31)] = wv[i];
    LDS_WAIT(); asm volatile("" ::: "memory");
    const int c = lane & 7;
#pragma unroll
    for (int j = 0; j < 4; ++j) { const int n = (lane >> 3) + 8 * j; const LAS float* q = scr + (8 * c) * 33 + n; const int nn = t.n0 + n;
        const int row = t.map == 0 ? nn : (t.map == 1 ? (nn < 1024 ? (nn & ~63) + qk_pos(nn & 63) : nn) : (nn >> 7) * 256 + (t.map - 2) * 128 + (nn & 127));
        v4u o; o.x = pk2(q[0 * 33], q[1 * 33]); o.y = pk2(q[2 * 33], q[3 * 33]); o.z = pk2(q[4 * 33], q[5 * 33]); o.w = pk2(q[6 * 33], q[7 * 33]);
        *(v4u*)(t.dst + (size_t)row * t.ldt + t.koff + t.k0 + 8 * c) = o; }
    LDS_WAIT(); asm volatile("" ::: "memory");
}
#define T_SWEEP(first, step, total, DEC) do { int it_ = (first); if (it_ < (total)) { TItem ta_, tb_; float va_[32], vb_[32]; DEC(it_, ta_); t_load(ta_, lane, va_); \
    for (;;) { const int i2_ = it_ + (step); const bool h2_ = i2_ < (total); if (h2_) { DEC(i2_, tb_); t_load(tb_, lane, vb_); } t_store(ta_, lane, va_, scr); if (!h2_) break; \
               it_ = i2_ + (step); const bool h3_ = it_ < (total); if (h3_) { DEC(it_, ta_); t_load(ta_, lane, va_); } t_store(tb_, lane, vb_, scr); if (!h3_) break; } } } while (0)

constexpr size_t WO_IN = 0, WO_GLU = WO_IN + 32 * MiB, WO_BR = WO_GLU + 2 * MiB, WO_OUT = WO_BR + 8 * MiB, WO_F13 = WO_OUT + 8 * MiB, WO_F2 = WO_F13 + 22 * MiB,
                 WO_M13 = WO_F2 + 11 * MiB, WO_M2 = WO_M13 + 88 * MiB, WO_BY = WO_M2 + 44 * MiB, WO_BX = WO_BY + 32 * MiB, WO_ROT = WO_BX + 16 * MiB, WO_END = WO_ROT + 2 * MiB;
static_assert(WS_WEIGHTS + WO_END <= WS_XN, "weights region");

__device__ __forceinline__ int ltid() { int t = threadIdx.x; asm volatile("" : "+v"(t)); return t; }
#define PHASE_IDS const int tid = ltid(), lane = tid & 63, wave = __builtin_amdgcn_readfirstlane(tid >> 6); (void)lane; (void)wave
struct Frame {
    LAS unsigned char* lds; int vcu, G, bx;
};
__device__ __forceinline__ Frame make_frame(LAS unsigned char* lds) {
    Frame F; F.lds = lds; int G = gridDim.x, bx = blockIdx.x; asm volatile("" : "+s"(G), "+s"(bx));
    F.G = G; F.bx = bx; F.vcu = (G % 8 == 0) ? (bx % 8) * (G / 8) + bx / 8 : bx; return F;
}
__device__ __forceinline__ float shx(float v, int o, int lane) { return __int_as_float(__builtin_amdgcn_ds_bpermute((lane ^ o) << 2, __float_as_int(v))); }
#define WS_DPP(v, ctrl) ((v) + __int_as_float(__builtin_amdgcn_mov_dpp(__float_as_int(v), (ctrl), 0xf, 0xf, true)))
__device__ __forceinline__ float wave_sum_l(float v, int lane) {
    (void)lane;
    v = WS_DPP(v, 0xB1);
    v = WS_DPP(v, 0x4E);
    v = WS_DPP(v, 0x141);
    v = WS_DPP(v, 0x140);
    { auto r = __builtin_amdgcn_permlane16_swap(__float_as_uint(v), __float_as_uint(v), false, false); v = __uint_as_float(r[0]) + __uint_as_float(r[1]); }
    { auto r = __builtin_amdgcn_permlane32_swap(__float_as_uint(v), __float_as_uint(v), false, false); v = __uint_as_float(r[0]) + __uint_as_float(r[1]); }
    return v;
}

__device__ __forceinline__ void ssm_gen_item(const Frame& F, ArgsP A, int item) {
    unsigned char* ws = A->ws;
    PHASE_IDS; const int layer = item >> 5, g = item & 31;
    LAS float* L = (LAS float*)(F.lds);
    LAS float* apr = L;
    LAS float* api = apr + 2 * 17 * 64;
    LAS float* bbr = api + 2 * 17 * 64;
    LAS float* bbi = bbr + 2 * 64 * 16;
    LAS float* cr = bbi + 2 * 64 * 16;
    LAS float* ci = cr + 2 * 16 * 64;
    LAS float* Kt = ci + 2 * 16 * 64;
    LAS float* ff = Kt + 2 * 16 * 256;
    LAS float* apj = ff + 2 * 64 * 2;
    const float* lam_re = A->in[5] + (size_t)layer * 2 * SSM_G * SSM_P; const float* lam_im = A->in[6] + (size_t)layer * 2 * SSM_G * SSM_P; const float* log_dt = A->in[7] + layer * 2 * SSM_G;
    const float* b_re = A->in[8] + (size_t)layer * 2 * SSM_G * SSM_P * 16; const float* b_im = A->in[9] + (size_t)layer * 2 * SSM_G * SSM_P * 16;
    const float* c_re = A->in[10] + (size_t)layer * 2 * SSM_G * 16 * SSM_P; const float* c_im = A->in[11] + (size_t)layer * 2 * SSM_G * 16 * SSM_P;
    const float* dsk = A->in[12] + layer * SSM_W + g * 16;
    {
        const int d = (tid >> 6) & 1, p = tid & 63, jq = tid >> 7; const size_t pi = ((size_t)d * SSM_G + g) * SSM_P + p;
        const float lr = lam_re[pi], li = lam_im[pi], dt = expf(log_dt[d * SSM_G + g]);
        for (int j = jq; j <= 16; j += 4) { const float er = expf((float)j * lr * dt); float sn, cs; sincosf((float)j * li * dt, &sn, &cs); const float ar_ = er * cs, ai_ = er * sn;
            apr[(d * 17 + j) * 64 + p] = ar_; api[(d * 17 + j) * 64 + p] = ai_;
            if (j < 16) { apj[((d * 64 + p) * 16 + j) * 2] = ar_; apj[((d * 64 + p) * 16 + j) * 2 + 1] = ai_; }
            if (j == 1) { const float nr = ar_ - 1.f, ni = ai_, den = lr * lr + li * li;
                ff[(d * 64 + p) * 2] = (nr * lr + ni * li) / den; ff[(d * 64 + p) * 2 + 1] = (ni * lr - nr * li) / den; } }
    }
    __syncthreads();
    for (int e = tid; e < 2048; e += 512) {
        const int d = e >> 10, p = (e >> 4) & 63, hh = e & 15; const size_t bi_ = (((size_t)d * SSM_G + g) * SSM_P + p) * 16 + hh;
        const float br = b_re[bi_], bi = b_im[bi_], fr = ff[(d * 64 + p) * 2], fi = ff[(d * 64 + p) * 2 + 1];
        bbr[e] = fr * br - fi * bi; bbi[e] = fr * bi + fi * br;
        const int h2 = (e >> 6) & 15, p2 = e & 63; const size_t ci_ = (((size_t)d * SSM_G + g) * 16 + h2) * SSM_P + p2;
        cr[e] = c_re[ci_]; ci[e] = c_im[ci_];
    }
    __syncthreads();
    {
        const int d = tid >> 8, h = (tid >> 4) & 15, h2 = tid & 15;
        float sj[16];
#pragma unroll
        for (int j = 0; j < 16; ++j) sj[j] = 0.f;
        for (int p = 0; p < 64; ++p) {
            const float c_r = cr[(d * 16 + h) * 64 + p], c_i = ci[(d * 16 + h) * 64 + p], b_r = bbr[(d * 64 + p) * 16 + h2], b_i = bbi[(d * 64 + p) * 16 + h2];
            const float t_r = c_r * b_r - c_i * b_i, t_i = c_r * b_i + c_i * b_r;
            const LAS f32x4* ap = (const LAS f32x4*)(apj + (d * 64 + p) * 32);
#pragma unroll
            for (int q = 0; q < 8; ++q) { const f32x4 a = ap[q]; sj[2 * q] += t_r * a.x - t_i * a.y; sj[2 * q + 1] += t_r * a.z - t_i * a.w; }
        }
#pragma unroll
        for (int j = 0; j < 16; ++j) Kt[(d * 16 + j) * 256 + h * 16 + h2] = sj[j];
    }
    __syncthreads();
    bf16* BY = (bf16*)(ws + WS_WEIGHTS + WO_BY) + ((size_t)layer * 32 + g) * 256 * 512;
    bf16* BX = (bf16*)(ws + WS_WEIGHTS + WO_BX) + ((size_t)layer * 32 + g) * 256 * 256;
    for (int e8 = tid; e8 < 256 * 64; e8 += 512) {
        const int n = e8 >> 6, k0 = (e8 & 63) * 8, i = n >> 4, h = n & 15; float v[8];
        if (k0 < 256) { const int i2 = k0 >> 4, h20 = k0 & 15;
#pragma unroll
            for (int q = 0; q < 8; ++q) { const int h2 = h20 + q; float t = 0.f;
                if (i >= i2) t += Kt[(0 * 16 + (i - i2)) * 256 + h * 16 + h2];
                if (i2 >= i) t += Kt[(1 * 16 + (i2 - i)) * 256 + h * 16 + h2];
                if (i == i2 && h == h2) t += dsk[h];
                v[q] = t; }
        } else { const int kk = k0 - 256, d = kk >> 7, im = (kk >> 6) & 1, p0 = kk & 63, j = d == 0 ? i + 1 : 16 - i;
#pragma unroll
            for (int q = 0; q < 8; ++q) { const int p = p0 + q; const float c_r = cr[(d * 16 + h) * 64 + p], c_i = ci[(d * 16 + h) * 64 + p], a_r = apr[(d * 17 + j) * 64 + p], a_i = api[(d * 17 + j) * 64 + p];
                v[q] = im ? -(c_r * a_i + c_i * a_r) : (c_r * a_r - c_i * a_i); } }
        v4u o; o.x = pk2(v[0], v[1]); o.y = pk2(v[2], v[3]); o.z = pk2(v[4], v[5]); o.w = pk2(v[6], v[7]);
        *(v4u*)(BY + (size_t)n * 512 + k0) = o;
    }
    for (int e8 = tid; e8 < 256 * 32; e8 += 512) {
        const int n = e8 >> 5, k0 = (e8 & 31) * 8, d = n >> 7, im = (n >> 6) & 1, p = n & 63, i2 = k0 >> 4, h20 = k0 & 15, j = d == 0 ? 15 - i2 : i2;
        const float a_r = apr[(d * 17 + j) * 64 + p], a_i = api[(d * 17 + j) * 64 + p]; float v[8];
#pragma unroll
        for (int q = 0; q < 8; ++q) { const float b_r = bbr[(d * 64 + p) * 16 + h20 + q], b_i = bbi[(d * 64 + p) * 16 + h20 + q]; v[q] = im ? (a_r * b_i + a_i * b_r) : (a_r * b_r - a_i * b_i); }
        v4u o; o.x = pk2(v[0], v[1]); o.y = pk2(v[2], v[3]); o.z = pk2(v[4], v[5]); o.w = pk2(v[6], v[7]);
        *(v4u*)(BX + (size_t)n * 256 + k0) = o;
    }
    __syncthreads();
}

__device__ __forceinline__ void prologue_phase(const Frame& F, ArgsP A) {
    unsigned char* ws = A->ws;
    PHASE_IDS;
    __syncthreads();
    for (int it = F.bx; it < DEPTH * SSM_G; it += F.G) ssm_gen_item(F, A, it);
    { float* COS = (float*)(ws + WS_WEIGHTS + WO_ROT); float* SIN = COS + SEQ * 32;
      for (int e = F.bx * 512 + tid; e < SEQ * 32; e += F.G * 512) { const int s = e >> 5, j = e & 31;
          double r = (double)s * A->inv_freq[j] * 0.15915494309189533577; r -= floor(r); const float th = (float)(r * 6.283185307179586477);
          float sn, cs; sincosf(th, &sn, &cs); COS[e] = cs; SIN[e] = sn; } }
    LAS float* scr = (LAS float*)(F.lds + wave * 16384);
    const int gw = F.vcu * NWAVES + wave, NGW = F.G * NWAVES;
    unsigned char* wb = ws + WS_WEIGHTS;
    constexpr int I_IN = 16 * 128, I_GLU = 8 * 16, I_BR = 8 * 32, I_OUT = 16 * 32, I_LAYER = I_IN + I_GLU + 2 * I_BR + I_OUT;
    constexpr int I_13 = 16 * 88, I_2 = 44 * 32, I_FFN = 2 * I_13 + I_2;
    constexpr int N_ITEMS = DEPTH * I_LAYER + 2 * I_FFN, POOL_A = (N_ITEMS * 99 / 100) & ~7;
    const bool split = F.G == 256; const int hw = (F.bx - 128) * NWAVES + wave;
    for (int k = 0;; ++k) {
        int it;
        if (!split) { it = gw + k * NGW; if (it >= N_ITEMS) break; }
        else if (F.bx >= 128) { const int a = hw + k * 128 * NWAVES; if (a < POOL_A) it = a; else { const int nA = (POOL_A - hw + 128 * NWAVES - 1) / (128 * NWAVES); it = POOL_A + gw + (k - nA) * NGW; if (it >= N_ITEMS) break; } }
        else { it = POOL_A + gw + k * NGW; if (it >= N_ITEMS) break; }
        int r = it;
        if (r < DEPTH * I_LAYER) {
            const int l = r / I_LAYER; r -= l * I_LAYER;
            if (r < I_IN) { transpose_item(A->in[2] + (size_t)l * 1024 * 4096, 4096, (bf16*)(wb + WO_IN) + (size_t)l * 4096 * 1024, 1024, 0, scr, r, lane, RmInProj{}, (l & 1) ? A->in[1] + l * D_MODEL : nullptr); continue; } r -= I_IN;
            if (r < I_GLU) { transpose_item(A->in[13] + (size_t)l * 512 * 512, 512, (bf16*)(wb + WO_GLU) + (size_t)l * 512 * 512, 512, 0, scr, r, lane, RmId{}); continue; } r -= I_GLU;
            if (r < 2 * I_BR) { const int br = r / I_BR; r -= br * I_BR;
                transpose_item(A->in[14] + ((size_t)l * 2 + br) * 512 * 1024, 1024, (bf16*)(wb + WO_BR) + (size_t)l * 1024 * 1024, 1024, br * 512, scr, r, lane, RmId{}); continue; } r -= 2 * I_BR;
            transpose_item(A->in[15] + (size_t)l * 1024 * 1024, 1024, (bf16*)(wb + WO_OUT) + (size_t)l * 1024 * 1024, 1024, 0, scr, r, lane, RmId{});
        } else {
            r -= DEPTH * I_LAYER; const int i = r / I_FFN; r -= i * I_FFN;
            bf16* F13 = (bf16*)(wb + WO_F13) + (size_t)i * 5632 * 1024; bf16* F2 = (bf16*)(wb + WO_F2) + (size_t)i * 1024 * 2816;
            if (r < I_13) { transpose_item(A->in[17] + (size_t)i * 1024 * 2816, 2816, F13, 1024, 0, scr, r, lane, RmGlu13{0}, A->in[16] + (2 * i) * D_MODEL); continue; } r -= I_13;
            if (r < I_13) { transpose_item(A->in[18] + (size_t)i * 1024 * 2816, 2816, F13, 1024, 0, scr, r, lane, RmGlu13{1}, A->in[16] + (2 * i) * D_MODEL); continue; } r -= I_13;
            transpose_item(A->in[19] + (size_t)i * 2816 * 1024, 1024, F2, 2816, 0, scr, r, lane, RmId{});
        }
    }
}
constexpr int MOE_EARLY = 4864;
__device__ __forceinline__ void moe_cvt(const Frame& F, ArgsP A, int i, int part) {
    unsigned char* ws = A->ws;
    PHASE_IDS;
    LAS float* scr = (LAS float*)(F.lds + 40960 + wave * 8704);
    const bool early = part < 2 && F.G == 256;
    if (part < 2 && !early) return;
    const int gw = early ? part * MOE_EARLY + (F.bx - 128) * NWAVES + wave : (F.G == 256 ? 2 * MOE_EARLY : 0) + F.vcu * NWAVES + wave, NGW = early ? 128 * NWAVES : F.G * NWAVES;
    const int itend = early ? (part + 1) * MOE_EARLY : 8 * (2 * 16 * 88 + 44 * 32);
    unsigned char* wb = ws + WS_WEIGHTS;
    constexpr int I_13 = 16 * 88, I_2 = 44 * 32, I_E = 2 * I_13 + I_2;
#define MOE_DEC(it, t) do { const int e_ = (it) / I_E; int r_ = (it) - e_ * I_E; const size_t wo_ = ((size_t)i * N_EXP + e_); \
        if (r_ < 2 * I_13) { const int h_ = r_ >= I_13; r_ -= h_ * I_13; (t).src = A->in[21 + h_] + wo_ * 1024 * 2816; (t).N = 2816; (t).dst = (bf16*)(wb + WO_M13) + (size_t)e_ * 5632 * 1024; (t).ldt = 1024; (t).koff = 0; (t).map = 2 + h_; } \
        else { r_ -= 2 * I_13; (t).src = A->in[23] + wo_ * 2816 * 1024; (t).N = 1024; (t).dst = (bf16*)(wb + WO_M2) + (size_t)e_ * 1024 * 2816; (t).ldt = 2816; (t).koff = 0; (t).map = 0; } \
        t_setkn((t), r_); } while (0)
    T_SWEEP(gw, NGW, itend, MOE_DEC);
#undef MOE_DEC
}

template <bool COMBINE, bool ROUTER, bool FINAL>
__device__ __forceinline__ void norm_phase(const Frame& F, const float* __restrict__ SRC, float* __restrict__ X, const float* __restrict__ gain, bf16* __restrict__ XN,
                                           const bf16* __restrict__ YS, const int* __restrict__ slot_prev, const float* __restrict__ gate_prev, const unsigned* __restrict__ SPLT, const float* __restrict__ PART,
                                           const float* __restrict__ wr, unsigned* __restrict__ cnt, int* __restrict__ asg_e, int* __restrict__ asg_pos, float* __restrict__ asg_g) {
    PHASE_IDS;
    LAS float* wrl = (LAS float*)F.lds;
    LAS int* rinfo = (LAS int*)(F.lds + 32768 + 64);
    LAS int* lcnt = (LAS int*)(F.lds + 32768 + 64 + 512);
    LAS float* rg = (LAS float*)(F.lds + 32768 + 64 + 1024);
    if (ROUTER) { for (int e = tid; e < 8192; e += 512) wrl[(e & 7) * 1024 + (e >> 3)] = wr[e]; __syncthreads(); }
    const int rpb = NTOK / F.G;
    f32x4 gg4[4], vn[4];
#pragma unroll
    for (int j = 0; j < 4; ++j) gg4[j] = ((const f32x4*)gain)[64 * j + lane];
    if (wave < rpb) { const f32x4* xr = (const f32x4*)(SRC + (size_t)(F.vcu * rpb + wave) * D_MODEL) + lane;
#pragma unroll
        for (int j = 0; j < 4; ++j) vn[j] = xr[64 * j]; }
    for (int rr = wave; rr < rpb; rr += NWAVES) {
        const int row = F.vcu * rpb + rr;
        f32x4 v[4]; float s = 0.f;
#pragma unroll
        for (int j = 0; j < 4; ++j) v[j] = vn[j];
        if (rr + NWAVES < rpb) { const f32x4* xr = (const f32x4*)(SRC + (size_t)(row + NWAVES) * D_MODEL) + lane;
#pragma unroll
            for (int j = 0; j < 4; ++j) vn[j] = xr[64 * j]; }
        if (COMBINE) {
            const int s0 = slot_prev[row * 2], s1 = slot_prev[row * 2 + 1]; const float g0 = gate_prev[row * 2], g1 = gate_prev[row * 2 + 1];
            const unsigned long long* y0 = (const unsigned long long*)(YS + (size_t)s0 * 1024) + lane; const unsigned long long* y1 = (const unsigned long long*)(YS + (size_t)s1 * 1024) + lane;
            const unsigned t0 = SPLT[s0 >> 8], t1 = SPLT[s1 >> 8];
            f32x4 ta[4] = {{0.f, 0.f, 0.f, 0.f}, {0.f, 0.f, 0.f, 0.f}, {0.f, 0.f, 0.f, 0.f}, {0.f, 0.f, 0.f, 0.f}}, tb[4] = {{0.f, 0.f, 0.f, 0.f}, {0.f, 0.f, 0.f, 0.f}, {0.f, 0.f, 0.f, 0.f}, {0.f, 0.f, 0.f, 0.f}};
            if (t0 != 0u) { const f32x4* pp = (const f32x4*)(PART + (size_t)(t0 - 1) * 24 * 65536 + (size_t)(s0 & 255) * 256) + lane;
#pragma unroll
                for (int j = 0; j < 4; ++j) { ta[j] = pp[(size_t)(j * 6) * 16384];
#pragma unroll
                    for (int ks = 1; ks < 6; ++ks) ta[j] += pp[(size_t)(j * 6 + ks) * 16384]; } }
            if (t1 != 0u) { const f32x4* pp = (const f32x4*)(PART + (size_t)(t1 - 1) * 24 * 65536 + (size_t)(s1 & 255) * 256) + lane;
#pragma unroll
                for (int j = 0; j < 4; ++j) { tb[j] = pp[(size_t)(j * 6) * 16384];
#pragma unroll
                    for (int ks = 1; ks < 6; ++ks) tb[j] += pp[(size_t)(j * 6 + ks) * 16384]; } }
#pragma unroll
            for (int j = 0; j < 4; ++j) { const unsigned long long a = y0[64 * j], b = y1[64 * j];
                f32x4 ya = {__uint_as_float((unsigned)(a << 16)), __uint_as_float((unsigned)a & 0xffff0000u), __uint_as_float((unsigned)(a >> 32) << 16), __uint_as_float((unsigned)(a >> 32) & 0xffff0000u)};
                f32x4 yb = {__uint_as_float((unsigned)(b << 16)), __uint_as_float((unsigned)b & 0xffff0000u), __uint_as_float((unsigned)(b >> 32) << 16), __uint_as_float((unsigned)(b >> 32) & 0xffff0000u)};
                if (t0 != 0u) ya = ta[j];
                if (t1 != 0u) yb = tb[j];
                v[j] += g0 * ya + g1 * yb;
                if (!FINAL) ((f32x4*)(X + (size_t)row * D_MODEL) + lane)[64 * j] = v[j]; }
        }
#pragma unroll
        for (int j = 0; j < 4; ++j) s += (v[j].x * v[j].x + v[j].y * v[j].y) + (v[j].z * v[j].z + v[j].w * v[j].w);
        const float rstd = rsqrtf(wave_sum_l(s, lane) * (1.f / D_MODEL) + RMS_EPS);
        float lg[8];
#pragma unroll
        for (int e = 0; e < 8; ++e) lg[e] = 0.f;
#pragma unroll
        for (int j = 0; j < 4; ++j) {
            const f32x4 gg = gg4[j];
            v[j].x *= rstd * gg.x; v[j].y *= rstd * gg.y; v[j].z *= rstd * gg.z; v[j].w *= rstd * gg.w;
            if (FINAL) ((f32x4*)(X + (size_t)row * D_MODEL) + lane)[64 * j] = v[j];
            else ((unsigned long long*)(XN + (size_t)row * D_MODEL))[64 * j + lane] = (unsigned long long)pk2(v[j].x, v[j].y) | ((unsigned long long)pk2(v[j].z, v[j].w) << 32);
            if (ROUTER) {
#pragma unroll
                for (int e = 0; e < 8; ++e) { const f32x4 w = *(const LAS f32x4*)(wrl + e * 1024 + (64 * j + lane) * 4); lg[e] += (v[j].x * w.x + v[j].y * w.y) + (v[j].z * w.z + v[j].w * w.w); } }
        }
        if (ROUTER) {
#pragma unroll
            for (int e = 0; e < 8; ++e) lg[e] = wave_sum_l(lg[e], lane);
            int e0 = 0; float l0 = lg[0];
#pragma unroll
            for (int e = 1; e < 8; ++e) if (lg[e] > l0) { l0 = lg[e]; e0 = e; }
            int e1 = -1; float l1 = -3.4e38f;
#pragma unroll
            for (int e = 0; e < 8; ++e) if (e != e0 && lg[e] > l1) { l1 = lg[e]; e1 = e; }
            const float p1 = __expf(l1 - l0), inv = 1.f / (1.f + p1);
            if (lane == 0) { rinfo[rr * 2] = e0; rinfo[rr * 2 + 1] = e1; rg[rr * 2] = inv; rg[rr * 2 + 1] = p1 * inv; }
        }
    }
    if (ROUTER) {
        __syncthreads();
        const int nW = (rpb * 2) >> 6;
        int e_my = 0, lp = 0;
        if (wave < nW) { e_my = rinfo[wave * 64 + lane]; unsigned long long mine = 0ull;
#pragma unroll
            for (int q = 0; q < 8; ++q) { const unsigned long long m = __ballot(e_my == q); mine = (e_my == q) ? m : mine; if (lane == 0) lcnt[wave * 8 + q] = __popcll(m); }
            lp = (int)__builtin_amdgcn_mbcnt_hi((unsigned)(mine >> 32), __builtin_amdgcn_mbcnt_lo((unsigned)mine, 0u)); }
        __syncthreads();
        if (wave < nW) { for (int w2 = 0; w2 < wave; ++w2) lp += lcnt[w2 * 8 + e_my];
            const int a = wave * 64 + lane, row2 = F.vcu * rpb * 2 + a; asg_e[row2] = e_my; asg_pos[row2] = lp; asg_g[row2] = rg[a]; }
        if (tid >= 256 && tid < 264) { const int e = tid - 256; int c = 0; for (int w2 = 0; w2 < nW; ++w2) c += lcnt[w2 * 8 + e]; cnt[F.vcu * 8 + e] = (unsigned)c; }
    }
}

__device__ __forceinline__ void rstd_prep(const Frame& F, const float* __restrict__ PS, int pm) {
    PHASE_IDS;
    LAS float* rs = (LAS float*)(F.lds + RSTD_OFF);
    if (tid < 256) { const float* q = PS + pm * 256 + tid; float s = 0.f;
#pragma unroll
        for (int i = 0; i < 16; ++i) s += q[(size_t)i * NTOK];
        rs[tid] = rsqrtf(s * (1.f / D_MODEL) + RMS_EPS); }
    __syncthreads();
}
struct MoeLayout { int ps[8]; int pe[8]; int nblk; };
template <class P> __device__ __forceinline__ MoeLayout moe_layout(P cnt) {
    MoeLayout L; int acc = 0;
#pragma unroll
    for (int e = 0; e < 8; ++e) { const int c = (int)cnt[e]; L.ps[e] = acc; acc += (c + 255) & ~255; L.pe[e] = acc; }
    L.nblk = acc >> 8; return L;
}
__device__ __forceinline__ void assign_phase(const Frame& F, const unsigned* blkcnt, unsigned* cnt, const int* asg_e, const int* asg_pos, int* slot_of, const bf16* XN, bf16* XB, unsigned* splt) {
    PHASE_IDS;
    LAS int* lt = (LAS int*)F.lds;
    if (tid < 16) lt[tid] = 0;
    __syncthreads();
    int tot = 0, pre = 0;
    if (tid < 128) { const int e = tid & 7, h = tid >> 3;
#pragma unroll
        for (int k = 0; k < 16; ++k) { const int b = h * 16 + k; const int c = b < F.G ? (int)blkcnt[b * 8 + e] : 0; tot += c; pre += (b < F.vcu) ? c : 0; } }
    const int rpb = NTOK / F.G;
    if (rpb == 64) {
        int ee[16], pp[16]; v4u d0[16], d1[16];
#pragma unroll
        for (int k = 0; k < 16; ++k) { const int ga = F.vcu * 128 + wave + 8 * k; ee[k] = asg_e[ga]; pp[k] = asg_pos[ga];
            const v4u* src = (const v4u*)(XN + (size_t)(ga >> 1) * 1024) + lane; d0[k] = src[0]; d1[k] = src[64]; }
        if (tid < 128) { const int e = tid & 7; __hip_atomic_fetch_add(&lt[e], tot, __ATOMIC_RELAXED, __HIP_MEMORY_SCOPE_WORKGROUP); __hip_atomic_fetch_add(&lt[8 + e], pre, __ATOMIC_RELAXED, __HIP_MEMORY_SCOPE_WORKGROUP); }
        __syncthreads();
        const MoeLayout L = moe_layout(lt);
        if (F.bx == 0) {
            if (tid < 8) cnt[tid] = (unsigned)lt[tid];
            const int tile0 = ((L.nblk * 4) >> 8) * 64;
            if (tid < L.nblk - tile0) splt[tile0 + tid] = (unsigned)(tid + 1);
        }
#pragma unroll
        for (int k = 0; k < 16; ++k) { const int ga = F.vcu * 128 + wave + 8 * k, e = ee[k];
            int ps = L.ps[0], pr = lt[8];
#pragma unroll
            for (int q = 1; q < 8; ++q) { ps = (e == q) ? L.ps[q] : ps; pr = (e == q) ? lt[8 + q] : pr; }
            const int dest = ps + pr + pp[k];
            if (lane == 0) slot_of[ga] = dest;
            v4u* dst = (v4u*)(XB + (size_t)dest * 1024) + lane; dst[0] = d0[k]; dst[64] = d1[k]; }
        return;
    }
    if (tid < 128) { const int e = tid & 7; __hip_atomic_fetch_add(&lt[e], tot, __ATOMIC_RELAXED, __HIP_MEMORY_SCOPE_WORKGROUP); __hip_atomic_fetch_add(&lt[8 + e], pre, __ATOMIC_RELAXED, __HIP_MEMORY_SCOPE_WORKGROUP); }
    __syncthreads();
    if (F.bx == 0 && tid < 8) cnt[tid] = (unsigned)lt[tid];
    const MoeLayout L = moe_layout(lt);
    if (F.bx == 0) {
        const int tile0 = ((L.nblk * 4) >> 8) * 64;
        if (tid < L.nblk - tile0) splt[tile0 + tid] = (unsigned)(tid + 1);
    }
    for (int a = wave; a < rpb * 2; a += NWAVES) {
        const int ga = F.vcu * rpb * 2 + a, tok = ga >> 1, e = asg_e[ga];
        int ps = L.ps[0];
#pragma unroll
        for (int q = 1; q < 8; ++q) ps = (e == q) ? L.ps[q] : ps;
        int pr = lt[8];
#pragma unroll
        for (int q = 1; q < 8; ++q) pr = (e == q) ? lt[8 + q] : pr;
        const int dest = ps + pr + asg_pos[ga];
        if (lane == 0) slot_of[ga] = dest;
        const v4u* src = (const v4u*)(XN + (size_t)tok * 1024) + lane; v4u* dst = (v4u*)(XB + (size_t)dest * 1024) + lane;
        dst[0] = src[0]; dst[64] = src[64];
    }
}

__device__ __forceinline__ void scan_phase(const Frame& F, ArgsP A, int layer, const float* __restrict__ XLOC, bf16* __restrict__ AY) {
    PHASE_IDS;
    LAS float* S = (LAS float*)F.lds;
    for (int it = F.vcu; it < 256; it += F.G) {
        const int b = it >> 7, g = (it >> 2) & 31, d = (it >> 1) & 1, ph = it & 1, pp = tid & 31, seg = tid >> 5, p = ph * 32 + pp;
        const size_t pi = ((size_t)layer * 2 + d) * SSM_G * SSM_P + (size_t)g * SSM_P + p;
        const float lr = A->in[5][pi], li = A->in[6][pi], dt = expf(A->in[7][(layer * 2 + d) * SSM_G + g]);
        const float er = expf(16.f * lr * dt); float sn, cs; sincosf(16.f * li * dt, &sn, &cs);
        const float ar = er * cs, ai = er * sn;
        float Ar = ar, Ai = ai;
#pragma unroll
        for (int q = 0; q < 5; ++q) { const float t = Ar * Ar - Ai * Ai; Ai = 2.f * Ar * Ai; Ar = t; }
        const int c0 = d == 0 ? seg * 32 : 511 - seg * 32, cstep = d == 0 ? 1 : -1;
        const float* xl = XLOC + ((size_t)g * 1024 + b * 512 + c0) * 256 + d * 128 + p; const long xs = (long)cstep * 256;
        float sr = 0.f, si = 0.f;
        float xrv[32], xiv[32];
#pragma unroll
        for (int k = 0; k < 32; ++k) { xrv[k] = xl[k * xs]; xiv[k] = xl[k * xs + 64]; }
#pragma unroll
        for (int k = 0; k < 32; ++k) { const float t = ar * sr - ai * si + xrv[k]; si = ar * si + ai * sr + xiv[k]; sr = t; }
        S[(seg * 32 + pp) * 2] = sr; S[(seg * 32 + pp) * 2 + 1] = si;
        __syncthreads();
        float cr_ = 0.f, ci_ = 0.f;
        for (int s2 = 0; s2 < seg; ++s2) { const float t = Ar * cr_ - Ai * ci_ + S[(s2 * 32 + pp) * 2]; ci_ = Ar * ci_ + Ai * cr_ + S[(s2 * 32 + pp) * 2 + 1]; cr_ = t; }
        bf16* ay = AY + ((size_t)g * 1024 + b * 512 + c0) * 512 + 256 + d * 128 + p; const long ys = (long)cstep * 512;
#pragma unroll
        for (int k = 0; k < 32; ++k) { const float xr = xrv[k], xi = xiv[k];
            {
              const float pr = __int_as_float(__builtin_amdgcn_mov_dpp(__float_as_int(cr_), 0xB1, 0xf, 0xf, true)), pi = __int_as_float(__builtin_amdgcn_mov_dpp(__float_as_int(ci_), 0xB1, 0xf, 0xf, true));
              const bool odd = (pp & 1) != 0;
              *(unsigned*)(ay + k * ys + (odd ? 63 : 0)) = odd ? pk2(pi, ci_) : pk2(cr_, pr); }
            const float t = ar * cr_ - ai * ci_ + xr; ci_ = ar * ci_ + ai * cr_ + xi; cr_ = t; }
        __syncthreads();
    }
}

__device__ __forceinline__ void kmax_phase(const Frame& F, const bf16* __restrict__ Kb, unsigned* __restrict__ KMAX) {
    PHASE_IDS;
    const int nw = F.G > 128 ? F.G - 128 : F.G, w0 = F.G > 128 ? F.bx - 128 : F.bx;
    if (w0 < 0) return;
    for (int it = w0; it < 128; it += nw) {
        const int slab = it >> 3; const bf16* base = Kb + ((size_t)slab * 8192 + (size_t)(it & 7) * 1024 + wave * 128) * 64;
        float mx = 0.f;
#pragma unroll 4
        for (int i = 0; i < 16; ++i) { const v4u v = *(const v4u*)(base + (size_t)(i * 8 + (lane >> 3)) * 64 + (lane & 7) * 8); float q = 0.f;
            const unsigned w[4] = {v.x, v.y, v.z, v.w};
#pragma unroll
            for (int e = 0; e < 4; ++e) { const float a = __uint_as_float(w[e] << 16), b2 = __uint_as_float(w[e] & 0xffff0000u); q = fmaf(a, a, q); q = fmaf(b2, b2, q); }
            q += shx(q, 1, lane); q += shx(q, 2, lane); q += shx(q, 4, lane); mx = fmaxf(mx, q); }
#pragma unroll
        for (int o = 8; o < 64; o <<= 1) mx = fmaxf(mx, shx(mx, o, lane));
        if (lane == 0) __hip_atomic_fetch_max(KMAX + slab, __float_as_uint(mx), __ATOMIC_RELAXED, __HIP_MEMORY_SCOPE_AGENT);
    }
}
#ifndef PHASE_MASK
#define PHASE_MASK 0xffffffu
#endif
#define PMB(b) ((PHASE_MASK >> (b)) & 1u)
#ifndef REP_MASK
#define REP_MASK 0u
#endif
#ifndef REP_N
#define REP_N 1
#endif
#define RPT(b, cond) for (int rep_ = 0; rep_ < 1 + (((REP_MASK >> (b)) & 1u) && (cond) ? REP_N : 0); ++rep_)
#define SITE ArgsP ap = get_args(); unsigned char* ws = ap->ws; unsigned char* wb = ws + WS_WEIGHTS; (void)wb; const Frame F = make_frame((LAS unsigned char*)lds); (void)F
__device__ __forceinline__ bool in_range(int k) { ArgsP a = get_args(); const int lo = a->ph_lo, hi = a->ph_hi; return lo <= k && k < hi; }
__global__ void __launch_bounds__(NWAVES * 64, 2) mk_fwd(Args args_unused) {
    extern __shared__ __attribute__((aligned(16))) unsigned char lds[];
    volatile LAS unsigned* MISC = (volatile LAS unsigned*)((LAS unsigned char*)lds + MISC_OFF);
    for (int u = threadIdx.x; u < (LDS_BYTES - LDSCTL_OFF) / 4; u += NWAVES * 64) ((LAS unsigned*)((LAS unsigned char*)lds + LDSCTL_OFF))[u] = 0u;
    __syncthreads();
    { SITE; if ((ap->ph_hi - ap->ph_lo) > 1) (void)xcd_barrier_post((unsigned*)(ws + WS_CTL) + CW_BAR, MISC + 8); }
#define IN(k) in_range((k))
#define SUB() (get_args()->sub)
#define SEAM(k) do { if (IN(k) && IN((k) + 1)) { ArgsP ap_ = get_args(); XcdBarrier b_; b_.bar = (unsigned*)(ap_->ws + WS_CTL) + CW_BAR; b_.x = xb_xcc_id(); \
        b_.st = (volatile LAS unsigned*)((LAS unsigned char*)lds + MISC_OFF) + 8; xcd_barrier(b_); } } while (0)

    RPT(0, true) if (PMB(0) && IN(PH_PRO)) { SITE; prologue_phase(F, ap); }
    SEAM(PH_PRO);

    for (int l = 0; l < DEPTH; ++l) {
        const int pb = PH_L0 + l * PH_PER_LAYER, moe = l & 1, i = l >> 1;
        const bool fold1 = (l & 1) != 0;
        RPT(1, l != 2) if (!fold1 && PMB(1) && IN(pb + P_NORM1)) {
            SITE; float* X = ap->out; bf16* XN = (bf16*)(ws + WS_XN);
            const float* gain = ap->in[1] + l * D_MODEL;
            if (l == 0) norm_phase<false, false, false>(F, ap->in[0], X, gain, XN, nullptr, nullptr, nullptr, nullptr, nullptr, nullptr, nullptr, nullptr, nullptr, nullptr);
            else if (l == 2 && ((SUB() & 4) != 0)) { const int* sp = (const int*)(ws + WS_ROUTE) + 3 * 32768; const float* gp = (const float*)(ws + WS_ROUTE) + 2 * 32768;
                norm_phase<true, false, false>(F, X, X, gain, XN, (const bf16*)(ws + WS_R2), sp, gp, (const unsigned*)(ws + WS_CTL) + CW_SPLT, (const float*)(ws + WS_PART), nullptr, nullptr, nullptr, nullptr, nullptr); }
            else norm_phase<false, false, false>(F, X, X, gain, XN, nullptr, nullptr, nullptr, nullptr, nullptr, nullptr, nullptr, nullptr, nullptr, nullptr);
        }
        if (!fold1) SEAM(pb + P_NORM1);
        RPT(2, true) if (PMB(2) && IN(pb + P_INPROJ)) {
            SITE;
            pg8::Gemm g{(const bf16*)(ws + WS_XN), (const bf16*)(wb + WO_IN) + (size_t)l * 4096 * 1024}; pg8::StaticOrderT<64, 16> S{F.bx};
            const float* COS = (const float*)(wb + WO_ROT);
            if (fold1) { pg8::Unit u0; S.next(0, u0); rstd_prep(F, (const float*)(ws + WS_PS), u0.pm);
                pg8::EpiInProjT<true> E{(bf16*)(ws + WS_Q), (bf16*)(ws + WS_K), (bf16*)(ws + WS_V), (bf16*)(ws + WS_AY), (bf16*)(ws + WS_G), COS, COS + SEQ * 32, (const LAS float*)(F.lds + RSTD_OFF)};
                pg8::gemm_phase<pg8::EpiInProjT<true>, pg8::StaticOrderT<64, 16>, 1024, 1024, 1024>(F.lds + RING_OFF, g, S, E); }
            else { pg8::EpiInProj E{(bf16*)(ws + WS_Q), (bf16*)(ws + WS_K), (bf16*)(ws + WS_V), (bf16*)(ws + WS_AY), (bf16*)(ws + WS_G), COS, COS + SEQ * 32, nullptr};
                pg8::gemm_phase<pg8::EpiInProj, pg8::StaticOrderT<64, 16>, 1024, 1024, 1024>(F.lds + RING_OFF, g, S, E); }
        }
        SEAM(pb + P_INPROJ);
        RPT(3, true) if (PMB(3) && IN(pb + P_XLOC)) {
            SITE;
            pg8::Gemm g{(const bf16*)(ws + WS_AY), (const bf16*)(wb + WO_BX) + (size_t)l * 32 * 256 * 256}; pg8::SsmOrder S{F.G, F.bx};
            pg8::EpiXloc E{(float*)(ws + WS_XLOC)};
            pg8::gemm_phase<pg8::EpiXloc, pg8::SsmOrder, 512, 256, 256>(F.lds + RING_OFF, g, S, E);
            kmax_phase(F, (const bf16*)(ws + WS_K), (unsigned*)(ws + WS_CTL) + CW_KMAX + 16 * l);
        }
        SEAM(pb + P_XLOC);
        RPT(4, true) if (PMB(4) && IN(pb + P_SCAN)) { SITE; scan_phase(F, ap, l, (const float*)(ws + WS_XLOC), (bf16*)(ws + WS_AY)); }
        SEAM(pb + P_SCAN);
        if (IN(pb + P_MIX)) {
            RPT(5, true) if (PMB(5) && (SUB() & 1)) {
                SITE;
                pg8::Gemm g{(const bf16*)(ws + WS_AY), (const bf16*)(wb + WO_BY) + (size_t)l * 32 * 256 * 512}; pg8::SsmOrder S{F.G, F.bx};
                pg8::EpiY E{(bf16*)(ws + WS_SACT)};
                pg8::gemm_phase<pg8::EpiY, pg8::SsmOrder, 512, 512, 512>(F.lds + RING_OFF, g, S, E);
            }
            if ((SUB() & 8) && (SUB() & 2)) { SITE; if (F.bx >= 128) moe_cvt(F, ap, i, l & 1); }
            RPT(6, true) if (PMB(6) && (SUB() & 2)) {
                SITE;
                const float* lp = ap->in[3] + l * 4 * HD; float d01 = 0.f, d23 = 0.f;
                for (int q = 0; q < HD; ++q) { d01 += lp[q] * lp[HD + q]; d23 += lp[2 * HD + q] * lp[3 * HD + q]; }
                const float lam_init = 0.8f - 0.6f * __expf(-0.3f * (float)l), lam = __expf(d01) - __expf(d23) + lam_init;
                const bf16* Q = (const bf16*)(ws + WS_Q); const bf16* Kb = (const bf16*)(ws + WS_K); const bf16* V = (const bf16*)(ws + WS_V);
                float* O1 = (float*)(ws + WS_MERGED);
                bf16* AS2 = (bf16*)(ws + WS_AS2);
                for (int u = F.vcu; u < 256; u += F.G) {
                    const int bh = u >> 5, qb = u & 31, b = bh >> 2, h = bh & 3;
                    att::diff_attn_unit(Q + (size_t)bh * 2 * SEQ * 64, Kb + (size_t)bh * 2 * SEQ * 64, V + (size_t)bh * SEQ * 128, qb * 256,
                                        (const unsigned*)(ws + WS_CTL) + CW_KMAX + 16 * l + bh * 2, O1 + (size_t)u * 65536, AS2 + ((size_t)b * SEQ + qb * 256) * 1024 + h * 128, ap->in[4] + l * VD, lam, 1.f - lam_init, (char*)lds + RING_OFF);
                    __syncthreads();
                }
            }
        }
        SEAM(pb + P_MIX);
        RPT(7, true) if (PMB(7) && IN(pb + P_GLU)) {
            SITE;
            pg8::Gemm g{(const bf16*)(ws + WS_SACT), (const bf16*)(wb + WO_GLU) + (size_t)l * 512 * 512}; pg8::StaticOrderT<64, 2> S{F.bx};
            pg8::EpiGlu E{(const bf16*)(ws + WS_SACT), (bf16*)(ws + WS_AS2)};
            pg8::gemm_phase<pg8::EpiGlu, pg8::StaticOrderT<64, 2>, 512, 512, 512>(F.lds + RING_OFF, g, S, E);
        }
        SEAM(pb + P_GLU);
        RPT(8, true) if (PMB(8) && IN(pb + P_BRANCH)) {
            SITE;
            pg8::Gemm g{(const bf16*)(ws + WS_AS2), (const bf16*)(wb + WO_BR) + (size_t)l * 1024 * 1024}; pg8::StaticOrderT<64, 4> S{F.bx};
            pg8::EpiBranch E{(const bf16*)(ws + WS_G), (bf16*)(ws + WS_MERGED)};
            pg8::gemm_phase<pg8::EpiBranch, pg8::StaticOrderT<64, 4>, 1024, 1024, 1024>(F.lds + RING_OFF, g, S, E);
        }
        SEAM(pb + P_BRANCH);
        RPT(9, l == 0) if (PMB(9) && IN(pb + P_OUT)) {
            SITE; float* X = ap->out;
            pg8::Gemm g{(const bf16*)(ws + WS_MERGED), (const bf16*)(wb + WO_OUT) + (size_t)l * 1024 * 1024}; pg8::StaticOrderT<64, 4> S{F.bx};
            if (!moe) { pg8::EpiResN E{l == 0 ? ap->in[0] : X, X, (bf16*)(ws + WS_XN), (float*)(ws + WS_PS)};
                pg8::gemm_phase<pg8::EpiResN, pg8::StaticOrderT<64, 4>, 1024, 1024, 1024>(F.lds + RING_OFF, g, S, E); }
            else { pg8::EpiRes E{X, X};
                pg8::gemm_phase<pg8::EpiRes, pg8::StaticOrderT<64, 4>, 1024, 1024, 1024>(F.lds + RING_OFF, g, S, E); }
        }
        SEAM(pb + P_OUT);
        RPT(10, false) if (moe && PMB(10) && IN(pb + P_NORM2)) {
            SITE; float* X = ap->out; bf16* XN = (bf16*)(ws + WS_XN);
            const float* gain = ap->in[16] + l * D_MODEL;
            if (moe) { int* asg_e = (int*)(ws + WS_ROUTE + (size_t)i * 512 * 1024); int* asg_pos = asg_e + 32768; float* asg_g = (float*)(asg_pos + 32768);
                       norm_phase<false, true, false>(F, X, X, gain, XN, nullptr, nullptr, nullptr, nullptr, nullptr, ap->in[20] + (size_t)i * D_MODEL * N_EXP, (unsigned*)(ws + WS_CTL) + CW_BLKCNT + 2048 * i, asg_e, asg_pos, asg_g);
                       RPT(17, true) { if (SUB() & 8) moe_cvt(F, ap, i, 2); } }
            else norm_phase<false, false, false>(F, X, X, gain, XN, nullptr, nullptr, nullptr, nullptr, nullptr, nullptr, nullptr, nullptr, nullptr, nullptr);
        }
        if (moe) SEAM(pb + P_NORM2);
        if (!moe) {
            RPT(11, true) if (PMB(11) && IN(pb + P_UP)) {
                SITE;
                pg8::Gemm g{(const bf16*)(ws + WS_XN), (const bf16*)(wb + WO_F13) + (size_t)i * 5632 * 1024}; pg8::StaticOrderT<64, 22> S{F.bx};
                { pg8::Unit u0; S.next(0, u0); rstd_prep(F, (const float*)(ws + WS_PS), u0.pm); }
                pg8::EpiSwigluT<true> E{(bf16*)(ws + WS_H), 22, (const LAS float*)(F.lds + RSTD_OFF)};
                pg8::gemm_phase<pg8::EpiSwigluT<true>, pg8::StaticOrderT<64, 22>, 1024, 1024, 1024>(F.lds + RING_OFF, g, S, E);
            }
            SEAM(pb + P_UP);
            if (PMB(12) && IN(pb + P_DOWN)) {
                SITE; float* X = ap->out;
                pg8::Gemm g{(const bf16*)(ws + WS_H), (const bf16*)(wb + WO_F2) + (size_t)i * 1024 * 2816}; pg8::StaticOrderT<64, 4> S{F.bx};
                pg8::EpiResN E{X, X, (bf16*)(ws + WS_XN), (float*)(ws + WS_PS)};
                pg8::gemm_phase<pg8::EpiResN, pg8::StaticOrderT<64, 4>, 2816, 2816, 2816>(F.lds + RING_OFF, g, S, E);
            }
            SEAM(pb + P_DOWN);
        } else {
            RPT(13, true) if (PMB(13) && IN(pb + P_ASSIGN)) {
                SITE; int* asg_e = (int*)(ws + WS_ROUTE + (size_t)i * 512 * 1024);
                assign_phase(F, (const unsigned*)(ws + WS_CTL) + CW_BLKCNT + 2048 * i, (unsigned*)(ws + WS_CTL) + CW_CNT + 64 * i, asg_e, asg_e + 32768, asg_e + 3 * 32768, (const bf16*)(ws + WS_XN), (bf16*)(ws + WS_R2), (unsigned*)(ws + WS_CTL) + CW_SPLT + 256 * i);
            }
            SEAM(pb + P_ASSIGN);
            RPT(14, true) if (PMB(14) && IN(pb + P_UP)) {
                SITE;
                const MoeLayout L = moe_layout((const unsigned*)(ws + WS_CTL) + CW_CNT + 64 * i);
                pg8::Gemm g{(const bf16*)(ws + WS_R2), (const bf16*)(wb + WO_M13)};
                pg8::MoeOrder S; S.so.init(L.nblk * 256, 5632, F.G, F.bx); S.pe0 = L.pe[0]; S.pe1 = L.pe[1]; S.pe2 = L.pe[2]; S.pe3 = L.pe[3]; S.pe4 = L.pe[4]; S.pe5 = L.pe[5]; S.pe6 = L.pe[6]; S.nN = 22; S.maxr = 1 << 20;
                pg8::EpiSwiglu E{(bf16*)(ws + WS_H), 22, nullptr};
                pg8::gemm_phase<pg8::EpiSwiglu, pg8::MoeOrder, 1024, 1024, 1024>(F.lds + RING_OFF, g, S, E);
            }
            SEAM(pb + P_UP);
            RPT(15, true) if (PMB(15) && IN(pb + P_DOWN)) {
                SITE;
                const MoeLayout L = moe_layout((const unsigned*)(ws + WS_CTL) + CW_CNT + 64 * i);
                pg8::Gemm g{(const bf16*)(ws + WS_H), (const bf16*)(wb + WO_M2)};
                const int tile0 = ((L.nblk * 4) >> 8) * 64;
                pg8::MoeOrder S; S.so.init(tile0 * 256, 1024, F.G, F.bx); S.pe0 = L.pe[0]; S.pe1 = L.pe[1]; S.pe2 = L.pe[2]; S.pe3 = L.pe[3]; S.pe4 = L.pe[4]; S.pe5 = L.pe[5]; S.pe6 = L.pe[6]; S.nN = 4; S.maxr = 1 << 20;
                pg8::EpiMoeDown E{(bf16*)(ws + WS_R2)};
                pg8::gemm_phase<pg8::EpiMoeDown, pg8::MoeOrder, 2816, 2816, 2816>(F.lds + RING_OFF, g, S, E);
                pg8::MoeSplitOrder T; T.c = F.bx; T.tile0 = tile0; T.nsub = (L.nblk - tile0) * 24; T.eoff = 0; T.pe0 = S.pe0; T.pe1 = S.pe1; T.pe2 = S.pe2; T.pe3 = S.pe3; T.pe4 = S.pe4; T.pe5 = S.pe5; T.pe6 = S.pe6; T.nN = 4;
                pg8::EpiMoeDownPart EP{(float*)(ws + WS_PART)};
                pg8::gemm_phase<pg8::EpiMoeDownPart, pg8::MoeSplitOrder, 2816, 2816, 0>(F.lds + RING_OFF, g, T, EP);
            }
            SEAM(pb + P_DOWN);
        }
    }
    if (PMB(16) && IN(PH_FINAL)) {
        SITE; float* X = ap->out;
        if (((SUB() & 4) != 0)) { const int* sp = (const int*)(ws + WS_ROUTE + 512 * 1024) + 3 * 32768; const float* gp = (const float*)(ws + WS_ROUTE + 512 * 1024) + 2 * 32768;
            norm_phase<true, false, true>(F, X, X, ap->in[24], nullptr, (const bf16*)(ws + WS_R2), sp, gp, (const unsigned*)(ws + WS_CTL) + CW_SPLT + 256, (const float*)(ws + WS_PART), nullptr, nullptr, nullptr, nullptr, nullptr); }
        else norm_phase<false, false, true>(F, X, X, ap->in[24], nullptr, nullptr, nullptr, nullptr, nullptr, nullptr, nullptr, nullptr, nullptr, nullptr, nullptr);
    }
#undef IN
#undef SEAM
}
#ifndef OPT_MASK
#define OPT_MASK 0x37f
#endif
#ifndef ONE_LAUNCH
#define ONE_LAUNCH 1
#endif
static void launch_mk(Args& a, int lo, int hi, int sub, int grid, hipStream_t stream) {
    a.ph_lo = lo; a.ph_hi = hi; a.sub = sub;
    hipLaunchKernelGGL(mk_fwd, dim3(grid), dim3(NWAVES * 64), LDS_BYTES, stream, a);
}
extern "C" void kernel_launch(void* const* d_in, const int* in_sizes, int n_in, void* d_out, int out_size, void* d_ws, size_t ws_size, hipStream_t stream) {
    static int grid = 0;
    if (grid == 0) {
        if (n_in != 25 || out_size != NTOK * D_MODEL || ws_size < WS_END + 64 * MiB) { fprintf(stderr, "kernel_launch: unexpected shapes n_in %d out %d ws %zu (need %zu)\n", n_in, out_size, ws_size, (size_t)(WS_END + 64 * MiB)); grid = -1; return; }
        int dev = 0, cus = 0;
        if (hipGetDevice(&dev) != hipSuccess || hipDeviceGetAttribute(&cus, hipDeviceAttributeMultiprocessorCount, dev) != hipSuccess) { grid = -1; return; }
        if (hipFuncSetAttribute((const void*)mk_fwd, hipFuncAttributeMaxDynamicSharedMemorySize, LDS_BYTES) != hipSuccess) { fprintf(stderr, "kernel_launch: hipFuncSetAttribute failed\n"); grid = -1; return; }
        int per_cu = 0;
        if (hipOccupancyMaxActiveBlocksPerMultiprocessor(&per_cu, (const void*)mk_fwd, NWAVES * 64, LDS_BYTES) != hipSuccess || per_cu < 1) fprintf(stderr, "kernel_launch: occupancy query reports %d\n", per_cu);
        (void)hipGetLastError();
        grid = cus;
        if (grid != 256) fprintf(stderr, "kernel_launch: %d CUs (built for 256)\n", grid);
    }
    if (grid < 0) return;
    const float* x_in = (const float*)d_in[0]; const float* norm_mix = (const float*)d_in[1]; const float* w_in = (const float*)d_in[2];
    const float* attn_lambda = (const float*)d_in[3]; const float* attn_subln = (const float*)d_in[4];
    const float* ssm_lam_re = (const float*)d_in[5]; const float* ssm_lam_im = (const float*)d_in[6]; const float* ssm_log_dt = (const float*)d_in[7];
    const float* ssm_b_re = (const float*)d_in[8]; const float* ssm_b_im = (const float*)d_in[9]; const float* ssm_c_re = (const float*)d_in[10]; const float* ssm_c_im = (const float*)d_in[11];
    const float* ssm_d = (const float*)d_in[12]; const float* w_glu = (const float*)d_in[13]; const float* w_branch = (const float*)d_in[14]; const float* w_out = (const float*)d_in[15];
    const float* norm_ffn = (const float*)d_in[16]; const float* ffn_w1 = (const float*)d_in[17]; const float* ffn_w3 = (const float*)d_in[18]; const float* ffn_w2 = (const float*)d_in[19];
    const float* moe_router = (const float*)d_in[20]; const float* moe_w1 = (const float*)d_in[21]; const float* moe_w3 = (const float*)d_in[22]; const float* moe_w2 = (const float*)d_in[23];
    const float* norm_final = (const float*)d_in[24];
    unsigned char* ws = (unsigned char*)d_ws; float* X = (float*)d_out;
    bf16* XN = (bf16*)(ws + WS_XN); bf16* Q = (bf16*)(ws + WS_Q); bf16* Kb = (bf16*)(ws + WS_K); bf16* V = (bf16*)(ws + WS_V); bf16* G = (bf16*)(ws + WS_G);
    bf16* AY = (bf16*)(ws + WS_AY); float* XLOC = (float*)(ws + WS_XLOC); bf16* AS2 = (bf16*)(ws + WS_AS2); bf16* H = (bf16*)(ws + WS_H);
    bf16* SACT = (bf16*)(ws + WS_SACT); bf16* MERGED = (bf16*)(ws + WS_MERGED);
    float* TMP = (float*)(ws + WS_END);
    if (hipMemsetAsync(ws + WS_CTL, 0, CTL_ZERO_BYTES, stream) != hipSuccess) { fprintf(stderr, "kernel_launch: memset failed\n"); return; }
    Args a{};
    for (int i = 0; i < 25; ++i) a.in[i] = (const float*)d_in[i];
    a.out = X; a.ws = ws;
    for (int j = 0; j < 32; ++j) a.inv_freq[j] = pow(10000.0, -(double)j / 32.0);
    constexpr int OM = OPT_MASK;
    if (ONE_LAUNCH) { launch_mk(a, 0, PH_END, 1 | 2 | 4 | 8, grid, stream); return; }
    constexpr bool o_norm = OM & 1, o_inproj = OM & 2, o_ssm = OM & 4, o_attn = OM & 8, o_glu = OM & 16, o_branch = OM & 32, o_out = OM & 64, o_ffn = OM & 256, o_moe = OM & 512;
    static_assert(!o_moe || o_norm, "optimized MoE needs the optimized norms");
    const int sub_c = o_moe ? 4 : 0;
    (void)hipMemcpyAsync(X, x_in, (size_t)NTOK * D_MODEL * 4, hipMemcpyDeviceToDevice, stream);
    if (OM & ~1) launch_mk(a, PH_PRO, PH_PRO + 1, 0, grid, stream);
    for (int layer = 0; layer < DEPTH; ++layer) {
        const int pb = PH_L0 + layer * PH_PER_LAYER, i = layer / 2;
        const float lam_init = 0.8f - 0.6f * expf(-0.3f * (float)layer);
        if (o_norm) launch_mk(a, pb + P_NORM1, pb + P_NORM1 + 1, sub_c, grid, stream);
        else k_norm<<<NTOK / 4, 256, 0, stream>>>(X, norm_mix + layer * D_MODEL, XN, nullptr, nullptr, nullptr);
        if (o_inproj) launch_mk(a, pb + P_INPROJ, pb + P_INPROJ + 1, 0, grid, stream);
        else { NEpiInProj e{Q, Kb, V, AY, G};
          k_ngemm<NEpiInProj, false><<<dim3(IN_W / 128, NTOK / 128), 256, 0, stream>>>(XN, D_MODEL, w_in + (size_t)layer * D_MODEL * IN_W, nullptr, IN_W, D_MODEL, e); }
        if (o_ssm) { launch_mk(a, pb + P_XLOC, pb + P_XLOC + 1, 0, grid, stream); launch_mk(a, pb + P_SCAN, pb + P_SCAN + 1, 0, grid, stream); launch_mk(a, pb + P_MIX, pb + P_MIX + 1, 1, grid, stream); }
        else { const size_t po = (size_t)layer * 2 * SSM_G * SSM_P;
          k_nssm<<<BATCH * SSM_G, 64, 0, stream>>>(AY, XLOC, SACT, ssm_lam_re + po, ssm_lam_im + po, ssm_log_dt + layer * 2 * SSM_G,
                                                   ssm_b_re + po * 16, ssm_b_im + po * 16, ssm_c_re + po * 16, ssm_c_im + po * 16, ssm_d + layer * SSM_W); }
        if (o_attn) launch_mk(a, pb + P_MIX, pb + P_MIX + 1, 2, grid, stream);
        else k_nattn<<<dim3(SEQ / 64, NHEAD, BATCH), 128, 0, stream>>>(Q, Kb, V, AS2, attn_lambda + layer * 4 * HD, attn_subln + layer * VD, lam_init);
        if (o_glu) launch_mk(a, pb + P_GLU, pb + P_GLU + 1, 0, grid, stream);
        else { NEpiGlu e{SACT, AS2};
          k_ngemm<NEpiGlu, false><<<dim3(SSM_W / 128, NTOK / 128), 256, 0, stream>>>(SACT, SSM_W, w_glu + (size_t)layer * SSM_W * SSM_W, nullptr, SSM_W, SSM_W, e); }
        if (o_branch) launch_mk(a, pb + P_BRANCH, pb + P_BRANCH + 1, 0, grid, stream);
        else { NEpiBranch e0{G, TMP, MERGED, 0, 0}, e1{G, TMP, MERGED, 1, 0};
            const float* wbp = w_branch + (size_t)layer * 2 * 512 * 1024;
            k_ngemm<NEpiBranch, false><<<dim3(1024 / 128, NTOK / 128), 256, 0, stream>>>(AS2, 1024, wbp, nullptr, 1024, 512, e0);
            k_ngemm<NEpiBranch, false><<<dim3(1024 / 128, NTOK / 128), 256, 0, stream>>>(AS2 + 512, 1024, wbp + 512 * 1024, nullptr, 1024, 512, e1); }
        if (o_out) launch_mk(a, pb + P_OUT, pb + P_OUT + 1, 0, grid, stream);
        else { NEpiRes e{X, nullptr, nullptr, 0, 0};
          k_ngemm<NEpiRes, false><<<dim3(1024 / 128, NTOK / 128), 256, 0, stream>>>(MERGED, 1024, w_out + (size_t)layer * 1024 * 1024, nullptr, 1024, 1024, e); }
        int* asg_e = (int*)(ws + WS_ROUTE + (size_t)i * 512 * 1024); float* asg_g = (float*)(asg_e + 2 * 32768);
        if (layer % 2 == 0) {
            if (o_norm) launch_mk(a, pb + P_NORM2, pb + P_NORM2 + 1, 0, grid, stream);
            else k_norm<<<NTOK / 4, 256, 0, stream>>>(X, norm_ffn + layer * D_MODEL, XN, nullptr, nullptr, nullptr);
            if (o_ffn) { launch_mk(a, pb + P_UP, pb + P_UP + 1, 0, grid, stream); launch_mk(a, pb + P_DOWN, pb + P_DOWN + 1, 0, grid, stream); }
            else {
              { NEpiSwiglu e{H};
                k_ngemm<NEpiSwiglu, true><<<dim3(D_FF / 128, NTOK / 128), 256, 0, stream>>>(XN, D_MODEL, ffn_w1 + (size_t)i * D_MODEL * D_FF, ffn_w3 + (size_t)i * D_MODEL * D_FF, D_FF, D_MODEL, e); }
              { NEpiRes e{X, nullptr, nullptr, 0, 0};
                k_ngemm<NEpiRes, false><<<dim3(1024 / 128, NTOK / 128), 256, 0, stream>>>(H, D_FF, ffn_w2 + (size_t)i * D_FF * D_MODEL, nullptr, D_MODEL, D_FF, e); }
            }
        } else {
            if (o_norm) launch_mk(a, pb + P_NORM2, pb + P_NORM2 + 1, o_moe ? 8 : 0, grid, stream);
            else k_norm<<<NTOK / 4, 256, 0, stream>>>(X, norm_ffn + layer * D_MODEL, XN, moe_router + (size_t)i * D_MODEL * N_EXP, asg_e, asg_g);
            if (o_moe) { launch_mk(a, pb + P_ASSIGN, pb + P_ASSIGN + 1, 0, grid, stream); launch_mk(a, pb + P_UP, pb + P_UP + 1, 0, grid, stream); launch_mk(a, pb + P_DOWN, pb + P_DOWN + 1, 0, grid, stream); }
            else for (int ex = 0; ex < N_EXP; ++ex) {
                const size_t wo = ((size_t)i * N_EXP + ex) * D_MODEL * D_FF;
                { NEpiSwiglu e{H};
                  k_ngemm<NEpiSwiglu, true><<<dim3(D_FF / 128, NTOK / 128), 256, 0, stream>>>(XN, D_MODEL, moe_w1 + wo, moe_w3 + wo, D_FF, D_MODEL, e); }
                { NEpiRes e{X, asg_e, asg_g, ex, 0};
                  k_ngemm<NEpiRes, false><<<dim3(1024 / 128, NTOK / 128), 256, 0, stream>>>(H, D_FF, moe_w2 + wo, nullptr, D_MODEL, D_FF, e); }
            }
        }
    }
    if (o_norm) launch_mk(a, PH_FINAL, PH_FINAL + 1, sub_c, grid, stream);
    else k_final_norm<<<NTOK / 4, 256, 0, stream>>>(X, norm_final);
}
```

```cpp
#include <hip/hip_runtime.h>
#include <cstdio>
#include <cstdint>
#include <cmath>

constexpr int D_MODEL = 1024, BATCH = 2, SEQ = 8192, DEPTH = 4, NTOK = BATCH * SEQ;
constexpr int NHEAD = 4, HD = 64, VD = 128;
constexpr int SSM_G = 32, SSM_CH = 16, SSM_P = 64, SSM_W = 512;
constexpr int IN_W = 4096, OFF_K = 512, OFF_V = 1024, OFF_U = 1536, OFF_G = 2048;
constexpr int D_FF = 2816, N_EXP = 8;
constexpr float RMS_EPS = 1e-6f;
constexpr int CHL = 16;
constexpr int NCH = SEQ / CHL;

typedef unsigned short bf16;
typedef float f32x4 __attribute__((ext_vector_type(4)));

constexpr size_t MiB = 1u << 20;
constexpr size_t WS_CTL = 0;
constexpr size_t WS_WEIGHTS = 1 * MiB;
constexpr size_t WS_XN = 267 * MiB;
constexpr size_t WS_R1 = WS_XN + 32 * MiB;
constexpr size_t WS_Q = WS_R1, WS_K = WS_Q + 16 * MiB, WS_V = WS_K + 16 * MiB, WS_G = WS_V + 16 * MiB;
constexpr size_t WS_AY = WS_G + 64 * MiB, WS_XLOC = WS_AY + 32 * MiB, WS_AS2 = WS_XLOC + 32 * MiB;
constexpr size_t WS_H = WS_R1;
constexpr size_t WS_R2 = WS_R1 + 208 * MiB;
constexpr size_t WS_SACT = WS_R2, WS_MERGED = WS_SACT + 16 * MiB, WS_O1 = WS_MERGED + 32 * MiB;
constexpr size_t WS_ROUTE = WS_R2 + 80 * MiB;
constexpr size_t WS_PART = WS_ROUTE + 1 * MiB;
constexpr size_t WS_PS = WS_PART + 48 * MiB;
constexpr size_t WS_END = WS_PS + 1 * MiB;

__device__ __forceinline__ float bf2f(bf16 v) { return __uint_as_float(((unsigned)v) << 16); }
__device__ __forceinline__ bf16 f2bf(float f) { unsigned u = __float_as_uint(f); return (bf16)((u + 0x7fffu + ((u >> 16) & 1u)) >> 16); }
__device__ __forceinline__ float wave_sum(float v) {
#pragma unroll
    for (int o = 1; o < 64; o <<= 1) v += __shfl_xor(v, o);
    return v;
}
__device__ __forceinline__ float sigmoidf_(float x) { return 1.f / (1.f + __expf(-x)); }
__host__ __device__ __forceinline__ int qk_pos(int d) { const int j = d & 31, n = d >> 5; return 32 * (j >> 4) + 8 * ((j & 15) >> 2) + 4 * n + (j & 3); }
__device__ __forceinline__ size_t q_index(int b, int h, int c, int s, int d) { return ((((size_t)b * NHEAD + h) * 2 + c) * SEQ + s) * HD + qk_pos(d); }
__device__ __forceinline__ size_t v_index(int b, int h, int s, int e) { return (((size_t)b * NHEAD + h) * SEQ + s) * VD + e; }
__device__ __forceinline__ size_t ay_index(int g, int b, int s, int hh) { return (((size_t)g * (BATCH * NCH)) + b * NCH + (s / CHL)) * 512 + (s % CHL) * SSM_CH + hh; }

__global__ __launch_bounds__(256) void k_norm(const float* __restrict__ x, const float* __restrict__ g, bf16* __restrict__ xn,
                                             const float* __restrict__ wr, int* __restrict__ top_e, float* __restrict__ top_g) {
    const int lane = threadIdx.x & 63, row = blockIdx.x * 4 + (threadIdx.x >> 6);
    const f32x4* xr = (const f32x4*)(x + (size_t)row * D_MODEL) + lane;
    f32x4 v[4]; float s = 0.f;
#pragma unroll
    for (int j = 0; j < 4; ++j) { v[j] = xr[64 * j]; s += (v[j].x * v[j].x + v[j].y * v[j].y) + (v[j].z * v[j].z + v[j].w * v[j].w); }
    const float rstd = rsqrtf(wave_sum(s) * (1.f / D_MODEL) + RMS_EPS);
    float lg[N_EXP];
#pragma unroll
    for (int e = 0; e < N_EXP; ++e) lg[e] = 0.f;
#pragma unroll
    for (int j = 0; j < 4; ++j) {
        const f32x4 gg = ((const f32x4*)g)[64 * j + lane];
        v[j].x *= rstd * gg.x; v[j].y *= rstd * gg.y; v[j].z *= rstd * gg.z; v[j].w *= rstd * gg.w;
        unsigned long long o = (unsigned long long)f2bf(v[j].x) | ((unsigned long long)f2bf(v[j].y) << 16) | ((unsigned long long)f2bf(v[j].z) << 32) | ((unsigned long long)f2bf(v[j].w) << 48);
        ((unsigned long long*)(xn + (size_t)row * D_MODEL))[64 * j + lane] = o;
        if (wr) {
            const int k0 = (64 * j + lane) * 4;
#pragma unroll
            for (int e = 0; e < N_EXP; ++e) lg[e] += v[j].x * wr[(k0 + 0) * N_EXP + e] + v[j].y * wr[(k0 + 1) * N_EXP + e] + v[j].z * wr[(k0 + 2) * N_EXP + e] + v[j].w * wr[(k0 + 3) * N_EXP + e];
        }
    }
    if (wr) {
#pragma unroll
        for (int e = 0; e < N_EXP; ++e) lg[e] = wave_sum(lg[e]);
        int e0 = 0; float l0 = lg[0];
#pragma unroll
        for (int e = 1; e < N_EXP; ++e) if (lg[e] > l0) { l0 = lg[e]; e0 = e; }
        int e1 = -1; float l1 = -3.4e38f;
#pragma unroll
        for (int e = 0; e < N_EXP; ++e) if (e != e0 && lg[e] > l1) { l1 = lg[e]; e1 = e; }
        const float p1 = __expf(l1 - l0), inv = 1.f / (1.f + p1);
        if (lane == 0) { top_e[row * 2] = e0; top_e[row * 2 + 1] = e1; top_g[row * 2] = inv; top_g[row * 2 + 1] = p1 * inv; }
    }
}

__global__ __launch_bounds__(256) void k_final_norm(float* __restrict__ x, const float* __restrict__ g) {
    const int lane = threadIdx.x & 63, row = blockIdx.x * 4 + (threadIdx.x >> 6);
    f32x4* xr = (f32x4*)(x + (size_t)row * D_MODEL) + lane;
    f32x4 v[4]; float s = 0.f;
#pragma unroll
    for (int j = 0; j < 4; ++j) { v[j] = xr[64 * j]; s += (v[j].x * v[j].x + v[j].y * v[j].y) + (v[j].z * v[j].z + v[j].w * v[j].w); }
    const float rstd = rsqrtf(wave_sum(s) * (1.f / D_MODEL) + RMS_EPS);
#pragma unroll
    for (int j = 0; j < 4; ++j) { const f32x4 gg = ((const f32x4*)g)[64 * j + lane]; f32x4 o = {v[j].x * rstd * gg.x, v[j].y * rstd * gg.y, v[j].z * rstd * gg.z, v[j].w * rstd * gg.w}; xr[64 * j] = o; }
}

template <class Epi, bool DUAL>
__global__ __launch_bounds__(256) void k_ngemm(const bf16* __restrict__ A, int lda, const float* __restrict__ W, const float* __restrict__ W2, int ldw, int K, Epi epi) {
    __shared__ float As[16][132];
    __shared__ float Bs[16][128];
    __shared__ float Bs2[DUAL ? 16 : 1][128];
    const int tid = threadIdx.x, tx = tid & 15, ty = tid >> 4;
    const int m0 = blockIdx.y * 128, n0 = blockIdx.x * 128;
    float acc[8][8], acc2[DUAL ? 8 : 1][8];
#pragma unroll
    for (int i = 0; i < 8; ++i)
#pragma unroll
        for (int j = 0; j < 8; ++j) { acc[i][j] = 0.f; if (DUAL) acc2[i][j] = 0.f; }
    const int ar = tid >> 1, ak = (tid & 1) * 8;
    const int bk = tid >> 4, bn = (tid & 15) * 8;
    for (int k0 = 0; k0 < K; k0 += 16) {
        const uint4 av = *(const uint4*)(A + (size_t)(m0 + ar) * lda + k0 + ak);
        const unsigned aw[4] = {av.x, av.y, av.z, av.w};
#pragma unroll
        for (int q = 0; q < 4; ++q) { As[ak + 2 * q][ar] = __uint_as_float(aw[q] << 16); As[ak + 2 * q + 1][ar] = __uint_as_float(aw[q] & 0xffff0000u); }
        const f32x4 b0 = *(const f32x4*)(W + (size_t)(k0 + bk) * ldw + n0 + bn), b1 = *(const f32x4*)(W + (size_t)(k0 + bk) * ldw + n0 + bn + 4);
        *(f32x4*)&Bs[bk][bn] = b0; *(f32x4*)&Bs[bk][bn + 4] = b1;
        if (DUAL) { const f32x4 c0 = *(const f32x4*)(W2 + (size_t)(k0 + bk) * ldw + n0 + bn), c1 = *(const f32x4*)(W2 + (size_t)(k0 + bk) * ldw + n0 + bn + 4);
            *(f32x4*)&Bs2[bk][bn] = c0; *(f32x4*)&Bs2[bk][bn + 4] = c1; }
        __syncthreads();
#pragma unroll
        for (int k = 0; k < 16; ++k) {
            float a[8], b[8], b2[8];
#pragma unroll
            for (int i = 0; i < 8; ++i) a[i] = As[k][ty * 8 + i];
#pragma unroll
            for (int j = 0; j < 8; ++j) { b[j] = Bs[k][tx * 2 + (j & 1) + 32 * (j >> 1)]; if (DUAL) b2[j] = Bs2[k][tx * 2 + (j & 1) + 32 * (j >> 1)]; }
#pragma unroll
            for (int i = 0; i < 8; ++i)
#pragma unroll
                for (int j = 0; j < 8; ++j) { acc[i][j] += a[i] * b[j]; if (DUAL) acc2[i][j] += a[i] * b2[j]; }
        }
        __syncthreads();
    }
#pragma unroll
    for (int i = 0; i < 8; ++i) { if constexpr (DUAL) epi.row2(m0 + ty * 8 + i, n0, tx, acc[i], acc2[i]); else epi.row(m0 + ty * 8 + i, n0, tx, acc[i]); }
}
#define NG_COL(n0, tx, jj) ((n0) + (tx) * 2 + ((jj) & 1) + 32 * ((jj) >> 1))

struct NEpiInProj {
    bf16 *Q, *Kb, *V, *AY, *G;
    __device__ void row(int m, int n0, int tx, const float (&a)[8]) const {
        const int b = m / SEQ, s = m % SEQ;
        if (n0 < OFF_V) {
            bf16* dst = n0 < OFF_K ? Q : Kb; const int h = (n0 % 512) / 128;
#pragma unroll
            for (int c = 0; c < 2; ++c)
#pragma unroll
                for (int e = 0; e < 2; ++e) {
                    const int j = tx * 2 + e;
                    const float x1 = a[c * 4 + e], x2 = a[c * 4 + 2 + e];
                    const double ang = (double)s * pow(10000.0, -(double)j / 32.0);
                    const float sn = (float)sin(ang), cs = (float)cos(ang);
                    dst[q_index(b, h, c, s, j)] = f2bf(x1 * cs - x2 * sn);
                    dst[q_index(b, h, c, s, j + 32)] = f2bf(x2 * cs + x1 * sn);
                }
        } else {
#pragma unroll
            for (int jj = 0; jj < 8; ++jj) {
                const int n = NG_COL(n0, tx, jj);
                if (n < OFF_U) { const int h = (n - OFF_V) / VD, e = (n - OFF_V) % VD; V[v_index(b, h, s, e)] = f2bf(a[jj]); }
                else if (n < OFF_G) { const int g = (n - OFF_U) / SSM_CH, hh = (n - OFF_U) % SSM_CH; AY[ay_index(g, b, s, hh)] = f2bf(a[jj]); }
                else G[(size_t)m * 2048 + (n - OFF_G)] = f2bf(sigmoidf_(a[jj]));
            }
        }
    }
};
struct NEpiGlu {
    const bf16* SACT; bf16* AS2;
    __device__ void row(int m, int n0, int tx, const float (&a)[8]) const {
#pragma unroll
        for (int jj = 0; jj < 8; ++jj) { const int n = NG_COL(n0, tx, jj); AS2[(size_t)m * 1024 + 512 + n] = f2bf(bf2f(SACT[(size_t)m * 512 + n]) * sigmoidf_(a[jj])); }
    }
};
struct NEpiBranch {
    const bf16* G; float* TMP; bf16* MERGED; int second, pad;
    __device__ void row(int m, int n0, int tx, const float (&a)[8]) const {
#pragma unroll
        for (int jj = 0; jj < 8; ++jj) { const int n = NG_COL(n0, tx, jj);
            if (!second) TMP[(size_t)m * 1024 + n] = bf2f(G[(size_t)m * 2048 + n]) * a[jj];
            else MERGED[(size_t)m * 1024 + n] = f2bf(TMP[(size_t)m * 1024 + n] + bf2f(G[(size_t)m * 2048 + 1024 + n]) * a[jj]); }
    }
};
struct NEpiRes {
    float* X; const int* top_e; const float* top_g; int e, pad;
    __device__ void row(int m, int n0, int tx, const float (&a)[8]) const {
        float gt = 1.f;
        if (top_e) { gt = 0.f; if (top_e[m * 2] == e) gt = top_g[m * 2]; else if (top_e[m * 2 + 1] == e) gt = top_g[m * 2 + 1]; if (gt == 0.f) return; }
#pragma unroll
        for (int jj = 0; jj < 8; ++jj) { const int n = NG_COL(n0, tx, jj); X[(size_t)m * 1024 + n] += gt * a[jj]; }
    }
};
struct NEpiSwiglu {
    bf16* H;
    __device__ void row2(int m, int n0, int tx, const float (&a)[8], const float (&b)[8]) const {
#pragma unroll
        for (int jj = 0; jj < 8; ++jj) { const int n = NG_COL(n0, tx, jj); H[(size_t)m * D_FF + n] = f2bf(a[jj] * sigmoidf_(a[jj]) * b[jj]); }
    }
};

__global__ __launch_bounds__(128) void k_nattn(const bf16* __restrict__ Q, const bf16* __restrict__ Kb, const bf16* __restrict__ V, bf16* __restrict__ AS2,
                                              const float* __restrict__ lam_p, const float* __restrict__ subln, float lam_init) {
    __shared__ float Ks[32][64];
    __shared__ float Vs[32][128];
    __shared__ float ssq[2][64];
    const int tid = threadIdx.x, r = tid & 63, vh = tid >> 6;
    const int b = blockIdx.z, h = blockIdx.y, s = blockIdx.x * 64 + r;
    float d01 = 0.f, d23 = 0.f;
    for (int i = 0; i < HD; ++i) { d01 += lam_p[i] * lam_p[HD + i]; d23 += lam_p[2 * HD + i] * lam_p[3 * HD + i]; }
    const float lam = __expf(d01) - __expf(d23) + lam_init;
    float res[64];
#pragma unroll
    for (int e = 0; e < 64; ++e) res[e] = 0.f;
    for (int c = 0; c < 2; ++c) {
        float q[64], o[64];
        const bf16* qp = Q + ((((size_t)b * NHEAD + h) * 2 + c) * SEQ + s) * HD;
#pragma unroll
        for (int d = 0; d < 64; ++d) { q[d] = bf2f(qp[d]) * 0.125f; o[d] = 0.f; }
        float mx = -1e30f, l = 0.f;
        const bf16* kp = Kb + ((((size_t)b * NHEAD + h) * 2 + c) * SEQ) * HD;
        const bf16* vp = V + (((size_t)b * NHEAD + h) * SEQ) * VD;
        for (int k0 = 0; k0 < SEQ; k0 += 32) {
            __syncthreads();
            for (int i = tid; i < 32 * 64; i += 128) Ks[i / 64][i % 64] = bf2f(kp[(size_t)k0 * HD + i]);
            for (int i = tid; i < 32 * 128; i += 128) Vs[i / 128][i % 128] = bf2f(vp[(size_t)k0 * VD + i]);
            __syncthreads();
            float sc[32]; float tm = mx;
#pragma unroll
            for (int j = 0; j < 32; ++j) { float a = 0.f;
#pragma unroll
                for (int d = 0; d < 64; ++d) a += q[d] * Ks[j][d];
                sc[j] = a; tm = fmaxf(tm, a); }
            const float alpha = __expf(mx - tm); mx = tm; l *= alpha;
#pragma unroll
            for (int e = 0; e < 64; ++e) o[e] *= alpha;
#pragma unroll
            for (int j = 0; j < 32; ++j) { const float p = __expf(sc[j] - mx); l += p;
#pragma unroll
                for (int e = 0; e < 64; ++e) o[e] += p * Vs[j][vh * 64 + e]; }
        }
        const float il = (c == 0 ? 1.f : -lam) / l;
#pragma unroll
        for (int e = 0; e < 64; ++e) res[e] += o[e] * il;
    }
    float sq = 0.f;
#pragma unroll
    for (int e = 0; e < 64; ++e) sq += res[e] * res[e];
    ssq[vh][r] = sq;
    __syncthreads();
    const float rstd = rsqrtf((ssq[0][r] + ssq[1][r]) * (1.f / VD) + RMS_EPS) * (1.f - lam_init);
    bf16* op = AS2 + (size_t)(b * SEQ + s) * 1024 + h * VD + vh * 64;
#pragma unroll
    for (int e = 0; e < 64; ++e) op[e] = f2bf(res[e] * rstd * subln[vh * 64 + e]);
}

__global__ __launch_bounds__(64) void k_nssm(const bf16* __restrict__ AY, float* __restrict__ Y, bf16* __restrict__ SACT,
                                            const float* __restrict__ lam_re, const float* __restrict__ lam_im, const float* __restrict__ log_dt,
                                            const float* __restrict__ b_re, const float* __restrict__ b_im, const float* __restrict__ c_re, const float* __restrict__ c_im,
                                            const float* __restrict__ dsk) {
    const int p = threadIdx.x, g = blockIdx.x % SSM_G, b = blockIdx.x / SSM_G;
    for (int dir = 0; dir < 2; ++dir) {
        const size_t pi = ((size_t)dir * SSM_G + g) * SSM_P + p;
        const float lr = lam_re[pi], li = lam_im[pi], dt = __expf(log_dt[dir * SSM_G + g]);
        const float er = expf(lr * dt); float sn, cs; sincosf(li * dt, &sn, &cs);
        const float ar = er * cs, ai = er * sn;
        const float nr = ar - 1.f, ni = ai, den = lr * lr + li * li;
        const float fr = (nr * lr + ni * li) / den, fi = (ni * lr - nr * li) / den;
        float bbr[16], bbi[16], cr[16], ci[16];
#pragma unroll
        for (int hh = 0; hh < 16; ++hh) { const float br = b_re[pi * 16 + hh], bi = b_im[pi * 16 + hh]; bbr[hh] = fr * br - fi * bi; bbi[hh] = fr * bi + fi * br;
            const size_t cidx = (((size_t)dir * SSM_G + g) * SSM_CH + hh) * SSM_P + p; cr[hh] = c_re[cidx]; ci[hh] = c_im[cidx]; }
        float xr = 0.f, xi = 0.f;
        for (int step = 0; step < SEQ; ++step) {
            const int s = dir == 0 ? step : SEQ - 1 - step;
            const bf16* up = AY + ay_index(g, b, s, 0);
            float u[16];
#pragma unroll
            for (int hh = 0; hh < 16; ++hh) u[hh] = bf2f(up[hh]);
            float br = 0.f, bi = 0.f;
#pragma unroll
            for (int hh = 0; hh < 16; ++hh) { br += bbr[hh] * u[hh]; bi += bbi[hh] * u[hh]; }
            const float nxr = ar * xr - ai * xi + br, nxi = ar * xi + ai * xr + bi; xr = nxr; xi = nxi;
            float mine = 0.f;
#pragma unroll
            for (int hh = 0; hh < 16; ++hh) { const float t = wave_sum(cr[hh] * xr - ci[hh] * xi); if (p == hh) mine = t; }
            if (p < 16) {
                const size_t yi = (size_t)(b * SEQ + s) * SSM_W + g * SSM_CH + p;
                if (dir == 0) Y[yi] = u[p] * dsk[g * SSM_CH + p] + mine;
                else { const float y = Y[yi] + mine; SACT[yi] = f2bf(0.5f * y * (1.f + erff(y * 0.70710678118654752f))); }
            }
        }
    }
}


#define GAS __attribute__((address_space(1)))
#define LAS __attribute__((address_space(3)))
namespace pg8 {
#define PG8_LAS __attribute__((address_space(3)))
typedef unsigned short bf16_t;
typedef short bf16x8 __attribute__((ext_vector_type(8)));
typedef float f32x4 __attribute__((ext_vector_type(4)));
typedef unsigned u32x4 __attribute__((ext_vector_type(4)));
constexpr int BM = 256, BK = 64, HALF = 128, HTB = HALF * BK * 2  , STAGE_BYTES = 8 * HTB, NXCD = 8, WGM = 8;

__host__ __device__ __forceinline__ int lds_byte(int r, int c) { const int st = (r >> 4) * 2 + (c >> 5), rr = r & 15, cc = c & 31, ob = rr * 64 + cc * 2; return st * 1024 + (ob ^ (((ob >> 9) & 1) << 5)); }
__host__ __device__ __forceinline__ void stage_rc(int b, int& R, int& C) { const int st = b / 1024, sb = b % 1024, swz = sb ^ (((sb >> 9) & 1) << 5); R = (st >> 1) * 16 + swz / 64; C = (st & 1) * 32 + (swz % 64) / 2; }
__host__ __device__ __forceinline__ int perm32(int rho) { const int n = rho >> 4, i = rho & 15; return 8 * (i >> 2) + 4 * n + (i & 3); }

struct Unit { int pm, pn; int ko = 0, aux = 0, nk = 0; };
struct Gemm { const bf16_t* A; const bf16_t* Bt; };

struct StaticOrder {
    int nM, nN, nwg, G, c;
    __host__ __device__ void init(int M, int N, int G_, int c_) { nM = M / BM; nN = N / BM; nwg = nM * nN; G = G_; c = c_; }
    __host__ __device__ void map(int L, Unit& u) const {
        int wgid = L; { const int q = nwg / NXCD, r = nwg % NXCD, xcd = wgid % NXCD, off = wgid / NXCD; wgid = (xcd < r ? xcd * (q + 1) : r * (q + 1) + (xcd - r) * q) + off; }
        const int nig = WGM * nN, gid = wgid / nig, fm = gid * WGM, gsz = (nM - fm) < WGM ? (nM - fm) : WGM;
        u.pm = fm + ((wgid % nig) % gsz); u.pn = (wgid % nig) / gsz;
    }
    __host__ __device__ bool next(int i, Unit& u) const {
        const long L = (long)i * G + c; if (L >= nwg) return false;
        map((int)L, u); return true;
    }
    __device__ __forceinline__ void a_ready(const Unit&) const {}
    __device__ __forceinline__ void done(const Unit&) const {}
};


template <int NM, int NN> struct StaticOrderT {
    int c;
    __device__ __forceinline__ bool next(int i, Unit& u) const {
        constexpr int nwg = NM * NN, q = nwg / NXCD, r = nwg % NXCD; const int L = i * 256 + c; if (L >= nwg) return false;
        int wgid = L; { const int xcd = wgid % NXCD, off = wgid / NXCD; wgid = (xcd < r ? xcd * (q + 1) : r * (q + 1) + (xcd - r) * q) + off; }
        constexpr int nig = WGM * NN; const int gid = wgid / nig, fm = gid * WGM, gsz = (NM - fm) < WGM ? (NM - fm) : WGM;
        u.pm = fm + ((wgid % nig) % gsz); u.pn = (wgid % nig) / gsz; return true;
    }
    __device__ __forceinline__ void a_ready(const Unit&) const {}
    __device__ __forceinline__ void done(const Unit&) const {}
};
typedef __bf16 bf16x2_cv __attribute__((ext_vector_type(2))); typedef float f32x2_cv __attribute__((ext_vector_type(2)));
__device__ __forceinline__ unsigned cvt_pk_bf16(float lo, float hi) { const bf16x2_cv r = __builtin_convertvector((f32x2_cv){lo, hi}, bf16x2_cv); return __builtin_bit_cast(unsigned, r); }
typedef float f32x2 __attribute__((ext_vector_type(2)));
__device__ __forceinline__ f32x2 gelu_pk(f32x2 v) {
    const f32x2 av = __builtin_elementwise_abs(v), d = av * 0.2316418882f + 1.0f;
    f32x2 t; t.x = __builtin_amdgcn_rcpf(d.x); t.y = __builtin_amdgcn_rcpf(d.y);
    f32x2 q = t * 0.5307027145f + (-0.7265760135f); q = q * t + 0.7107068705f; q = q * t + (-0.142248368f); q = q * t + 0.127414796f; q = q * t;
    const f32x2 s = (v * v) * (-0.72134752044f);
    f32x2 e; e.x = __builtin_amdgcn_exp2f(s.x); e.y = __builtin_amdgcn_exp2f(s.y);
    const f32x2 m = v * (q * e), r = v - m;
    f32x2 o; o.x = v.x < 0.f ? m.x : r.x; o.y = v.y < 0.f ? m.y : r.y; return o;
}

template <class Epi, class Sched, int LDA, int LDB, int KK, bool ALIGN_EPI = true, bool SP2 = true>
__device__ __forceinline__ void gemm_phase(PG8_LAS unsigned char* lds, const Gemm g, const Sched& S, const Epi& E) {
    int tid_l = threadIdx.x; asm volatile("" : "+v"(tid_l));
    const int tid = tid_l, wid = __builtin_amdgcn_readfirstlane(tid >> 6), lane = tid & 63, wr = wid >> 2, wc = wid & 3, fr = lane & 15, fq = lane >> 4;
    static_assert(KK % 128 == 0, "K multiple of 128");
    unsigned voffA[2], voffB[2];
#pragma unroll
    for (int i = 0; i < 2; ++i) { int R, C; stage_rc(tid * 16 + i * 8192, R, C); const int Rb = Epi::PERM ? ((R & ~31) + perm32(R & 31)) : R;
        voffA[i] = (unsigned)(R * LDA + C) * 2u; voffB[i] = (unsigned)(Rb * LDB + C) * 2u; }
    constexpr size_t kstep = (size_t)(BK * 2);
    constexpr size_t hstepA = (size_t)HALF * LDA * 2, hstepB = (size_t)HALF * LDB * 2;
    constexpr size_t tstepA = 2 * hstepA, tstepB = 2 * hstepB;
    const unsigned ldsw = (unsigned)wid * 1024u;
    const int aoff = lds_byte(wr * 64 + fr, fq * 8), boff = lds_byte(wc * 32 + fr, fq * 8);
#define PG8_SA(b, h) (((b) * 2 + (h)) * HTB)
#define PG8_SB(b, h) ((4 + (b) * 2 + (h)) * HTB)
#define PG8_STAGE(bufoff, gbase, voff) do { _Pragma("unroll") for (int _i = 0; _i < 2; ++_i) \
        __builtin_amdgcn_global_load_lds((const unsigned*)((const char*)(gbase) + (voff)[_i]), (PG8_LAS unsigned*)(lds + (bufoff) + ldsw + _i * 8192), 16, 0, 0); } while (0)
#define PG8_LDA(dst, b, h) do { _Pragma("unroll") for (int m = 0; m < 4; ++m) _Pragma("unroll") for (int k = 0; k < 2; ++k) dst[m][k] = *(const PG8_LAS bf16x8*)(lds + PG8_SA(b, h) + aoff + m * 2048 + k * 1024); } while (0)
#define PG8_LDB(dst, b, h) do { _Pragma("unroll") for (int n = 0; n < 2; ++n) _Pragma("unroll") for (int k = 0; k < 2; ++k) dst[n][k] = *(const PG8_LAS bf16x8*)(lds + PG8_SB(b, h) + boff + n * 2048 + k * 1024); } while (0)
#define PG8_MMA(ai, bj, At, Bt) do { __builtin_amdgcn_s_setprio(1); _Pragma("unroll") for (int m = 0; m < 4; ++m) _Pragma("unroll") for (int n = 0; n < 2; ++n) _Pragma("unroll") for (int k = 0; k < 2; ++k) \
        acc[ai][bj][m][n] = __builtin_amdgcn_mfma_f32_16x16x32_bf16(Bt[n][k], At[m][k], acc[ai][bj][m][n], 0, 0, 0); __builtin_amdgcn_s_setprio(0); } while (0)
#define PG8_WAIT_V(n) asm volatile("s_waitcnt vmcnt(" #n ")" ::: "memory")
#define PG8_WAIT_L(n) asm volatile("s_waitcnt lgkmcnt(" #n ")" ::: "memory")
#define PG8_BAR __builtin_amdgcn_s_barrier()
#define PG8_SCHED __builtin_amdgcn_sched_barrier(0)
    Unit cur, nxt; int ui = 0;
    if (!S.next(0, cur)) return;
    f32x4 acc[2][2][4][2];
#pragma unroll
    for (int a = 0; a < 2; ++a)
#pragma unroll
        for (int b = 0; b < 2; ++b)
#pragma unroll
            for (int m = 0; m < 4; ++m)
#pragma unroll
                for (int n = 0; n < 2; ++n) acc[a][b][m][n] = (f32x4){0.f, 0.f, 0.f, 0.f};
    bf16x8 At[4][2], B0[2][2], B1[2][2];
    const char* cA = (const char*)g.A + (size_t)cur.pm * tstepA + cur.ko; const char* cB = (const char*)g.Bt + (size_t)cur.pn * tstepB + cur.ko;
    S.a_ready(cur);
    if constexpr (SP2) {
        PG8_STAGE(PG8_SB(0, 0), cB, voffB); PG8_STAGE(PG8_SB(0, 1), cB + hstepB, voffB); PG8_STAGE(PG8_SA(0, 0), cA, voffA); PG8_STAGE(PG8_SA(0, 1), cA + hstepA, voffA);
        if (wr == 1) PG8_BAR;
        PG8_WAIT_V(2); PG8_BAR;
        PG8_STAGE(PG8_SB(1, 0), cB + kstep, voffB); PG8_STAGE(PG8_SA(1, 0), cA + kstep, voffA); PG8_STAGE(PG8_SB(1, 1), cB + hstepB + kstep, voffB);
        PG8_WAIT_V(6); PG8_BAR;
    } else {
        PG8_STAGE(PG8_SB(0, 0), cB, voffB); PG8_STAGE(PG8_SA(0, 0), cA, voffA); PG8_STAGE(PG8_SB(0, 1), cB + hstepB, voffB); PG8_STAGE(PG8_SA(0, 1), cA + hstepA, voffA);
        if (wr == 1) PG8_BAR;
        PG8_WAIT_V(4); PG8_BAR;
        PG8_STAGE(PG8_SB(1, 0), cB + kstep, voffB); PG8_STAGE(PG8_SA(1, 0), cA + kstep, voffA); PG8_STAGE(PG8_SB(1, 1), cB + hstepB + kstep, voffB);
        PG8_WAIT_V(6); PG8_BAR;
    }
    for (;;) {
        const bool has_next = S.next(ui + 1, nxt);
        const char* nA = has_next ? (const char*)g.A + (size_t)nxt.pm * tstepA + nxt.ko : cA; const char* nB = has_next ? (const char*)g.Bt + (size_t)nxt.pn * tstepB + nxt.ko : cB;
        const int nt = KK > 0 ? KK / BK : cur.nk;
        for (int t = 0; t < nt; t += 2) {
            if constexpr (Epi::MIDHOOK) { if (t == nt / 2) E.mid(acc, cur, wr, wc, fr, fq); }
            const bool last = (t == nt - 2);
            const char* a1 = cA + (size_t)(t + 1) * kstep;
            const char* a2 = last ? nA : cA + (size_t)(t + 2) * kstep; const char* b2 = last ? nB : cB + (size_t)(t + 2) * kstep;
            const char* a3 = a2 + kstep; const char* b3 = b2 + kstep;
            if (last && has_next) S.a_ready(nxt);
            if constexpr (SP2) {
            PG8_LDB(B0, 0, 0); PG8_LDB(B1, 0, 1); PG8_SCHED; PG8_LDA(At, 0, 0); PG8_STAGE(PG8_SA(1, 1), a1 + hstepA, voffA);
            PG8_WAIT_V(8); PG8_WAIT_L(0); PG8_BAR; PG8_MMA(0, 0, At, B0); PG8_MMA(0, 1, At, B1); PG8_BAR; PG8_SCHED;
            PG8_LDA(At, 0, 1); PG8_STAGE(PG8_SB(0, 0), b2, voffB); PG8_STAGE(PG8_SB(0, 1), b2 + hstepB, voffB); PG8_STAGE(PG8_SA(0, 0), a2, voffA);
            PG8_WAIT_V(8); PG8_WAIT_L(0); PG8_BAR; PG8_MMA(1, 0, At, B0); PG8_MMA(1, 1, At, B1); PG8_BAR; PG8_SCHED;
            PG8_LDB(B0, 1, 0); PG8_LDB(B1, 1, 1); PG8_SCHED; PG8_LDA(At, 1, 0); PG8_STAGE(PG8_SA(0, 1), a2 + hstepA, voffA);
            PG8_WAIT_V(8); PG8_WAIT_L(0); PG8_BAR; PG8_MMA(0, 0, At, B0); PG8_MMA(0, 1, At, B1); PG8_BAR; PG8_SCHED;
            PG8_LDA(At, 1, 1); PG8_STAGE(PG8_SB(1, 0), b3, voffB); PG8_STAGE(PG8_SB(1, 1), b3 + hstepB, voffB); PG8_STAGE(PG8_SA(1, 0), a3, voffA);
            PG8_WAIT_V(8); PG8_WAIT_L(0); PG8_BAR; PG8_MMA(1, 0, At, B0); PG8_MMA(1, 1, At, B1); PG8_BAR; PG8_SCHED;
            } else {
            PG8_LDB(B0, 0, 0); PG8_SCHED; PG8_LDA(At, 0, 0); PG8_STAGE(PG8_SA(1, 1), a1 + hstepA, voffA);
            PG8_WAIT_L(8); PG8_BAR; PG8_WAIT_L(0); PG8_MMA(0, 0, At, B0); PG8_BAR; PG8_SCHED;
            PG8_LDB(B1, 0, 1); PG8_STAGE(PG8_SB(0, 0), b2, voffB);
            PG8_BAR; PG8_WAIT_L(0); PG8_MMA(0, 1, At, B1); PG8_BAR;
            PG8_LDA(At, 0, 1); PG8_STAGE(PG8_SA(0, 0), a2, voffA);
            PG8_BAR; PG8_WAIT_L(0); PG8_MMA(1, 0, At, B0); PG8_BAR; PG8_SCHED;
            PG8_STAGE(PG8_SB(0, 1), b2 + hstepB, voffB);
            PG8_WAIT_V(6); PG8_BAR; PG8_MMA(1, 1, At, B1); PG8_BAR;
            PG8_LDB(B0, 1, 0); PG8_SCHED; PG8_LDA(At, 1, 0); PG8_STAGE(PG8_SA(0, 1), a2 + hstepA, voffA);
            PG8_WAIT_L(8); PG8_BAR; PG8_WAIT_L(0); PG8_MMA(0, 0, At, B0); PG8_BAR; PG8_SCHED;
            PG8_LDB(B1, 1, 1); PG8_STAGE(PG8_SB(1, 0), b3, voffB);
            PG8_BAR; PG8_WAIT_L(0); PG8_MMA(0, 1, At, B1); PG8_BAR;
            PG8_LDA(At, 1, 1); PG8_STAGE(PG8_SA(1, 0), a3, voffA);
            PG8_BAR; PG8_WAIT_L(0); PG8_MMA(1, 0, At, B0); PG8_BAR; PG8_SCHED;
            PG8_STAGE(PG8_SB(1, 1), b3 + hstepB, voffB);
            PG8_WAIT_V(6); PG8_BAR; PG8_MMA(1, 1, At, B1); PG8_BAR;
            }
        }
        if constexpr (ALIGN_EPI) { if (wr == 0) PG8_BAR; }
        if constexpr (!Epi::AFTER_DRAIN) { E(acc, cur, wr, wc, fr, fq); S.done(cur); }
        if (!has_next) break;
#pragma unroll
        for (int a = 0; a < 2; ++a)
#pragma unroll
            for (int b = 0; b < 2; ++b)
#pragma unroll
                for (int m = 0; m < 4; ++m)
#pragma unroll
                    for (int n = 0; n < 2; ++n) acc[a][b][m][n] = (f32x4){0.f, 0.f, 0.f, 0.f};
        cur = nxt; cA = nA; cB = nB; ++ui;
        if constexpr (ALIGN_EPI) { if (wr == 1) PG8_BAR; }
    }
    PG8_WAIT_V(0);
    if constexpr (!ALIGN_EPI) { if (wr == 0) PG8_BAR; }
    PG8_BAR;
    if constexpr (Epi::AFTER_DRAIN) { E.fused(acc, cur, wr, wc, fr, fq, lds, wid, lane); S.done(cur); }
#undef PG8_SA
#undef PG8_SB
#undef PG8_STAGE
#undef PG8_LDA
#undef PG8_LDB
#undef PG8_MMA
#undef PG8_WAIT_V
#undef PG8_WAIT_L
#undef PG8_BAR
#undef PG8_SCHED
}
}
namespace pg8 {
__device__ __forceinline__ u32x4 pack8(const f32x4 a, const f32x4 b) { u32x4 w; w.x = cvt_pk_bf16(a[0], a[1]); w.y = cvt_pk_bf16(a[2], a[3]); w.z = cvt_pk_bf16(b[0], b[1]); w.w = cvt_pk_bf16(b[2], b[3]); return w; }
__device__ __forceinline__ void unpack8(const u32x4 w, f32x4& a, f32x4& b) {
    a[0] = __uint_as_float(w.x << 16); a[1] = __uint_as_float(w.x & 0xffff0000u); a[2] = __uint_as_float(w.y << 16); a[3] = __uint_as_float(w.y & 0xffff0000u);
    b[0] = __uint_as_float(w.z << 16); b[1] = __uint_as_float(w.z & 0xffff0000u); b[2] = __uint_as_float(w.w << 16); b[3] = __uint_as_float(w.w & 0xffff0000u); }
__device__ __forceinline__ float fsig(float x) { return __builtin_amdgcn_rcpf(1.f + __builtin_amdgcn_exp2f(-1.4426950408889634f * x)); }
__device__ __forceinline__ f32x4 fsig4(const f32x4 v) { f32x4 r; r[0] = fsig(v[0]); r[1] = fsig(v[1]); r[2] = fsig(v[2]); r[3] = fsig(v[3]); return r; }
__device__ __forceinline__ f32x4 gelu4(const f32x4 v) { const f32x2 a = gelu_pk((f32x2){v[0], v[1]}), b = gelu_pk((f32x2){v[2], v[3]}); return (f32x4){a.x, a.y, b.x, b.y}; }

struct SsmOrder {
    int G, c;
    __device__ bool next(int i, Unit& u) const { const int L = i * G + c; if (L >= 128) return false; u.pm = L; u.pn = L >> 2; return true; }
    __device__ __forceinline__ void a_ready(const Unit&) const {}
    __device__ __forceinline__ void done(const Unit&) const {}
};
struct MoeOrder {
    StaticOrder so; int pe0, pe1, pe2, pe3, pe4, pe5, pe6; int nN; int maxr;
    __device__ bool next(int i, Unit& u) const {
        if (i >= maxr || !so.next(i, u)) return false;
        const int r0 = u.pm * 256; const int e = (pe0 <= r0) + (pe1 <= r0) + (pe2 <= r0) + (pe3 <= r0) + (pe4 <= r0) + (pe5 <= r0) + (pe6 <= r0);
        u.pn += e * nN; return true; }
    __device__ __forceinline__ void a_ready(const Unit&) const {}
    __device__ __forceinline__ void done(const Unit&) const {}
};

struct MoeSplitOrder {
    int c, tile0, nsub, eoff;
    int pe0, pe1, pe2, pe3, pe4, pe5, pe6; int nN;
    __device__ bool next(int i, Unit& u) const {
        const int q = i * 256 + c; if (q >= nsub) return false;
        const int j = q / 6, ks = q - j * 6;
        u.pm = tile0 + (j >> 2);
        const int r0 = u.pm * 256; const int e = (pe0 <= r0) + (pe1 <= r0) + (pe2 <= r0) + (pe3 <= r0) + (pe4 <= r0) + (pe5 <= r0) + (pe6 <= r0);
        u.pn = (j & 3) + e * nN; u.ko = (ks < 4 ? ks * 8 : 32 + (ks - 4) * 6) * 128; u.nk = ks < 4 ? 8 : 6; u.aux = q; return true; }
    __device__ __forceinline__ void a_ready(const Unit&) const {}
    __device__ __forceinline__ void done(const Unit&) const {}
};

#define EPI_ROWS(u) const int rowb = (u).pm * BM + wr * 64 + fr
template <bool RS> struct EpiInProjT {
    static constexpr bool PERM = true, AFTER_DRAIN = false, MIDHOOK = false;
    bf16_t *Q, *Kb, *V, *AY, *G; const float *COS, *SIN; const PG8_LAS float* RSTD;
    __device__ __forceinline__ void operator()(const f32x4 (&acc_)[2][2][4][2], const Unit& u, int wr, int wc, int fr, int fq) const {
        EPI_ROWS(u); const int pn = u.pn;
#pragma unroll
        for (int ai = 0; ai < 2; ++ai)
#pragma unroll
            for (int m = 0; m < 4; ++m) {
                f32x4 c_[2][2];
                { const float rs = RS ? RSTD[ai * HALF + wr * 64 + m * 16 + fr] : 1.f;
#pragma unroll
                  for (int bj = 0; bj < 2; ++bj) { c_[bj][0] = RS ? acc_[ai][bj][m][0] * rs : acc_[ai][bj][m][0]; c_[bj][1] = RS ? acc_[ai][bj][m][1] * rs : acc_[ai][bj][m][1]; } }
                const int row = rowb + ai * HALF + m * 16, b = row >> 13, s = row & 8191;
                if (pn < 4) {
                    bf16_t* dst = pn < 2 ? Q : Kb; const int c = wc >> 1, jb = 16 * (wc & 1) + 4 * fq;
                    const f32x4 cs = *(const f32x4*)(COS + s * 32 + jb), sn = *(const f32x4*)(SIN + s * 32 + jb);
#pragma unroll
                    for (int bj = 0; bj < 2; ++bj) { const int h = 2 * (pn & 1) + bj; const f32x4 x1 = c_[bj][0], x2 = c_[bj][1];
                        *(u32x4*)(dst + ((((size_t)b * 4 + h) * 2 + c) * 8192 + s) * 64 + 32 * (wc & 1) + 8 * fq) = pack8(x1 * cs - x2 * sn, x2 * cs + x1 * sn); }
                } else if (pn < 6) {
#pragma unroll
                    for (int bj = 0; bj < 2; ++bj) { const int h = 2 * (pn - 4) + bj;
                        *(u32x4*)(V + (((size_t)b * 4 + h) * 8192 + s) * 128 + 32 * wc + 8 * fq) = pack8(c_[bj][0], c_[bj][1]); }
                } else if (pn < 8) {
#pragma unroll
                    for (int bj = 0; bj < 2; ++bj) { const int ucol = 256 * (pn - 6) + 128 * bj + 32 * wc + 8 * fq, g = ucol >> 4, hh0 = ucol & 15;
                        *(u32x4*)(AY + ((size_t)g * 1024 + b * 512 + (s >> 4)) * 512 + (s & 15) * 16 + hh0) = pack8(c_[bj][0], c_[bj][1]); }
                } else {
#pragma unroll
                    for (int bj = 0; bj < 2; ++bj) { const int gcol = 256 * (pn - 8) + 128 * bj + 32 * wc + 8 * fq;
                        *(u32x4*)(G + (size_t)row * 2048 + gcol) = pack8(fsig4(c_[bj][0]), fsig4(c_[bj][1])); }
                }
            }
    }
};
typedef EpiInProjT<false> EpiInProj;
struct EpiXloc {
    static constexpr bool PERM = true, AFTER_DRAIN = false, MIDHOOK = false;
    float* XLOC;
    __device__ __forceinline__ void operator()(const f32x4 (&acc)[2][2][4][2], const Unit& u, int wr, int wc, int fr, int fq) const {
        EPI_ROWS(u);
#pragma unroll
        for (int ai = 0; ai < 2; ++ai)
#pragma unroll
            for (int m = 0; m < 4; ++m)
#pragma unroll
                for (int bj = 0; bj < 2; ++bj) { float* p = XLOC + (size_t)(rowb + ai * HALF + m * 16) * 256 + bj * HALF + 32 * wc + 8 * fq;
                    *(f32x4*)p = acc[ai][bj][m][0]; *(f32x4*)(p + 4) = acc[ai][bj][m][1]; }
    }
};
struct EpiY {
    static constexpr bool PERM = true, AFTER_DRAIN = false, MIDHOOK = false;
    bf16_t* SACT;
    __device__ __forceinline__ void operator()(const f32x4 (&acc)[2][2][4][2], const Unit& u, int wr, int wc, int fr, int fq) const {
        EPI_ROWS(u);
#pragma unroll
        for (int ai = 0; ai < 2; ++ai)
#pragma unroll
            for (int m = 0; m < 4; ++m) { const int R = rowb + ai * HALF + m * 16, g = R >> 10, bc = R & 1023;
#pragma unroll
                for (int bj = 0; bj < 2; ++bj) { const int col0 = bj * HALF + 32 * wc + 8 * fq, i = col0 >> 4, hh0 = col0 & 15;
                    *(u32x4*)(SACT + (size_t)(bc * 16 + i) * 512 + g * 16 + hh0) = pack8(gelu4(acc[ai][bj][m][0]), gelu4(acc[ai][bj][m][1])); } }
    }
};
struct EpiGlu {
    static constexpr bool PERM = true, AFTER_DRAIN = false, MIDHOOK = false;
    const bf16_t* SACT; bf16_t* AS2;
    __device__ __forceinline__ void operator()(const f32x4 (&acc)[2][2][4][2], const Unit& u, int wr, int wc, int fr, int fq) const {
        EPI_ROWS(u);
#pragma unroll
        for (int ai = 0; ai < 2; ++ai)
#pragma unroll
            for (int m = 0; m < 4; ++m) { const int row = rowb + ai * HALF + m * 16;
#pragma unroll
                for (int bj = 0; bj < 2; ++bj) { const int col0 = u.pn * BM + bj * HALF + 32 * wc + 8 * fq;
                    f32x4 s0, s1; unpack8(*(const u32x4*)(SACT + (size_t)row * 512 + col0), s0, s1);
                    *(u32x4*)(AS2 + (size_t)row * 1024 + 512 + col0) = pack8(s0 * fsig4(acc[ai][bj][m][0]), s1 * fsig4(acc[ai][bj][m][1])); } }
    }
};
struct EpiBranch {
    static constexpr bool PERM = true, AFTER_DRAIN = false, MIDHOOK = true;
    const bf16_t* G; bf16_t* MERGED;
    __device__ __forceinline__ void mid(f32x4 (&acc)[2][2][4][2], const Unit& u, int wr, int wc, int fr, int fq) const {
        asm volatile("" : "+v"(fr), "+v"(fq));
        EPI_ROWS(u);
#pragma unroll
        for (int ai = 0; ai < 2; ++ai)
#pragma unroll
            for (int m = 0; m < 4; ++m) { const int row = rowb + ai * HALF + m * 16;
#pragma unroll
                for (int bj = 0; bj < 2; ++bj) { const int col0 = u.pn * BM + bj * HALF + 32 * wc + 8 * fq;
                    f32x4 a0, a1, b0, b1; unpack8(*(const u32x4*)(G + (size_t)row * 2048 + col0), a0, a1); unpack8(*(const u32x4*)(G + (size_t)row * 2048 + 1024 + col0), b0, b1);
#pragma unroll
                    for (int e = 0; e < 4; ++e) { acc[ai][bj][m][0][e] *= a0[e] * __builtin_amdgcn_rcpf(b0[e]); acc[ai][bj][m][1][e] *= a1[e] * __builtin_amdgcn_rcpf(b1[e]); } }
                asm volatile("" ::: "memory"); }
    }
    __device__ __forceinline__ void operator()(const f32x4 (&acc)[2][2][4][2], const Unit& u, int wr, int wc, int fr, int fq) const {
        EPI_ROWS(u);
#pragma unroll
        for (int ai = 0; ai < 2; ++ai)
#pragma unroll
            for (int m = 0; m < 4; ++m) { const int row = rowb + ai * HALF + m * 16;
#pragma unroll
                for (int bj = 0; bj < 2; ++bj) { const int col0 = u.pn * BM + bj * HALF + 32 * wc + 8 * fq;
                    f32x4 b0, b1; unpack8(*(const u32x4*)(G + (size_t)row * 2048 + 1024 + col0), b0, b1);
                    *(u32x4*)(MERGED + (size_t)row * 1024 + col0) = pack8(acc[ai][bj][m][0] * b0, acc[ai][bj][m][1] * b1); } }
    }
};
struct EpiRes {
    static constexpr bool PERM = true, AFTER_DRAIN = false, MIDHOOK = false;
    const float* SRC; float* X;
    __device__ __forceinline__ void operator()(const f32x4 (&acc)[2][2][4][2], const Unit& u, int wr, int wc, int fr, int fq) const {
        EPI_ROWS(u);
#pragma unroll
        for (int ai = 0; ai < 2; ++ai)
#pragma unroll
            for (int m = 0; m < 4; ++m) { const int row = rowb + ai * HALF + m * 16;
#pragma unroll
                for (int bj = 0; bj < 2; ++bj) { const size_t o = (size_t)row * 1024 + u.pn * BM + bj * HALF + 32 * wc + 8 * fq;
                    const f32x4 s0 = *(const f32x4*)(SRC + o), s1 = *(const f32x4*)(SRC + o + 4);
                    *(f32x4*)(X + o) = s0 + acc[ai][bj][m][0]; *(f32x4*)(X + o + 4) = s1 + acc[ai][bj][m][1]; } }
    }
};
template <bool RS> struct EpiSwigluT {
    static constexpr bool PERM = true, AFTER_DRAIN = false, MIDHOOK = false;
    bf16_t* H; int nN; const PG8_LAS float* RSTD;
    __device__ __forceinline__ void operator()(const f32x4 (&acc)[2][2][4][2], const Unit& u, int wr, int wc, int fr, int fq) const {
        EPI_ROWS(u); const int col0 = 128 * (u.pn % nN) + 32 * wc + 8 * fq;
#pragma unroll
        for (int ai = 0; ai < 2; ++ai)
#pragma unroll
            for (int m = 0; m < 4; ++m) { const int row = rowb + ai * HALF + m * 16;
                const float rs = RS ? RSTD[ai * HALF + wr * 64 + m * 16 + fr] : 1.f;
                const f32x4 a0 = RS ? acc[ai][0][m][0] * rs : acc[ai][0][m][0], a1 = RS ? acc[ai][0][m][1] * rs : acc[ai][0][m][1];
                const f32x4 b0 = RS ? acc[ai][1][m][0] * rs : acc[ai][1][m][0], b1 = RS ? acc[ai][1][m][1] * rs : acc[ai][1][m][1];
                *(u32x4*)(H + (size_t)row * 2816 + col0) = pack8(a0 * fsig4(a0) * b0, a1 * fsig4(a1) * b1); }
    }
};
typedef EpiSwigluT<false> EpiSwiglu;
struct EpiResN {
    static constexpr bool PERM = true, AFTER_DRAIN = false, MIDHOOK = false;
    const float* SRC; float* X; bf16_t* XN; float* PS;
    __device__ __forceinline__ void operator()(const f32x4 (&acc)[2][2][4][2], const Unit& u, int wr, int wc, int fr, int fq) const {
        EPI_ROWS(u);
#pragma unroll
        for (int ai = 0; ai < 2; ++ai)
#pragma unroll
            for (int m = 0; m < 4; ++m) { const int row = rowb + ai * HALF + m * 16; float ss = 0.f;
#pragma unroll
                for (int bj = 0; bj < 2; ++bj) { const size_t o = (size_t)row * 1024 + u.pn * BM + bj * HALF + 32 * wc + 8 * fq;
                    const f32x4 s0 = *(const f32x4*)(SRC + o), s1 = *(const f32x4*)(SRC + o + 4);
                    const f32x4 y0 = s0 + acc[ai][bj][m][0], y1 = s1 + acc[ai][bj][m][1];
                    *(f32x4*)(X + o) = y0; *(f32x4*)(X + o + 4) = y1; *(u32x4*)(XN + o) = pack8(y0, y1);
                    ss += (y0[0] * y0[0] + y0[1] * y0[1]) + (y0[2] * y0[2] + y0[3] * y0[3]) + (y1[0] * y1[0] + y1[1] * y1[1]) + (y1[2] * y1[2] + y1[3] * y1[3]); }
                { auto r = __builtin_amdgcn_permlane16_swap(__float_as_uint(ss), __float_as_uint(ss), false, false); ss = __uint_as_float(r[0]) + __uint_as_float(r[1]); }
                { auto r = __builtin_amdgcn_permlane32_swap(__float_as_uint(ss), __float_as_uint(ss), false, false); ss = __uint_as_float(r[0]) + __uint_as_float(r[1]); }
                if (fq == 0) PS[(size_t)(u.pn * 4 + wc) * 16384 + row] = ss; }
    }
};
struct EpiMoeDown {
    static constexpr bool PERM = true, AFTER_DRAIN = false, MIDHOOK = false;
    bf16_t* YS;
    __device__ __forceinline__ void operator()(const f32x4 (&acc)[2][2][4][2], const Unit& u, int wr, int wc, int fr, int fq) const {
        EPI_ROWS(u);
#pragma unroll
        for (int ai = 0; ai < 2; ++ai)
#pragma unroll
            for (int m = 0; m < 4; ++m) { const int row = rowb + ai * HALF + m * 16;
#pragma unroll
                for (int bj = 0; bj < 2; ++bj)
                    *(u32x4*)(YS + (size_t)row * 1024 + (u.pn & 3) * BM + bj * HALF + 32 * wc + 8 * fq) = pack8(acc[ai][bj][m][0], acc[ai][bj][m][1]); }
    }
};
struct EpiMoeDownPart {
    static constexpr bool PERM = true, AFTER_DRAIN = false, MIDHOOK = false;
    float* P;
    __device__ __forceinline__ void operator()(const f32x4 (&acc)[2][2][4][2], const Unit& u, int wr, int wc, int fr, int fq) const {
        float* base = P + (size_t)u.aux * 65536 + (size_t)(wr * 64 + fr) * 256 + 32 * wc + 8 * fq;
#pragma unroll
        for (int ai = 0; ai < 2; ++ai)
#pragma unroll
            for (int m = 0; m < 4; ++m)
#pragma unroll
                for (int bj = 0; bj < 2; ++bj) { float* d = base + (ai * HALF + m * 16) * 256 + bj * HALF;
                    *(f32x4*)d = acc[ai][bj][m][0]; *(f32x4*)(d + 4) = acc[ai][bj][m][1]; }
    }
};
#undef EPI_ROWS
}
#define XB_TMO      128
#define XB_XCNT(j)  (256  + 64 * (j))
#define XB_XSUB(j)  (1280 + 64 * (j))
#define XB_XGEN(j)  (2304 + 64 * (j))
#define XB_TOP      3328
#define XB_TOPGEN   3392
#define XCD_BAR_WORDS 3456
#define XB_SPIN_CAP (1u << 18)

__device__ __forceinline__ unsigned xb_ld(unsigned* p)              { return __hip_atomic_load(p, __ATOMIC_RELAXED, __HIP_MEMORY_SCOPE_AGENT); }
__device__ __forceinline__ unsigned xb_add(unsigned* p, unsigned v) { return __hip_atomic_fetch_add(p, v, __ATOMIC_RELAXED, __HIP_MEMORY_SCOPE_AGENT); }
__device__ __forceinline__ unsigned xb_xcc_id() { return (unsigned)__builtin_amdgcn_s_getreg((3 << 11) | 20) & 0xFu; }
#define XB_SPIN(cond, bar) do { unsigned _sp = 0; while (cond) { __builtin_amdgcn_s_sleep(1); \
    if ((++_sp & 255u) == 0u) { if (xb_ld(&(bar)[XB_TMO])) break; if (_sp > XB_SPIN_CAP) { atomicAdd(&(bar)[XB_TMO], 1u); break; } } } } while (0)

struct XcdBarrier {
    unsigned* bar; unsigned x;
    volatile LAS unsigned* st;
};

__device__ __forceinline__ XcdBarrier xcd_barrier_post(unsigned* bar, volatile LAS unsigned* st) {
    XcdBarrier b; b.bar = bar; b.x = xb_xcc_id(); b.st = st;
    if (threadIdx.x == 0) (void)xb_add(&bar[XB_XCNT(b.x)], 1u);
    return b;
}
__device__ __forceinline__ void xcd_barrier_complete(unsigned* bar, unsigned x, unsigned& nloc, unsigned& nx) {
    const unsigned G = gridDim.x * gridDim.y * gridDim.z;
    unsigned sum, cnt, mine, sp = 0u;
    for (;;) {
        sum = 0u; cnt = 0u; mine = 0u;
#pragma unroll
        for (unsigned j = 0; j < 16; ++j) { const unsigned c = xb_ld(&bar[XB_XCNT(j)]); sum += c; cnt += (c > 0u) ? 1u : 0u; mine = (j == x) ? c : mine; }
        if (sum == G) break;
        __builtin_amdgcn_s_sleep(1);
        if ((++sp & 255u) == 0u) { if (xb_ld(&bar[XB_TMO])) break; if (sp > XB_SPIN_CAP) { atomicAdd(&bar[XB_TMO], 1u); break; } }
    }
    nloc = mine > 0u ? mine : 1u; nx = cnt > 0u ? cnt : 1u;
}

__device__ __forceinline__ void xcd_barrier(const XcdBarrier& b) {
    asm volatile("s_waitcnt vmcnt(0)" ::: "memory");
    __syncthreads();
    if (threadIdx.x == 0) {
        unsigned* bar = b.bar;
        __builtin_amdgcn_s_waitcnt(0);
        unsigned nloc = b.st[0], nx = b.st[1];
        if (nloc == 0u) { xcd_barrier_complete(bar, b.x, nloc, nx); b.st[0] = nloc; b.st[1] = nx; }
        const unsigned old = xb_add(&bar[XB_XSUB(b.x)], 1u);
        const unsigned gen = old / nloc;
        if (old + 1u == (gen + 1u) * nloc) {
            __builtin_amdgcn_fence(__ATOMIC_RELEASE, "agent");
            asm volatile("s_waitcnt vmcnt(0)" ::: "memory");
            const unsigned og = xb_add(&bar[XB_TOP], 1u);
            const unsigned tg = og / nx;
            if (og + 1u == (tg + 1u) * nx) xb_add(&bar[XB_TOPGEN], 1u);
            else XB_SPIN(xb_ld(&bar[XB_TOPGEN]) == tg, bar);
            __builtin_amdgcn_fence(__ATOMIC_ACQUIRE, "agent");
            xb_add(&bar[XB_XGEN(b.x)], 1u);
            asm volatile("s_waitcnt vmcnt(0)" ::: "memory");
        } else {
            XB_SPIN(xb_ld(&bar[XB_XGEN(b.x)]) == gen, bar);
            __builtin_amdgcn_fence(__ATOMIC_ACQUIRE, "agent");
            asm volatile("s_waitcnt vmcnt(0)" ::: "memory");
        }
    }
    __syncthreads();
}

namespace att {
using bf16x8 = __attribute__((ext_vector_type(8))) short;
using s16x4  = __attribute__((ext_vector_type(4))) short;
using f32x16 = __attribute__((ext_vector_type(16))) float;
using u32x4  = __attribute__((ext_vector_type(4))) unsigned;
constexpr int NW = 8, QBLK = 32, KVBLK = 64;
constexpr float SCALE = 0.125f;
constexpr int SHM_V = KVBLK * 128 * 2, SHM_K = KVBLK * 64 * 2, SHM_ATTN = 4 * SHM_V + 4 * SHM_K + NW * 64 * 4;
#define KSWZ64(row, colB) ((row) * 128 + ((colB) ^ ((((row) >> 1) & 7) << 4)))
#define SBAR() __builtin_amdgcn_sched_barrier(0)
__device__ __forceinline__ int crow(int r, int hi) { return (r & 3) + 8 * (r >> 2) + 4 * hi; }
typedef __bf16 bf16x2_cv __attribute__((ext_vector_type(2))); typedef float f32x2_cv __attribute__((ext_vector_type(2)));
__device__ __forceinline__ unsigned cvtpk(float lo, float hi) { const bf16x2_cv r = __builtin_convertvector((f32x2_cv){lo, hi}, bf16x2_cv); return __builtin_bit_cast(unsigned, r); }
__device__ __forceinline__ void partialSM(f32x16& p0, f32x16& p1, float mb) {
  constexpr float C = SCALE * 1.4426950408889634f;
#pragma unroll
  for (int r = 0; r < 16; ++r) p0[r] = fmaf(p0[r], C, -mb);
#pragma unroll
  for (int r = 0; r < 16; ++r) p1[r] = fmaf(p1[r], C, -mb);
#pragma unroll
  for (int r = 0; r < 16; ++r) p0[r] = __builtin_amdgcn_exp2f(p0[r]);
}
__device__ __forceinline__ void finishSM(f32x16& p0, f32x16& p1, float& l_reg, bf16x8& pa0, bf16x8& pa1, bf16x8& pa2, bf16x8& pa3) {
#pragma unroll
  for (int r = 0; r < 16; ++r) p1[r] = __builtin_amdgcn_exp2f(p1[r]);
  typedef __bf16 bf2_t __attribute__((ext_vector_type(2)));
  const bf2_t one2 = {(__bf16)1.0f, (__bf16)1.0f};
  float ps0 = 0.f, ps1 = 0.f;
#define DOT1(acc, w) acc = __builtin_amdgcn_fdot2_f32_bf16(__builtin_bit_cast(bf2_t, (unsigned)(w)), one2, acc, false)
#define PK4(P, BASE, OUT) do { unsigned a0 = cvtpk(P[BASE + 0], P[BASE + 1]), a1 = cvtpk(P[BASE + 2], P[BASE + 3]);   \
    unsigned b0 = cvtpk(P[BASE + 4], P[BASE + 5]), b1 = cvtpk(P[BASE + 6], P[BASE + 7]);                              \
    DOT1(ps0, a0); DOT1(ps1, a1); DOT1(ps0, b0); DOT1(ps1, b1);                                                       \
    u32x4 w = {a0, a1, b0, b1}; OUT = *reinterpret_cast<bf16x8*>(&w); } while (0)
  PK4(p0, 0, pa0); PK4(p0, 8, pa1); PK4(p1, 0, pa2); PK4(p1, 8, pa3);
  l_reg += ps0 + ps1;
#undef DOT1
#undef PK4
}
template <int OFF> __device__ __forceinline__ bf16x8 k_read(int ka) { bf16x8 r; asm volatile("ds_read_b128 %0, %1 offset:%2" : "=&v"(r) : "v"(ka), "i"(OFF) : "memory"); return r; }
__device__ __forceinline__ void qkt(f32x16& p0, f32x16& p1, const char* Ks, const bf16x8* qr, int r32, int hi) {
  p0 = f32x16{}; p1 = f32x16{};
  const int sw = (r32 >> 1) & 7, base = (int)(uintptr_t)Ks + r32 * 128;
  const int a0 = base + (((0 + hi) ^ sw) << 4), a1 = base + (((2 + hi) ^ sw) << 4), a2 = base + (((4 + hi) ^ sw) << 4), a3 = base + (((6 + hi) ^ sw) << 4);
  const bf16x8 k00 = k_read<0>(a0), k01 = k_read<4096>(a0), k10 = k_read<0>(a1), k11 = k_read<4096>(a1), k20 = k_read<0>(a2), k21 = k_read<4096>(a2), k30 = k_read<0>(a3), k31 = k_read<4096>(a3);
  asm volatile("s_waitcnt lgkmcnt(0)" ::: "memory"); SBAR();
  p0 = __builtin_amdgcn_mfma_f32_32x32x16_bf16(k00, qr[0], p0, 0, 0, 0); p1 = __builtin_amdgcn_mfma_f32_32x32x16_bf16(k01, qr[0], p1, 0, 0, 0);
  p0 = __builtin_amdgcn_mfma_f32_32x32x16_bf16(k10, qr[1], p0, 0, 0, 0); p1 = __builtin_amdgcn_mfma_f32_32x32x16_bf16(k11, qr[1], p1, 0, 0, 0);
  p0 = __builtin_amdgcn_mfma_f32_32x32x16_bf16(k20, qr[2], p0, 0, 0, 0); p1 = __builtin_amdgcn_mfma_f32_32x32x16_bf16(k21, qr[2], p1, 0, 0, 0);
  p0 = __builtin_amdgcn_mfma_f32_32x32x16_bf16(k30, qr[3], p0, 0, 0, 0); p1 = __builtin_amdgcn_mfma_f32_32x32x16_bf16(k31, qr[3], p1, 0, 0, 0);
}
__device__ __forceinline__ int v_st(int k, int c) { const int kk = k; return ((kk >> 3) * 4 + (c >> 5)) * 512 + ((kk & 7) * 32 + (c & 31)) * 2; }
__device__ __forceinline__ int v_rd_base(int lane) { return ((lane & 3) << 3) | (((lane >> 2) & 3) << 6) | (((lane >> 4) & 1) << 5) | (((lane >> 5) & 1) << 8); }
constexpr int v_rd_off(int d0, int ks, int half) { return d0 * 512 + ks * 4096 + half * 2048; }
template <int OFF> __device__ __forceinline__ s16x4 tr_read(int vb) {
  s16x4 r; asm volatile("ds_read_b64_tr_b16 %0, %1 offset:%2" : "=&v"(r) : "v"(vb), "i"(OFF) : "memory"); return r;
}
template <int D0> __device__ __forceinline__ void pv_one(f32x16& od, int vb, bf16x8 pa0, bf16x8 pa1, bf16x8 pa2, bf16x8 pa3) {
  const s16x4 l0 = tr_read<v_rd_off(D0, 0, 0)>(vb), h0 = tr_read<v_rd_off(D0, 0, 1)>(vb), l1 = tr_read<v_rd_off(D0, 1, 0)>(vb), h1 = tr_read<v_rd_off(D0, 1, 1)>(vb);
  const s16x4 l2 = tr_read<v_rd_off(D0, 2, 0)>(vb), h2 = tr_read<v_rd_off(D0, 2, 1)>(vb), l3 = tr_read<v_rd_off(D0, 3, 0)>(vb), h3 = tr_read<v_rd_off(D0, 3, 1)>(vb);
  asm volatile("s_waitcnt lgkmcnt(0)" ::: "memory"); SBAR();
#define PK(L, H) (bf16x8){L[0], L[1], L[2], L[3], H[0], H[1], H[2], H[3]}
  od = __builtin_amdgcn_mfma_f32_32x32x16_bf16(pa0, PK(l0, h0), od, 0, 0, 0);
  od = __builtin_amdgcn_mfma_f32_32x32x16_bf16(pa1, PK(l1, h1), od, 0, 0, 0);
  od = __builtin_amdgcn_mfma_f32_32x32x16_bf16(pa2, PK(l2, h2), od, 0, 0, 0);
  od = __builtin_amdgcn_mfma_f32_32x32x16_bf16(pa3, PK(l3, h3), od, 0, 0, 0);
#undef PK
}
__device__ __forceinline__ void pv_d0(f32x16* o, int vb, bf16x8 pa0, bf16x8 pa1, bf16x8 pa2, bf16x8 pa3) {
  pv_one<0>(o[0], vb, pa0, pa1, pa2, pa3); pv_one<1>(o[1], vb, pa0, pa1, pa2, pa3); pv_one<2>(o[2], vb, pa0, pa1, pa2, pa3); pv_one<3>(o[3], vb, pa0, pa1, pa2, pa3);
}

__device__ __forceinline__ void diff_attn_unit(const unsigned short* __restrict__ Qh, const unsigned short* __restrict__ Kh, const unsigned short* __restrict__ Vh, int i0,
                                               const unsigned* __restrict__ kmax2, float* __restrict__ O1s, unsigned short* __restrict__ OUT, const float* __restrict__ subln, float lam, float oml, char* lds) {
  constexpr int SEQL = 8192, NT = SEQL / KVBLK;
  char* V_lds = lds; char* K_lds = lds + 4 * SHM_V;
  for (int c = 0; c < 2; ++c) {
    int tid_l = threadIdx.x; asm volatile("" : "+v"(tid_l));
    const int tid = tid_l, wid = __builtin_amdgcn_readfirstlane(tid >> 6), lane = tid & 63, r32 = lane & 31, hi = lane >> 5;
    const int sr = tid >> 4, sc = (tid & 15) * 8, vst0 = v_st(sr, sc), vst1 = v_st(32 + sr, sc);
    const int kr = tid >> 3, kcb = (tid & 7) * 16, kst = KSWZ64(kr, kcb);
    const int vb0 = (int)(uintptr_t)V_lds + v_rd_base(lane);
    const unsigned short* Kc = Kh + (size_t)c * SEQL * 64;
    float l_reg = 0; f32x16 o[4] = {}; bf16x8 qr[4];
    const unsigned short* Qw = Qh + (size_t)c * SEQL * 64 + (size_t)(i0 + wid * QBLK + r32) * 64 + hi * 8;
#pragma unroll
    for (int d0 = 0; d0 < 4; ++d0) qr[d0] = *reinterpret_cast<const bf16x8*>(Qw + d0 * 16);
    float mb;
    { float q2 = 0.f;
#pragma unroll
      for (int d0 = 0; d0 < 4; ++d0)
#pragma unroll
        for (int e = 0; e < 8; ++e) { const float qv = __uint_as_float(((unsigned)(unsigned short)qr[d0][e]) << 16); q2 = fmaf(qv, qv, q2); }
      { auto rr = __builtin_amdgcn_permlane32_swap(__float_as_uint(q2), __float_as_uint(q2), false, false); q2 = __uint_as_float(rr[0]) + __uint_as_float(rr[1]); }
      mb = sqrtf(q2 * __uint_as_float(kmax2[c])) * (SCALE * 1.4426950408889634f); }
    struct { bf16x8 vs0, vs1, ks0; } sr_[3];
    const unsigned voV = (unsigned)(sr * 128 + sc) * 2u, voV1 = voV + 8192u, voK = (unsigned)(kr * 64 + (tid & 7) * 8) * 2u;
    const __amdgpu_buffer_rsrc_t rV = __builtin_amdgcn_make_buffer_rsrc((void*)Vh, 0, 0x7fffffff, 0x00020000), rK = __builtin_amdgcn_make_buffer_rsrc((void*)Kc, 0, 0x7fffffff, 0x00020000);
#define SLOAD(i, k0) do { const u32x4 a_ = __builtin_amdgcn_raw_buffer_load_b128(rV, voV, (k0) * 256, 0), b_ = __builtin_amdgcn_raw_buffer_load_b128(rV, voV1, (k0) * 256, 0), \
        c_ = __builtin_amdgcn_raw_buffer_load_b128(rK, voK, (k0) * 128, 0); \
    sr_[i].vs0 = __builtin_bit_cast(bf16x8, a_); sr_[i].vs1 = __builtin_bit_cast(bf16x8, b_); sr_[i].ks0 = __builtin_bit_cast(bf16x8, c_); } while (0)
#define SWRITE(b, i) do { *(bf16x8*)(V_lds + (b) * SHM_V + vst0) = sr_[i].vs0; *(bf16x8*)(V_lds + (b) * SHM_V + vst1) = sr_[i].vs1; \
    *(bf16x8*)(K_lds + (b) * SHM_K + kst) = sr_[i].ks0; } while (0)
#define LBAR() do { asm volatile("s_waitcnt lgkmcnt(0)" ::: "memory"); __builtin_amdgcn_s_barrier(); asm volatile("" ::: "memory"); } while (0)
    f32x16 pA0, pA1, pB0, pB1; bf16x8 pa0, pa1, pa2, pa3;
    __syncthreads();
    SLOAD(0, 0); SLOAD(1, KVBLK); SLOAD(2, 2 * KVBLK); SWRITE(0, 0); SWRITE(1, 1); SWRITE(2, 2); __syncthreads();
    qkt(pA0, pA1, K_lds, qr, r32, hi); partialSM(pA0, pA1, mb);
    if (wid >= 4) { __builtin_amdgcn_s_setprio(1); LBAR(); }
    for (int j = 1; j + 1 < NT; j += 2) {
      SLOAD(0, (j + 2) * KVBLK);
      SBAR(); qkt(pB0, pB1, K_lds + (j & 3) * SHM_K, qr, r32, hi);
      finishSM(pA0, pA1, l_reg, pa0, pa1, pa2, pa3); SBAR();
      LBAR();
      pv_d0(o, vb0 + ((j - 1) & 3) * SHM_V, pa0, pa1, pa2, pa3); SBAR(); partialSM(pB0, pB1, mb); SBAR();
      SWRITE((j + 2) & 3, 0);
      LBAR();
      if (j + 3 < NT) SLOAD(0, (j + 3) * KVBLK);
      SBAR(); qkt(pA0, pA1, K_lds + ((j + 1) & 3) * SHM_K, qr, r32, hi);
      finishSM(pB0, pB1, l_reg, pa0, pa1, pa2, pa3); SBAR();
      LBAR();
      pv_d0(o, vb0 + (j & 3) * SHM_V, pa0, pa1, pa2, pa3); SBAR(); partialSM(pA0, pA1, mb); SBAR();
      if (j + 3 < NT) SWRITE((j + 3) & 3, 0);
      LBAR();
    }
    SBAR(); qkt(pB0, pB1, K_lds + ((NT - 1) & 3) * SHM_K, qr, r32, hi);
    finishSM(pA0, pA1, l_reg, pa0, pa1, pa2, pa3); SBAR();
    pv_d0(o, vb0 + ((NT - 2) & 3) * SHM_V, pa0, pa1, pa2, pa3); partialSM(pB0, pB1, mb);
    finishSM(pB0, pB1, l_reg, pa0, pa1, pa2, pa3); SBAR();
    pv_d0(o, vb0 + ((NT - 1) & 3) * SHM_V, pa0, pa1, pa2, pa3);
    if (wid < 4) LBAR();
    __builtin_amdgcn_s_setprio(0);
    { auto rr = __builtin_amdgcn_permlane32_swap(__float_as_uint(l_reg), __float_as_uint(l_reg), false, false); l_reg = __uint_as_float(rr[0]) + __uint_as_float(rr[1]); }
    { int t2 = threadIdx.x; asm volatile("" : "+v"(t2));
      const int wid2 = __builtin_amdgcn_readfirstlane(t2 >> 6), lane2 = t2 & 63, r322 = lane2 & 31, hi2 = lane2 >> 5;
      float* li_l = (float*)(lds + 4 * SHM_V + 4 * SHM_K) + wid2 * 64;
      if (hi2 == 0) li_l[r322] = l_reg; asm volatile("s_waitcnt lgkmcnt(0)" ::: "memory");
      float* O1w = O1s + (size_t)c * 32768 + (size_t)wid2 * 4096 + lane2;
#pragma unroll
      for (int r = 0; r < 16; ++r) { const float rl = __builtin_amdgcn_rcpf(li_l[crow(r, hi2)]);
#pragma unroll
        for (int d0 = 0; d0 < 4; ++d0) O1w[(d0 * 16 + r) * 64] = o[d0][r] * rl; } }
#undef SLOAD
#undef SWRITE
#undef LBAR
  }
  {
    int t3 = threadIdx.x; asm volatile("" : "+v"(t3));
    const int wid = __builtin_amdgcn_readfirstlane(t3 >> 6), lane = t3 & 63, r32 = lane & 31, hi = lane >> 5;
    const float* Ow = O1s + (size_t)wid * 4096 + lane;
    float sg[4];
#pragma unroll
    for (int d0 = 0; d0 < 4; ++d0) sg[d0] = subln[d0 * 32 + r32] * oml;
#pragma unroll 4
    for (int r = 0; r < 16; ++r) {
      float v[4], ss = 0.f;
#pragma unroll
      for (int d0 = 0; d0 < 4; ++d0) { v[d0] = Ow[(d0 * 16 + r) * 64] - lam * Ow[32768 + (d0 * 16 + r) * 64]; ss += v[d0] * v[d0]; }
#pragma unroll
      for (int of = 1; of < 32; of <<= 1) ss += __int_as_float(__builtin_amdgcn_ds_bpermute((lane ^ of) << 2, __float_as_int(ss)));
      const float rstd = rsqrtf(ss * (1.f / 128.f) + 1e-6f);
      unsigned short* op = OUT + (size_t)(wid * QBLK + crow(r, hi)) * 1024 + r32;
#pragma unroll
      for (int d0 = 0; d0 < 4; ++d0) { const float y = v[d0] * rstd * sg[d0]; unsigned u = __float_as_uint(y); op[d0 * 32] = (unsigned short)((u + 0x7fffu + ((u >> 16) & 1u)) >> 16); }
    }
  }
}
}
constexpr int NWAVES = 8;
constexpr int RING_OFF = 0, RING_BYTES = 131072;
constexpr int LDSCTL_OFF = RING_BYTES, MISC_OFF = LDSCTL_OFF + 320;
constexpr int LDS_BYTES = 147456;
constexpr int RSTD_OFF = LDSCTL_OFF + 8192;
constexpr int CW_BAR = 4096;
constexpr int CW_KMAX = 8448;
constexpr int CW_CNT = 8192;
constexpr int CW_BLKCNT = 10240;
constexpr int CW_SPLT = 9216;
constexpr size_t CTL_ZERO_BYTES = 64 * 1024;
constexpr int PH_PRO = 0, PH_L0 = 1, PH_PER_LAYER = 12, PH_FINAL = PH_L0 + DEPTH * PH_PER_LAYER, PH_END = PH_FINAL + 1;
enum { P_NORM1 = 0, P_INPROJ, P_XLOC, P_SCAN, P_MIX, P_GLU, P_BRANCH, P_OUT, P_NORM2, P_ASSIGN, P_UP, P_DOWN };

struct Args {
    const float* in[25]; float* out; unsigned char* ws;
    double inv_freq[32];
    int ph_lo, ph_hi, sub, pad;
};

typedef const __attribute__((address_space(4))) Args* ArgsP;
__device__ __forceinline__ ArgsP get_args() { ArgsP p = (ArgsP)__builtin_amdgcn_kernarg_segment_ptr(); asm volatile("" : "+s"(p)); return p; }
#define LDS_WAIT() asm volatile("s_waitcnt lgkmcnt(0)" ::: "memory")
#define VM_WAIT() asm volatile("s_waitcnt vmcnt(0)" ::: "memory")
typedef unsigned v4u __attribute__((ext_vector_type(4)));
__device__ __forceinline__ unsigned pk2(float lo, float hi) { return (unsigned)f2bf(lo) | ((unsigned)f2bf(hi) << 16); }

template <class RowMap>
__device__ __forceinline__ void transpose_item(const float* __restrict__ W, int N, bf16* __restrict__ WT, int ldt, int koff, LAS float* scr, int item, int lane, const RowMap& rm, const float* __restrict__ gk = nullptr) {
    const int nblk = N / 32, kb = item / nblk, nb = item % nblk, k0 = 64 * kb, n0 = 32 * nb;
    float wv[32];
    const float* wp = W + (size_t)(k0 + (lane >> 5)) * N + n0 + (lane & 31);
#pragma unroll
    for (int i = 0; i < 32; ++i) wv[i] = wp[(size_t)(2 * i) * N];
#pragma unroll
    for (int i = 0; i < 32; ++i) scr[(2 * i + (lane >> 5)) * 33 + (lane & 31)] = wv[i];
    LDS_WAIT(); asm volatile("" ::: "memory");
    const int c = lane & 7;
    f32x4 g0 = {1.f, 1.f, 1.f, 1.f}, g1 = g0;
    if (gk) { g0 = *(const f32x4*)(gk + k0 + 8 * c); g1 = *(const f32x4*)(gk + k0 + 8 * c + 4); }
#pragma unroll
    for (int j = 0; j < 4; ++j) { const int n = (lane >> 3) + 8 * j; const LAS float* s = scr + (8 * c) * 33 + n;
        v4u o; o.x = pk2(s[0 * 33] * g0.x, s[1 * 33] * g0.y); o.y = pk2(s[2 * 33] * g0.z, s[3 * 33] * g0.w); o.z = pk2(s[4 * 33] * g1.x, s[5 * 33] * g1.y); o.w = pk2(s[6 * 33] * g1.z, s[7 * 33] * g1.w);
        *(v4u*)(WT + (size_t)rm(n0 + n) * ldt + koff + k0 + 8 * c) = o; }
    LDS_WAIT(); asm volatile("" ::: "memory");
}
struct RmId { __device__ __forceinline__ int operator()(int n) const { return n; } };
struct RmInProj { __device__ __forceinline__ int operator()(int n) const { return n < 1024 ? (n & ~63) + qk_pos(n & 63) : n; } };
struct RmGlu13 { int half; __device__ __forceinline__ int operator()(int n) const { return (n >> 7) * 256 + half * 128 + (n & 127); } };
struct TItem { const float* src; bf16* dst; int N, ldt, koff, map, k0, n0; };
__device__ __forceinline__ void t_setkn(TItem& t, int item) { const int nblk = t.N / 32; t.k0 = 64 * (item / nblk); t.n0 = 32 * (item % nblk); }
__device__ __forceinline__ void t_load(const TItem& t, int lane, float (&wv)[32]) {
    const float* wp = t.src + (size_t)(t.k0 + (lane >> 5)) * t.N + t.n0 + (lane & 31);
#pragma unroll
    for (int i = 0; i < 32; ++i) wv[i] = wp[(size_t)(2 * i) * t.N];
}
__device__ __forceinline__ void t_store(const TItem& t, int lane, const float (&wv)[32], LAS float* scr) {
#pragma unroll
    for (int i = 0; i < 32; ++i) scr[(2 * i + (lane >> 5)) * 33 + (lane & 31)] = wv[i];
    LDS_WAIT(); asm volatile("" ::: "memory");
    const int c = lane & 7;
#pragma unroll
    for (int j = 0; j < 4; ++j) { const int n = (lane >> 3) + 8 * j; const LAS float* q = scr + (8 * c) * 33 + n; const int nn = t.n0 + n;
        const int row = t.map == 0 ? nn : (t.map == 1 ? (nn < 1024 ? (nn & ~63) + qk_pos(nn & 63) : nn) : (nn >> 7) * 256 + (t.map - 2) * 128 + (nn & 127));
        v4u o; o.x = pk2(q[0 * 33], q[1 * 33]); o.y = pk2(q[2 * 33], q[3 * 33]); o.z = pk2(q[4 * 33], q[5 * 33]); o.w = pk2(q[6 * 33], q[7 * 33]);
        *(v4u*)(t.dst + (size_t)row * t.ldt + t.koff + t.k0 + 8 * c) = o; }
    LDS_WAIT(); asm volatile("" ::: "memory");
}
#define T_SWEEP(first, step, total, DEC) do { int it_ = (first); if (it_ < (total)) { TItem ta_, tb_; float va_[32], vb_[32]; DEC(it_, ta_); t_load(ta_, lane, va_); \
    for (;;) { const int i2_ = it_ + (step); const bool h2_ = i2_ < (total); if (h2_) { DEC(i2_, tb_); t_load(tb_, lane, vb_); } t_store(ta_, lane, va_, scr); if (!h2_) break; \
               it_ = i2_ + (step); const bool h3_ = it_ < (total); if (h3_) { DEC(it_, ta_); t_load(ta_, lane, va_); } t_store(tb_, lane, vb_, scr); if (!h3_) break; } } } while (0)

constexpr size_t WO_IN = 0, WO_GLU = WO_IN + 32 * MiB, WO_BR = WO_GLU + 2 * MiB, WO_OUT = WO_BR + 8 * MiB, WO_F13 = WO_OUT + 8 * MiB, WO_F2 = WO_F13 + 22 * MiB,
                 WO_M13 = WO_F2 + 11 * MiB, WO_M2 = WO_M13 + 88 * MiB, WO_BY = WO_M2 + 44 * MiB, WO_BX = WO_BY + 32 * MiB, WO_ROT = WO_BX + 16 * MiB, WO_END = WO_ROT + 2 * MiB;
static_assert(WS_WEIGHTS + WO_END <= WS_XN, "weights region");

__device__ __forceinline__ int ltid() { int t = threadIdx.x; asm volatile("" : "+v"(t)); return t; }
#define PHASE_IDS const int tid = ltid(), lane = tid & 63, wave = __builtin_amdgcn_readfirstlane(tid >> 6); (void)lane; (void)wave
struct Frame {
    LAS unsigned char* lds; int vcu, G, bx;
};
__device__ __forceinline__ Frame make_frame(LAS unsigned char* lds) {
    Frame F; F.lds = lds; int G = gridDim.x, bx = blockIdx.x; asm volatile("" : "+s"(G), "+s"(bx));
    F.G = G; F.bx = bx; F.vcu = (G % 8 == 0) ? (bx % 8) * (G / 8) + bx / 8 : bx; return F;
}
__device__ __forceinline__ float shx(float v, int o, int lane) { return __int_as_float(__builtin_amdgcn_ds_bpermute((lane ^ o) << 2, __float_as_int(v))); }
#define WS_DPP(v, ctrl) ((v) + __int_as_float(__builtin_amdgcn_mov_dpp(__float_as_int(v), (ctrl), 0xf, 0xf, true)))
__device__ __forceinline__ float wave_sum_l(float v, int lane) {
    (void)lane;
    v = WS_DPP(v, 0xB1);
    v = WS_DPP(v, 0x4E);
    v = WS_DPP(v, 0x141);
    v = WS_DPP(v, 0x140);
    { auto r = __builtin_amdgcn_permlane16_swap(__float_as_uint(v), __float_as_uint(v), false, false); v = __uint_as_float(r[0]) + __uint_as_float(r[1]); }
    { auto r = __builtin_amdgcn_permlane32_swap(__float_as_uint(v), __float_as_uint(v), false, false); v = __uint_as_float(r[0]) + __uint_as_float(r[1]); }
    return v;
}

__device__ __forceinline__ void ssm_gen_item(const Frame& F, ArgsP A, int item) {
    unsigned char* ws = A->ws;
    PHASE_IDS; const int layer = item >> 5, g = item & 31;
    LAS float* L = (LAS float*)(F.lds);
    LAS float* apr = L;
    LAS float* api = apr + 2 * 17 * 64;
    LAS float* bbr = api + 2 * 17 * 64;
    LAS float* bbi = bbr + 2 * 64 * 16;
    LAS float* cr = bbi + 2 * 64 * 16;
    LAS float* ci = cr + 2 * 16 * 64;
    LAS float* Kt = ci + 2 * 16 * 64;
    LAS float* ff = Kt + 2 * 16 * 256;
    LAS float* apj = ff + 2 * 64 * 2;
    const float* lam_re = A->in[5] + (size_t)layer * 2 * SSM_G * SSM_P; const float* lam_im = A->in[6] + (size_t)layer * 2 * SSM_G * SSM_P; const float* log_dt = A->in[7] + layer * 2 * SSM_G;
    const float* b_re = A->in[8] + (size_t)layer * 2 * SSM_G * SSM_P * 16; const float* b_im = A->in[9] + (size_t)layer * 2 * SSM_G * SSM_P * 16;
    const float* c_re = A->in[10] + (size_t)layer * 2 * SSM_G * 16 * SSM_P; const float* c_im = A->in[11] + (size_t)layer * 2 * SSM_G * 16 * SSM_P;
    const float* dsk = A->in[12] + layer * SSM_W + g * 16;
    {
        const int d = (tid >> 6) & 1, p = tid & 63, jq = tid >> 7; const size_t pi = ((size_t)d * SSM_G + g) * SSM_P + p;
        const float lr = lam_re[pi], li = lam_im[pi], dt = expf(log_dt[d * SSM_G + g]);
        for (int j = jq; j <= 16; j += 4) { const float er = expf((float)j * lr * dt); float sn, cs; sincosf((float)j * li * dt, &sn, &cs); const float ar_ = er * cs, ai_ = er * sn;
            apr[(d * 17 + j) * 64 + p] = ar_; api[(d * 17 + j) * 64 + p] = ai_;
            if (j < 16) { apj[((d * 64 + p) * 16 + j) * 2] = ar_; apj[((d * 64 + p) * 16 + j) * 2 + 1] = ai_; }
            if (j == 1) { const float nr = ar_ - 1.f, ni = ai_, den = lr * lr + li * li;
                ff[(d * 64 + p) * 2] = (nr * lr + ni * li) / den; ff[(d * 64 + p) * 2 + 1] = (ni * lr - nr * li) / den; } }
    }
    __syncthreads();
    for (int e = tid; e < 2048; e += 512) {
        const int d = e >> 10, p = (e >> 4) & 63, hh = e & 15; const size_t bi_ = (((size_t)d * SSM_G + g) * SSM_P + p) * 16 + hh;
        const float br = b_re[bi_], bi = b_im[bi_], fr = ff[(d * 64 + p) * 2], fi = ff[(d * 64 + p) * 2 + 1];
        bbr[e] = fr * br - fi * bi; bbi[e] = fr * bi + fi * br;
        const int h2 = (e >> 6) & 15, p2 = e & 63; const size_t ci_ = (((size_t)d * SSM_G + g) * 16 + h2) * SSM_P + p2;
        cr[e] = c_re[ci_]; ci[e] = c_im[ci_];
    }
    __syncthreads();
    {
        const int d = tid >> 8, h = (tid >> 4) & 15, h2 = tid & 15;
        float sj[16];
#pragma unroll
        for (int j = 0; j < 16; ++j) sj[j] = 0.f;
        for (int p = 0; p < 64; ++p) {
            const float c_r = cr[(d * 16 + h) * 64 + p], c_i = ci[(d * 16 + h) * 64 + p], b_r = bbr[(d * 64 + p) * 16 + h2], b_i = bbi[(d * 64 + p) * 16 + h2];
            const float t_r = c_r * b_r - c_i * b_i, t_i = c_r * b_i + c_i * b_r;
            const LAS f32x4* ap = (const LAS f32x4*)(apj + (d * 64 + p) * 32);
#pragma unroll
            for (int q = 0; q < 8; ++q) { const f32x4 a = ap[q]; sj[2 * q] += t_r * a.x - t_i * a.y; sj[2 * q + 1] += t_r * a.z - t_i * a.w; }
        }
#pragma unroll
        for (int j = 0; j < 16; ++j) Kt[(d * 16 + j) * 256 + h * 16 + h2] = sj[j];
    }
    __syncthreads();
    bf16* BY = (bf16*)(ws + WS_WEIGHTS + WO_BY) + ((size_t)layer * 32 + g) * 256 * 512;
    bf16* BX = (bf16*)(ws + WS_WEIGHTS + WO_BX) + ((size_t)layer * 32 + g) * 256 * 256;
    for (int e8 = tid; e8 < 256 * 64; e8 += 512) {
        const int n = e8 >> 6, k0 = (e8 & 63) * 8, i = n >> 4, h = n & 15; float v[8];
        if (k0 < 256) { const int i2 = k0 >> 4, h20 = k0 & 15;
#pragma unroll
            for (int q = 0; q < 8; ++q) { const int h2 = h20 + q; float t = 0.f;
                if (i >= i2) t += Kt[(0 * 16 + (i - i2)) * 256 + h * 16 + h2];
                if (i2 >= i) t += Kt[(1 * 16 + (i2 - i)) * 256 + h * 16 + h2];
                if (i == i2 && h == h2) t += dsk[h];
                v[q] = t; }
        } else { const int kk = k0 - 256, d = kk >> 7, im = (kk >> 6) & 1, p0 = kk & 63, j = d == 0 ? i + 1 : 16 - i;
#pragma unroll
            for (int q = 0; q < 8; ++q) { const int p = p0 + q; const float c_r = cr[(d * 16 + h) * 64 + p], c_i = ci[(d * 16 + h) * 64 + p], a_r = apr[(d * 17 + j) * 64 + p], a_i = api[(d * 17 + j) * 64 + p];
                v[q] = im ? -(c_r * a_i + c_i * a_r) : (c_r * a_r - c_i * a_i); } }
        v4u o; o.x = pk2(v[0], v[1]); o.y = pk2(v[2], v[3]); o.z = pk2(v[4], v[5]); o.w = pk2(v[6], v[7]);
        *(v4u*)(BY + (size_t)n * 512 + k0) = o;
    }
    for (int e8 = tid; e8 < 256 * 32; e8 += 512) {
        const int n = e8 >> 5, k0 = (e8 & 31) * 8, d = n >> 7, im = (n >> 6) & 1, p = n & 63, i2 = k0 >> 4, h20 = k0 & 15, j = d == 0 ? 15 - i2 : i2;
        const float a_r = apr[(d * 17 + j) * 64 + p], a_i = api[(d * 17 + j) * 64 + p]; float v[8];
#pragma unroll
        for (int q = 0; q < 8; ++q) { const float b_r = bbr[(d * 64 + p) * 16 + h20 + q], b_i = bbi[(d * 64 + p) * 16 + h20 + q]; v[q] = im ? (a_r * b_i + a_i * b_r) : (a_r * b_r - a_i * b_i); }
        v4u o; o.x = pk2(v[0], v[1]); o.y = pk2(v[2], v[3]); o.z = pk2(v[4], v[5]); o.w = pk2(v[6], v[7]);
        *(v4u*)(BX + (size_t)n * 256 + k0) = o;
    }
    __syncthreads();
}

__device__ __forceinline__ void prologue_phase(const Frame& F, ArgsP A) {
    unsigned char* ws = A->ws;
    PHASE_IDS;
    __syncthreads();
    for (int it = F.bx; it < DEPTH * SSM_G; it += F.G) ssm_gen_item(F, A, it);
    { float* COS = (float*)(ws + WS_WEIGHTS + WO_ROT); float* SIN = COS + SEQ * 32;
      for (int e = F.bx * 512 + tid; e < SEQ * 32; e += F.G * 512) { const int s = e >> 5, j = e & 31;
          double r = (double)s * A->inv_freq[j] * 0.15915494309189533577; r -= floor(r); const float th = (float)(r * 6.283185307179586477);
          float sn, cs; sincosf(th, &sn, &cs); COS[e] = cs; SIN[e] = sn; } }
    LAS float* scr = (LAS float*)(F.lds + wave * 16384);
    const int gw = F.vcu * NWAVES + wave, NGW = F.G * NWAVES;
    unsigned char* wb = ws + WS_WEIGHTS;
    constexpr int I_IN = 16 * 128, I_GLU = 8 * 16, I_BR = 8 * 32, I_OUT = 16 * 32, I_LAYER = I_IN + I_GLU + 2 * I_BR + I_OUT;
    constexpr int I_13 = 16 * 88, I_2 = 44 * 32, I_FFN = 2 * I_13 + I_2;
    constexpr int N_ITEMS = DEPTH * I_LAYER + 2 * I_FFN, POOL_A = (N_ITEMS * 99 / 100) & ~7;
    const bool split = F.G == 256; const int hw = (F.bx - 128) * NWAVES + wave;
    for (int k = 0;; ++k) {
        int it;
        if (!split) { it = gw + k * NGW; if (it >= N_ITEMS) break; }
        else if (F.bx >= 128) { const int a = hw + k * 128 * NWAVES; if (a < POOL_A) it = a; else { const int nA = (POOL_A - hw + 128 * NWAVES - 1) / (128 * NWAVES); it = POOL_A + gw + (k - nA) * NGW; if (it >= N_ITEMS) break; } }
        else { it = POOL_A + gw + k * NGW; if (it >= N_ITEMS) break; }
        int r = it;
        if (r < DEPTH * I_LAYER) {
            const int l = r / I_LAYER; r -= l * I_LAYER;
            if (r < I_IN) { transpose_item(A->in[2] + (size_t)l * 1024 * 4096, 4096, (bf16*)(wb + WO_IN) + (size_t)l * 4096 * 1024, 1024, 0, scr, r, lane, RmInProj{}, (l & 1) ? A->in[1] + l * D_MODEL : nullptr); continue; } r -= I_IN;
            if (r < I_GLU) { transpose_item(A->in[13] + (size_t)l * 512 * 512, 512, (bf16*)(wb + WO_GLU) + (size_t)l * 512 * 512, 512, 0, scr, r, lane, RmId{}); continue; } r -= I_GLU;
            if (r < 2 * I_BR) { const int br = r / I_BR; r -= br * I_BR;
                transpose_item(A->in[14] + ((size_t)l * 2 + br) * 512 * 1024, 1024, (bf16*)(wb + WO_BR) + (size_t)l * 1024 * 1024, 1024, br * 512, scr, r, lane, RmId{}); continue; } r -= 2 * I_BR;
            transpose_item(A->in[15] + (size_t)l * 1024 * 1024, 1024, (bf16*)(wb + WO_OUT) + (size_t)l * 1024 * 1024, 1024, 0, scr, r, lane, RmId{});
        } else {
            r -= DEPTH * I_LAYER; const int i = r / I_FFN; r -= i * I_FFN;
            bf16* F13 = (bf16*)(wb + WO_F13) + (size_t)i * 5632 * 1024; bf16* F2 = (bf16*)(wb + WO_F2) + (size_t)i * 1024 * 2816;
            if (r < I_13) { transpose_item(A->in[17] + (size_t)i * 1024 * 2816, 2816, F13, 1024, 0, scr, r, lane, RmGlu13{0}, A->in[16] + (2 * i) * D_MODEL); continue; } r -= I_13;
            if (r < I_13) { transpose_item(A->in[18] + (size_t)i * 1024 * 2816, 2816, F13, 1024, 0, scr, r, lane, RmGlu13{1}, A->in[16] + (2 * i) * D_MODEL); continue; } r -= I_13;
            transpose_item(A->in[19] + (size_t)i * 2816 * 1024, 1024, F2, 2816, 0, scr, r, lane, RmId{});
        }
    }
}
constexpr int MOE_EARLY = 4864;
__device__ __forceinline__ void moe_cvt(const Frame& F, ArgsP A, int i, int part) {
    unsigned char* ws = A->ws;
    PHASE_IDS;
    LAS float* scr = (LAS float*)(F.lds + 40960 + wave * 8704);
    const bool early = part < 2 && F.G == 256;
    if (part < 2 && !early) return;
    const int gw = early ? part * MOE_EARLY + (F.bx - 128) * NWAVES + wave : (F.G == 256 ? 2 * MOE_EARLY : 0) + F.vcu * NWAVES + wave, NGW = early ? 128 * NWAVES : F.G * NWAVES;
    const int itend = early ? (part + 1) * MOE_EARLY : 8 * (2 * 16 * 88 + 44 * 32);
    unsigned char* wb = ws + WS_WEIGHTS;
    constexpr int I_13 = 16 * 88, I_2 = 44 * 32, I_E = 2 * I_13 + I_2;
#define MOE_DEC(it, t) do { const int e_ = (it) / I_E; int r_ = (it) - e_ * I_E; const size_t wo_ = ((size_t)i * N_EXP + e_); \
        if (r_ < 2 * I_13) { const int h_ = r_ >= I_13; r_ -= h_ * I_13; (t).src = A->in[21 + h_] + wo_ * 1024 * 2816; (t).N = 2816; (t).dst = (bf16*)(wb + WO_M13) + (size_t)e_ * 5632 * 1024; (t).ldt = 1024; (t).koff = 0; (t).map = 2 + h_; } \
        else { r_ -= 2 * I_13; (t).src = A->in[23] + wo_ * 2816 * 1024; (t).N = 1024; (t).dst = (bf16*)(wb + WO_M2) + (size_t)e_ * 1024 * 2816; (t).ldt = 2816; (t).koff = 0; (t).map = 0; } \
        t_setkn((t), r_); } while (0)
    T_SWEEP(gw, NGW, itend, MOE_DEC);
#undef MOE_DEC
}

template <bool COMBINE, bool ROUTER, bool FINAL>
__device__ __forceinline__ void norm_phase(const Frame& F, const float* __restrict__ SRC, float* __restrict__ X, const float* __restrict__ gain, bf16* __restrict__ XN,
                                           const bf16* __restrict__ YS, const int* __restrict__ slot_prev, const float* __restrict__ gate_prev, const unsigned* __restrict__ SPLT, const float* __restrict__ PART,
                                           const float* __restrict__ wr, unsigned* __restrict__ cnt, int* __restrict__ asg_e, int* __restrict__ asg_pos, float* __restrict__ asg_g) {
    PHASE_IDS;
    LAS float* wrl = (LAS float*)F.lds;
    LAS int* rinfo = (LAS int*)(F.lds + 32768 + 64);
    LAS int* lcnt = (LAS int*)(F.lds + 32768 + 64 + 512);
    LAS float* rg = (LAS float*)(F.lds + 32768 + 64 + 1024);
    if (ROUTER) { for (int e = tid; e < 8192; e += 512) wrl[(e & 7) * 1024 + (e >> 3)] = wr[e]; __syncthreads(); }
    const int rpb = NTOK / F.G;
    f32x4 gg4[4], vn[4];
#pragma unroll
    for (int j = 0; j < 4; ++j) gg4[j] = ((const f32x4*)gain)[64 * j + lane];
    if (wave < rpb) { const f32x4* xr = (const f32x4*)(SRC + (size_t)(F.vcu * rpb + wave) * D_MODEL) + lane;
#pragma unroll
        for (int j = 0; j < 4; ++j) vn[j] = xr[64 * j]; }
    for (int rr = wave; rr < rpb; rr += NWAVES) {
        const int row = F.vcu * rpb + rr;
        f32x4 v[4]; float s = 0.f;
#pragma unroll
        for (int j = 0; j < 4; ++j) v[j] = vn[j];
        if (rr + NWAVES < rpb) { const f32x4* xr = (const f32x4*)(SRC + (size_t)(row + NWAVES) * D_MODEL) + lane;
#pragma unroll
            for (int j = 0; j < 4; ++j) vn[j] = xr[64 * j]; }
        if (COMBINE) {
            const int s0 = slot_prev[row * 2], s1 = slot_prev[row * 2 + 1]; const float g0 = gate_prev[row * 2], g1 = gate_prev[row * 2 + 1];
            const unsigned long long* y0 = (const unsigned long long*)(YS + (size_t)s0 * 1024) + lane; const unsigned long long* y1 = (const unsigned long long*)(YS + (size_t)s1 * 1024) + lane;
            const unsigned t0 = SPLT[s0 >> 8], t1 = SPLT[s1 >> 8];
            f32x4 ta[4] = {{0.f, 0.f, 0.f, 0.f}, {0.f, 0.f, 0.f, 0.f}, {0.f, 0.f, 0.f, 0.f}, {0.f, 0.f, 0.f, 0.f}}, tb[4] = {{0.f, 0.f, 0.f, 0.f}, {0.f, 0.f, 0.f, 0.f}, {0.f, 0.f, 0.f, 0.f}, {0.f, 0.f, 0.f, 0.f}};
            if (t0 != 0u) { const f32x4* pp = (const f32x4*)(PART + (size_t)(t0 - 1) * 24 * 65536 + (size_t)(s0 & 255) * 256) + lane;
#pragma unroll
                for (int j = 0; j < 4; ++j) { ta[j] = pp[(size_t)(j * 6) * 16384];
#pragma unroll
                    for (int ks = 1; ks < 6; ++ks) ta[j] += pp[(size_t)(j * 6 + ks) * 16384]; } }
            if (t1 != 0u) { const f32x4* pp = (const f32x4*)(PART + (size_t)(t1 - 1) * 24 * 65536 + (size_t)(s1 & 255) * 256) + lane;
#pragma unroll
                for (int j = 0; j < 4; ++j) { tb[j] = pp[(size_t)(j * 6) * 16384];
#pragma unroll
                    for (int ks = 1; ks < 6; ++ks) tb[j] += pp[(size_t)(j * 6 + ks) * 16384]; } }
#pragma unroll
            for (int j = 0; j < 4; ++j) { const unsigned long long a = y0[64 * j], b = y1[64 * j];
                f32x4 ya = {__uint_as_float((unsigned)(a << 16)), __uint_as_float((unsigned)a & 0xffff0000u), __uint_as_float((unsigned)(a >> 32) << 16), __uint_as_float((unsigned)(a >> 32) & 0xffff0000u)};
                f32x4 yb = {__uint_as_float((unsigned)(b << 16)), __uint_as_float((unsigned)b & 0xffff0000u), __uint_as_float((unsigned)(b >> 32) << 16), __uint_as_float((unsigned)(b >> 32) & 0xffff0000u)};
                if (t0 != 0u) ya = ta[j];
                if (t1 != 0u) yb = tb[j];
                v[j] += g0 * ya + g1 * yb;
                if (!FINAL) ((f32x4*)(X + (size_t)row * D_MODEL) + lane)[64 * j] = v[j]; }
        }
#pragma unroll
        for (int j = 0; j < 4; ++j) s += (v[j].x * v[j].x + v[j].y * v[j].y) + (v[j].z * v[j].z + v[j].w * v[j].w);
        const float rstd = rsqrtf(wave_sum_l(s, lane) * (1.f / D_MODEL) + RMS_EPS);
        float lg[8];
#pragma unroll
        for (int e = 0; e < 8; ++e) lg[e] = 0.f;
#pragma unroll
        for (int j = 0; j < 4; ++j) {
            const f32x4 gg = gg4[j];
            v[j].x *= rstd * gg.x; v[j].y *= rstd * gg.y; v[j].z *= rstd * gg.z; v[j].w *= rstd * gg.w;
            if (FINAL) ((f32x4*)(X + (size_t)row * D_MODEL) + lane)[64 * j] = v[j];
            else ((unsigned long long*)(XN + (size_t)row * D_MODEL))[64 * j + lane] = (unsigned long long)pk2(v[j].x, v[j].y) | ((unsigned long long)pk2(v[j].z, v[j].w) << 32);
            if (ROUTER) {
#pragma unroll
                for (int e = 0; e < 8; ++e) { const f32x4 w = *(const LAS f32x4*)(wrl + e * 1024 + (64 * j + lane) * 4); lg[e] += (v[j].x * w.x + v[j].y * w.y) + (v[j].z * w.z + v[j].w * w.w); } }
        }
        if (ROUTER) {
#pragma unroll
            for (int e = 0; e < 8; ++e) lg[e] = wave_sum_l(lg[e], lane);
            int e0 = 0; float l0 = lg[0];
#pragma unroll
            for (int e = 1; e < 8; ++e) if (lg[e] > l0) { l0 = lg[e]; e0 = e; }
            int e1 = -1; float l1 = -3.4e38f;
#pragma unroll
            for (int e = 0; e < 8; ++e) if (e != e0 && lg[e] > l1) { l1 = lg[e]; e1 = e; }
            const float p1 = __expf(l1 - l0), inv = 1.f / (1.f + p1);
            if (lane == 0) { rinfo[rr * 2] = e0; rinfo[rr * 2 + 1] = e1; rg[rr * 2] = inv; rg[rr * 2 + 1] = p1 * inv; }
        }
    }
    if (ROUTER) {
        __syncthreads();
        const int nW = (rpb * 2) >> 6;
        int e_my = 0, lp = 0;
        if (wave < nW) { e_my = rinfo[wave * 64 + lane]; unsigned long long mine = 0ull;
#pragma unroll
            for (int q = 0; q < 8; ++q) { const unsigned long long m = __ballot(e_my == q); mine = (e_my == q) ? m : mine; if (lane == 0) lcnt[wave * 8 + q] = __popcll(m); }
            lp = (int)__builtin_amdgcn_mbcnt_hi((unsigned)(mine >> 32), __builtin_amdgcn_mbcnt_lo((unsigned)mine, 0u)); }
        __syncthreads();
        if (wave < nW) { for (int w2 = 0; w2 < wave; ++w2) lp += lcnt[w2 * 8 + e_my];
            const int a = wave * 64 + lane, row2 = F.vcu * rpb * 2 + a; asg_e[row2] = e_my; asg_pos[row2] = lp; asg_g[row2] = rg[a]; }
        if (tid >= 256 && tid < 264) { const int e = tid - 256; int c = 0; for (int w2 = 0; w2 < nW; ++w2) c += lcnt[w2 * 8 + e]; cnt[F.vcu * 8 + e] = (unsigned)c; }
    }
}

__device__ __forceinline__ void rstd_prep(const Frame& F, const float* __restrict__ PS, int pm) {
    PHASE_IDS;
    LAS float* rs = (LAS float*)(F.lds + RSTD_OFF);
    if (tid < 256) { const float* q = PS + pm * 256 + tid; float s = 0.f;
#pragma unroll
        for (int i = 0; i < 16; ++i) s += q[(size_t)i * NTOK];
        rs[tid] = rsqrtf(s * (1.f / D_MODEL) + RMS_EPS); }
    __syncthreads();
}
struct MoeLayout { int ps[8]; int pe[8]; int nblk; };
template <class P> __device__ __forceinline__ MoeLayout moe_layout(P cnt) {
    MoeLayout L; int acc = 0;
#pragma unroll
    for (int e = 0; e < 8; ++e) { const int c = (int)cnt[e]; L.ps[e] = acc; acc += (c + 255) & ~255; L.pe[e] = acc; }
    L.nblk = acc >> 8; return L;
}
__device__ __forceinline__ void assign_phase(const Frame& F, const unsigned* blkcnt, unsigned* cnt, const int* asg_e, const int* asg_pos, int* slot_of, const bf16* XN, bf16* XB, unsigned* splt) {
    PHASE_IDS;
    LAS int* lt = (LAS int*)F.lds;
    if (tid < 16) lt[tid] = 0;
    __syncthreads();
    int tot = 0, pre = 0;
    if (tid < 128) { const int e = tid & 7, h = tid >> 3;
#pragma unroll
        for (int k = 0; k < 16; ++k) { const int b = h * 16 + k; const int c = b < F.G ? (int)blkcnt[b * 8 + e] : 0; tot += c; pre += (b < F.vcu) ? c : 0; } }
    const int rpb = NTOK / F.G;
    if (rpb == 64) {
        int ee[16], pp[16]; v4u d0[16], d1[16];
#pragma unroll
        for (int k = 0; k < 16; ++k) { const int ga = F.vcu * 128 + wave + 8 * k; ee[k] = asg_e[ga]; pp[k] = asg_pos[ga];
            const v4u* src = (const v4u*)(XN + (size_t)(ga >> 1) * 1024) + lane; d0[k] = src[0]; d1[k] = src[64]; }
        if (tid < 128) { const int e = tid & 7; __hip_atomic_fetch_add(&lt[e], tot, __ATOMIC_RELAXED, __HIP_MEMORY_SCOPE_WORKGROUP); __hip_atomic_fetch_add(&lt[8 + e], pre, __ATOMIC_RELAXED, __HIP_MEMORY_SCOPE_WORKGROUP); }
        __syncthreads();
        const MoeLayout L = moe_layout(lt);
        if (F.bx == 0) {
            if (tid < 8) cnt[tid] = (unsigned)lt[tid];
            const int tile0 = ((L.nblk * 4) >> 8) * 64;
            if (tid < L.nblk - tile0) splt[tile0 + tid] = (unsigned)(tid + 1);
        }
#pragma unroll
        for (int k = 0; k < 16; ++k) { const int ga = F.vcu * 128 + wave + 8 * k, e = ee[k];
            int ps = L.ps[0], pr = lt[8];
#pragma unroll
            for (int q = 1; q < 8; ++q) { ps = (e == q) ? L.ps[q] : ps; pr = (e == q) ? lt[8 + q] : pr; }
            const int dest = ps + pr + pp[k];
            if (lane == 0) slot_of[ga] = dest;
            v4u* dst = (v4u*)(XB + (size_t)dest * 1024) + lane; dst[0] = d0[k]; dst[64] = d1[k]; }
        return;
    }
    if (tid < 128) { const int e = tid & 7; __hip_atomic_fetch_add(&lt[e], tot, __ATOMIC_RELAXED, __HIP_MEMORY_SCOPE_WORKGROUP); __hip_atomic_fetch_add(&lt[8 + e], pre, __ATOMIC_RELAXED, __HIP_MEMORY_SCOPE_WORKGROUP); }
    __syncthreads();
    if (F.bx == 0 && tid < 8) cnt[tid] = (unsigned)lt[tid];
    const MoeLayout L = moe_layout(lt);
    if (F.bx == 0) {
        const int tile0 = ((L.nblk * 4) >> 8) * 64;
        if (tid < L.nblk - tile0) splt[tile0 + tid] = (unsigned)(tid + 1);
    }
    for (int a = wave; a < rpb * 2; a += NWAVES) {
        const int ga = F.vcu * rpb * 2 + a, tok = ga >> 1, e = asg_e[ga];
        int ps = L.ps[0];
#pragma unroll
        for (int q = 1; q < 8; ++q) ps = (e == q) ? L.ps[q] : ps;
        int pr = lt[8];
#pragma unroll
        for (int q = 1; q < 8; ++q) pr = (e == q) ? lt[8 + q] : pr;
        const int dest = ps + pr + asg_pos[ga];
        if (lane == 0) slot_of[ga] = dest;
        const v4u* src = (const v4u*)(XN + (size_t)tok * 1024) + lane; v4u* dst = (v4u*)(XB + (size_t)dest * 1024) + lane;
        dst[0] = src[0]; dst[64] = src[64];
    }
}

__device__ __forceinline__ void scan_phase(const Frame& F, ArgsP A, int layer, const float* __restrict__ XLOC, bf16* __restrict__ AY) {
    PHASE_IDS;
    LAS float* S = (LAS float*)F.lds;
    for (int it = F.vcu; it < 256; it += F.G) {
        const int b = it >> 7, g = (it >> 2) & 31, d = (it >> 1) & 1, ph = it & 1, pp = tid & 31, seg = tid >> 5, p = ph * 32 + pp;
        const size_t pi = ((size_t)layer * 2 + d) * SSM_G * SSM_P + (size_t)g * SSM_P + p;
        const float lr = A->in[5][pi], li = A->in[6][pi], dt = expf(A->in[7][(layer * 2 + d) * SSM_G + g]);
        const float er = expf(16.f * lr * dt); float sn, cs; sincosf(16.f * li * dt, &sn, &cs);
        const float ar = er * cs, ai = er * sn;
        float Ar = ar, Ai = ai;
#pragma unroll
        for (int q = 0; q < 5; ++q) { const float t = Ar * Ar - Ai * Ai; Ai = 2.f * Ar * Ai; Ar = t; }
        const int c0 = d == 0 ? seg * 32 : 511 - seg * 32, cstep = d == 0 ? 1 : -1;
        const float* xl = XLOC + ((size_t)g * 1024 + b * 512 + c0) * 256 + d * 128 + p; const long xs = (long)cstep * 256;
        float sr = 0.f, si = 0.f;
        float xrv[32], xiv[32];
#pragma unroll
        for (int k = 0; k < 32; ++k) { xrv[k] = xl[k * xs]; xiv[k] = xl[k * xs + 64]; }
#pragma unroll
        for (int k = 0; k < 32; ++k) { const float t = ar * sr - ai * si + xrv[k]; si = ar * si + ai * sr + xiv[k]; sr = t; }
        S[(seg * 32 + pp) * 2] = sr; S[(seg * 32 + pp) * 2 + 1] = si;
        __syncthreads();
        float cr_ = 0.f, ci_ = 0.f;
        for (int s2 = 0; s2 < seg; ++s2) { const float t = Ar * cr_ - Ai * ci_ + S[(s2 * 32 + pp) * 2]; ci_ = Ar * ci_ + Ai * cr_ + S[(s2 * 32 + pp) * 2 + 1]; cr_ = t; }
        bf16* ay = AY + ((size_t)g * 1024 + b * 512 + c0) * 512 + 256 + d * 128 + p; const long ys = (long)cstep * 512;
#pragma unroll
        for (int k = 0; k < 32; ++k) { const float xr = xrv[k], xi = xiv[k];
            {
              const float pr = __int_as_float(__builtin_amdgcn_mov_dpp(__float_as_int(cr_), 0xB1, 0xf, 0xf, true)), pi = __int_as_float(__builtin_amdgcn_mov_dpp(__float_as_int(ci_), 0xB1, 0xf, 0xf, true));
              const bool odd = (pp & 1) != 0;
              *(unsigned*)(ay + k * ys + (odd ? 63 : 0)) = odd ? pk2(pi, ci_) : pk2(cr_, pr); }
            const float t = ar * cr_ - ai * ci_ + xr; ci_ = ar * ci_ + ai * cr_ + xi; cr_ = t; }
        __syncthreads();
    }
}

__device__ __forceinline__ void kmax_phase(const Frame& F, const bf16* __restrict__ Kb, unsigned* __restrict__ KMAX) {
    PHASE_IDS;
    const int nw = F.G > 128 ? F.G - 128 : F.G, w0 = F.G > 128 ? F.bx - 128 : F.bx;
    if (w0 < 0) return;
    for (int it = w0; it < 128; it += nw) {
        const int slab = it >> 3; const bf16* base = Kb + ((size_t)slab * 8192 + (size_t)(it & 7) * 1024 + wave * 128) * 64;
        float mx = 0.f;
#pragma unroll 4
        for (int i = 0; i < 16; ++i) { const v4u v = *(const v4u*)(base + (size_t)(i * 8 + (lane >> 3)) * 64 + (lane & 7) * 8); float q = 0.f;
            const unsigned w[4] = {v.x, v.y, v.z, v.w};
#pragma unroll
            for (int e = 0; e < 4; ++e) { const float a = __uint_as_float(w[e] << 16), b2 = __uint_as_float(w[e] & 0xffff0000u); q = fmaf(a, a, q); q = fmaf(b2, b2, q); }
            q += shx(q, 1, lane); q += shx(q, 2, lane); q += shx(q, 4, lane); mx = fmaxf(mx, q); }
#pragma unroll
        for (int o = 8; o < 64; o <<= 1) mx = fmaxf(mx, shx(mx, o, lane));
        if (lane == 0) __hip_atomic_fetch_max(KMAX + slab, __float_as_uint(mx), __ATOMIC_RELAXED, __HIP_MEMORY_SCOPE_AGENT);
    }
}
#ifndef PHASE_MASK
#define PHASE_MASK 0xffffffu
#endif
#define PMB(b) ((PHASE_MASK >> (b)) & 1u)
#ifndef REP_MASK
#define REP_MASK 0u
#endif
#ifndef REP_N
#define REP_N 1
#endif
#define RPT(b, cond) for (int rep_ = 0; rep_ < 1 + (((REP_MASK >> (b)) & 1u) && (cond) ? REP_N : 0); ++rep_)
#define SITE ArgsP ap = get_args(); unsigned char* ws = ap->ws; unsigned char* wb = ws + WS_WEIGHTS; (void)wb; const Frame F = make_frame((LAS unsigned char*)lds); (void)F
__device__ __forceinline__ bool in_range(int k) { ArgsP a = get_args(); const int lo = a->ph_lo, hi = a->ph_hi; return lo <= k && k < hi; }
__global__ void __launch_bounds__(NWAVES * 64, 2) mk_fwd(Args args_unused) {
    extern __shared__ __attribute__((aligned(16))) unsigned char lds[];
    volatile LAS unsigned* MISC = (volatile LAS unsigned*)((LAS unsigned char*)lds + MISC_OFF);
    for (int u = threadIdx.x; u < (LDS_BYTES - LDSCTL_OFF) / 4; u += NWAVES * 64) ((LAS unsigned*)((LAS unsigned char*)lds + LDSCTL_OFF))[u] = 0u;
    __syncthreads();
    { SITE; if ((ap->ph_hi - ap->ph_lo) > 1) (void)xcd_barrier_post((unsigned*)(ws + WS_CTL) + CW_BAR, MISC + 8); }
#define IN(k) in_range((k))
#define SUB() (get_args()->sub)
#define SEAM(k) do { if (IN(k) && IN((k) + 1)) { ArgsP ap_ = get_args(); XcdBarrier b_; b_.bar = (unsigned*)(ap_->ws + WS_CTL) + CW_BAR; b_.x = xb_xcc_id(); \
        b_.st = (volatile LAS unsigned*)((LAS unsigned char*)lds + MISC_OFF) + 8; xcd_barrier(b_); } } while (0)

    RPT(0, true) if (PMB(0) && IN(PH_PRO)) { SITE; prologue_phase(F, ap); }
    SEAM(PH_PRO);

    for (int l = 0; l < DEPTH; ++l) {
        const int pb = PH_L0 + l * PH_PER_LAYER, moe = l & 1, i = l >> 1;
        const bool fold1 = (l & 1) != 0;
        RPT(1, l != 2) if (!fold1 && PMB(1) && IN(pb + P_NORM1)) {
            SITE; float* X = ap->out; bf16* XN = (bf16*)(ws + WS_XN);
            const float* gain = ap->in[1] + l * D_MODEL;
            if (l == 0) norm_phase<false, false, false>(F, ap->in[0], X, gain, XN, nullptr, nullptr, nullptr, nullptr, nullptr, nullptr, nullptr, nullptr, nullptr, nullptr);
            else if (l == 2 && ((SUB() & 4) != 0)) { const int* sp = (const int*)(ws + WS_ROUTE) + 3 * 32768; const float* gp = (const float*)(ws + WS_ROUTE) + 2 * 32768;
                norm_phase<true, false, false>(F, X, X, gain, XN, (const bf16*)(ws + WS_R2), sp, gp, (const unsigned*)(ws + WS_CTL) + CW_SPLT, (const float*)(ws + WS_PART), nullptr, nullptr, nullptr, nullptr, nullptr); }
            else norm_phase<false, false, false>(F, X, X, gain, XN, nullptr, nullptr, nullptr, nullptr, nullptr, nullptr, nullptr, nullptr, nullptr, nullptr);
        }
        if (!fold1) SEAM(pb + P_NORM1);
        RPT(2, true) if (PMB(2) && IN(pb + P_INPROJ)) {
            SITE;
            pg8::Gemm g{(const bf16*)(ws + WS_XN), (const bf16*)(wb + WO_IN) + (size_t)l * 4096 * 1024}; pg8::StaticOrderT<64, 16> S{F.bx};
            const float* COS = (const float*)(wb + WO_ROT);
            if (fold1) { pg8::Unit u0; S.next(0, u0); rstd_prep(F, (const float*)(ws + WS_PS), u0.pm);
                pg8::EpiInProjT<true> E{(bf16*)(ws + WS_Q), (bf16*)(ws + WS_K), (bf16*)(ws + WS_V), (bf16*)(ws + WS_AY), (bf16*)(ws + WS_G), COS, COS + SEQ * 32, (const LAS float*)(F.lds + RSTD_OFF)};
                pg8::gemm_phase<pg8::EpiInProjT<true>, pg8::StaticOrderT<64, 16>, 1024, 1024, 1024>(F.lds + RING_OFF, g, S, E); }
            else { pg8::EpiInProj E{(bf16*)(ws + WS_Q), (bf16*)(ws + WS_K), (bf16*)(ws + WS_V), (bf16*)(ws + WS_AY), (bf16*)(ws + WS_G), COS, COS + SEQ * 32, nullptr};
                pg8::gemm_phase<pg8::EpiInProj, pg8::StaticOrderT<64, 16>, 1024, 1024, 1024>(F.lds + RING_OFF, g, S, E); }
        }
        SEAM(pb + P_INPROJ);
        RPT(3, true) if (PMB(3) && IN(pb + P_XLOC)) {
            SITE;
            pg8::Gemm g{(const bf16*)(ws + WS_AY), (const bf16*)(wb + WO_BX) + (size_t)l * 32 * 256 * 256}; pg8::SsmOrder S{F.G, F.bx};
            pg8::EpiXloc E{(float*)(ws + WS_XLOC)};
            pg8::gemm_phase<pg8::EpiXloc, pg8::SsmOrder, 512, 256, 256>(F.lds + RING_OFF, g, S, E);
            kmax_phase(F, (const bf16*)(ws + WS_K), (unsigned*)(ws + WS_CTL) + CW_KMAX + 16 * l);
        }
        SEAM(pb + P_XLOC);
        RPT(4, true) if (PMB(4) && IN(pb + P_SCAN)) { SITE; scan_phase(F, ap, l, (const float*)(ws + WS_XLOC), (bf16*)(ws + WS_AY)); }
        SEAM(pb + P_SCAN);
        if (IN(pb + P_MIX)) {
            RPT(5, true) if (PMB(5) && (SUB() & 1)) {
                SITE;
                pg8::Gemm g{(const bf16*)(ws + WS_AY), (const bf16*)(wb + WO_BY) + (size_t)l * 32 * 256 * 512}; pg8::SsmOrder S{F.G, F.bx};
                pg8::EpiY E{(bf16*)(ws + WS_SACT)};
                pg8::gemm_phase<pg8::EpiY, pg8::SsmOrder, 512, 512, 512>(F.lds + RING_OFF, g, S, E);
            }
            if ((SUB() & 8) && (SUB() & 2)) { SITE; if (F.bx >= 128) moe_cvt(F, ap, i, l & 1); }
            RPT(6, true) if (PMB(6) && (SUB() & 2)) {
                SITE;
                const float* lp = ap->in[3] + l * 4 * HD; float d01 = 0.f, d23 = 0.f;
                for (int q = 0; q < HD; ++q) { d01 += lp[q] * lp[HD + q]; d23 += lp[2 * HD + q] * lp[3 * HD + q]; }
                const float lam_init = 0.8f - 0.6f * __expf(-0.3f * (float)l), lam = __expf(d01) - __expf(d23) + lam_init;
                const bf16* Q = (const bf16*)(ws + WS_Q); const bf16* Kb = (const bf16*)(ws + WS_K); const bf16* V = (const bf16*)(ws + WS_V);
                float* O1 = (float*)(ws + WS_MERGED);
                bf16* AS2 = (bf16*)(ws + WS_AS2);
                for (int u = F.vcu; u < 256; u += F.G) {
                    const int bh = u >> 5, qb = u & 31, b = bh >> 2, h = bh & 3;
                    att::diff_attn_unit(Q + (size_t)bh * 2 * SEQ * 64, Kb + (size_t)bh * 2 * SEQ * 64, V + (size_t)bh * SEQ * 128, qb * 256,
                                        (const unsigned*)(ws + WS_CTL) + CW_KMAX + 16 * l + bh * 2, O1 + (size_t)u * 65536, AS2 + ((size_t)b * SEQ + qb * 256) * 1024 + h * 128, ap->in[4] + l * VD, lam, 1.f - lam_init, (char*)lds + RING_OFF);
                    __syncthreads();
                }
            }
        }
        SEAM(pb + P_MIX);
        RPT(7, true) if (PMB(7) && IN(pb + P_GLU)) {
            SITE;
            pg8::Gemm g{(const bf16*)(ws + WS_SACT), (const bf16*)(wb + WO_GLU) + (size_t)l * 512 * 512}; pg8::StaticOrderT<64, 2> S{F.bx};
            pg8::EpiGlu E{(const bf16*)(ws + WS_SACT), (bf16*)(ws + WS_AS2)};
            pg8::gemm_phase<pg8::EpiGlu, pg8::StaticOrderT<64, 2>, 512, 512, 512>(F.lds + RING_OFF, g, S, E);
        }
        SEAM(pb + P_GLU);
        RPT(8, true) if (PMB(8) && IN(pb + P_BRANCH)) {
            SITE;
            pg8::Gemm g{(const bf16*)(ws + WS_AS2), (const bf16*)(wb + WO_BR) + (size_t)l * 1024 * 1024}; pg8::StaticOrderT<64, 4> S{F.bx};
            pg8::EpiBranch E{(const bf16*)(ws + WS_G), (bf16*)(ws + WS_MERGED)};
            pg8::gemm_phase<pg8::EpiBranch, pg8::StaticOrderT<64, 4>, 1024, 1024, 1024>(F.lds + RING_OFF, g, S, E);
        }
        SEAM(pb + P_BRANCH);
        RPT(9, l == 0) if (PMB(9) && IN(pb + P_OUT)) {
            SITE; float* X = ap->out;
            pg8::Gemm g{(const bf16*)(ws + WS_MERGED), (const bf16*)(wb + WO_OUT) + (size_t)l * 1024 * 1024}; pg8::StaticOrderT<64, 4> S{F.bx};
            if (!moe) { pg8::EpiResN E{l == 0 ? ap->in[0] : X, X, (bf16*)(ws + WS_XN), (float*)(ws + WS_PS)};
                pg8::gemm_phase<pg8::EpiResN, pg8::StaticOrderT<64, 4>, 1024, 1024, 1024>(F.lds + RING_OFF, g, S, E); }
            else { pg8::EpiRes E{X, X};
                pg8::gemm_phase<pg8::EpiRes, pg8::StaticOrderT<64, 4>, 1024, 1024, 1024>(F.lds + RING_OFF, g, S, E); }
        }
        SEAM(pb + P_OUT);
        RPT(10, false) if (moe && PMB(10) && IN(pb + P_NORM2)) {
            SITE; float* X = ap->out; bf16* XN = (bf16*)(ws + WS_XN);
            const float* gain = ap->in[16] + l * D_MODEL;
            if (moe) { int* asg_e = (int*)(ws + WS_ROUTE + (size_t)i * 512 * 1024); int* asg_pos = asg_e + 32768; float* asg_g = (float*)(asg_pos + 32768);
                       norm_phase<false, true, false>(F, X, X, gain, XN, nullptr, nullptr, nullptr, nullptr, nullptr, ap->in[20] + (size_t)i * D_MODEL * N_EXP, (unsigned*)(ws + WS_CTL) + CW_BLKCNT + 2048 * i, asg_e, asg_pos, asg_g);
                       RPT(17, true) { if (SUB() & 8) moe_cvt(F, ap, i, 2); } }
            else norm_phase<false, false, false>(F, X, X, gain, XN, nullptr, nullptr, nullptr, nullptr, nullptr, nullptr, nullptr, nullptr, nullptr, nullptr);
        }
        if (moe) SEAM(pb + P_NORM2);
        if (!moe) {
            RPT(11, true) if (PMB(11) && IN(pb + P_UP)) {
                SITE;
                pg8::Gemm g{(const bf16*)(ws + WS_XN), (const bf16*)(wb + WO_F13) + (size_t)i * 5632 * 1024}; pg8::StaticOrderT<64, 22> S{F.bx};
                { pg8::Unit u0; S.next(0, u0); rstd_prep(F, (const float*)(ws + WS_PS), u0.pm); }
                pg8::EpiSwigluT<true> E{(bf16*)(ws + WS_H), 22, (const LAS float*)(F.lds + RSTD_OFF)};
                pg8::gemm_phase<pg8::EpiSwigluT<true>, pg8::StaticOrderT<64, 22>, 1024, 1024, 1024>(F.lds + RING_OFF, g, S, E);
            }
            SEAM(pb + P_UP);
            if (PMB(12) && IN(pb + P_DOWN)) {
                SITE; float* X = ap->out;
                pg8::Gemm g{(const bf16*)(ws + WS_H), (const bf16*)(wb + WO_F2) + (size_t)i * 1024 * 2816}; pg8::StaticOrderT<64, 4> S{F.bx};
                pg8::EpiResN E{X, X, (bf16*)(ws + WS_XN), (float*)(ws + WS_PS)};
                pg8::gemm_phase<pg8::EpiResN, pg8::StaticOrderT<64, 4>, 2816, 2816, 2816>(F.lds + RING_OFF, g, S, E);
            }
            SEAM(pb + P_DOWN);
        } else {
            RPT(13, true) if (PMB(13) && IN(pb + P_ASSIGN)) {
                SITE; int* asg_e = (int*)(ws + WS_ROUTE + (size_t)i * 512 * 1024);
                assign_phase(F, (const unsigned*)(ws + WS_CTL) + CW_BLKCNT + 2048 * i, (unsigned*)(ws + WS_CTL) + CW_CNT + 64 * i, asg_e, asg_e + 32768, asg_e + 3 * 32768, (const bf16*)(ws + WS_XN), (bf16*)(ws + WS_R2), (unsigned*)(ws + WS_CTL) + CW_SPLT + 256 * i);
            }
            SEAM(pb + P_ASSIGN);
            RPT(14, true) if (PMB(14) && IN(pb + P_UP)) {
                SITE;
                const MoeLayout L = moe_layout((const unsigned*)(ws + WS_CTL) + CW_CNT + 64 * i);
                pg8::Gemm g{(const bf16*)(ws + WS_R2), (const bf16*)(wb + WO_M13)};
                pg8::MoeOrder S; S.so.init(L.nblk * 256, 5632, F.G, F.bx); S.pe0 = L.pe[0]; S.pe1 = L.pe[1]; S.pe2 = L.pe[2]; S.pe3 = L.pe[3]; S.pe4 = L.pe[4]; S.pe5 = L.pe[5]; S.pe6 = L.pe[6]; S.nN = 22; S.maxr = 1 << 20;
                pg8::EpiSwiglu E{(bf16*)(ws + WS_H), 22, nullptr};
                pg8::gemm_phase<pg8::EpiSwiglu, pg8::MoeOrder, 1024, 1024, 1024>(F.lds + RING_OFF, g, S, E);
            }
            SEAM(pb + P_UP);
            RPT(15, true) if (PMB(15) && IN(pb + P_DOWN)) {
                SITE;
                const MoeLayout L = moe_layout((const unsigned*)(ws + WS_CTL) + CW_CNT + 64 * i);
                pg8::Gemm g{(const bf16*)(ws + WS_H), (const bf16*)(wb + WO_M2)};
                const int tile0 = ((L.nblk * 4) >> 8) * 64;
                pg8::MoeOrder S; S.so.init(tile0 * 256, 1024, F.G, F.bx); S.pe0 = L.pe[0]; S.pe1 = L.pe[1]; S.pe2 = L.pe[2]; S.pe3 = L.pe[3]; S.pe4 = L.pe[4]; S.pe5 = L.pe[5]; S.pe6 = L.pe[6]; S.nN = 4; S.maxr = 1 << 20;
                pg8::EpiMoeDown E{(bf16*)(ws + WS_R2)};
                pg8::gemm_phase<pg8::EpiMoeDown, pg8::MoeOrder, 2816, 2816, 2816>(F.lds + RING_OFF, g, S, E);
                pg8::MoeSplitOrder T; T.c = F.bx; T.tile0 = tile0; T.nsub = (L.nblk - tile0) * 24; T.eoff = 0; T.pe0 = S.pe0; T.pe1 = S.pe1; T.pe2 = S.pe2; T.pe3 = S.pe3; T.pe4 = S.pe4; T.pe5 = S.pe5; T.pe6 = S.pe6; T.nN = 4;
                pg8::EpiMoeDownPart EP{(float*)(ws + WS_PART)};
                pg8::gemm_phase<pg8::EpiMoeDownPart, pg8::MoeSplitOrder, 2816, 2816, 0>(F.lds + RING_OFF, g, T, EP);
            }
            SEAM(pb + P_DOWN);
        }
    }
    if (PMB(16) && IN(PH_FINAL)) {
        SITE; float* X = ap->out;
        if (((SUB() & 4) != 0)) { const int* sp = (const int*)(ws + WS_ROUTE + 512 * 1024) + 3 * 32768; const float* gp = (const float*)(ws + WS_ROUTE + 512 * 1024) + 2 * 32768;
            norm_phase<true, false, true>(F, X, X, ap->in[24], nullptr, (const bf16*)(ws + WS_R2), sp, gp, (const unsigned*)(ws + WS_CTL) + CW_SPLT + 256, (const float*)(ws + WS_PART), nullptr, nullptr, nullptr, nullptr, nullptr); }
        else norm_phase<false, false, true>(F, X, X, ap->in[24], nullptr, nullptr, nullptr, nullptr, nullptr, nullptr, nullptr, nullptr, nullptr, nullptr, nullptr);
    }
#undef IN
#undef SEAM
}
#ifndef OPT_MASK
#define OPT_MASK 0x37f
#endif
#ifndef ONE_LAUNCH
#define ONE_LAUNCH 1
#endif
static void launch_mk(Args& a, int lo, int hi, int sub, int grid, hipStream_t stream) {
    a.ph_lo = lo; a.ph_hi = hi; a.sub = sub;
    hipLaunchKernelGGL(mk_fwd, dim3(grid), dim3(NWAVES * 64), LDS_BYTES, stream, a);
}
extern "C" void kernel_launch(void* const* d_in, const int* in_sizes, int n_in, void* d_out, int out_size, void* d_ws, size_t ws_size, hipStream_t stream) {
    static int grid = 0;
    if (grid == 0) {
        if (n_in != 25 || out_size != NTOK * D_MODEL || ws_size < WS_END + 64 * MiB) { fprintf(stderr, "kernel_launch: unexpected shapes n_in %d out %d ws %zu (need %zu)\n", n_in, out_size, ws_size, (size_t)(WS_END + 64 * MiB)); grid = -1; return; }
        int dev = 0, cus = 0;
        if (hipGetDevice(&dev) != hipSuccess || hipDeviceGetAttribute(&cus, hipDeviceAttributeMultiprocessorCount, dev) != hipSuccess) { grid = -1; return; }
        if (hipFuncSetAttribute((const void*)mk_fwd, hipFuncAttributeMaxDynamicSharedMemorySize, LDS_BYTES) != hipSuccess) { fprintf(stderr, "kernel_launch: hipFuncSetAttribute failed\n"); grid = -1; return; }
        int per_cu = 0;
        if (hipOccupancyMaxActiveBlocksPerMultiprocessor(&per_cu, (const void*)mk_fwd, NWAVES * 64, LDS_BYTES) != hipSuccess || per_cu < 1) fprintf(stderr, "kernel_launch: occupancy query reports %d\n", per_cu);
        (void)hipGetLastError();
        grid = cus;
        if (grid != 256) fprintf(stderr, "kernel_launch: %d CUs (built for 256)\n", grid);
    }
    if (grid < 0) return;
    const float* x_in = (const float*)d_in[0]; const float* norm_mix = (const float*)d_in[1]; const float* w_in = (const float*)d_in[2];
    const float* attn_lambda = (const float*)d_in[3]; const float* attn_subln = (const float*)d_in[4];
    const float* ssm_lam_re = (const float*)d_in[5]; const float* ssm_lam_im = (const float*)d_in[6]; const float* ssm_log_dt = (const float*)d_in[7];
    const float* ssm_b_re = (const float*)d_in[8]; const float* ssm_b_im = (const float*)d_in[9]; const float* ssm_c_re = (const float*)d_in[10]; const float* ssm_c_im = (const float*)d_in[11];
    const float* ssm_d = (const float*)d_in[12]; const float* w_glu = (const float*)d_in[13]; const float* w_branch = (const float*)d_in[14]; const float* w_out = (const float*)d_in[15];
    const float* norm_ffn = (const float*)d_in[16]; const float* ffn_w1 = (const float*)d_in[17]; const float* ffn_w3 = (const float*)d_in[18]; const float* ffn_w2 = (const float*)d_in[19];
    const float* moe_router = (const float*)d_in[20]; const float* moe_w1 = (const float*)d_in[21]; const float* moe_w3 = (const float*)d_in[22]; const float* moe_w2 = (const float*)d_in[23];
    const float* norm_final = (const float*)d_in[24];
    unsigned char* ws = (unsigned char*)d_ws; float* X = (float*)d_out;
    bf16* XN = (bf16*)(ws + WS_XN); bf16* Q = (bf16*)(ws + WS_Q); bf16* Kb = (bf16*)(ws + WS_K); bf16* V = (bf16*)(ws + WS_V); bf16* G = (bf16*)(ws + WS_G);
    bf16* AY = (bf16*)(ws + WS_AY); float* XLOC = (float*)(ws + WS_XLOC); bf16* AS2 = (bf16*)(ws + WS_AS2); bf16* H = (bf16*)(ws + WS_H);
    bf16* SACT = (bf16*)(ws + WS_SACT); bf16* MERGED = (bf16*)(ws + WS_MERGED);
    float* TMP = (float*)(ws + WS_END);
    if (hipMemsetAsync(ws + WS_CTL, 0, CTL_ZERO_BYTES, stream) != hipSuccess) { fprintf(stderr, "kernel_launch: memset failed\n"); return; }
    Args a{};
    for (int i = 0; i < 25; ++i) a.in[i] = (const float*)d_in[i];
    a.out = X; a.ws = ws;
    for (int j = 0; j < 32; ++j) a.inv_freq[j] = pow(10000.0, -(double)j / 32.0);
    constexpr int OM = OPT_MASK;
    if (ONE_LAUNCH) { launch_mk(a, 0, PH_END, 1 | 2 | 4 | 8, grid, stream); return; }
    constexpr bool o_norm = OM & 1, o_inproj = OM & 2, o_ssm = OM & 4, o_attn = OM & 8, o_glu = OM & 16, o_branch = OM & 32, o_out = OM & 64, o_ffn = OM & 256, o_moe = OM & 512;
    static_assert(!o_moe || o_norm, "optimized MoE needs the optimized norms");
    const int sub_c = o_moe ? 4 : 0;
    (void)hipMemcpyAsync(X, x_in, (size_t)NTOK * D_MODEL * 4, hipMemcpyDeviceToDevice, stream);
    if (OM & ~1) launch_mk(a, PH_PRO, PH_PRO + 1, 0, grid, stream);
    for (int layer = 0; layer < DEPTH; ++layer) {
        const int pb = PH_L0 + layer * PH_PER_LAYER, i = layer / 2;
        const float lam_init = 0.8f - 0.6f * expf(-0.3f * (float)layer);
        if (o_norm) launch_mk(a, pb + P_NORM1, pb + P_NORM1 + 1, sub_c, grid, stream);
        else k_norm<<<NTOK / 4, 256, 0, stream>>>(X, norm_mix + layer * D_MODEL, XN, nullptr, nullptr, nullptr);
        if (o_inproj) launch_mk(a, pb + P_INPROJ, pb + P_INPROJ + 1, 0, grid, stream);
        else { NEpiInProj e{Q, Kb, V, AY, G};
          k_ngemm<NEpiInProj, false><<<dim3(IN_W / 128, NTOK / 128), 256, 0, stream>>>(XN, D_MODEL, w_in + (size_t)layer * D_MODEL * IN_W, nullptr, IN_W, D_MODEL, e); }
        if (o_ssm) { launch_mk(a, pb + P_XLOC, pb + P_XLOC + 1, 0, grid, stream); launch_mk(a, pb + P_SCAN, pb + P_SCAN + 1, 0, grid, stream); launch_mk(a, pb + P_MIX, pb + P_MIX + 1, 1, grid, stream); }
        else { const size_t po = (size_t)layer * 2 * SSM_G * SSM_P;
          k_nssm<<<BATCH * SSM_G, 64, 0, stream>>>(AY, XLOC, SACT, ssm_lam_re + po, ssm_lam_im + po, ssm_log_dt + layer * 2 * SSM_G,
                                                   ssm_b_re + po * 16, ssm_b_im + po * 16, ssm_c_re + po * 16, ssm_c_im + po * 16, ssm_d + layer * SSM_W); }
        if (o_attn) launch_mk(a, pb + P_MIX, pb + P_MIX + 1, 2, grid, stream);
        else k_nattn<<<dim3(SEQ / 64, NHEAD, BATCH), 128, 0, stream>>>(Q, Kb, V, AS2, attn_lambda + layer * 4 * HD, attn_subln + layer * VD, lam_init);
        if (o_glu) launch_mk(a, pb + P_GLU, pb + P_GLU + 1, 0, grid, stream);
        else { NEpiGlu e{SACT, AS2};
          k_ngemm<NEpiGlu, false><<<dim3(SSM_W / 128, NTOK / 128), 256, 0, stream>>>(SACT, SSM_W, w_glu + (size_t)layer * SSM_W * SSM_W, nullptr, SSM_W, SSM_W, e); }
        if (o_branch) launch_mk(a, pb + P_BRANCH, pb + P_BRANCH + 1, 0, grid, stream);
        else { NEpiBranch e0{G, TMP, MERGED, 0, 0}, e1{G, TMP, MERGED, 1, 0};
            const float* wbp = w_branch + (size_t)layer * 2 * 512 * 1024;
            k_ngemm<NEpiBranch, false><<<dim3(1024 / 128, NTOK / 128), 256, 0, stream>>>(AS2, 1024, wbp, nullptr, 1024, 512, e0);
            k_ngemm<NEpiBranch, false><<<dim3(1024 / 128, NTOK / 128), 256, 0, stream>>>(AS2 + 512, 1024, wbp + 512 * 1024, nullptr, 1024, 512, e1); }
        if (o_out) launch_mk(a, pb + P_OUT, pb + P_OUT + 1, 0, grid, stream);
        else { NEpiRes e{X, nullptr, nullptr, 0, 0};
          k_ngemm<NEpiRes, false><<<dim3(1024 / 128, NTOK / 128), 256, 0, stream>>>(MERGED, 1024, w_out + (size_t)layer * 1024 * 1024, nullptr, 1024, 1024, e); }
        int* asg_e = (int*)(ws + WS_ROUTE + (size_t)i * 512 * 1024); float* asg_g = (float*)(asg_e + 2 * 32768);
        if (layer % 2 == 0) {
            if (o_norm) launch_mk(a, pb + P_NORM2, pb + P_NORM2 + 1, 0, grid, stream);
            else k_norm<<<NTOK / 4, 256, 0, stream>>>(X, norm_ffn + layer * D_MODEL, XN, nullptr, nullptr, nullptr);
            if (o_ffn) { launch_mk(a, pb + P_UP, pb + P_UP + 1, 0, grid, stream); launch_mk(a, pb + P_DOWN, pb + P_DOWN + 1, 0, grid, stream); }
            else {
              { NEpiSwiglu e{H};
                k_ngemm<NEpiSwiglu, true><<<dim3(D_FF / 128, NTOK / 128), 256, 0, stream>>>(XN, D_MODEL, ffn_w1 + (size_t)i * D_MODEL * D_FF, ffn_w3 + (size_t)i * D_MODEL * D_FF, D_FF, D_MODEL, e); }
              { NEpiRes e{X, nullptr, nullptr, 0, 0};
                k_ngemm<NEpiRes, false><<<dim3(1024 / 128, NTOK / 128), 256, 0, stream>>>(H, D_FF, ffn_w2 + (size_t)i * D_FF * D_MODEL, nullptr, D_MODEL, D_FF, e); }
            }
        } else {
            if (o_norm) launch_mk(a, pb + P_NORM2, pb + P_NORM2 + 1, o_moe ? 8 : 0, grid, stream);
            else k_norm<<<NTOK / 4, 256, 0, stream>>>(X, norm_ffn + layer * D_MODEL, XN, moe_router + (size_t)i * D_MODEL * N_EXP, asg_e, asg_g);
            if (o_moe) { launch_mk(a, pb + P_ASSIGN, pb + P_ASSIGN + 1, 0, grid, stream); launch_mk(a, pb + P_UP, pb + P_UP + 1, 0, grid, stream); launch_mk(a, pb + P_DOWN, pb + P_DOWN + 1, 0, grid, stream); }
            else for (int ex = 0; ex < N_EXP; ++ex) {
                const size_t wo = ((size_t)i * N_EXP + ex) * D_MODEL * D_FF;
                { NEpiSwiglu e{H};
                  k_ngemm<NEpiSwiglu, true><<<dim3(D_FF / 128, NTOK / 128), 256, 0, stream>>>(XN, D_MODEL, moe_w1 + wo, moe_w3 + wo, D_FF, D_MODEL, e); }
                { NEpiRes e{X, asg_e, asg_g, ex, 0};
                  k_ngemm<NEpiRes, false><<<dim3(1024 / 128, NTOK / 128), 256, 0, stream>>>(H, D_FF, moe_w2 + wo, nullptr, D_MODEL, D_FF, e); }
            }
        }
    }
    if (o_norm) launch_mk(a, PH_FINAL, PH_FINAL + 1, sub_c, grid, stream);
    else k_final_norm<<<NTOK / 4, 256, 0, stream>>>(X, norm_final);
}
```

```cpp
#include <hip/hip_runtime.h>
#include <cstdio>
#include <cstdint>
#include <cmath>

constexpr int D_MODEL = 1024, BATCH = 2, SEQ = 8192, DEPTH = 4, NTOK = BATCH * SEQ;
constexpr int NHEAD = 4, HD = 64, VD = 128;
constexpr int SSM_G = 32, SSM_CH = 16, SSM_P = 64, SSM_W = 512;
constexpr int IN_W = 4096, OFF_K = 512, OFF_V = 1024, OFF_U = 1536, OFF_G = 2048;
constexpr int D_FF = 2816, N_EXP = 8;
constexpr float RMS_EPS = 1e-6f;
constexpr int CHL = 16;
constexpr int NCH = SEQ / CHL;

typedef unsigned short bf16;
typedef float f32x4 __attribute__((ext_vector_type(4)));

constexpr size_t MiB = 1u << 20;
constexpr size_t WS_CTL = 0;
constexpr size_t WS_WEIGHTS = 1 * MiB;
constexpr size_t WS_XN = 267 * MiB;
constexpr size_t WS_R1 = WS_XN + 32 * MiB;
constexpr size_t WS_Q = WS_R1, WS_K = WS_Q + 16 * MiB, WS_V = WS_K + 16 * MiB, WS_G = WS_V + 16 * MiB;
constexpr size_t WS_AY = WS_G + 64 * MiB, WS_XLOC = WS_AY + 32 * MiB, WS_AS2 = WS_XLOC + 32 * MiB;
constexpr size_t WS_H = WS_R1;
constexpr size_t WS_R2 = WS_R1 + 208 * MiB;
constexpr size_t WS_SACT = WS_R2, WS_MERGED = WS_SACT + 16 * MiB, WS_O1 = WS_MERGED + 32 * MiB;
constexpr size_t WS_ROUTE = WS_R2 + 80 * MiB;
constexpr size_t WS_PART = WS_ROUTE + 1 * MiB;
constexpr size_t WS_PS = WS_PART + 48 * MiB;
constexpr size_t WS_END = WS_PS + 1 * MiB;

__device__ __forceinline__ float bf2f(bf16 v) { return __uint_as_float(((unsigned)v) << 16); }
__device__ __forceinline__ bf16 f2bf(float f) { unsigned u = __float_as_uint(f); return (bf16)((u + 0x7fffu + ((u >> 16) & 1u)) >> 16); }
__device__ __forceinline__ float wave_sum(float v) {
#pragma unroll
    for (int o = 1; o < 64; o <<= 1) v += __shfl_xor(v, o);
    return v;
}
__device__ __forceinline__ float sigmoidf_(float x) { return 1.f / (1.f + __expf(-x)); }
__host__ __device__ __forceinline__ int qk_pos(int d) { const int j = d & 31, n = d >> 5; return 32 * (j >> 4) + 8 * ((j & 15) >> 2) + 4 * n + (j & 3); }
__device__ __forceinline__ size_t q_index(int b, int h, int c, int s, int d) { return ((((size_t)b * NHEAD + h) * 2 + c) * SEQ + s) * HD + qk_pos(d); }
__device__ __forceinline__ size_t v_index(int b, int h, int s, int e) { return (((size_t)b * NHEAD + h) * SEQ + s) * VD + e; }
__device__ __forceinline__ size_t ay_index(int g, int b, int s, int hh) { return (((size_t)g * (BATCH * NCH)) + b * NCH + (s / CHL)) * 512 + (s % CHL) * SSM_CH + hh; }

__global__ __launch_bounds__(256) void k_norm(const float* __restrict__ x, const float* __restrict__ g, bf16* __restrict__ xn,
                                             const float* __restrict__ wr, int* __restrict__ top_e, float* __restrict__ top_g) {
    const int lane = threadIdx.x & 63, row = blockIdx.x * 4 + (threadIdx.x >> 6);
    const f32x4* xr = (const f32x4*)(x + (size_t)row * D_MODEL) + lane;
    f32x4 v[4]; float s = 0.f;
#pragma unroll
    for (int j = 0; j < 4; ++j) { v[j] = xr[64 * j]; s += (v[j].x * v[j].x + v[j].y * v[j].y) + (v[j].z * v[j].z + v[j].w * v[j].w); }
    const float rstd = rsqrtf(wave_sum(s) * (1.f / D_MODEL) + RMS_EPS);
    float lg[N_EXP];
#pragma unroll
    for (int e = 0; e < N_EXP; ++e) lg[e] = 0.f;
#pragma unroll
    for (int j = 0; j < 4; ++j) {
        const f32x4 gg = ((const f32x4*)g)[64 * j + lane];
        v[j].x *= rstd * gg.x; v[j].y *= rstd * gg.y; v[j].z *= rstd * gg.z; v[j].w *= rstd * gg.w;
        unsigned long long o = (unsigned long long)f2bf(v[j].x) | ((unsigned long long)f2bf(v[j].y) << 16) | ((unsigned long long)f2bf(v[j].z) << 32) | ((unsigned long long)f2bf(v[j].w) << 48);
        ((unsigned long long*)(xn + (size_t)row * D_MODEL))[64 * j + lane] = o;
        if (wr) {
            const int k0 = (64 * j + lane) * 4;
#pragma unroll
            for (int e = 0; e < N_EXP; ++e) lg[e] += v[j].x * wr[(k0 + 0) * N_EXP + e] + v[j].y * wr[(k0 + 1) * N_EXP + e] + v[j].z * wr[(k0 + 2) * N_EXP + e] + v[j].w * wr[(k0 + 3) * N_EXP + e];
        }
    }
    if (wr) {
#pragma unroll
        for (int e = 0; e < N_EXP; ++e) lg[e] = wave_sum(lg[e]);
        int e0 = 0; float l0 = lg[0];
#pragma unroll
        for (int e = 1; e < N_EXP; ++e) if (lg[e] > l0) { l0 = lg[e]; e0 = e; }
        int e1 = -1; float l1 = -3.4e38f;
#pragma unroll
        for (int e = 0; e < N_EXP; ++e) if (e != e0 && lg[e] > l1) { l1 = lg[e]; e1 = e; }
        const float p1 = __expf(l1 - l0), inv = 1.f / (1.f + p1);
        if (lane == 0) { top_e[row * 2] = e0; top_e[row * 2 + 1] = e1; top_g[row * 2] = inv; top_g[row * 2 + 1] = p1 * inv; }
    }
}

__global__ __launch_bounds__(256) void k_final_norm(float* __restrict__ x, const float* __restrict__ g) {
    const int lane = threadIdx.x & 63, row = blockIdx.x * 4 + (threadIdx.x >> 6);
    f32x4* xr = (f32x4*)(x + (size_t)row * D_MODEL) + lane;
    f32x4 v[4]; float s = 0.f;
#pragma unroll
    for (int j = 0; j < 4; ++j) { v[j] = xr[64 * j]; s += (v[j].x * v[j].x + v[j].y * v[j].y) + (v[j].z * v[j].z + v[j].w * v[j].w); }
    const float rstd = rsqrtf(wave_sum(s) * (1.f / D_MODEL) + RMS_EPS);
#pragma unroll
    for (int j = 0; j < 4; ++j) { const f32x4 gg = ((const f32x4*)g)[64 * j + lane]; f32x4 o = {v[j].x * rstd * gg.x, v[j].y * rstd * gg.y, v[j].z * rstd * gg.z, v[j].w * rstd * gg.w}; xr[64 * j] = o; }
}

template <class Epi, bool DUAL>
__global__ __launch_bounds__(256) void k_ngemm(const bf16* __restrict__ A, int lda, const float* __restrict__ W, const float* __restrict__ W2, int ldw, int K, Epi epi) {
    __shared__ float As[16][132];
    __shared__ float Bs[16][128];
    __shared__ float Bs2[DUAL ? 16 : 1][128];
    const int tid = threadIdx.x, tx = tid & 15, ty = tid >> 4;
    const int m0 = blockIdx.y * 128, n0 = blockIdx.x * 128;
    float acc[8][8], acc2[DUAL ? 8 : 1][8];
#pragma unroll
    for (int i = 0; i < 8; ++i)
#pragma unroll
        for (int j = 0; j < 8; ++j) { acc[i][j] = 0.f; if (DUAL) acc2[i][j] = 0.f; }
    const int ar = tid >> 1, ak = (tid & 1) * 8;
    const int bk = tid >> 4, bn = (tid & 15) * 8;
    for (int k0 = 0; k0 < K; k0 += 16) {
        const uint4 av = *(const uint4*)(A + (size_t)(m0 + ar) * lda + k0 + ak);
        const unsigned aw[4] = {av.x, av.y, av.z, av.w};
#pragma unroll
        for (int q = 0; q < 4; ++q) { As[ak + 2 * q][ar] = __uint_as_float(aw[q] << 16); As[ak + 2 * q + 1][ar] = __uint_as_float(aw[q] & 0xffff0000u); }
        const f32x4 b0 = *(const f32x4*)(W + (size_t)(k0 + bk) * ldw + n0 + bn), b1 = *(const f32x4*)(W + (size_t)(k0 + bk) * ldw + n0 + bn + 4);
        *(f32x4*)&Bs[bk][bn] = b0; *(f32x4*)&Bs[bk][bn + 4] = b1;
        if (DUAL) { const f32x4 c0 = *(const f32x4*)(W2 + (size_t)(k0 + bk) * ldw + n0 + bn), c1 = *(const f32x4*)(W2 + (size_t)(k0 + bk) * ldw + n0 + bn + 4);
            *(f32x4*)&Bs2[bk][bn] = c0; *(f32x4*)&Bs2[bk][bn + 4] = c1; }
        __syncthreads();
#pragma unroll
        for (int k = 0; k < 16; ++k) {
            float a[8], b[8], b2[8];
#pragma unroll
            for (int i = 0; i < 8; ++i) a[i] = As[k][ty * 8 + i];
#pragma unroll
            for (int j = 0; j < 8; ++j) { b[j] = Bs[k][tx * 2 + (j & 1) + 32 * (j >> 1)]; if (DUAL) b2[j] = Bs2[k][tx * 2 + (j & 1) + 32 * (j >> 1)]; }
#pragma unroll
            for (int i = 0; i < 8; ++i)
#pragma unroll
                for (int j = 0; j < 8; ++j) { acc[i][j] += a[i] * b[j]; if (DUAL) acc2[i][j] += a[i] * b2[j]; }
        }
        __syncthreads();
    }
#pragma unroll
    for (int i = 0; i < 8; ++i) { if constexpr (DUAL) epi.row2(m0 + ty * 8 + i, n0, tx, acc[i], acc2[i]); else epi.row(m0 + ty * 8 + i, n0, tx, acc[i]); }
}
#define NG_COL(n0, tx, jj) ((n0) + (tx) * 2 + ((jj) & 1) + 32 * ((jj) >> 1))

struct NEpiInProj {
    bf16 *Q, *Kb, *V, *AY, *G;
    __device__ void row(int m, int n0, int tx, const float (&a)[8]) const {
        const int b = m / SEQ, s = m % SEQ;
        if (n0 < OFF_V) {
            bf16* dst = n0 < OFF_K ? Q : Kb; const int h = (n0 % 512) / 128;
#pragma unroll
            for (int c = 0; c < 2; ++c)
#pragma unroll
                for (int e = 0; e < 2; ++e) {
                    const int j = tx * 2 + e;
                    const float x1 = a[c * 4 + e], x2 = a[c * 4 + 2 + e];
                    const double ang = (double)s * pow(10000.0, -(double)j / 32.0);
                    const float sn = (float)sin(ang), cs = (float)cos(ang);
                    dst[q_index(b, h, c, s, j)] = f2bf(x1 * cs - x2 * sn);
                    dst[q_index(b, h, c, s, j + 32)] = f2bf(x2 * cs + x1 * sn);
                }
        } else {
#pragma unroll
            for (int jj = 0; jj < 8; ++jj) {
                const int n = NG_COL(n0, tx, jj);
                if (n < OFF_U) { const int h = (n - OFF_V) / VD, e = (n - OFF_V) % VD; V[v_index(b, h, s, e)] = f2bf(a[jj]); }
                else if (n < OFF_G) { const int g = (n - OFF_U) / SSM_CH, hh = (n - OFF_U) % SSM_CH; AY[ay_index(g, b, s, hh)] = f2bf(a[jj]); }
                else G[(size_t)m * 2048 + (n - OFF_G)] = f2bf(sigmoidf_(a[jj]));
            }
        }
    }
};
struct NEpiGlu {
    const bf16* SACT; bf16* AS2;
    __device__ void row(int m, int n0, int tx, const float (&a)[8]) const {
#pragma unroll
        for (int jj = 0; jj < 8; ++jj) { const int n = NG_COL(n0, tx, jj); AS2[(size_t)m * 1024 + 512 + n] = f2bf(bf2f(SACT[(size_t)m * 512 + n]) * sigmoidf_(a[jj])); }
    }
};
struct NEpiBranch {
    const bf16* G; float* TMP; bf16* MERGED; int second, pad;
    __device__ void row(int m, int n0, int tx, const float (&a)[8]) const {
#pragma unroll
        for (int jj = 0; jj < 8; ++jj) { const int n = NG_COL(n0, tx, jj);
            if (!second) TMP[(size_t)m * 1024 + n] = bf2f(G[(size_t)m * 2048 + n]) * a[jj];
            else MERGED[(size_t)m * 1024 + n] = f2bf(TMP[(size_t)m * 1024 + n] + bf2f(G[(size_t)m * 2048 + 1024 + n]) * a[jj]); }
    }
};
struct NEpiRes {
    float* X; const int* top_e; const float* top_g; int e, pad;
    __device__ void row(int m, int n0, int tx, const float (&a)[8]) const {
        float gt = 1.f;
        if (top_e) { gt = 0.f; if (top_e[m * 2] == e) gt = top_g[m * 2]; else if (top_e[m * 2 + 1] == e) gt = top_g[m * 2 + 1]; if (gt == 0.f) return; }
#pragma unroll
        for (int jj = 0; jj < 8; ++jj) { const int n = NG_COL(n0, tx, jj); X[(size_t)m * 1024 + n] += gt * a[jj]; }
    }
};
struct NEpiSwiglu {
    bf16* H;
    __device__ void row2(int m, int n0, int tx, const float (&a)[8], const float (&b)[8]) const {
#pragma unroll
        for (int jj = 0; jj < 8; ++jj) { const int n = NG_COL(n0, tx, jj); H[(size_t)m * D_FF + n] = f2bf(a[jj] * sigmoidf_(a[jj]) * b[jj]); }
    }
};

__global__ __launch_bounds__(128) void k_nattn(const bf16* __restrict__ Q, const bf16* __restrict__ Kb, const bf16* __restrict__ V, bf16* __restrict__ AS2,
                                              const float* __restrict__ lam_p, const float* __restrict__ subln, float lam_init) {
    __shared__ float Ks[32][64];
    __shared__ float Vs[32][128];
    __shared__ float ssq[2][64];
    const int tid = threadIdx.x, r = tid & 63, vh = tid >> 6;
    const int b = blockIdx.z, h = blockIdx.y, s = blockIdx.x * 64 + r;
    float d01 = 0.f, d23 = 0.f;
    for (int i = 0; i < HD; ++i) { d01 += lam_p[i] * lam_p[HD + i]; d23 += lam_p[2 * HD + i] * lam_p[3 * HD + i]; }
    const float lam = __expf(d01) - __expf(d23) + lam_init;
    float res[64];
#pragma unroll
    for (int e = 0; e < 64; ++e) res[e] = 0.f;
    for (int c = 0; c < 2; ++c) {
        float q[64], o[64];
        const bf16* qp = Q + ((((size_t)b * NHEAD + h) * 2 + c) * SEQ + s) * HD;
#pragma unroll
        for (int d = 0; d < 64; ++d) { q[d] = bf2f(qp[d]) * 0.125f; o[d] = 0.f; }
        float mx = -1e30f, l = 0.f;
        const bf16* kp = Kb + ((((size_t)b * NHEAD + h) * 2 + c) * SEQ) * HD;
        const bf16* vp = V + (((size_t)b * NHEAD + h) * SEQ) * VD;
        for (int k0 = 0; k0 < SEQ; k0 += 32) {
            __syncthreads();
            for (int i = tid; i < 32 * 64; i += 128) Ks[i / 64][i % 64] = bf2f(kp[(size_t)k0 * HD + i]);
            for (int i = tid; i < 32 * 128; i += 128) Vs[i / 128][i % 128] = bf2f(vp[(size_t)k0 * VD + i]);
            __syncthreads();
            float sc[32]; float tm = mx;
#pragma unroll
            for (int j = 0; j < 32; ++j) { float a = 0.f;
#pragma unroll
                for (int d = 0; d < 64; ++d) a += q[d] * Ks[j][d];
                sc[j] = a; tm = fmaxf(tm, a); }
            const float alpha = __expf(mx - tm); mx = tm; l *= alpha;
#pragma unroll
            for (int e = 0; e < 64; ++e) o[e] *= alpha;
#pragma unroll
            for (int j = 0; j < 32; ++j) { const float p = __expf(sc[j] - mx); l += p;
#pragma unroll
                for (int e = 0; e < 64; ++e) o[e] += p * Vs[j][vh * 64 + e]; }
        }
        const float il = (c == 0 ? 1.f : -lam) / l;
#pragma unroll
        for (int e = 0; e < 64; ++e) res[e] += o[e] * il;
    }
    float sq = 0.f;
#pragma unroll
    for (int e = 0; e < 64; ++e) sq += res[e] * res[e];
    ssq[vh][r] = sq;
    __syncthreads();
    const float rstd = rsqrtf((ssq[0][r] + ssq[1][r]) * (1.f / VD) + RMS_EPS) * (1.f - lam_init);
    bf16* op = AS2 + (size_t)(b * SEQ + s) * 1024 + h * VD + vh * 64;
#pragma unroll
    for (int e = 0; e < 64; ++e) op[e] = f2bf(res[e] * rstd * subln[vh * 64 + e]);
}

__global__ __launch_bounds__(64) void k_nssm(const bf16* __restrict__ AY, float* __restrict__ Y, bf16* __restrict__ SACT,
                                            const float* __restrict__ lam_re, const float* __restrict__ lam_im, const float* __restrict__ log_dt,
                                            const float* __restrict__ b_re, const float* __restrict__ b_im, const float* __restrict__ c_re, const float* __restrict__ c_im,
                                            const float* __restrict__ dsk) {
    const int p = threadIdx.x, g = blockIdx.x % SSM_G, b = blockIdx.x / SSM_G;
    for (int dir = 0; dir < 2; ++dir) {
        const size_t pi = ((size_t)dir * SSM_G + g) * SSM_P + p;
        const float lr = lam_re[pi], li = lam_im[pi], dt = __expf(log_dt[dir * SSM_G + g]);
        const float er = expf(lr * dt); float sn, cs; sincosf(li * dt, &sn, &cs);
        const float ar = er * cs, ai = er * sn;
        const float nr = ar - 1.f, ni = ai, den = lr * lr + li * li;
        const float fr = (nr * lr + ni * li) / den, fi = (ni * lr - nr * li) / den;
        float bbr[16], bbi[16], cr[16], ci[16];
#pragma unroll
        for (int hh = 0; hh < 16; ++hh) { const float br = b_re[pi * 16 + hh], bi = b_im[pi * 16 + hh]; bbr[hh] = fr * br - fi * bi; bbi[hh] = fr * bi + fi * br;
            const size_t cidx = (((size_t)dir * SSM_G + g) * SSM_CH + hh) * SSM_P + p; cr[hh] = c_re[cidx]; ci[hh] = c_im[cidx]; }
        float xr = 0.f, xi = 0.f;
        for (int step = 0; step < SEQ; ++step) {
            const int s = dir == 0 ? step : SEQ - 1 - step;
            const bf16* up = AY + ay_index(g, b, s, 0);
            float u[16];
#pragma unroll
            for (int hh = 0; hh < 16; ++hh) u[hh] = bf2f(up[hh]);
            float br = 0.f, bi = 0.f;
#pragma unroll
            for (int hh = 0; hh < 16; ++hh) { br += bbr[hh] * u[hh]; bi += bbi[hh] * u[hh]; }
            const float nxr = ar * xr - ai * xi + br, nxi = ar * xi + ai * xr + bi; xr = nxr; xi = nxi;
            float mine = 0.f;
#pragma unroll
            for (int hh = 0; hh < 16; ++hh) { const float t = wave_sum(cr[hh] * xr - ci[hh] * xi); if (p == hh) mine = t; }
            if (p < 16) {
                const size_t yi = (size_t)(b * SEQ + s) * SSM_W + g * SSM_CH + p;
                if (dir == 0) Y[yi] = u[p] * dsk[g * SSM_CH + p] + mine;
                else { const float y = Y[yi] + mine; SACT[yi] = f2bf(0.5f * y * (1.f + erff(y * 0.70710678118654752f))); }
            }
        }
    }
}


#define GAS __attribute__((address_space(1)))
#define LAS __attribute__((address_space(3)))
namespace pg8 {
#define PG8_LAS __attribute__((address_space(3)))
typedef unsigned short bf16_t;
typedef short bf16x8 __attribute__((ext_vector_type(8)));
typedef float f32x4 __attribute__((ext_vector_type(4)));
typedef unsigned u32x4 __attribute__((ext_vector_type(4)));
constexpr int BM = 256, BK = 64, HALF = 128, HTB = HALF * BK * 2  , STAGE_BYTES = 8 * HTB, NXCD = 8, WGM = 8;

__host__ __device__ __forceinline__ int lds_byte(int r, int c) { const int st = (r >> 4) * 2 + (c >> 5), rr = r & 15, cc = c & 31, ob = rr * 64 + cc * 2; return st * 1024 + (ob ^ (((ob >> 9) & 1) << 5)); }
__host__ __device__ __forceinline__ void stage_rc(int b, int& R, int& C) { const int st = b / 1024, sb = b % 1024, swz = sb ^ (((sb >> 9) & 1) << 5); R = (st >> 1) * 16 + swz / 64; C = (st & 1) * 32 + (swz % 64) / 2; }
__host__ __device__ __forceinline__ int perm32(int rho) { const int n = rho >> 4, i = rho & 15; return 8 * (i >> 2) + 4 * n + (i & 3); }

struct Unit { int pm, pn; int ko = 0, aux = 0, nk = 0; };
struct Gemm { const bf16_t* A; const bf16_t* Bt; };

struct StaticOrder {
    int nM, nN, nwg, G, c;
    __host__ __device__ void init(int M, int N, int G_, int c_) { nM = M / BM; nN = N / BM; nwg = nM * nN; G = G_; c = c_; }
    __host__ __device__ void map(int L, Unit& u) const {
        int wgid = L; { const int q = nwg / NXCD, r = nwg % NXCD, xcd = wgid % NXCD, off = wgid / NXCD; wgid = (xcd < r ? xcd * (q + 1) : r * (q + 1) + (xcd - r) * q) + off; }
        const int nig = WGM * nN, gid = wgid / nig, fm = gid * WGM, gsz = (nM - fm) < WGM ? (nM - fm) : WGM;
        u.pm = fm + ((wgid % nig) % gsz); u.pn = (wgid % nig) / gsz;
    }
    __host__ __device__ bool next(int i, Unit& u) const {
        const long L = (long)i * G + c; if (L >= nwg) return false;
        map((int)L, u); return true;
    }
    __device__ __forceinline__ void a_ready(const Unit&) const {}
    __device__ __forceinline__ void done(const Unit&) const {}
};


template <int NM, int NN> struct StaticOrderT {
    int c;
    __device__ __forceinline__ bool next(int i, Unit& u) const {
        constexpr int nwg = NM * NN, q = nwg / NXCD, r = nwg % NXCD; const int L = i * 256 + c; if (L >= nwg) return false;
        int wgid = L; { const int xcd = wgid % NXCD, off = wgid / NXCD; wgid = (xcd < r ? xcd * (q + 1) : r * (q + 1) + (xcd - r) * q) + off; }
        constexpr int nig = WGM * NN; const int gid = wgid / nig, fm = gid * WGM, gsz = (NM - fm) < WGM ? (NM - fm) : WGM;
        u.pm = fm + ((wgid % nig) % gsz); u.pn = (wgid % nig) / gsz; return true;
    }
    __device__ __forceinline__ void a_ready(const Unit&) const {}
    __device__ __forceinline__ void done(const Unit&) const {}
};
typedef __bf16 bf16x2_cv __attribute__((ext_vector_type(2))); typedef float f32x2_cv __attribute__((ext_vector_type(2)));
__device__ __forceinline__ unsigned cvt_pk_bf16(float lo, float hi) { const bf16x2_cv r = __builtin_convertvector((f32x2_cv){lo, hi}, bf16x2_cv); return __builtin_bit_cast(unsigned, r); }
typedef float f32x2 __attribute__((ext_vector_type(2)));
__device__ __forceinline__ f32x2 gelu_pk(f32x2 v) {
    const f32x2 av = __builtin_elementwise_abs(v), d = av * 0.2316418882f + 1.0f;
    f32x2 t; t.x = __builtin_amdgcn_rcpf(d.x); t.y = __builtin_amdgcn_rcpf(d.y);
    f32x2 q = t * 0.5307027145f + (-0.7265760135f); q = q * t + 0.7107068705f; q = q * t + (-0.142248368f); q = q * t + 0.127414796f; q = q * t;
    const f32x2 s = (v * v) * (-0.72134752044f);
    f32x2 e; e.x = __builtin_amdgcn_exp2f(s.x); e.y = __builtin_amdgcn_exp2f(s.y);
    const f32x2 m = v * (q * e), r = v - m;
    f32x2 o; o.x = v.x < 0.f ? m.x : r.x; o.y = v.y < 0.f ? m.y : r.y; return o;
}

template <class Epi, class Sched, int LDA, int LDB, int KK, bool ALIGN_EPI = true, bool SP2 = true>
__device__ __forceinline__ void gemm_phase(PG8_LAS unsigned char* lds, const Gemm g, const Sched& S, const Epi& E) {
    int tid_l = threadIdx.x; asm volatile("" : "+v"(tid_l));
    const int tid = tid_l, wid = __builtin_amdgcn_readfirstlane(tid >> 6), lane = tid & 63, wr = wid >> 2, wc = wid & 3, fr = lane & 15, fq = lane >> 4;
    static_assert(KK % 128 == 0, "K multiple of 128");
    unsigned voffA[2], voffB[2];
#pragma unroll
    for (int i = 0; i < 2; ++i) { int R, C; stage_rc(tid * 16 + i * 8192, R, C); const int Rb = Epi::PERM ? ((R & ~31) + perm32(R & 31)) : R;
        voffA[i] = (unsigned)(R * LDA + C) * 2u; voffB[i] = (unsigned)(Rb * LDB + C) * 2u; }
    constexpr size_t kstep = (size_t)(BK * 2);
    constexpr size_t hstepA = (size_t)HALF * LDA * 2, hstepB = (size_t)HALF * LDB * 2;
    constexpr size_t tstepA = 2 * hstepA, tstepB = 2 * hstepB;
    const unsigned ldsw = (unsigned)wid * 1024u;
    const int aoff = lds_byte(wr * 64 + fr, fq * 8), boff = lds_byte(wc * 32 + fr, fq * 8);
#define PG8_SA(b, h) (((b) * 2 + (h)) * HTB)
#define PG8_SB(b, h) ((4 + (b) * 2 + (h)) * HTB)
#define PG8_STAGE(bufoff, gbase, voff) do { _Pragma("unroll") for (int _i = 0; _i < 2; ++_i) \
        __builtin_amdgcn_global_load_lds((const unsigned*)((const char*)(gbase) + (voff)[_i]), (PG8_LAS unsigned*)(lds + (bufoff) + ldsw + _i * 8192), 16, 0, 0); } while (0)
#define PG8_LDA(dst, b, h) do { _Pragma("unroll") for (int m = 0; m < 4; ++m) _Pragma("unroll") for (int k = 0; k < 2; ++k) dst[m][k] = *(const PG8_LAS bf16x8*)(lds + PG8_SA(b, h) + aoff + m * 2048 + k * 1024); } while (0)
#define PG8_LDB(dst, b, h) do { _Pragma("unroll") for (int n = 0; n < 2; ++n) _Pragma("unroll") for (int k = 0; k < 2; ++k) dst[n][k] = *(const PG8_LAS bf16x8*)(lds + PG8_SB(b, h) + boff + n * 2048 + k * 1024); } while (0)
#define PG8_MMA(ai, bj, At, Bt) do { __builtin_amdgcn_s_setprio(1); _Pragma("unroll") for (int m = 0; m < 4; ++m) _Pragma("unroll") for (int n = 0; n < 2; ++n) _Pragma("unroll") for (int k = 0; k < 2; ++k) \
        acc[ai][bj][m][n] = __builtin_amdgcn_mfma_f32_16x16x32_bf16(Bt[n][k], At[m][k], acc[ai][bj][m][n], 0, 0, 0); __builtin_amdgcn_s_setprio(0); } while (0)
#define PG8_WAIT_V(n) asm volatile("s_waitcnt vmcnt(" #n ")" ::: "memory")
#define PG8_WAIT_L(n) asm volatile("s_waitcnt lgkmcnt(" #n ")" ::: "memory")
#define PG8_BAR __builtin_amdgcn_s_barrier()
#define PG8_SCHED __builtin_amdgcn_sched_barrier(0)
    Unit cur, nxt; int ui = 0;
    if (!S.next(0, cur)) return;
    f32x4 acc[2][2][4][2];
#pragma unroll
    for (int a = 0; a < 2; ++a)
#pragma unroll
        for (int b = 0; b < 2; ++b)
#pragma unroll
            for (int m = 0; m < 4; ++m)
#pragma unroll
                for (int n = 0; n < 2; ++n) acc[a][b][m][n] = (f32x4){0.f, 0.f, 0.f, 0.f};
    bf16x8 At[4][2], B0[2][2], B1[2][2];
    const char* cA = (const char*)g.A + (size_t)cur.pm * tstepA + cur.ko; const char* cB = (const char*)g.Bt + (size_t)cur.pn * tstepB + cur.ko;
    S.a_ready(cur);
    if constexpr (SP2) {
        PG8_STAGE(PG8_SB(0, 0), cB, voffB); PG8_STAGE(PG8_SB(0, 1), cB + hstepB, voffB); PG8_STAGE(PG8_SA(0, 0), cA, voffA); PG8_STAGE(PG8_SA(0, 1), cA + hstepA, voffA);
        if (wr == 1) PG8_BAR;
        PG8_WAIT_V(2); PG8_BAR;
        PG8_STAGE(PG8_SB(1, 0), cB + kstep, voffB); PG8_STAGE(PG8_SA(1, 0), cA + kstep, voffA); PG8_STAGE(PG8_SB(1, 1), cB + hstepB + kstep, voffB);
        PG8_WAIT_V(6); PG8_BAR;
    } else {
        PG8_STAGE(PG8_SB(0, 0), cB, voffB); PG8_STAGE(PG8_SA(0, 0), cA, voffA); PG8_STAGE(PG8_SB(0, 1), cB + hstepB, voffB); PG8_STAGE(PG8_SA(0, 1), cA + hstepA, voffA);
        if (wr == 1) PG8_BAR;
        PG8_WAIT_V(4); PG8_BAR;
        PG8_STAGE(PG8_SB(1, 0), cB + kstep, voffB); PG8_STAGE(PG8_SA(1, 0), cA + kstep, voffA); PG8_STAGE(PG8_SB(1, 1), cB + hstepB + kstep, voffB);
        PG8_WAIT_V(6); PG8_BAR;
    }
    for (;;) {
        const bool has_next = S.next(ui + 1, nxt);
        const char* nA = has_next ? (const char*)g.A + (size_t)nxt.pm * tstepA + nxt.ko : cA; const char* nB = has_next ? (const char*)g.Bt + (size_t)nxt.pn * tstepB + nxt.ko : cB;
        const int nt = KK > 0 ? KK / BK : cur.nk;
        for (int t = 0; t < nt; t += 2) {
            if constexpr (Epi::MIDHOOK) { if (t == nt / 2) E.mid(acc, cur, wr, wc, fr, fq); }
            const bool last = (t == nt - 2);
            const char* a1 = cA + (size_t)(t + 1) * kstep;
            const char* a2 = last ? nA : cA + (size_t)(t + 2) * kstep; const char* b2 = last ? nB : cB + (size_t)(t + 2) * kstep;
            const char* a3 = a2 + kstep; const char* b3 = b2 + kstep;
            if (last && has_next) S.a_ready(nxt);
            if constexpr (SP2) {
            PG8_LDB(B0, 0, 0); PG8_LDB(B1, 0, 1); PG8_SCHED; PG8_LDA(At, 0, 0); PG8_STAGE(PG8_SA(1, 1), a1 + hstepA, voffA);
            PG8_WAIT_V(8); PG8_WAIT_L(0); PG8_BAR; PG8_MMA(0, 0, At, B0); PG8_MMA(0, 1, At, B1); PG8_BAR; PG8_SCHED;
            PG8_LDA(At, 0, 1); PG8_STAGE(PG8_SB(0, 0), b2, voffB); PG8_STAGE(PG8_SB(0, 1), b2 + hstepB, voffB); PG8_STAGE(PG8_SA(0, 0), a2, voffA);
            PG8_WAIT_V(8); PG8_WAIT_L(0); PG8_BAR; PG8_MMA(1, 0, At, B0); PG8_MMA(1, 1, At, B1); PG8_BAR; PG8_SCHED;
            PG8_LDB(B0, 1, 0); PG8_LDB(B1, 1, 1); PG8_SCHED; PG8_LDA(At, 1, 0); PG8_STAGE(PG8_SA(0, 1), a2 + hstepA, voffA);
            PG8_WAIT_V(8); PG8_WAIT_L(0); PG8_BAR; PG8_MMA(0, 0, At, B0); PG8_MMA(0, 1, At, B1); PG8_BAR; PG8_SCHED;
            PG8_LDA(At, 1, 1); PG8_STAGE(PG8_SB(1, 0), b3, voffB); PG8_STAGE(PG8_SB(1, 1), b3 + hstepB, voffB); PG8_STAGE(PG8_SA(1, 0), a3, voffA);
            PG8_WAIT_V(8); PG8_WAIT_L(0); PG8_BAR; PG8_MMA(1, 0, At, B0); PG8_MMA(1, 1, At, B1); PG8_BAR; PG8_SCHED;
            } else {
            PG8_LDB(B0, 0, 0); PG8_SCHED; PG8_LDA(At, 0, 0); PG8_STAGE(PG8_SA(1, 1), a1 + hstepA, voffA);
            PG8_WAIT_L(8); PG8_BAR; PG8_WAIT_L(0); PG8_MMA(0, 0, At, B0); PG8_BAR; PG8_SCHED;
            PG8_LDB(B1, 0, 1); PG8_STAGE(PG8_SB(0, 0), b2, voffB);
            PG8_BAR; PG8_WAIT_L(0); PG8_MMA(0, 1, At, B1); PG8_BAR;
            PG8_LDA(At, 0, 1); PG8_STAGE(PG8_SA(0, 0), a2, voffA);
            PG8_BAR; PG8_WAIT_L(0); PG8_MMA(1, 0, At, B0); PG8_BAR; PG8_SCHED;
            PG8_STAGE(PG8_SB(0, 1), b2 + hstepB, voffB);
            PG8_WAIT_V(6); PG8_BAR; PG8_MMA(1, 1, At, B1); PG8_BAR;
            PG8_LDB(B0, 1, 0); PG8_SCHED; PG8_LDA(At, 1, 0); PG8_STAGE(PG8_SA(0, 1), a2 + hstepA, voffA);
            PG8_WAIT_L(8); PG8_BAR; PG8_WAIT_L(0); PG8_MMA(0, 0, At, B0); PG8_BAR; PG8_SCHED;
            PG8_LDB(B1, 1, 1); PG8_STAGE(PG8_SB(1, 0), b3, voffB);
            PG8_BAR; PG8_WAIT_L(0); PG8_MMA(0, 1, At, B1); PG8_BAR;
            PG8_LDA(At, 1, 1); PG8_STAGE(PG8_SA(1, 0), a3, voffA);
            PG8_BAR; PG8_WAIT_L(0); PG8_MMA(1, 0, At, B0); PG8_BAR; PG8_SCHED;
            PG8_STAGE(PG8_SB(1, 1), b3 + hstepB, voffB);
            PG8_WAIT_V(6); PG8_BAR; PG8_MMA(1, 1, At, B1); PG8_BAR;
            }
        }
        if constexpr (ALIGN_EPI) { if (wr == 0) PG8_BAR; }
        if constexpr (!Epi::AFTER_DRAIN) { E(acc, cur, wr, wc, fr, fq); S.done(cur); }
        if (!has_next) break;
#pragma unroll
        for (int a = 0; a < 2; ++a)
#pragma unroll
            for (int b = 0; b < 2; ++b)
#pragma unroll
                for (int m = 0; m < 4; ++m)
#pragma unroll
                    for (int n = 0; n < 2; ++n) acc[a][b][m][n] = (f32x4){0.f, 0.f, 0.f, 0.f};
        cur = nxt; cA = nA; cB = nB; ++ui;
        if constexpr (ALIGN_EPI) { if (wr == 1) PG8_BAR; }
    }
    PG8_WAIT_V(0);
    if constexpr (!ALIGN_EPI) { if (wr == 0) PG8_BAR; }
    PG8_BAR;
    if constexpr (Epi::AFTER_DRAIN) { E.fused(acc, cur, wr, wc, fr, fq, lds, wid, lane); S.done(cur); }
#undef PG8_SA
#undef PG8_SB
#undef PG8_STAGE
#undef PG8_LDA
#undef PG8_LDB
#undef PG8_MMA
#undef PG8_WAIT_V
#undef PG8_WAIT_L
#undef PG8_BAR
#undef PG8_SCHED
}
}
namespace pg8 {
__device__ __forceinline__ u32x4 pack8(const f32x4 a, const f32x4 b) { u32x4 w; w.x = cvt_pk_bf16(a[0], a[1]); w.y = cvt_pk_bf16(a[2], a[3]); w.z = cvt_pk_bf16(b[0], b[1]); w.w = cvt_pk_bf16(b[2], b[3]); return w; }
__device__ __forceinline__ void unpack8(const u32x4 w, f32x4& a, f32x4& b) {
    a[0] = __uint_as_float(w.x << 16); a[1] = __uint_as_float(w.x & 0xffff0000u); a[2] = __uint_as_float(w.y << 16); a[3] = __uint_as_float(w.y & 0xffff0000u);
    b[0] = __uint_as_float(w.z << 16); b[1] = __uint_as_float(w.z & 0xffff0000u); b[2] = __uint_as_float(w.w << 16); b[3] = __uint_as_float(w.w & 0xffff0000u); }
__device__ __forceinline__ float fsig(float x) { return __builtin_amdgcn_rcpf(1.f + __builtin_amdgcn_exp2f(-1.4426950408889634f * x)); }
__device__ __forceinline__ f32x4 fsig4(const f32x4 v) { f32x4 r; r[0] = fsig(v[0]); r[1] = fsig(v[1]); r[2] = fsig(v[2]); r[3] = fsig(v[3]); return r; }
__device__ __forceinline__ f32x4 gelu4(const f32x4 v) { const f32x2 a = gelu_pk((f32x2){v[0], v[1]}), b = gelu_pk((f32x2){v[2], v[3]}); return (f32x4){a.x, a.y, b.x, b.y}; }

struct SsmOrder {
    int G, c;
    __device__ bool next(int i, Unit& u) const { const int L = i * G + c; if (L >= 128) return false; u.pm = L; u.pn = L >> 2; return true; }
    __device__ __forceinline__ void a_ready(const Unit&) const {}
    __device__ __forceinline__ void done(const Unit&) const {}
};
struct MoeOrder {
    StaticOrder so; int pe0, pe1, pe2, pe3, pe4, pe5, pe6; int nN; int maxr;
    __device__ bool next(int i, Unit& u) const {
        if (i >= maxr || !so.next(i, u)) return false;
        const int r0 = u.pm * 256; const int e = (pe0 <= r0) + (pe1 <= r0) + (pe2 <= r0) + (pe3 <= r0) + (pe4 <= r0) + (pe5 <= r0) + (pe6 <= r0);
        u.pn += e * nN; return true; }
    __device__ __forceinline__ void a_ready(const Unit&) const {}
    __device__ __forceinline__ void done(const Unit&) const {}
};

struct MoeSplitOrder {
    int c, tile0, nsub, eoff;
    int pe0, pe1, pe2, pe3, pe4, pe5, pe6; int nN;
    __device__ bool next(int i, Unit& u) const {
        const int q = i * 256 + c; if (q >= nsub) return false;
        const int j = q / 6, ks = q - j * 6;
        u.pm = tile0 + (j >> 2);
        const int r0 = u.pm * 256; const int e = (pe0 <= r0) + (pe1 <= r0) + (pe2 <= r0) + (pe3 <= r0) + (pe4 <= r0) + (pe5 <= r0) + (pe6 <= r0);
        u.pn = (j & 3) + e * nN; u.ko = (ks < 4 ? ks * 8 : 32 + (ks - 4) * 6) * 128; u.nk = ks < 4 ? 8 : 6; u.aux = q; return true; }
    __device__ __forceinline__ void a_ready(const Unit&) const {}
    __device__ __forceinline__ void done(const Unit&) const {}
};

#define EPI_ROWS(u) const int rowb = (u).pm * BM + wr * 64 + fr
template <bool RS> struct EpiInProjT {
    static constexpr bool PERM = true, AFTER_DRAIN = false, MIDHOOK = false;
    bf16_t *Q, *Kb, *V, *AY, *G; const float *COS, *SIN; const PG8_LAS float* RSTD;
    __device__ __forceinline__ void operator()(const f32x4 (&acc_)[2][2][4][2], const Unit& u, int wr, int wc, int fr, int fq) const {
        EPI_ROWS(u); const int pn = u.pn;
#pragma unroll
        for (int ai = 0; ai < 2; ++ai)
#pragma unroll
            for (int m = 0; m < 4; ++m) {
                f32x4 c_[2][2];
                { const float rs = RS ? RSTD[ai * HALF + wr * 64 + m * 16 + fr] : 1.f;
#pragma unroll
                  for (int bj = 0; bj < 2; ++bj) { c_[bj][0] = RS ? acc_[ai][bj][m][0] * rs : acc_[ai][bj][m][0]; c_[bj][1] = RS ? acc_[ai][bj][m][1] * rs : acc_[ai][bj][m][1]; } }
                const int row = rowb + ai * HALF + m * 16, b = row >> 13, s = row & 8191;
                if (pn < 4) {
                    bf16_t* dst = pn < 2 ? Q : Kb; const int c = wc >> 1, jb = 16 * (wc & 1) + 4 * fq;
                    const f32x4 cs = *(const f32x4*)(COS + s * 32 + jb), sn = *(const f32x4*)(SIN + s * 32 + jb);
#pragma unroll
                    for (int bj = 0; bj < 2; ++bj) { const int h = 2 * (pn & 1) + bj; const f32x4 x1 = c_[bj][0], x2 = c_[bj][1];
                        *(u32x4*)(dst + ((((size_t)b * 4 + h) * 2 + c) * 8192 + s) * 64 + 32 * (wc & 1) + 8 * fq) = pack8(x1 * cs - x2 * sn, x2 * cs + x1 * sn); }
                } else if (pn < 6) {
#pragma unroll
                    for (int bj = 0; bj < 2; ++bj) { const int h = 2 * (pn - 4) + bj;
                        *(u32x4*)(V + (((size_t)b * 4 + h) * 8192 + s) * 128 + 32 * wc + 8 * fq) = pack8(c_[bj][0], c_[bj][1]); }
                } else if (pn < 8) {
#pragma unroll
                    for (int bj = 0; bj < 2; ++bj) { const int ucol = 256 * (pn - 6) + 128 * bj + 32 * wc + 8 * fq, g = ucol >> 4, hh0 = ucol & 15;
                        *(u32x4*)(AY + ((size_t)g * 1024 + b * 512 + (s >> 4)) * 512 + (s & 15) * 16 + hh0) = pack8(c_[bj][0], c_[bj][1]); }
                } else {
                    const int gcol = 128 * (pn - 8) + 32 * wc + 8 * fq; f32x4 rt[2], g1[2];
#pragma unroll
                    for (int n = 0; n < 2; ++n)
#pragma unroll
                        for (int e = 0; e < 4; ++e) { const float ea = __builtin_amdgcn_exp2f(-1.4426950408889634f * c_[0][n][e]), eb1 = 1.f + __builtin_amdgcn_exp2f(-1.4426950408889634f * c_[1][n][e]);
                            g1[n][e] = __builtin_amdgcn_rcpf(eb1); rt[n][e] = eb1 * __builtin_amdgcn_rcpf(1.f + ea); }
                    *(u32x4*)(G + (size_t)row * 2048 + gcol) = pack8(rt[0], rt[1]); *(u32x4*)(G + (size_t)row * 2048 + 1024 + gcol) = pack8(g1[0], g1[1]);
                }
            }
    }
};
typedef EpiInProjT<false> EpiInProj;
struct EpiXloc {
    static constexpr bool PERM = true, AFTER_DRAIN = false, MIDHOOK = false;
    float* XLOC;
    __device__ __forceinline__ void operator()(const f32x4 (&acc)[2][2][4][2], const Unit& u, int wr, int wc, int fr, int fq) const {
        EPI_ROWS(u);
#pragma unroll
        for (int ai = 0; ai < 2; ++ai)
#pragma unroll
            for (int m = 0; m < 4; ++m)
#pragma unroll
                for (int bj = 0; bj < 2; ++bj) { float* p = XLOC + (size_t)(rowb + ai * HALF + m * 16) * 256 + bj * HALF + 32 * wc + 8 * fq;
                    *(f32x4*)p = acc[ai][bj][m][0]; *(f32x4*)(p + 4) = acc[ai][bj][m][1]; }
    }
};
struct EpiY {
    static constexpr bool PERM = true, AFTER_DRAIN = false, MIDHOOK = false;
    bf16_t* SACT;
    __device__ __forceinline__ void operator()(const f32x4 (&acc)[2][2][4][2], const Unit& u, int wr, int wc, int fr, int fq) const {
        EPI_ROWS(u);
#pragma unroll
        for (int ai = 0; ai < 2; ++ai)
#pragma unroll
            for (int m = 0; m < 4; ++m) { const int R = rowb + ai * HALF + m * 16, g = R >> 10, bc = R & 1023;
#pragma unroll
                for (int bj = 0; bj < 2; ++bj) { const int col0 = bj * HALF + 32 * wc + 8 * fq, i = col0 >> 4, hh0 = col0 & 15;
                    *(u32x4*)(SACT + (size_t)(bc * 16 + i) * 512 + g * 16 + hh0) = pack8(gelu4(acc[ai][bj][m][0]), gelu4(acc[ai][bj][m][1])); } }
    }
};
struct EpiGlu {
    static constexpr bool PERM = true, AFTER_DRAIN = false, MIDHOOK = false;
    const bf16_t* SACT; bf16_t* AS2;
    __device__ __forceinline__ void operator()(const f32x4 (&acc)[2][2][4][2], const Unit& u, int wr, int wc, int fr, int fq) const {
        EPI_ROWS(u);
#pragma unroll
        for (int ai = 0; ai < 2; ++ai)
#pragma unroll
            for (int m = 0; m < 4; ++m) { const int row = rowb + ai * HALF + m * 16;
#pragma unroll
                for (int bj = 0; bj < 2; ++bj) { const int col0 = u.pn * BM + bj * HALF + 32 * wc + 8 * fq;
                    f32x4 s0, s1; unpack8(*(const u32x4*)(SACT + (size_t)row * 512 + col0), s0, s1);
                    *(u32x4*)(AS2 + (size_t)row * 1024 + 512 + col0) = pack8(s0 * fsig4(acc[ai][bj][m][0]), s1 * fsig4(acc[ai][bj][m][1])); } }
    }
};
struct EpiBranch {
    static constexpr bool PERM = true, AFTER_DRAIN = false, MIDHOOK = true;
    const bf16_t* G; bf16_t* MERGED;
    __device__ __forceinline__ void mid(f32x4 (&acc)[2][2][4][2], const Unit& u, int wr, int wc, int fr, int fq) const {
        asm volatile("" : "+v"(fr), "+v"(fq));
        EPI_ROWS(u);
#pragma unroll
        for (int ai = 0; ai < 2; ++ai)
#pragma unroll
            for (int m = 0; m < 4; ++m) { const int row = rowb + ai * HALF + m * 16;
#pragma unroll
                for (int bj = 0; bj < 2; ++bj) { const int col0 = u.pn * BM + bj * HALF + 32 * wc + 8 * fq;
                    f32x4 a0, a1; unpack8(*(const u32x4*)(G + (size_t)row * 2048 + col0), a0, a1);
#pragma unroll
                    for (int e = 0; e < 4; ++e) { acc[ai][bj][m][0][e] *= a0[e]; acc[ai][bj][m][1][e] *= a1[e]; } }
                asm volatile("" ::: "memory"); }
    }
    __device__ __forceinline__ void operator()(const f32x4 (&acc)[2][2][4][2], const Unit& u, int wr, int wc, int fr, int fq) const {
        EPI_ROWS(u);
#pragma unroll
        for (int ai = 0; ai < 2; ++ai)
#pragma unroll
            for (int m = 0; m < 4; ++m) { const int row = rowb + ai * HALF + m * 16;
#pragma unroll
                for (int bj = 0; bj < 2; ++bj) { const int col0 = u.pn * BM + bj * HALF + 32 * wc + 8 * fq;
                    f32x4 b0, b1; unpack8(*(const u32x4*)(G + (size_t)row * 2048 + 1024 + col0), b0, b1);
                    *(u32x4*)(MERGED + (size_t)row * 1024 + col0) = pack8(acc[ai][bj][m][0] * b0, acc[ai][bj][m][1] * b1); } }
    }
};
struct EpiRes {
    static constexpr bool PERM = true, AFTER_DRAIN = false, MIDHOOK = false;
    const float* SRC; float* X;
    __device__ __forceinline__ void operator()(const f32x4 (&acc)[2][2][4][2], const Unit& u, int wr, int wc, int fr, int fq) const {
        EPI_ROWS(u);
#pragma unroll
        for (int ai = 0; ai < 2; ++ai)
#pragma unroll
            for (int m = 0; m < 4; ++m) { const int row = rowb + ai * HALF + m * 16;
#pragma unroll
                for (int bj = 0; bj < 2; ++bj) { const size_t o = (size_t)row * 1024 + u.pn * BM + bj * HALF + 32 * wc + 8 * fq;
                    const f32x4 s0 = *(const f32x4*)(SRC + o), s1 = *(const f32x4*)(SRC + o + 4);
                    *(f32x4*)(X + o) = s0 + acc[ai][bj][m][0]; *(f32x4*)(X + o + 4) = s1 + acc[ai][bj][m][1]; } }
    }
};
template <bool RS> struct EpiSwigluT {
    static constexpr bool PERM = true, AFTER_DRAIN = false, MIDHOOK = false;
    bf16_t* H; int nN; const PG8_LAS float* RSTD;
    __device__ __forceinline__ void operator()(const f32x4 (&acc)[2][2][4][2], const Unit& u, int wr, int wc, int fr, int fq) const {
        EPI_ROWS(u); const int col0 = 128 * (u.pn % nN) + 32 * wc + 8 * fq;
#pragma unroll
        for (int ai = 0; ai < 2; ++ai)
#pragma unroll
            for (int m = 0; m < 4; ++m) { const int row = rowb + ai * HALF + m * 16;
                const float rs = RS ? RSTD[ai * HALF + wr * 64 + m * 16 + fr] : 1.f;
                const f32x4 a0 = RS ? acc[ai][0][m][0] * rs : acc[ai][0][m][0], a1 = RS ? acc[ai][0][m][1] * rs : acc[ai][0][m][1];
                const f32x4 b0 = RS ? acc[ai][1][m][0] * rs : acc[ai][1][m][0], b1 = RS ? acc[ai][1][m][1] * rs : acc[ai][1][m][1];
                *(u32x4*)(H + (size_t)row * 2816 + col0) = pack8(a0 * fsig4(a0) * b0, a1 * fsig4(a1) * b1); }
    }
};
typedef EpiSwigluT<false> EpiSwiglu;
struct EpiResN {
    static constexpr bool PERM = true, AFTER_DRAIN = false, MIDHOOK = false;
    const float* SRC; float* X; bf16_t* XN; float* PS;
    __device__ __forceinline__ void operator()(const f32x4 (&acc)[2][2][4][2], const Unit& u, int wr, int wc, int fr, int fq) const {
        EPI_ROWS(u);
#pragma unroll
        for (int ai = 0; ai < 2; ++ai)
#pragma unroll
            for (int m = 0; m < 4; ++m) { const int row = rowb + ai * HALF + m * 16; float ss = 0.f;
#pragma unroll
                for (int bj = 0; bj < 2; ++bj) { const size_t o = (size_t)row * 1024 + u.pn * BM + bj * HALF + 32 * wc + 8 * fq;
                    const f32x4 s0 = *(const f32x4*)(SRC + o), s1 = *(const f32x4*)(SRC + o + 4);
                    const f32x4 y0 = s0 + acc[ai][bj][m][0], y1 = s1 + acc[ai][bj][m][1];
                    *(f32x4*)(X + o) = y0; *(f32x4*)(X + o + 4) = y1; *(u32x4*)(XN + o) = pack8(y0, y1);
                    ss += (y0[0] * y0[0] + y0[1] * y0[1]) + (y0[2] * y0[2] + y0[3] * y0[3]) + (y1[0] * y1[0] + y1[1] * y1[1]) + (y1[2] * y1[2] + y1[3] * y1[3]); }
                { auto r = __builtin_amdgcn_permlane16_swap(__float_as_uint(ss), __float_as_uint(ss), false, false); ss = __uint_as_float(r[0]) + __uint_as_float(r[1]); }
                { auto r = __builtin_amdgcn_permlane32_swap(__float_as_uint(ss), __float_as_uint(ss), false, false); ss = __uint_as_float(r[0]) + __uint_as_float(r[1]); }
                if (fq == 0) PS[(size_t)(u.pn * 4 + wc) * 16384 + row] = ss; }
    }
};
struct EpiMoeDown {
    static constexpr bool PERM = true, AFTER_DRAIN = false, MIDHOOK = false;
    bf16_t* YS;
    __device__ __forceinline__ void operator()(const f32x4 (&acc)[2][2][4][2], const Unit& u, int wr, int wc, int fr, int fq) const {
        EPI_ROWS(u);
#pragma unroll
        for (int ai = 0; ai < 2; ++ai)
#pragma unroll
            for (int m = 0; m < 4; ++m) { const int row = rowb + ai * HALF + m * 16;
#pragma unroll
                for (int bj = 0; bj < 2; ++bj)
                    *(u32x4*)(YS + (size_t)row * 1024 + (u.pn & 3) * BM + bj * HALF + 32 * wc + 8 * fq) = pack8(acc[ai][bj][m][0], acc[ai][bj][m][1]); }
    }
};
struct EpiMoeDownPart {
    static constexpr bool PERM = true, AFTER_DRAIN = false, MIDHOOK = false;
    float* P;
    __device__ __forceinline__ void operator()(const f32x4 (&acc)[2][2][4][2], const Unit& u, int wr, int wc, int fr, int fq) const {
        float* base = P + (size_t)u.aux * 65536 + (size_t)(wr * 64 + fr) * 256 + 32 * wc + 8 * fq;
#pragma unroll
        for (int ai = 0; ai < 2; ++ai)
#pragma unroll
            for (int m = 0; m < 4; ++m)
#pragma unroll
                for (int bj = 0; bj < 2; ++bj) { float* d = base + (ai * HALF + m * 16) * 256 + bj * HALF;
                    *(f32x4*)d = acc[ai][bj][m][0]; *(f32x4*)(d + 4) = acc[ai][bj][m][1]; }
    }
};
#undef EPI_ROWS
}
#define XB_TMO      128
#define XB_XCNT(j)  (256  + 64 * (j))
#define XB_XSUB(j)  (1280 + 64 * (j))
#define XB_XGEN(j)  (2304 + 64 * (j))
#define XB_TOP      3328
#define XB_TOPGEN   3392
#define XCD_BAR_WORDS 3456
#define XB_SPIN_CAP (1u << 18)

__device__ __forceinline__ unsigned xb_ld(unsigned* p)              { return __hip_atomic_load(p, __ATOMIC_RELAXED, __HIP_MEMORY_SCOPE_AGENT); }
__device__ __forceinline__ unsigned xb_add(unsigned* p, unsigned v) { return __hip_atomic_fetch_add(p, v, __ATOMIC_RELAXED, __HIP_MEMORY_SCOPE_AGENT); }
__device__ __forceinline__ unsigned xb_xcc_id() { return (unsigned)__builtin_amdgcn_s_getreg((3 << 11) | 20) & 0xFu; }
#define XB_SPIN(cond, bar) do { unsigned _sp = 0; while (cond) { __builtin_amdgcn_s_sleep(1); \
    if ((++_sp & 255u) == 0u) { if (xb_ld(&(bar)[XB_TMO])) break; if (_sp > XB_SPIN_CAP) { atomicAdd(&(bar)[XB_TMO], 1u); break; } } } } while (0)

struct XcdBarrier {
    unsigned* bar; unsigned x;
    volatile LAS unsigned* st;
};

__device__ __forceinline__ XcdBarrier xcd_barrier_post(unsigned* bar, volatile LAS unsigned* st) {
    XcdBarrier b; b.bar = bar; b.x = xb_xcc_id(); b.st = st;
    if (threadIdx.x == 0) (void)xb_add(&bar[XB_XCNT(b.x)], 1u);
    return b;
}
__device__ __forceinline__ void xcd_barrier_complete(unsigned* bar, unsigned x, unsigned& nloc, unsigned& nx) {
    const unsigned G = gridDim.x * gridDim.y * gridDim.z;
    unsigned sum, cnt, mine, sp = 0u;
    for (;;) {
        sum = 0u; cnt = 0u; mine = 0u;
#pragma unroll
        for (unsigned j = 0; j < 16; ++j) { const unsigned c = xb_ld(&bar[XB_XCNT(j)]); sum += c; cnt += (c > 0u) ? 1u : 0u; mine = (j == x) ? c : mine; }
        if (sum == G) break;
        __builtin_amdgcn_s_sleep(1);
        if ((++sp & 255u) == 0u) { if (xb_ld(&bar[XB_TMO])) break; if (sp > XB_SPIN_CAP) { atomicAdd(&bar[XB_TMO], 1u); break; } }
    }
    nloc = mine > 0u ? mine : 1u; nx = cnt > 0u ? cnt : 1u;
}

__device__ __forceinline__ void xcd_barrier(const XcdBarrier& b) {
    asm volatile("s_waitcnt vmcnt(0)" ::: "memory");
    __syncthreads();
    if (threadIdx.x == 0) {
        unsigned* bar = b.bar;
        __builtin_amdgcn_s_waitcnt(0);
        unsigned nloc = b.st[0], nx = b.st[1];
        if (nloc == 0u) { xcd_barrier_complete(bar, b.x, nloc, nx); b.st[0] = nloc; b.st[1] = nx; }
        const unsigned old = xb_add(&bar[XB_XSUB(b.x)], 1u);
        const unsigned gen = old / nloc;
        if (old + 1u == (gen + 1u) * nloc) {
            __builtin_amdgcn_fence(__ATOMIC_RELEASE, "agent");
            asm volatile("s_waitcnt vmcnt(0)" ::: "memory");
            const unsigned og = xb_add(&bar[XB_TOP], 1u);
            const unsigned tg = og / nx;
            if (og + 1u == (tg + 1u) * nx) xb_add(&bar[XB_TOPGEN], 1u);
            else XB_SPIN(xb_ld(&bar[XB_TOPGEN]) == tg, bar);
            __builtin_amdgcn_fence(__ATOMIC_ACQUIRE, "agent");
            xb_add(&bar[XB_XGEN(b.x)], 1u);
            asm volatile("s_waitcnt vmcnt(0)" ::: "memory");
        } else {
            XB_SPIN(xb_ld(&bar[XB_XGEN(b.x)]) == gen, bar);
            __builtin_amdgcn_fence(__ATOMIC_ACQUIRE, "agent");
            asm volatile("s_waitcnt vmcnt(0)" ::: "memory");
        }
    }
    __syncthreads();
}

namespace att {
using bf16x8 = __attribute__((ext_vector_type(8))) short;
using s16x4  = __attribute__((ext_vector_type(4))) short;
using f32x16 = __attribute__((ext_vector_type(16))) float;
using u32x4  = __attribute__((ext_vector_type(4))) unsigned;
constexpr int NW = 8, QBLK = 32, KVBLK = 64;
constexpr float SCALE = 0.125f;
constexpr int SHM_V = KVBLK * 128 * 2, SHM_K = KVBLK * 64 * 2, SHM_ATTN = 4 * SHM_V + 4 * SHM_K + NW * 64 * 4;
#define KSWZ64(row, colB) ((row) * 128 + ((colB) ^ ((((row) >> 1) & 7) << 4)))
#define SBAR() __builtin_amdgcn_sched_barrier(0)
__device__ __forceinline__ int crow(int r, int hi) { return (r & 3) + 8 * (r >> 2) + 4 * hi; }
typedef __bf16 bf16x2_cv __attribute__((ext_vector_type(2))); typedef float f32x2_cv __attribute__((ext_vector_type(2)));
__device__ __forceinline__ unsigned cvtpk(float lo, float hi) { const bf16x2_cv r = __builtin_convertvector((f32x2_cv){lo, hi}, bf16x2_cv); return __builtin_bit_cast(unsigned, r); }
__device__ __forceinline__ void partialSM(f32x16& p0, f32x16& p1, float mb) {
  constexpr float C = SCALE * 1.4426950408889634f;
#pragma unroll
  for (int r = 0; r < 16; ++r) p0[r] = fmaf(p0[r], C, -mb);
#pragma unroll
  for (int r = 0; r < 16; ++r) p1[r] = fmaf(p1[r], C, -mb);
#pragma unroll
  for (int r = 0; r < 16; ++r) p0[r] = __builtin_amdgcn_exp2f(p0[r]);
}
__device__ __forceinline__ void finishSM(f32x16& p0, f32x16& p1, float& l_reg, bf16x8& pa0, bf16x8& pa1, bf16x8& pa2, bf16x8& pa3) {
#pragma unroll
  for (int r = 0; r < 16; ++r) p1[r] = __builtin_amdgcn_exp2f(p1[r]);
  typedef __bf16 bf2_t __attribute__((ext_vector_type(2)));
  const bf2_t one2 = {(__bf16)1.0f, (__bf16)1.0f};
  float ps0 = 0.f, ps1 = 0.f;
#define DOT1(acc, w) acc = __builtin_amdgcn_fdot2_f32_bf16(__builtin_bit_cast(bf2_t, (unsigned)(w)), one2, acc, false)
#define PK4(P, BASE, OUT) do { unsigned a0 = cvtpk(P[BASE + 0], P[BASE + 1]), a1 = cvtpk(P[BASE + 2], P[BASE + 3]);   \
    unsigned b0 = cvtpk(P[BASE + 4], P[BASE + 5]), b1 = cvtpk(P[BASE + 6], P[BASE + 7]);                              \
    DOT1(ps0, a0); DOT1(ps1, a1); DOT1(ps0, b0); DOT1(ps1, b1);                                                       \
    u32x4 w = {a0, a1, b0, b1}; OUT = *reinterpret_cast<bf16x8*>(&w); } while (0)
  PK4(p0, 0, pa0); PK4(p0, 8, pa1); PK4(p1, 0, pa2); PK4(p1, 8, pa3);
  l_reg += ps0 + ps1;
#undef DOT1
#undef PK4
}
template <int OFF> __device__ __forceinline__ bf16x8 k_read(int ka) { bf16x8 r; asm volatile("ds_read_b128 %0, %1 offset:%2" : "=&v"(r) : "v"(ka), "i"(OFF) : "memory"); return r; }
__device__ __forceinline__ void qkt(f32x16& p0, f32x16& p1, const char* Ks, const bf16x8* qr, int r32, int hi) {
  p0 = f32x16{}; p1 = f32x16{};
  const int sw = (r32 >> 1) & 7, base = (int)(uintptr_t)Ks + r32 * 128;
  const int a0 = base + (((0 + hi) ^ sw) << 4), a1 = base + (((2 + hi) ^ sw) << 4), a2 = base + (((4 + hi) ^ sw) << 4), a3 = base + (((6 + hi) ^ sw) << 4);
  const bf16x8 k00 = k_read<0>(a0), k01 = k_read<4096>(a0), k10 = k_read<0>(a1), k11 = k_read<4096>(a1), k20 = k_read<0>(a2), k21 = k_read<4096>(a2), k30 = k_read<0>(a3), k31 = k_read<4096>(a3);
  asm volatile("s_waitcnt lgkmcnt(0)" ::: "memory"); SBAR();
  p0 = __builtin_amdgcn_mfma_f32_32x32x16_bf16(k00, qr[0], p0, 0, 0, 0); p1 = __builtin_amdgcn_mfma_f32_32x32x16_bf16(k01, qr[0], p1, 0, 0, 0);
  p0 = __builtin_amdgcn_mfma_f32_32x32x16_bf16(k10, qr[1], p0, 0, 0, 0); p1 = __builtin_amdgcn_mfma_f32_32x32x16_bf16(k11, qr[1], p1, 0, 0, 0);
  p0 = __builtin_amdgcn_mfma_f32_32x32x16_bf16(k20, qr[2], p0, 0, 0, 0); p1 = __builtin_amdgcn_mfma_f32_32x32x16_bf16(k21, qr[2], p1, 0, 0, 0);
  p0 = __builtin_amdgcn_mfma_f32_32x32x16_bf16(k30, qr[3], p0, 0, 0, 0); p1 = __builtin_amdgcn_mfma_f32_32x32x16_bf16(k31, qr[3], p1, 0, 0, 0);
}
__device__ __forceinline__ int v_st(int k, int c) { const int kk = k; return ((kk >> 3) * 4 + (c >> 5)) * 512 + ((kk & 7) * 32 + (c & 31)) * 2; }
__device__ __forceinline__ int v_rd_base(int lane) { return ((lane & 3) << 3) | (((lane >> 2) & 3) << 6) | (((lane >> 4) & 1) << 5) | (((lane >> 5) & 1) << 8); }
constexpr int v_rd_off(int d0, int ks, int half) { return d0 * 512 + ks * 4096 + half * 2048; }
template <int OFF> __device__ __forceinline__ s16x4 tr_read(int vb) {
  s16x4 r; asm volatile("ds_read_b64_tr_b16 %0, %1 offset:%2" : "=&v"(r) : "v"(vb), "i"(OFF) : "memory"); return r;
}
template <int D0> __device__ __forceinline__ void pv_one(f32x16& od, int vb, bf16x8 pa0, bf16x8 pa1, bf16x8 pa2, bf16x8 pa3) {
  const s16x4 l0 = tr_read<v_rd_off(D0, 0, 0)>(vb), h0 = tr_read<v_rd_off(D0, 0, 1)>(vb), l1 = tr_read<v_rd_off(D0, 1, 0)>(vb), h1 = tr_read<v_rd_off(D0, 1, 1)>(vb);
  const s16x4 l2 = tr_read<v_rd_off(D0, 2, 0)>(vb), h2 = tr_read<v_rd_off(D0, 2, 1)>(vb), l3 = tr_read<v_rd_off(D0, 3, 0)>(vb), h3 = tr_read<v_rd_off(D0, 3, 1)>(vb);
  asm volatile("s_waitcnt lgkmcnt(0)" ::: "memory"); SBAR();
#define PK(L, H) (bf16x8){L[0], L[1], L[2], L[3], H[0], H[1], H[2], H[3]}
  od = __builtin_amdgcn_mfma_f32_32x32x16_bf16(pa0, PK(l0, h0), od, 0, 0, 0);
  od = __builtin_amdgcn_mfma_f32_32x32x16_bf16(pa1, PK(l1, h1), od, 0, 0, 0);
  od = __builtin_amdgcn_mfma_f32_32x32x16_bf16(pa2, PK(l2, h2), od, 0, 0, 0);
  od = __builtin_amdgcn_mfma_f32_32x32x16_bf16(pa3, PK(l3, h3), od, 0, 0, 0);
#undef PK
}
__device__ __forceinline__ void pv_d0(f32x16* o, int vb, bf16x8 pa0, bf16x8 pa1, bf16x8 pa2, bf16x8 pa3) {
  pv_one<0>(o[0], vb, pa0, pa1, pa2, pa3); pv_one<1>(o[1], vb, pa0, pa1, pa2, pa3); pv_one<2>(o[2], vb, pa0, pa1, pa2, pa3); pv_one<3>(o[3], vb, pa0, pa1, pa2, pa3);
}

__device__ __forceinline__ void diff_attn_unit(const unsigned short* __restrict__ Qh, const unsigned short* __restrict__ Kh, const unsigned short* __restrict__ Vh, int i0,
                                               const unsigned* __restrict__ kmax2, float* __restrict__ O1s, unsigned short* __restrict__ OUT, const float* __restrict__ subln, float lam, float oml, char* lds) {
  constexpr int SEQL = 8192, NT = SEQL / KVBLK;
  char* V_lds = lds; char* K_lds = lds + 4 * SHM_V;
  for (int c = 0; c < 2; ++c) {
    int tid_l = threadIdx.x; asm volatile("" : "+v"(tid_l));
    const int tid = tid_l, wid = __builtin_amdgcn_readfirstlane(tid >> 6), lane = tid & 63, r32 = lane & 31, hi = lane >> 5;
    const int sr = tid >> 4, sc = (tid & 15) * 8, vst0 = v_st(sr, sc), vst1 = v_st(32 + sr, sc);
    const int kr = tid >> 3, kcb = (tid & 7) * 16, kst = KSWZ64(kr, kcb);
    const int vb0 = (int)(uintptr_t)V_lds + v_rd_base(lane);
    const unsigned short* Kc = Kh + (size_t)c * SEQL * 64;
    float l_reg = 0; f32x16 o[4] = {}; bf16x8 qr[4];
    const unsigned short* Qw = Qh + (size_t)c * SEQL * 64 + (size_t)(i0 + wid * QBLK + r32) * 64 + hi * 8;
#pragma unroll
    for (int d0 = 0; d0 < 4; ++d0) qr[d0] = *reinterpret_cast<const bf16x8*>(Qw + d0 * 16);
    float mb;
    { float q2 = 0.f;
#pragma unroll
      for (int d0 = 0; d0 < 4; ++d0)
#pragma unroll
        for (int e = 0; e < 8; ++e) { const float qv = __uint_as_float(((unsigned)(unsigned short)qr[d0][e]) << 16); q2 = fmaf(qv, qv, q2); }
      { auto rr = __builtin_amdgcn_permlane32_swap(__float_as_uint(q2), __float_as_uint(q2), false, false); q2 = __uint_as_float(rr[0]) + __uint_as_float(rr[1]); }
      mb = sqrtf(q2 * __uint_as_float(kmax2[c])) * (SCALE * 1.4426950408889634f); }
    struct { bf16x8 vs0, vs1, ks0; } sr_[3];
    const unsigned voV = (unsigned)(sr * 128 + sc) * 2u, voV1 = voV + 8192u, voK = (unsigned)(kr * 64 + (tid & 7) * 8) * 2u;
    const __amdgpu_buffer_rsrc_t rV = __builtin_amdgcn_make_buffer_rsrc((void*)Vh, 0, 0x7fffffff, 0x00020000), rK = __builtin_amdgcn_make_buffer_rsrc((void*)Kc, 0, 0x7fffffff, 0x00020000);
#define SLOAD(i, k0) do { const u32x4 a_ = __builtin_amdgcn_raw_buffer_load_b128(rV, voV, (k0) * 256, 0), b_ = __builtin_amdgcn_raw_buffer_load_b128(rV, voV1, (k0) * 256, 0), \
        c_ = __builtin_amdgcn_raw_buffer_load_b128(rK, voK, (k0) * 128, 0); \
    sr_[i].vs0 = __builtin_bit_cast(bf16x8, a_); sr_[i].vs1 = __builtin_bit_cast(bf16x8, b_); sr_[i].ks0 = __builtin_bit_cast(bf16x8, c_); } while (0)
#define SWRITE(b, i) do { *(bf16x8*)(V_lds + (b) * SHM_V + vst0) = sr_[i].vs0; *(bf16x8*)(V_lds + (b) * SHM_V + vst1) = sr_[i].vs1; \
    *(bf16x8*)(K_lds + (b) * SHM_K + kst) = sr_[i].ks0; } while (0)
#define LBAR() do { asm volatile("s_waitcnt lgkmcnt(0)" ::: "memory"); __builtin_amdgcn_s_barrier(); asm volatile("" ::: "memory"); } while (0)
    f32x16 pA0, pA1, pB0, pB1; bf16x8 pa0, pa1, pa2, pa3;
    __syncthreads();
    SLOAD(0, 0); SLOAD(1, KVBLK); SLOAD(2, 2 * KVBLK); SWRITE(0, 0); SWRITE(1, 1); SWRITE(2, 2); __syncthreads();
    qkt(pA0, pA1, K_lds, qr, r32, hi); partialSM(pA0, pA1, mb);
    if (wid >= 4) { __builtin_amdgcn_s_setprio(1); LBAR(); }
    for (int j = 1; j + 1 < NT; j += 2) {
      SLOAD(0, (j + 2) * KVBLK);
      SBAR(); qkt(pB0, pB1, K_lds + (j & 3) * SHM_K, qr, r32, hi);
      finishSM(pA0, pA1, l_reg, pa0, pa1, pa2, pa3); SBAR();
      LBAR();
      pv_d0(o, vb0 + ((j - 1) & 3) * SHM_V, pa0, pa1, pa2, pa3); SBAR(); partialSM(pB0, pB1, mb); SBAR();
      SWRITE((j + 2) & 3, 0);
      LBAR();
      if (j + 3 < NT) SLOAD(0, (j + 3) * KVBLK);
      SBAR(); qkt(pA0, pA1, K_lds + ((j + 1) & 3) * SHM_K, qr, r32, hi);
      finishSM(pB0, pB1, l_reg, pa0, pa1, pa2, pa3); SBAR();
      LBAR();
      pv_d0(o, vb0 + (j & 3) * SHM_V, pa0, pa1, pa2, pa3); SBAR(); partialSM(pA0, pA1, mb); SBAR();
      if (j + 3 < NT) SWRITE((j + 3) & 3, 0);
      LBAR();
    }
    SBAR(); qkt(pB0, pB1, K_lds + ((NT - 1) & 3) * SHM_K, qr, r32, hi);
    finishSM(pA0, pA1, l_reg, pa0, pa1, pa2, pa3); SBAR();
    pv_d0(o, vb0 + ((NT - 2) & 3) * SHM_V, pa0, pa1, pa2, pa3); partialSM(pB0, pB1, mb);
    finishSM(pB0, pB1, l_reg, pa0, pa1, pa2, pa3); SBAR();
    pv_d0(o, vb0 + ((NT - 1) & 3) * SHM_V, pa0, pa1, pa2, pa3);
    if (wid < 4) LBAR();
    __builtin_amdgcn_s_setprio(0);
    { auto rr = __builtin_amdgcn_permlane32_swap(__float_as_uint(l_reg), __float_as_uint(l_reg), false, false); l_reg = __uint_as_float(rr[0]) + __uint_as_float(rr[1]); }
    { int t2 = threadIdx.x; asm volatile("" : "+v"(t2));
      const int wid2 = __builtin_amdgcn_readfirstlane(t2 >> 6), lane2 = t2 & 63, r322 = lane2 & 31, hi2 = lane2 >> 5;
      float* li_l = (float*)(lds + 4 * SHM_V + 4 * SHM_K) + wid2 * 64;
      if (hi2 == 0) li_l[r322] = l_reg; asm volatile("s_waitcnt lgkmcnt(0)" ::: "memory");
      float* O1w = O1s + (size_t)c * 32768 + (size_t)wid2 * 4096 + lane2;
#pragma unroll
      for (int r = 0; r < 16; ++r) { const float rl = __builtin_amdgcn_rcpf(li_l[crow(r, hi2)]);
#pragma unroll
        for (int d0 = 0; d0 < 4; ++d0) O1w[(d0 * 16 + r) * 64] = o[d0][r] * rl; } }
#undef SLOAD
#undef SWRITE
#undef LBAR
  }
  {
    int t3 = threadIdx.x; asm volatile("" : "+v"(t3));
    const int wid = __builtin_amdgcn_readfirstlane(t3 >> 6), lane = t3 & 63, r32 = lane & 31, hi = lane >> 5;
    const float* Ow = O1s + (size_t)wid * 4096 + lane;
    float sg[4];
#pragma unroll
    for (int d0 = 0; d0 < 4; ++d0) sg[d0] = subln[d0 * 32 + r32] * oml;
#pragma unroll 4
    for (int r = 0; r < 16; ++r) {
      float v[4], ss = 0.f;
#pragma unroll
      for (int d0 = 0; d0 < 4; ++d0) { v[d0] = Ow[(d0 * 16 + r) * 64] - lam * Ow[32768 + (d0 * 16 + r) * 64]; ss += v[d0] * v[d0]; }
#pragma unroll
      for (int of = 1; of < 32; of <<= 1) ss += __int_as_float(__builtin_amdgcn_ds_bpermute((lane ^ of) << 2, __float_as_int(ss)));
      const float rstd = rsqrtf(ss * (1.f / 128.f) + 1e-6f);
      unsigned short* op = OUT + (size_t)(wid * QBLK + crow(r, hi)) * 1024 + r32;
#pragma unroll
      for (int d0 = 0; d0 < 4; ++d0) { const float y = v[d0] * rstd * sg[d0]; unsigned u = __float_as_uint(y); op[d0 * 32] = (unsigned short)((u + 0x7fffu + ((u >> 16) & 1u)) >> 16); }
    }
  }
}
}
constexpr int NWAVES = 8;
constexpr int RING_OFF = 0, RING_BYTES = 131072;
constexpr int LDSCTL_OFF = RING_BYTES, MISC_OFF = LDSCTL_OFF + 320;
constexpr int LDS_BYTES = 147456;
constexpr int RSTD_OFF = LDSCTL_OFF + 8192;
constexpr int CW_BAR = 4096;
constexpr int CW_KMAX = 8448;
constexpr int CW_CNT = 8192;
constexpr int CW_BLKCNT = 10240;
constexpr int CW_SPLT = 9216;
constexpr size_t CTL_ZERO_BYTES = 64 * 1024;
constexpr int PH_PRO = 0, PH_L0 = 1, PH_PER_LAYER = 12, PH_FINAL = PH_L0 + DEPTH * PH_PER_LAYER, PH_END = PH_FINAL + 1;
enum { P_NORM1 = 0, P_INPROJ, P_XLOC, P_SCAN, P_MIX, P_GLU, P_BRANCH, P_OUT, P_NORM2, P_ASSIGN, P_UP, P_DOWN };

struct Args {
    const float* in[25]; float* out; unsigned char* ws;
    double inv_freq[32];
    int ph_lo, ph_hi, sub, pad;
};

typedef const __attribute__((address_space(4))) Args* ArgsP;
__device__ __forceinline__ ArgsP get_args() { ArgsP p = (ArgsP)__builtin_amdgcn_kernarg_segment_ptr(); asm volatile("" : "+s"(p)); return p; }
#define LDS_WAIT() asm volatile("s_waitcnt lgkmcnt(0)" ::: "memory")
#define VM_WAIT() asm volatile("s_waitcnt vmcnt(0)" ::: "memory")
typedef unsigned v4u __attribute__((ext_vector_type(4)));
__device__ __forceinline__ unsigned pk2(float lo, float hi) { return (unsigned)f2bf(lo) | ((unsigned)f2bf(hi) << 16); }

template <class RowMap>
__device__ __forceinline__ void transpose_item(const float* __restrict__ W, int N, bf16* __restrict__ WT, int ldt, int koff, LAS float* scr, int item, int lane, const RowMap& rm, const float* __restrict__ gk = nullptr) {
    const int nblk = N / 32, kb = item / nblk, nb = item % nblk, k0 = 64 * kb, n0 = 32 * nb;
    float wv[32];
    const float* wp = W + (size_t)(k0 + (lane >> 5)) * N + n0 + (lane & 31);
#pragma unroll
    for (int i = 0; i < 32; ++i) wv[i] = wp[(size_t)(2 * i) * N];
#pragma unroll
    for (int i = 0; i < 32; ++i) scr[(2 * i + (lane >> 5)) * 33 + (lane & 31)] = wv[i];
    LDS_WAIT(); asm volatile("" ::: "memory");
    const int c = lane & 7;
    f32x4 g0 = {1.f, 1.f, 1.f, 1.f}, g1 = g0;
    if (gk) { g0 = *(const f32x4*)(gk + k0 + 8 * c); g1 = *(const f32x4*)(gk + k0 + 8 * c + 4); }
#pragma unroll
    for (int j = 0; j < 4; ++j) { const int n = (lane >> 3) + 8 * j; const LAS float* s = scr + (8 * c) * 33 + n;
        v4u o; o.x = pk2(s[0 * 33] * g0.x, s[1 * 33] * g0.y); o.y = pk2(s[2 * 33] * g0.z, s[3 * 33] * g0.w); o.z = pk2(s[4 * 33] * g1.x, s[5 * 33] * g1.y); o.w = pk2(s[6 * 33] * g1.z, s[7 * 33] * g1.w);
        *(v4u*)(WT + (size_t)rm(n0 + n) * ldt + koff + k0 + 8 * c) = o; }
    LDS_WAIT(); asm volatile("" ::: "memory");
}
struct RmId { __device__ __forceinline__ int operator()(int n) const { return n; } };
struct RmInProj { __device__ __forceinline__ int operator()(int n) const {
    if (n < 1024) return (n & ~63) + qk_pos(n & 63);
    if (n < 2048) return n;
    const int j = n - 2048, k = j & 1023; return 2048 + (k >> 7) * 256 + (j >= 1024 ? 128 : 0) + (k & 127); } };
struct RmGlu13 { int half; __device__ __forceinline__ int operator()(int n) const { return (n >> 7) * 256 + half * 128 + (n & 127); } };
struct TItem { const float* src; bf16* dst; int N, ldt, koff, map, k0, n0; };
__device__ __forceinline__ void t_setkn(TItem& t, int item) { const int nblk = t.N / 32; t.k0 = 64 * (item / nblk); t.n0 = 32 * (item % nblk); }
__device__ __forceinline__ void t_load(const TItem& t, int lane, float (&wv)[32]) {
    const float* wp = t.src + (size_t)(t.k0 + (lane >> 5)) * t.N + t.n0 + (lane & 31);
#pragma unroll
    for (int i = 0; i < 32; ++i) wv[i] = wp[(size_t)(2 * i) * t.N];
}
__device__ __forceinline__ void t_store(const TItem& t, int lane, const float (&wv)[32], LAS float* scr) {
#pragma unroll
    for (int i = 0; i < 32; ++i) scr[(2 * i + (lane >> 5)) * 33 + (lane & 31)] = wv[i];
    LDS_WAIT(); asm volatile("" ::: "memory");
    const int c = lane & 7;
#pragma unroll
    for (int j = 0; j < 4; ++j) { const int n = (lane >> 3) + 8 * j; const LAS float* q = scr + (8 * c) * 33 + n; const int nn = t.n0 + n;
        const int row = t.map == 0 ? nn : (t.map == 1 ? (nn < 1024 ? (nn & ~63) + qk_pos(nn & 63) : nn) : (nn >> 7) * 256 + (t.map - 2) * 128 + (nn & 127));
        v4u o; o.x = pk2(q[0 * 33], q[1 * 33]); o.y = pk2(q[2 * 33], q[3 * 33]); o.z = pk2(q[4 * 33], q[5 * 33]); o.w = pk2(q[6 * 33], q[7 * 33]);
        *(v4u*)(t.dst + (size_t)row * t.ldt + t.koff + t.k0 + 8 * c) = o; }
    LDS_WAIT(); asm volatile("" ::: "memory");
}
#define T_SWEEP(first, step, total, DEC) do { int it_ = (first); if (it_ < (total)) { TItem ta_, tb_; float va_[32], vb_[32]; DEC(it_, ta_); t_load(ta_, lane, va_); \
    for (;;) { const int i2_ = it_ + (step); const bool h2_ = i2_ < (total); if (h2_) { DEC(i2_, tb_); t_load(tb_, lane, vb_); } t_store(ta_, lane, va_, scr); if (!h2_) break; \
               it_ = i2_ + (step); const bool h3_ = it_ < (total); if (h3_) { DEC(it_, ta_); t_load(ta_, lane, va_); } t_store(tb_, lane, vb_, scr); if (!h3_) break; } } } while (0)

constexpr size_t WO_IN = 0, WO_GLU = WO_IN + 32 * MiB, WO_BR = WO_GLU + 2 * MiB, WO_OUT = WO_BR + 8 * MiB, WO_F13 = WO_OUT + 8 * MiB, WO_F2 = WO_F13 + 22 * MiB,
                 WO_M13 = WO_F2 + 11 * MiB, WO_M2 = WO_M13 + 88 * MiB, WO_BY = WO_M2 + 44 * MiB, WO_BX = WO_BY + 32 * MiB, WO_ROT = WO_BX + 16 * MiB, WO_END = WO_ROT + 2 * MiB;
static_assert(WS_WEIGHTS + WO_END <= WS_XN, "weights region");

__device__ __forceinline__ int ltid() { int t = threadIdx.x; asm volatile("" : "+v"(t)); return t; }
#define PHASE_IDS const int tid = ltid(), lane = tid & 63, wave = __builtin_amdgcn_readfirstlane(tid >> 6); (void)lane; (void)wave
struct Frame {
    LAS unsigned char* lds; int vcu, G, bx;
};
__device__ __forceinline__ Frame make_frame(LAS unsigned char* lds) {
    Frame F; F.lds = lds; int G = gridDim.x, bx = blockIdx.x; asm volatile("" : "+s"(G), "+s"(bx));
    F.G = G; F.bx = bx; F.vcu = (G % 8 == 0) ? (bx % 8) * (G / 8) + bx / 8 : bx; return F;
}
__device__ __forceinline__ float shx(float v, int o, int lane) { return __int_as_float(__builtin_amdgcn_ds_bpermute((lane ^ o) << 2, __float_as_int(v))); }
#define WS_DPP(v, ctrl) ((v) + __int_as_float(__builtin_amdgcn_mov_dpp(__float_as_int(v), (ctrl), 0xf, 0xf, true)))
__device__ __forceinline__ float wave_sum_l(float v, int lane) {
    (void)lane;
    v = WS_DPP(v, 0xB1);
    v = WS_DPP(v, 0x4E);
    v = WS_DPP(v, 0x141);
    v = WS_DPP(v, 0x140);
    { auto r = __builtin_amdgcn_permlane16_swap(__float_as_uint(v), __float_as_uint(v), false, false); v = __uint_as_float(r[0]) + __uint_as_float(r[1]); }
    { auto r = __builtin_amdgcn_permlane32_swap(__float_as_uint(v), __float_as_uint(v), false, false); v = __uint_as_float(r[0]) + __uint_as_float(r[1]); }
    return v;
}

__device__ __forceinline__ void ssm_gen_item(const Frame& F, ArgsP A, int item) {
    unsigned char* ws = A->ws;
    PHASE_IDS; const int layer = item >> 5, g = item & 31;
    LAS float* L = (LAS float*)(F.lds);
    LAS float* apr = L;
    LAS float* api = apr + 2 * 17 * 64;
    LAS float* bbr = api + 2 * 17 * 64;
    LAS float* bbi = bbr + 2 * 64 * 16;
    LAS float* cr = bbi + 2 * 64 * 16;
    LAS float* ci = cr + 2 * 16 * 64;
    LAS float* Kt = ci + 2 * 16 * 64;
    LAS float* ff = Kt + 2 * 16 * 256;
    LAS float* apj = ff + 2 * 64 * 2;
    const float* lam_re = A->in[5] + (size_t)layer * 2 * SSM_G * SSM_P; const float* lam_im = A->in[6] + (size_t)layer * 2 * SSM_G * SSM_P; const float* log_dt = A->in[7] + layer * 2 * SSM_G;
    const float* b_re = A->in[8] + (size_t)layer * 2 * SSM_G * SSM_P * 16; const float* b_im = A->in[9] + (size_t)layer * 2 * SSM_G * SSM_P * 16;
    const float* c_re = A->in[10] + (size_t)layer * 2 * SSM_G * 16 * SSM_P; const float* c_im = A->in[11] + (size_t)layer * 2 * SSM_G * 16 * SSM_P;
    const float* dsk = A->in[12] + layer * SSM_W + g * 16;
    {
        const int d = (tid >> 6) & 1, p = tid & 63, jq = tid >> 7; const size_t pi = ((size_t)d * SSM_G + g) * SSM_P + p;
        const float lr = lam_re[pi], li = lam_im[pi], dt = expf(log_dt[d * SSM_G + g]);
        for (int j = jq; j <= 16; j += 4) { const float er = expf((float)j * lr * dt); float sn, cs; sincosf((float)j * li * dt, &sn, &cs); const float ar_ = er * cs, ai_ = er * sn;
            apr[(d * 17 + j) * 64 + p] = ar_; api[(d * 17 + j) * 64 + p] = ai_;
            if (j < 16) { apj[((d * 64 + p) * 16 + j) * 2] = ar_; apj[((d * 64 + p) * 16 + j) * 2 + 1] = ai_; }
            if (j == 1) { const float nr = ar_ - 1.f, ni = ai_, den = lr * lr + li * li;
                ff[(d * 64 + p) * 2] = (nr * lr + ni * li) / den; ff[(d * 64 + p) * 2 + 1] = (ni * lr - nr * li) / den; } }
    }
    __syncthreads();
    for (int e = tid; e < 2048; e += 512) {
        const int d = e >> 10, p = (e >> 4) & 63, hh = e & 15; const size_t bi_ = (((size_t)d * SSM_G + g) * SSM_P + p) * 16 + hh;
        const float br = b_re[bi_], bi = b_im[bi_], fr = ff[(d * 64 + p) * 2], fi = ff[(d * 64 + p) * 2 + 1];
        bbr[e] = fr * br - fi * bi; bbi[e] = fr * bi + fi * br;
        const int h2 = (e >> 6) & 15, p2 = e & 63; const size_t ci_ = (((size_t)d * SSM_G + g) * 16 + h2) * SSM_P + p2;
        cr[e] = c_re[ci_]; ci[e] = c_im[ci_];
    }
    __syncthreads();
    {
        const int d = tid >> 8, h = (tid >> 4) & 15, h2 = tid & 15;
        float sj[16];
#pragma unroll
        for (int j = 0; j < 16; ++j) sj[j] = 0.f;
        for (int p = 0; p < 64; ++p) {
            const float c_r = cr[(d * 16 + h) * 64 + p], c_i = ci[(d * 16 + h) * 64 + p], b_r = bbr[(d * 64 + p) * 16 + h2], b_i = bbi[(d * 64 + p) * 16 + h2];
            const float t_r = c_r * b_r - c_i * b_i, t_i = c_r * b_i + c_i * b_r;
            const LAS f32x4* ap = (const LAS f32x4*)(apj + (d * 64 + p) * 32);
#pragma unroll
            for (int q = 0; q < 8; ++q) { const f32x4 a = ap[q]; sj[2 * q] += t_r * a.x - t_i * a.y; sj[2 * q + 1] += t_r * a.z - t_i * a.w; }
        }
#pragma unroll
        for (int j = 0; j < 16; ++j) Kt[(d * 16 + j) * 256 + h * 16 + h2] = sj[j];
    }
    __syncthreads();
    bf16* BY = (bf16*)(ws + WS_WEIGHTS + WO_BY) + ((size_t)layer * 32 + g) * 256 * 512;
    bf16* BX = (bf16*)(ws + WS_WEIGHTS + WO_BX) + ((size_t)layer * 32 + g) * 256 * 256;
    for (int e8 = tid; e8 < 256 * 64; e8 += 512) {
        const int n = e8 >> 6, k0 = (e8 & 63) * 8, i = n >> 4, h = n & 15; float v[8];
        if (k0 < 256) { const int i2 = k0 >> 4, h20 = k0 & 15;
#pragma unroll
            for (int q = 0; q < 8; ++q) { const int h2 = h20 + q; float t = 0.f;
                if (i >= i2) t += Kt[(0 * 16 + (i - i2)) * 256 + h * 16 + h2];
                if (i2 >= i) t += Kt[(1 * 16 + (i2 - i)) * 256 + h * 16 + h2];
                if (i == i2 && h == h2) t += dsk[h];
                v[q] = t; }
        } else { const int kk = k0 - 256, d = kk >> 7, im = (kk >> 6) & 1, p0 = kk & 63, j = d == 0 ? i + 1 : 16 - i;
#pragma unroll
            for (int q = 0; q < 8; ++q) { const int p = p0 + q; const float c_r = cr[(d * 16 + h) * 64 + p], c_i = ci[(d * 16 + h) * 64 + p], a_r = apr[(d * 17 + j) * 64 + p], a_i = api[(d * 17 + j) * 64 + p];
                v[q] = im ? -(c_r * a_i + c_i * a_r) : (c_r * a_r - c_i * a_i); } }
        v4u o; o.x = pk2(v[0], v[1]); o.y = pk2(v[2], v[3]); o.z = pk2(v[4], v[5]); o.w = pk2(v[6], v[7]);
        *(v4u*)(BY + (size_t)n * 512 + k0) = o;
    }
    for (int e8 = tid; e8 < 256 * 32; e8 += 512) {
        const int n = e8 >> 5, k0 = (e8 & 31) * 8, d = n >> 7, im = (n >> 6) & 1, p = n & 63, i2 = k0 >> 4, h20 = k0 & 15, j = d == 0 ? 15 - i2 : i2;
        const float a_r = apr[(d * 17 + j) * 64 + p], a_i = api[(d * 17 + j) * 64 + p]; float v[8];
#pragma unroll
        for (int q = 0; q < 8; ++q) { const float b_r = bbr[(d * 64 + p) * 16 + h20 + q], b_i = bbi[(d * 64 + p) * 16 + h20 + q]; v[q] = im ? (a_r * b_i + a_i * b_r) : (a_r * b_r - a_i * b_i); }
        v4u o; o.x = pk2(v[0], v[1]); o.y = pk2(v[2], v[3]); o.z = pk2(v[4], v[5]); o.w = pk2(v[6], v[7]);
        *(v4u*)(BX + (size_t)n * 256 + k0) = o;
    }
    __syncthreads();
}

__device__ __forceinline__ void prologue_phase(const Frame& F, ArgsP A) {
    unsigned char* ws = A->ws;
    PHASE_IDS;
    __syncthreads();
    for (int it = F.bx; it < DEPTH * SSM_G; it += F.G) ssm_gen_item(F, A, it);
    { float* COS = (float*)(ws + WS_WEIGHTS + WO_ROT); float* SIN = COS + SEQ * 32;
      for (int e = F.bx * 512 + tid; e < SEQ * 32; e += F.G * 512) { const int s = e >> 5, j = e & 31;
          double r = (double)s * A->inv_freq[j] * 0.15915494309189533577; r -= floor(r); const float th = (float)(r * 6.283185307179586477);
          float sn, cs; sincosf(th, &sn, &cs); COS[e] = cs; SIN[e] = sn; } }
    LAS float* scr = (LAS float*)(F.lds + wave * 16384);
    const int gw = F.vcu * NWAVES + wave, NGW = F.G * NWAVES;
    unsigned char* wb = ws + WS_WEIGHTS;
    constexpr int I_IN = 16 * 128, I_GLU = 8 * 16, I_BR = 8 * 32, I_OUT = 16 * 32, I_LAYER = I_IN + I_GLU + 2 * I_BR + I_OUT;
    constexpr int I_13 = 16 * 88, I_2 = 44 * 32, I_FFN = 2 * I_13 + I_2;
    constexpr int N_ITEMS = DEPTH * I_LAYER + 2 * I_FFN, POOL_A = (N_ITEMS * 99 / 100) & ~7;
    const bool split = F.G == 256; const int hw = (F.bx - 128) * NWAVES + wave;
    for (int k = 0;; ++k) {
        int it;
        if (!split) { it = gw + k * NGW; if (it >= N_ITEMS) break; }
        else if (F.bx >= 128) { const int a = hw + k * 128 * NWAVES; if (a < POOL_A) it = a; else { const int nA = (POOL_A - hw + 128 * NWAVES - 1) / (128 * NWAVES); it = POOL_A + gw + (k - nA) * NGW; if (it >= N_ITEMS) break; } }
        else { it = POOL_A + gw + k * NGW; if (it >= N_ITEMS) break; }
        int r = it;
        if (r < DEPTH * I_LAYER) {
            const int l = r / I_LAYER; r -= l * I_LAYER;
            if (r < I_IN) { transpose_item(A->in[2] + (size_t)l * 1024 * 4096, 4096, (bf16*)(wb + WO_IN) + (size_t)l * 4096 * 1024, 1024, 0, scr, r, lane, RmInProj{}, (l & 1) ? A->in[1] + l * D_MODEL : nullptr); continue; } r -= I_IN;
            if (r < I_GLU) { transpose_item(A->in[13] + (size_t)l * 512 * 512, 512, (bf16*)(wb + WO_GLU) + (size_t)l * 512 * 512, 512, 0, scr, r, lane, RmId{}); continue; } r -= I_GLU;
            if (r < 2 * I_BR) { const int br = r / I_BR; r -= br * I_BR;
                transpose_item(A->in[14] + ((size_t)l * 2 + br) * 512 * 1024, 1024, (bf16*)(wb + WO_BR) + (size_t)l * 1024 * 1024, 1024, br * 512, scr, r, lane, RmId{}); continue; } r -= 2 * I_BR;
            transpose_item(A->in[15] + (size_t)l * 1024 * 1024, 1024, (bf16*)(wb + WO_OUT) + (size_t)l * 1024 * 1024, 1024, 0, scr, r, lane, RmId{});
        } else {
            r -= DEPTH * I_LAYER; const int i = r / I_FFN; r -= i * I_FFN;
            bf16* F13 = (bf16*)(wb + WO_F13) + (size_t)i * 5632 * 1024; bf16* F2 = (bf16*)(wb + WO_F2) + (size_t)i * 1024 * 2816;
            if (r < I_13) { transpose_item(A->in[17] + (size_t)i * 1024 * 2816, 2816, F13, 1024, 0, scr, r, lane, RmGlu13{0}, A->in[16] + (2 * i) * D_MODEL); continue; } r -= I_13;
            if (r < I_13) { transpose_item(A->in[18] + (size_t)i * 1024 * 2816, 2816, F13, 1024, 0, scr, r, lane, RmGlu13{1}, A->in[16] + (2 * i) * D_MODEL); continue; } r -= I_13;
            transpose_item(A->in[19] + (size_t)i * 2816 * 1024, 1024, F2, 2816, 0, scr, r, lane, RmId{});
        }
    }
}
constexpr int MOE_EARLY = 4864;
__device__ __forceinline__ void moe_cvt(const Frame& F, ArgsP A, int i, int part) {
    unsigned char* ws = A->ws;
    PHASE_IDS;
    LAS float* scr = (LAS float*)(F.lds + 40960 + wave * 8704);
    const bool early = part < 2 && F.G == 256;
    if (part < 2 && !early) return;
    const int gw = early ? part * MOE_EARLY + (F.bx - 128) * NWAVES + wave : (F.G == 256 ? 2 * MOE_EARLY : 0) + F.vcu * NWAVES + wave, NGW = early ? 128 * NWAVES : F.G * NWAVES;
    const int itend = early ? (part + 1) * MOE_EARLY : 8 * (2 * 16 * 88 + 44 * 32);
    unsigned char* wb = ws + WS_WEIGHTS;
    constexpr int I_13 = 16 * 88, I_2 = 44 * 32, I_E = 2 * I_13 + I_2;
#define MOE_DEC(it, t) do { const int e_ = (it) / I_E; int r_ = (it) - e_ * I_E; const size_t wo_ = ((size_t)i * N_EXP + e_); \
        if (r_ < 2 * I_13) { const int h_ = r_ >= I_13; r_ -= h_ * I_13; (t).src = A->in[21 + h_] + wo_ * 1024 * 2816; (t).N = 2816; (t).dst = (bf16*)(wb + WO_M13) + (size_t)e_ * 5632 * 1024; (t).ldt = 1024; (t).koff = 0; (t).map = 2 + h_; } \
        else { r_ -= 2 * I_13; (t).src = A->in[23] + wo_ * 2816 * 1024; (t).N = 1024; (t).dst = (bf16*)(wb + WO_M2) + (size_t)e_ * 1024 * 2816; (t).ldt = 2816; (t).koff = 0; (t).map = 0; } \
        t_setkn((t), r_); } while (0)
    T_SWEEP(gw, NGW, itend, MOE_DEC);
#undef MOE_DEC
}

template <bool COMBINE, bool ROUTER, bool FINAL>
__device__ __forceinline__ void norm_phase(const Frame& F, const float* __restrict__ SRC, float* __restrict__ X, const float* __restrict__ gain, bf16* __restrict__ XN,
                                           const bf16* __restrict__ YS, const int* __restrict__ slot_prev, const float* __restrict__ gate_prev, const unsigned* __restrict__ SPLT, const float* __restrict__ PART,
                                           const float* __restrict__ wr, unsigned* __restrict__ cnt, int* __restrict__ asg_e, int* __restrict__ asg_pos, float* __restrict__ asg_g) {
    PHASE_IDS;
    LAS float* wrl = (LAS float*)F.lds;
    LAS int* rinfo = (LAS int*)(F.lds + 32768 + 64);
    LAS int* lcnt = (LAS int*)(F.lds + 32768 + 64 + 512);
    LAS float* rg = (LAS float*)(F.lds + 32768 + 64 + 1024);
    if (ROUTER) { for (int e = tid; e < 8192; e += 512) wrl[(e & 7) * 1024 + (e >> 3)] = wr[e]; __syncthreads(); }
    const int rpb = NTOK / F.G;
    f32x4 gg4[4], vn[4];
#pragma unroll
    for (int j = 0; j < 4; ++j) gg4[j] = ((const f32x4*)gain)[64 * j + lane];
    if (wave < rpb) { const f32x4* xr = (const f32x4*)(SRC + (size_t)(F.vcu * rpb + wave) * D_MODEL) + lane;
#pragma unroll
        for (int j = 0; j < 4; ++j) vn[j] = xr[64 * j]; }
    for (int rr = wave; rr < rpb; rr += NWAVES) {
        const int row = F.vcu * rpb + rr;
        f32x4 v[4]; float s = 0.f;
#pragma unroll
        for (int j = 0; j < 4; ++j) v[j] = vn[j];
        if (rr + NWAVES < rpb) { const f32x4* xr = (const f32x4*)(SRC + (size_t)(row + NWAVES) * D_MODEL) + lane;
#pragma unroll
            for (int j = 0; j < 4; ++j) vn[j] = xr[64 * j]; }
        if (COMBINE) {
            const int s0 = slot_prev[row * 2], s1 = slot_prev[row * 2 + 1]; const float g0 = gate_prev[row * 2], g1 = gate_prev[row * 2 + 1];
            const unsigned long long* y0 = (const unsigned long long*)(YS + (size_t)s0 * 1024) + lane; const unsigned long long* y1 = (const unsigned long long*)(YS + (size_t)s1 * 1024) + lane;
            const unsigned t0 = SPLT[s0 >> 8], t1 = SPLT[s1 >> 8];
            f32x4 ta[4] = {{0.f, 0.f, 0.f, 0.f}, {0.f, 0.f, 0.f, 0.f}, {0.f, 0.f, 0.f, 0.f}, {0.f, 0.f, 0.f, 0.f}}, tb[4] = {{0.f, 0.f, 0.f, 0.f}, {0.f, 0.f, 0.f, 0.f}, {0.f, 0.f, 0.f, 0.f}, {0.f, 0.f, 0.f, 0.f}};
            if (t0 != 0u) { const f32x4* pp = (const f32x4*)(PART + (size_t)(t0 - 1) * 24 * 65536 + (size_t)(s0 & 255) * 256) + lane;
#pragma unroll
                for (int j = 0; j < 4; ++j) { ta[j] = pp[(size_t)(j * 6) * 16384];
#pragma unroll
                    for (int ks = 1; ks < 6; ++ks) ta[j] += pp[(size_t)(j * 6 + ks) * 16384]; } }
            if (t1 != 0u) { const f32x4* pp = (const f32x4*)(PART + (size_t)(t1 - 1) * 24 * 65536 + (size_t)(s1 & 255) * 256) + lane;
#pragma unroll
                for (int j = 0; j < 4; ++j) { tb[j] = pp[(size_t)(j * 6) * 16384];
#pragma unroll
                    for (int ks = 1; ks < 6; ++ks) tb[j] += pp[(size_t)(j * 6 + ks) * 16384]; } }
#pragma unroll
            for (int j = 0; j < 4; ++j) { const unsigned long long a = y0[64 * j], b = y1[64 * j];
                f32x4 ya = {__uint_as_float((unsigned)(a << 16)), __uint_as_float((unsigned)a & 0xffff0000u), __uint_as_float((unsigned)(a >> 32) << 16), __uint_as_float((unsigned)(a >> 32) & 0xffff0000u)};
                f32x4 yb = {__uint_as_float((unsigned)(b << 16)), __uint_as_float((unsigned)b & 0xffff0000u), __uint_as_float((unsigned)(b >> 32) << 16), __uint_as_float((unsigned)(b >> 32) & 0xffff0000u)};
                if (t0 != 0u) ya = ta[j];
                if (t1 != 0u) yb = tb[j];
                v[j] += g0 * ya + g1 * yb;
                if (!FINAL) ((f32x4*)(X + (size_t)row * D_MODEL) + lane)[64 * j] = v[j]; }
        }
#pragma unroll
        for (int j = 0; j < 4; ++j) s += (v[j].x * v[j].x + v[j].y * v[j].y) + (v[j].z * v[j].z + v[j].w * v[j].w);
        const float rstd = rsqrtf(wave_sum_l(s, lane) * (1.f / D_MODEL) + RMS_EPS);
        float lg[8];
#pragma unroll
        for (int e = 0; e < 8; ++e) lg[e] = 0.f;
#pragma unroll
        for (int j = 0; j < 4; ++j) {
            const f32x4 gg = gg4[j];
            v[j].x *= rstd * gg.x; v[j].y *= rstd * gg.y; v[j].z *= rstd * gg.z; v[j].w *= rstd * gg.w;
            if (FINAL) ((f32x4*)(X + (size_t)row * D_MODEL) + lane)[64 * j] = v[j];
            else ((unsigned long long*)(XN + (size_t)row * D_MODEL))[64 * j + lane] = (unsigned long long)pk2(v[j].x, v[j].y) | ((unsigned long long)pk2(v[j].z, v[j].w) << 32);
            if (ROUTER) {
#pragma unroll
                for (int e = 0; e < 8; ++e) { const f32x4 w = *(const LAS f32x4*)(wrl + e * 1024 + (64 * j + lane) * 4); lg[e] += (v[j].x * w.x + v[j].y * w.y) + (v[j].z * w.z + v[j].w * w.w); } }
        }
        if (ROUTER) {
#pragma unroll
            for (int e = 0; e < 8; ++e) lg[e] = wave_sum_l(lg[e], lane);
            int e0 = 0; float l0 = lg[0];
#pragma unroll
            for (int e = 1; e < 8; ++e) if (lg[e] > l0) { l0 = lg[e]; e0 = e; }
            int e1 = -1; float l1 = -3.4e38f;
#pragma unroll
            for (int e = 0; e < 8; ++e) if (e != e0 && lg[e] > l1) { l1 = lg[e]; e1 = e; }
            const float p1 = __expf(l1 - l0), inv = 1.f / (1.f + p1);
            if (lane == 0) { rinfo[rr * 2] = e0; rinfo[rr * 2 + 1] = e1; rg[rr * 2] = inv; rg[rr * 2 + 1] = p1 * inv; }
        }
    }
    if (ROUTER) {
        __syncthreads();
        const int nW = (rpb * 2) >> 6;
        int e_my = 0, lp = 0;
        if (wave < nW) { e_my = rinfo[wave * 64 + lane]; unsigned long long mine = 0ull;
#pragma unroll
            for (int q = 0; q < 8; ++q) { const unsigned long long m = __ballot(e_my == q); mine = (e_my == q) ? m : mine; if (lane == 0) lcnt[wave * 8 + q] = __popcll(m); }
            lp = (int)__builtin_amdgcn_mbcnt_hi((unsigned)(mine >> 32), __builtin_amdgcn_mbcnt_lo((unsigned)mine, 0u)); }
        __syncthreads();
        if (wave < nW) { for (int w2 = 0; w2 < wave; ++w2) lp += lcnt[w2 * 8 + e_my];
            const int a = wave * 64 + lane, row2 = F.vcu * rpb * 2 + a; asg_e[row2] = e_my; asg_pos[row2] = lp; asg_g[row2] = rg[a]; }
        if (tid >= 256 && tid < 264) { const int e = tid - 256; int c = 0; for (int w2 = 0; w2 < nW; ++w2) c += lcnt[w2 * 8 + e]; cnt[F.vcu * 8 + e] = (unsigned)c; }
    }
}

__device__ __forceinline__ void rstd_prep(const Frame& F, const float* __restrict__ PS, int pm) {
    PHASE_IDS;
    LAS float* rs = (LAS float*)(F.lds + RSTD_OFF);
    if (tid < 256) { const float* q = PS + pm * 256 + tid; float s = 0.f;
#pragma unroll
        for (int i = 0; i < 16; ++i) s += q[(size_t)i * NTOK];
        rs[tid] = rsqrtf(s * (1.f / D_MODEL) + RMS_EPS); }
    __syncthreads();
}
struct MoeLayout { int ps[8]; int pe[8]; int nblk; };
template <class P> __device__ __forceinline__ MoeLayout moe_layout(P cnt) {
    MoeLayout L; int acc = 0;
#pragma unroll
    for (int e = 0; e < 8; ++e) { const int c = (int)cnt[e]; L.ps[e] = acc; acc += (c + 255) & ~255; L.pe[e] = acc; }
    L.nblk = acc >> 8; return L;
}
__device__ __forceinline__ void assign_phase(const Frame& F, const unsigned* blkcnt, unsigned* cnt, const int* asg_e, const int* asg_pos, int* slot_of, const bf16* XN, bf16* XB, unsigned* splt) {
    PHASE_IDS;
    LAS int* lt = (LAS int*)F.lds;
    if (tid < 16) lt[tid] = 0;
    __syncthreads();
    int tot = 0, pre = 0;
    if (tid < 128) { const int e = tid & 7, h = tid >> 3;
#pragma unroll
        for (int k = 0; k < 16; ++k) { const int b = h * 16 + k; const int c = b < F.G ? (int)blkcnt[b * 8 + e] : 0; tot += c; pre += (b < F.vcu) ? c : 0; } }
    const int rpb = NTOK / F.G;
    if (rpb == 64) {
        int ee[16], pp[16]; v4u d0[16], d1[16];
#pragma unroll
        for (int k = 0; k < 16; ++k) { const int ga = F.vcu * 128 + wave + 8 * k; ee[k] = asg_e[ga]; pp[k] = asg_pos[ga];
            const v4u* src = (const v4u*)(XN + (size_t)(ga >> 1) * 1024) + lane; d0[k] = src[0]; d1[k] = src[64]; }
        if (tid < 128) { const int e = tid & 7; __hip_atomic_fetch_add(&lt[e], tot, __ATOMIC_RELAXED, __HIP_MEMORY_SCOPE_WORKGROUP); __hip_atomic_fetch_add(&lt[8 + e], pre, __ATOMIC_RELAXED, __HIP_MEMORY_SCOPE_WORKGROUP); }
        __syncthreads();
        const MoeLayout L = moe_layout(lt);
        if (F.bx == 0) {
            if (tid < 8) cnt[tid] = (unsigned)lt[tid];
            const int tile0 = ((L.nblk * 4) >> 8) * 64;
            if (tid < L.nblk - tile0) splt[tile0 + tid] = (unsigned)(tid + 1);
        }
#pragma unroll
        for (int k = 0; k < 16; ++k) { const int ga = F.vcu * 128 + wave + 8 * k, e = ee[k];
            int ps = L.ps[0], pr = lt[8];
#pragma unroll
            for (int q = 1; q < 8; ++q) { ps = (e == q) ? L.ps[q] : ps; pr = (e == q) ? lt[8 + q] : pr; }
            const int dest = ps + pr + pp[k];
            if (lane == 0) slot_of[ga] = dest;
            v4u* dst = (v4u*)(XB + (size_t)dest * 1024) + lane; dst[0] = d0[k]; dst[64] = d1[k]; }
        return;
    }
    if (tid < 128) { const int e = tid & 7; __hip_atomic_fetch_add(&lt[e], tot, __ATOMIC_RELAXED, __HIP_MEMORY_SCOPE_WORKGROUP); __hip_atomic_fetch_add(&lt[8 + e], pre, __ATOMIC_RELAXED, __HIP_MEMORY_SCOPE_WORKGROUP); }
    __syncthreads();
    if (F.bx == 0 && tid < 8) cnt[tid] = (unsigned)lt[tid];
    const MoeLayout L = moe_layout(lt);
    if (F.bx == 0) {
        const int tile0 = ((L.nblk * 4) >> 8) * 64;
        if (tid < L.nblk - tile0) splt[tile0 + tid] = (unsigned)(tid + 1);
    }
    for (int a = wave; a < rpb * 2; a += NWAVES) {
        const int ga = F.vcu * rpb * 2 + a, tok = ga >> 1, e = asg_e[ga];
        int ps = L.ps[0];
#pragma unroll
        for (int q = 1; q < 8; ++q) ps = (e == q) ? L.ps[q] : ps;
        int pr = lt[8];
#pragma unroll
        for (int q = 1; q < 8; ++q) pr = (e == q) ? lt[8 + q] : pr;
        const int dest = ps + pr + asg_pos[ga];
        if (lane == 0) slot_of[ga] = dest;
        const v4u* src = (const v4u*)(XN + (size_t)tok * 1024) + lane; v4u* dst = (v4u*)(XB + (size_t)dest * 1024) + lane;
        dst[0] = src[0]; dst[64] = src[64];
    }
}

__device__ __forceinline__ void scan_phase(const Frame& F, ArgsP A, int layer, const float* __restrict__ XLOC, bf16* __restrict__ AY) {
    PHASE_IDS;
    LAS float* S = (LAS float*)F.lds;
    for (int it = F.vcu; it < 256; it += F.G) {
        const int b = it >> 7, g = (it >> 2) & 31, d = (it >> 1) & 1, ph = it & 1, pp = tid & 31, seg = tid >> 5, p = ph * 32 + pp;
        const size_t pi = ((size_t)layer * 2 + d) * SSM_G * SSM_P + (size_t)g * SSM_P + p;
        const float lr = A->in[5][pi], li = A->in[6][pi], dt = expf(A->in[7][(layer * 2 + d) * SSM_G + g]);
        const float er = expf(16.f * lr * dt); float sn, cs; sincosf(16.f * li * dt, &sn, &cs);
        const float ar = er * cs, ai = er * sn;
        float Ar = ar, Ai = ai;
#pragma unroll
        for (int q = 0; q < 5; ++q) { const float t = Ar * Ar - Ai * Ai; Ai = 2.f * Ar * Ai; Ar = t; }
        const int c0 = d == 0 ? seg * 32 : 511 - seg * 32, cstep = d == 0 ? 1 : -1;
        const float* xl = XLOC + ((size_t)g * 1024 + b * 512 + c0) * 256 + d * 128 + p; const long xs = (long)cstep * 256;
        float sr = 0.f, si = 0.f;
        float xrv[32], xiv[32];
#pragma unroll
        for (int k = 0; k < 32; ++k) { xrv[k] = xl[k * xs]; xiv[k] = xl[k * xs + 64]; }
#pragma unroll
        for (int k = 0; k < 32; ++k) { const float t = ar * sr - ai * si + xrv[k]; si = ar * si + ai * sr + xiv[k]; sr = t; }
        S[(seg * 32 + pp) * 2] = sr; S[(seg * 32 + pp) * 2 + 1] = si;
        __syncthreads();
        float cr_ = 0.f, ci_ = 0.f;
        for (int s2 = 0; s2 < seg; ++s2) { const float t = Ar * cr_ - Ai * ci_ + S[(s2 * 32 + pp) * 2]; ci_ = Ar * ci_ + Ai * cr_ + S[(s2 * 32 + pp) * 2 + 1]; cr_ = t; }
        bf16* ay = AY + ((size_t)g * 1024 + b * 512 + c0) * 512 + 256 + d * 128 + p; const long ys = (long)cstep * 512;
#pragma unroll
        for (int k = 0; k < 32; ++k) { const float xr = xrv[k], xi = xiv[k];
            {
              const float pr = __int_as_float(__builtin_amdgcn_mov_dpp(__float_as_int(cr_), 0xB1, 0xf, 0xf, true)), pi = __int_as_float(__builtin_amdgcn_mov_dpp(__float_as_int(ci_), 0xB1, 0xf, 0xf, true));
              const bool odd = (pp & 1) != 0;
              *(unsigned*)(ay + k * ys + (odd ? 63 : 0)) = odd ? pk2(pi, ci_) : pk2(cr_, pr); }
            const float t = ar * cr_ - ai * ci_ + xr; ci_ = ar * ci_ + ai * cr_ + xi; cr_ = t; }
        __syncthreads();
    }
}

__device__ __forceinline__ void kmax_phase(const Frame& F, const bf16* __restrict__ Kb, unsigned* __restrict__ KMAX) {
    PHASE_IDS;
    const int nw = F.G > 128 ? F.G - 128 : F.G, w0 = F.G > 128 ? F.bx - 128 : F.bx;
    if (w0 < 0) return;
    for (int it = w0; it < 128; it += nw) {
        const int slab = it >> 3; const bf16* base = Kb + ((size_t)slab * 8192 + (size_t)(it & 7) * 1024 + wave * 128) * 64;
        float mx = 0.f;
#pragma unroll 4
        for (int i = 0; i < 16; ++i) { const v4u v = *(const v4u*)(base + (size_t)(i * 8 + (lane >> 3)) * 64 + (lane & 7) * 8); float q = 0.f;
            const unsigned w[4] = {v.x, v.y, v.z, v.w};
#pragma unroll
            for (int e = 0; e < 4; ++e) { const float a = __uint_as_float(w[e] << 16), b2 = __uint_as_float(w[e] & 0xffff0000u); q = fmaf(a, a, q); q = fmaf(b2, b2, q); }
            q += shx(q, 1, lane); q += shx(q, 2, lane); q += shx(q, 4, lane); mx = fmaxf(mx, q); }
#pragma unroll
        for (int o = 8; o < 64; o <<= 1) mx = fmaxf(mx, shx(mx, o, lane));
        if (lane == 0) __hip_atomic_fetch_max(KMAX + slab, __float_as_uint(mx), __ATOMIC_RELAXED, __HIP_MEMORY_SCOPE_AGENT);
    }
}
#ifndef PHASE_MASK
#define PHASE_MASK 0xffffffu
#endif
#define PMB(b) ((PHASE_MASK >> (b)) & 1u)
#ifndef REP_MASK
#define REP_MASK 0u
#endif
#ifndef REP_N
#define REP_N 1
#endif
#define RPT(b, cond) for (int rep_ = 0; rep_ < 1 + (((REP_MASK >> (b)) & 1u) && (cond) ? REP_N : 0); ++rep_)
#define SITE ArgsP ap = get_args(); unsigned char* ws = ap->ws; unsigned char* wb = ws + WS_WEIGHTS; (void)wb; const Frame F = make_frame((LAS unsigned char*)lds); (void)F
__device__ __forceinline__ bool in_range(int k) { ArgsP a = get_args(); const int lo = a->ph_lo, hi = a->ph_hi; return lo <= k && k < hi; }
__global__ void __launch_bounds__(NWAVES * 64, 2) mk_fwd(Args args_unused) {
    extern __shared__ __attribute__((aligned(16))) unsigned char lds[];
    volatile LAS unsigned* MISC = (volatile LAS unsigned*)((LAS unsigned char*)lds + MISC_OFF);
    for (int u = threadIdx.x; u < (LDS_BYTES - LDSCTL_OFF) / 4; u += NWAVES * 64) ((LAS unsigned*)((LAS unsigned char*)lds + LDSCTL_OFF))[u] = 0u;
    __syncthreads();
    { SITE; if ((ap->ph_hi - ap->ph_lo) > 1) (void)xcd_barrier_post((unsigned*)(ws + WS_CTL) + CW_BAR, MISC + 8); }
#define IN(k) in_range((k))
#define SUB() (get_args()->sub)
#define SEAM(k) do { if (IN(k) && IN((k) + 1)) { ArgsP ap_ = get_args(); XcdBarrier b_; b_.bar = (unsigned*)(ap_->ws + WS_CTL) + CW_BAR; b_.x = xb_xcc_id(); \
        b_.st = (volatile LAS unsigned*)((LAS unsigned char*)lds + MISC_OFF) + 8; xcd_barrier(b_); } } while (0)

    RPT(0, true) if (PMB(0) && IN(PH_PRO)) { SITE; prologue_phase(F, ap); }
    SEAM(PH_PRO);

    for (int l = 0; l < DEPTH; ++l) {
        const int pb = PH_L0 + l * PH_PER_LAYER, moe = l & 1, i = l >> 1;
        const bool fold1 = (l & 1) != 0;
        RPT(1, l != 2) if (!fold1 && PMB(1) && IN(pb + P_NORM1)) {
            SITE; float* X = ap->out; bf16* XN = (bf16*)(ws + WS_XN);
            const float* gain = ap->in[1] + l * D_MODEL;
            if (l == 0) norm_phase<false, false, false>(F, ap->in[0], X, gain, XN, nullptr, nullptr, nullptr, nullptr, nullptr, nullptr, nullptr, nullptr, nullptr, nullptr);
            else if (l == 2 && ((SUB() & 4) != 0)) { const int* sp = (const int*)(ws + WS_ROUTE) + 3 * 32768; const float* gp = (const float*)(ws + WS_ROUTE) + 2 * 32768;
                norm_phase<true, false, false>(F, X, X, gain, XN, (const bf16*)(ws + WS_R2), sp, gp, (const unsigned*)(ws + WS_CTL) + CW_SPLT, (const float*)(ws + WS_PART), nullptr, nullptr, nullptr, nullptr, nullptr); }
            else norm_phase<false, false, false>(F, X, X, gain, XN, nullptr, nullptr, nullptr, nullptr, nullptr, nullptr, nullptr, nullptr, nullptr, nullptr);
        }
        if (!fold1) SEAM(pb + P_NORM1);
        RPT(2, true) if (PMB(2) && IN(pb + P_INPROJ)) {
            SITE;
            pg8::Gemm g{(const bf16*)(ws + WS_XN), (const bf16*)(wb + WO_IN) + (size_t)l * 4096 * 1024}; pg8::StaticOrderT<64, 16> S{F.bx};
            const float* COS = (const float*)(wb + WO_ROT);
            if (fold1) { pg8::Unit u0; S.next(0, u0); rstd_prep(F, (const float*)(ws + WS_PS), u0.pm);
                pg8::EpiInProjT<true> E{(bf16*)(ws + WS_Q), (bf16*)(ws + WS_K), (bf16*)(ws + WS_V), (bf16*)(ws + WS_AY), (bf16*)(ws + WS_G), COS, COS + SEQ * 32, (const LAS float*)(F.lds + RSTD_OFF)};
                pg8::gemm_phase<pg8::EpiInProjT<true>, pg8::StaticOrderT<64, 16>, 1024, 1024, 1024>(F.lds + RING_OFF, g, S, E); }
            else { pg8::EpiInProj E{(bf16*)(ws + WS_Q), (bf16*)(ws + WS_K), (bf16*)(ws + WS_V), (bf16*)(ws + WS_AY), (bf16*)(ws + WS_G), COS, COS + SEQ * 32, nullptr};
                pg8::gemm_phase<pg8::EpiInProj, pg8::StaticOrderT<64, 16>, 1024, 1024, 1024>(F.lds + RING_OFF, g, S, E); }
        }
        SEAM(pb + P_INPROJ);
        RPT(3, true) if (PMB(3) && IN(pb + P_XLOC)) {
            SITE;
            pg8::Gemm g{(const bf16*)(ws + WS_AY), (const bf16*)(wb + WO_BX) + (size_t)l * 32 * 256 * 256}; pg8::SsmOrder S{F.G, F.bx};
            pg8::EpiXloc E{(float*)(ws + WS_XLOC)};
            pg8::gemm_phase<pg8::EpiXloc, pg8::SsmOrder, 512, 256, 256>(F.lds + RING_OFF, g, S, E);
            kmax_phase(F, (const bf16*)(ws + WS_K), (unsigned*)(ws + WS_CTL) + CW_KMAX + 16 * l);
        }
        SEAM(pb + P_XLOC);
        RPT(4, true) if (PMB(4) && IN(pb + P_SCAN)) { SITE; scan_phase(F, ap, l, (const float*)(ws + WS_XLOC), (bf16*)(ws + WS_AY)); }
        SEAM(pb + P_SCAN);
        if (IN(pb + P_MIX)) {
            RPT(5, true) if (PMB(5) && (SUB() & 1)) {
                SITE;
                pg8::Gemm g{(const bf16*)(ws + WS_AY), (const bf16*)(wb + WO_BY) + (size_t)l * 32 * 256 * 512}; pg8::SsmOrder S{F.G, F.bx};
                pg8::EpiY E{(bf16*)(ws + WS_SACT)};
                pg8::gemm_phase<pg8::EpiY, pg8::SsmOrder, 512, 512, 512>(F.lds + RING_OFF, g, S, E);
            }
            if ((SUB() & 8) && (SUB() & 2)) { SITE; if (F.bx >= 128) moe_cvt(F, ap, i, l & 1); }
            RPT(6, true) if (PMB(6) && (SUB() & 2)) {
                SITE;
                const float* lp = ap->in[3] + l * 4 * HD; float d01 = 0.f, d23 = 0.f;
                for (int q = 0; q < HD; ++q) { d01 += lp[q] * lp[HD + q]; d23 += lp[2 * HD + q] * lp[3 * HD + q]; }
                const float lam_init = 0.8f - 0.6f * __expf(-0.3f * (float)l), lam = __expf(d01) - __expf(d23) + lam_init;
                const bf16* Q = (const bf16*)(ws + WS_Q); const bf16* Kb = (const bf16*)(ws + WS_K); const bf16* V = (const bf16*)(ws + WS_V);
                float* O1 = (float*)(ws + WS_MERGED);
                bf16* AS2 = (bf16*)(ws + WS_AS2);
                for (int u = F.vcu; u < 256; u += F.G) {
                    const int bh = u >> 5, qb = u & 31, b = bh >> 2, h = bh & 3;
                    att::diff_attn_unit(Q + (size_t)bh * 2 * SEQ * 64, Kb + (size_t)bh * 2 * SEQ * 64, V + (size_t)bh * SEQ * 128, qb * 256,
                                        (const unsigned*)(ws + WS_CTL) + CW_KMAX + 16 * l + bh * 2, O1 + (size_t)u * 65536, AS2 + ((size_t)b * SEQ + qb * 256) * 1024 + h * 128, ap->in[4] + l * VD, lam, 1.f - lam_init, (char*)lds + RING_OFF);
                    __syncthreads();
                }
            }
        }
        SEAM(pb + P_MIX);
        RPT(7, true) if (PMB(7) && IN(pb + P_GLU)) {
            SITE;
            pg8::Gemm g{(const bf16*)(ws + WS_SACT), (const bf16*)(wb + WO_GLU) + (size_t)l * 512 * 512}; pg8::StaticOrderT<64, 2> S{F.bx};
            pg8::EpiGlu E{(const bf16*)(ws + WS_SACT), (bf16*)(ws + WS_AS2)};
            pg8::gemm_phase<pg8::EpiGlu, pg8::StaticOrderT<64, 2>, 512, 512, 512>(F.lds + RING_OFF, g, S, E);
        }
        SEAM(pb + P_GLU);
        RPT(8, true) if (PMB(8) && IN(pb + P_BRANCH)) {
            SITE;
            pg8::Gemm g{(const bf16*)(ws + WS_AS2), (const bf16*)(wb + WO_BR) + (size_t)l * 1024 * 1024}; pg8::StaticOrderT<64, 4> S{F.bx};
            pg8::EpiBranch E{(const bf16*)(ws + WS_G), (bf16*)(ws + WS_MERGED)};
            pg8::gemm_phase<pg8::EpiBranch, pg8::StaticOrderT<64, 4>, 1024, 1024, 1024>(F.lds + RING_OFF, g, S, E);
        }
        SEAM(pb + P_BRANCH);
        RPT(9, l == 0) if (PMB(9) && IN(pb + P_OUT)) {
            SITE; float* X = ap->out;
            pg8::Gemm g{(const bf16*)(ws + WS_MERGED), (const bf16*)(wb + WO_OUT) + (size_t)l * 1024 * 1024}; pg8::StaticOrderT<64, 4> S{F.bx};
            if (!moe) { pg8::EpiResN E{l == 0 ? ap->in[0] : X, X, (bf16*)(ws + WS_XN), (float*)(ws + WS_PS)};
                pg8::gemm_phase<pg8::EpiResN, pg8::StaticOrderT<64, 4>, 1024, 1024, 1024>(F.lds + RING_OFF, g, S, E); }
            else { pg8::EpiRes E{X, X};
                pg8::gemm_phase<pg8::EpiRes, pg8::StaticOrderT<64, 4>, 1024, 1024, 1024>(F.lds + RING_OFF, g, S, E); }
        }
        SEAM(pb + P_OUT);
        RPT(10, false) if (moe && PMB(10) && IN(pb + P_NORM2)) {
            SITE; float* X = ap->out; bf16* XN = (bf16*)(ws + WS_XN);
            const float* gain = ap->in[16] + l * D_MODEL;
            if (moe) { int* asg_e = (int*)(ws + WS_ROUTE + (size_t)i * 512 * 1024); int* asg_pos = asg_e + 32768; float* asg_g = (float*)(asg_pos + 32768);
                       norm_phase<false, true, false>(F, X, X, gain, XN, nullptr, nullptr, nullptr, nullptr, nullptr, ap->in[20] + (size_t)i * D_MODEL * N_EXP, (unsigned*)(ws + WS_CTL) + CW_BLKCNT + 2048 * i, asg_e, asg_pos, asg_g);
                       RPT(17, true) { if (SUB() & 8) moe_cvt(F, ap, i, 2); } }
            else norm_phase<false, false, false>(F, X, X, gain, XN, nullptr, nullptr, nullptr, nullptr, nullptr, nullptr, nullptr, nullptr, nullptr, nullptr);
        }
        if (moe) SEAM(pb + P_NORM2);
        if (!moe) {
            RPT(11, true) if (PMB(11) && IN(pb + P_UP)) {
                SITE;
                pg8::Gemm g{(const bf16*)(ws + WS_XN), (const bf16*)(wb + WO_F13) + (size_t)i * 5632 * 1024}; pg8::StaticOrderT<64, 22> S{F.bx};
                { pg8::Unit u0; S.next(0, u0); rstd_prep(F, (const float*)(ws + WS_PS), u0.pm); }
                pg8::EpiSwigluT<true> E{(bf16*)(ws + WS_H), 22, (const LAS float*)(F.lds + RSTD_OFF)};
                pg8::gemm_phase<pg8::EpiSwigluT<true>, pg8::StaticOrderT<64, 22>, 1024, 1024, 1024>(F.lds + RING_OFF, g, S, E);
            }
            SEAM(pb + P_UP);
            if (PMB(12) && IN(pb + P_DOWN)) {
                SITE; float* X = ap->out;
                pg8::Gemm g{(const bf16*)(ws + WS_H), (const bf16*)(wb + WO_F2) + (size_t)i * 1024 * 2816}; pg8::StaticOrderT<64, 4> S{F.bx};
                pg8::EpiResN E{X, X, (bf16*)(ws + WS_XN), (float*)(ws + WS_PS)};
                pg8::gemm_phase<pg8::EpiResN, pg8::StaticOrderT<64, 4>, 2816, 2816, 2816>(F.lds + RING_OFF, g, S, E);
            }
            SEAM(pb + P_DOWN);
        } else {
            RPT(13, true) if (PMB(13) && IN(pb + P_ASSIGN)) {
                SITE; int* asg_e = (int*)(ws + WS_ROUTE + (size_t)i * 512 * 1024);
                assign_phase(F, (const unsigned*)(ws + WS_CTL) + CW_BLKCNT + 2048 * i, (unsigned*)(ws + WS_CTL) + CW_CNT + 64 * i, asg_e, asg_e + 32768, asg_e + 3 * 32768, (const bf16*)(ws + WS_XN), (bf16*)(ws + WS_R2), (unsigned*)(ws + WS_CTL) + CW_SPLT + 256 * i);
            }
            SEAM(pb + P_ASSIGN);
            RPT(14, true) if (PMB(14) && IN(pb + P_UP)) {
                SITE;
                const MoeLayout L = moe_layout((const unsigned*)(ws + WS_CTL) + CW_CNT + 64 * i);
                pg8::Gemm g{(const bf16*)(ws + WS_R2), (const bf16*)(wb + WO_M13)};
                pg8::MoeOrder S; S.so.init(L.nblk * 256, 5632, F.G, F.bx); S.pe0 = L.pe[0]; S.pe1 = L.pe[1]; S.pe2 = L.pe[2]; S.pe3 = L.pe[3]; S.pe4 = L.pe[4]; S.pe5 = L.pe[5]; S.pe6 = L.pe[6]; S.nN = 22; S.maxr = 1 << 20;
                pg8::EpiSwiglu E{(bf16*)(ws + WS_H), 22, nullptr};
                pg8::gemm_phase<pg8::EpiSwiglu, pg8::MoeOrder, 1024, 1024, 1024>(F.lds + RING_OFF, g, S, E);
            }
            SEAM(pb + P_UP);
            RPT(15, true) if (PMB(15) && IN(pb + P_DOWN)) {
                SITE;
                const MoeLayout L = moe_layout((const unsigned*)(ws + WS_CTL) + CW_CNT + 64 * i);
                pg8::Gemm g{(const bf16*)(ws + WS_H), (const bf16*)(wb + WO_M2)};
                const int tile0 = ((L.nblk * 4) >> 8) * 64;
                pg8::MoeOrder S; S.so.init(tile0 * 256, 1024, F.G, F.bx); S.pe0 = L.pe[0]; S.pe1 = L.pe[1]; S.pe2 = L.pe[2]; S.pe3 = L.pe[3]; S.pe4 = L.pe[4]; S.pe5 = L.pe[5]; S.pe6 = L.pe[6]; S.nN = 4; S.maxr = 1 << 20;
                pg8::EpiMoeDown E{(bf16*)(ws + WS_R2)};
                pg8::gemm_phase<pg8::EpiMoeDown, pg8::MoeOrder, 2816, 2816, 2816>(F.lds + RING_OFF, g, S, E);
                pg8::MoeSplitOrder T; T.c = F.bx; T.tile0 = tile0; T.nsub = (L.nblk - tile0) * 24; T.eoff = 0; T.pe0 = S.pe0; T.pe1 = S.pe1; T.pe2 = S.pe2; T.pe3 = S.pe3; T.pe4 = S.pe4; T.pe5 = S.pe5; T.pe6 = S.pe6; T.nN = 4;
                pg8::EpiMoeDownPart EP{(float*)(ws + WS_PART)};
                pg8::gemm_phase<pg8::EpiMoeDownPart, pg8::MoeSplitOrder, 2816, 2816, 0>(F.lds + RING_OFF, g, T, EP);
            }
            SEAM(pb + P_DOWN);
        }
    }
    if (PMB(16) && IN(PH_FINAL)) {
        SITE; float* X = ap->out;
        if (((SUB() & 4) != 0)) { const int* sp = (const int*)(ws + WS_ROUTE + 512 * 1024) + 3 * 32768; const float* gp = (const float*)(ws + WS_ROUTE + 512 * 1024) + 2 * 32768;
            norm_phase<true, false, true>(F, X, X, ap->in[24], nullptr, (const bf16*)(ws + WS_R2), sp, gp, (const unsigned*)(ws + WS_CTL) + CW_SPLT + 256, (const float*)(ws + WS_PART), nullptr, nullptr, nullptr, nullptr, nullptr); }
        else norm_phase<false, false, true>(F, X, X, ap->in[24], nullptr, nullptr, nullptr, nullptr, nullptr, nullptr, nullptr, nullptr, nullptr, nullptr, nullptr);
    }
#undef IN
#undef SEAM
}
#ifndef OPT_MASK
#define OPT_MASK 0x37f
#endif
#ifndef ONE_LAUNCH
#define ONE_LAUNCH 1
#endif
static void launch_mk(Args& a, int lo, int hi, int sub, int grid, hipStream_t stream) {
    a.ph_lo = lo; a.ph_hi = hi; a.sub = sub;
    hipLaunchKernelGGL(mk_fwd, dim3(grid), dim3(NWAVES * 64), LDS_BYTES, stream, a);
}
extern "C" void kernel_launch(void* const* d_in, const int* in_sizes, int n_in, void* d_out, int out_size, void* d_ws, size_t ws_size, hipStream_t stream) {
    static int grid = 0;
    if (grid == 0) {
        if (n_in != 25 || out_size != NTOK * D_MODEL || ws_size < WS_END + 64 * MiB) { fprintf(stderr, "kernel_launch: unexpected shapes n_in %d out %d ws %zu (need %zu)\n", n_in, out_size, ws_size, (size_t)(WS_END + 64 * MiB)); grid = -1; return; }
        int dev = 0, cus = 0;
        if (hipGetDevice(&dev) != hipSuccess || hipDeviceGetAttribute(&cus, hipDeviceAttributeMultiprocessorCount, dev) != hipSuccess) { grid = -1; return; }
        if (hipFuncSetAttribute((const void*)mk_fwd, hipFuncAttributeMaxDynamicSharedMemorySize, LDS_BYTES) != hipSuccess) { fprintf(stderr, "kernel_launch: hipFuncSetAttribute failed\n"); grid = -1; return; }
        int per_cu = 0;
        if (hipOccupancyMaxActiveBlocksPerMultiprocessor(&per_cu, (const void*)mk_fwd, NWAVES * 64, LDS_BYTES) != hipSuccess || per_cu < 1) fprintf(stderr, "kernel_launch: occupancy query reports %d\n", per_cu);
        (void)hipGetLastError();
        grid = cus;
        if (grid != 256) fprintf(stderr, "kernel_launch: %d CUs (built for 256)\n", grid);
    }
    if (grid < 0) return;
    const float* x_in = (const float*)d_in[0]; const float* norm_mix = (const float*)d_in[1]; const float* w_in = (const float*)d_in[2];
    const float* attn_lambda = (const float*)d_in[3]; const float* attn_subln = (const float*)d_in[4];
    const float* ssm_lam_re = (const float*)d_in[5]; const float* ssm_lam_im = (const float*)d_in[6]; const float* ssm_log_dt = (const float*)d_in[7];
    const float* ssm_b_re = (const float*)d_in[8]; const float* ssm_b_im = (const float*)d_in[9]; const float* ssm_c_re = (const float*)d_in[10]; const float* ssm_c_im = (const float*)d_in[11];
    const float* ssm_d = (const float*)d_in[12]; const float* w_glu = (const float*)d_in[13]; const float* w_branch = (const float*)d_in[14]; const float* w_out = (const float*)d_in[15];
    const float* norm_ffn = (const float*)d_in[16]; const float* ffn_w1 = (const float*)d_in[17]; const float* ffn_w3 = (const float*)d_in[18]; const float* ffn_w2 = (const float*)d_in[19];
    const float* moe_router = (const float*)d_in[20]; const float* moe_w1 = (const float*)d_in[21]; const float* moe_w3 = (const float*)d_in[22]; const float* moe_w2 = (const float*)d_in[23];
    const float* norm_final = (const float*)d_in[24];
    unsigned char* ws = (unsigned char*)d_ws; float* X = (float*)d_out;
    bf16* XN = (bf16*)(ws + WS_XN); bf16* Q = (bf16*)(ws + WS_Q); bf16* Kb = (bf16*)(ws + WS_K); bf16* V = (bf16*)(ws + WS_V); bf16* G = (bf16*)(ws + WS_G);
    bf16* AY = (bf16*)(ws + WS_AY); float* XLOC = (float*)(ws + WS_XLOC); bf16* AS2 = (bf16*)(ws + WS_AS2); bf16* H = (bf16*)(ws + WS_H);
    bf16* SACT = (bf16*)(ws + WS_SACT); bf16* MERGED = (bf16*)(ws + WS_MERGED);
    float* TMP = (float*)(ws + WS_END);
    if (hipMemsetAsync(ws + WS_CTL, 0, CTL_ZERO_BYTES, stream) != hipSuccess) { fprintf(stderr, "kernel_launch: memset failed\n"); return; }
    Args a{};
    for (int i = 0; i < 25; ++i) a.in[i] = (const float*)d_in[i];
    a.out = X; a.ws = ws;
    for (int j = 0; j < 32; ++j) a.inv_freq[j] = pow(10000.0, -(double)j / 32.0);
    constexpr int OM = OPT_MASK;
    if (ONE_LAUNCH) { launch_mk(a, 0, PH_END, 1 | 2 | 4 | 8, grid, stream); return; }
    constexpr bool o_norm = OM & 1, o_inproj = OM & 2, o_ssm = OM & 4, o_attn = OM & 8, o_glu = OM & 16, o_branch = OM & 32, o_out = OM & 64, o_ffn = OM & 256, o_moe = OM & 512;
    static_assert(!o_moe || o_norm, "optimized MoE needs the optimized norms");
    const int sub_c = o_moe ? 4 : 0;
    (void)hipMemcpyAsync(X, x_in, (size_t)NTOK * D_MODEL * 4, hipMemcpyDeviceToDevice, stream);
    if (OM & ~1) launch_mk(a, PH_PRO, PH_PRO + 1, 0, grid, stream);
    for (int layer = 0; layer < DEPTH; ++layer) {
        const int pb = PH_L0 + layer * PH_PER_LAYER, i = layer / 2;
        const float lam_init = 0.8f - 0.6f * expf(-0.3f * (float)layer);
        if (o_norm) launch_mk(a, pb + P_NORM1, pb + P_NORM1 + 1, sub_c, grid, stream);
        else k_norm<<<NTOK / 4, 256, 0, stream>>>(X, norm_mix + layer * D_MODEL, XN, nullptr, nullptr, nullptr);
        if (o_inproj) launch_mk(a, pb + P_INPROJ, pb + P_INPROJ + 1, 0, grid, stream);
        else { NEpiInProj e{Q, Kb, V, AY, G};
          k_ngemm<NEpiInProj, false><<<dim3(IN_W / 128, NTOK / 128), 256, 0, stream>>>(XN, D_MODEL, w_in + (size_t)layer * D_MODEL * IN_W, nullptr, IN_W, D_MODEL, e); }
        if (o_ssm) { launch_mk(a, pb + P_XLOC, pb + P_XLOC + 1, 0, grid, stream); launch_mk(a, pb + P_SCAN, pb + P_SCAN + 1, 0, grid, stream); launch_mk(a, pb + P_MIX, pb + P_MIX + 1, 1, grid, stream); }
        else { const size_t po = (size_t)layer * 2 * SSM_G * SSM_P;
          k_nssm<<<BATCH * SSM_G, 64, 0, stream>>>(AY, XLOC, SACT, ssm_lam_re + po, ssm_lam_im + po, ssm_log_dt + layer * 2 * SSM_G,
                                                   ssm_b_re + po * 16, ssm_b_im + po * 16, ssm_c_re + po * 16, ssm_c_im + po * 16, ssm_d + layer * SSM_W); }
        if (o_attn) launch_mk(a, pb + P_MIX, pb + P_MIX + 1, 2, grid, stream);
        else k_nattn<<<dim3(SEQ / 64, NHEAD, BATCH), 128, 0, stream>>>(Q, Kb, V, AS2, attn_lambda + layer * 4 * HD, attn_subln + layer * VD, lam_init);
        if (o_glu) launch_mk(a, pb + P_GLU, pb + P_GLU + 1, 0, grid, stream);
        else { NEpiGlu e{SACT, AS2};
          k_ngemm<NEpiGlu, false><<<dim3(SSM_W / 128, NTOK / 128), 256, 0, stream>>>(SACT, SSM_W, w_glu + (size_t)layer * SSM_W * SSM_W, nullptr, SSM_W, SSM_W, e); }
        if (o_branch) launch_mk(a, pb + P_BRANCH, pb + P_BRANCH + 1, 0, grid, stream);
        else { NEpiBranch e0{G, TMP, MERGED, 0, 0}, e1{G, TMP, MERGED, 1, 0};
            const float* wbp = w_branch + (size_t)layer * 2 * 512 * 1024;
            k_ngemm<NEpiBranch, false><<<dim3(1024 / 128, NTOK / 128), 256, 0, stream>>>(AS2, 1024, wbp, nullptr, 1024, 512, e0);
            k_ngemm<NEpiBranch, false><<<dim3(1024 / 128, NTOK / 128), 256, 0, stream>>>(AS2 + 512, 1024, wbp + 512 * 1024, nullptr, 1024, 512, e1); }
        if (o_out) launch_mk(a, pb + P_OUT, pb + P_OUT + 1, 0, grid, stream);
        else { NEpiRes e{X, nullptr, nullptr, 0, 0};
          k_ngemm<NEpiRes, false><<<dim3(1024 / 128, NTOK / 128), 256, 0, stream>>>(MERGED, 1024, w_out + (size_t)layer * 1024 * 1024, nullptr, 1024, 1024, e); }
        int* asg_e = (int*)(ws + WS_ROUTE + (size_t)i * 512 * 1024); float* asg_g = (float*)(asg_e + 2 * 32768);
        if (layer % 2 == 0) {
            if (o_norm) launch_mk(a, pb + P_NORM2, pb + P_NORM2 + 1, 0, grid, stream);
            else k_norm<<<NTOK / 4, 256, 0, stream>>>(X, norm_ffn + layer * D_MODEL, XN, nullptr, nullptr, nullptr);
            if (o_ffn) { launch_mk(a, pb + P_UP, pb + P_UP + 1, 0, grid, stream); launch_mk(a, pb + P_DOWN, pb + P_DOWN + 1, 0, grid, stream); }
            else {
              { NEpiSwiglu e{H};
                k_ngemm<NEpiSwiglu, true><<<dim3(D_FF / 128, NTOK / 128), 256, 0, stream>>>(XN, D_MODEL, ffn_w1 + (size_t)i * D_MODEL * D_FF, ffn_w3 + (size_t)i * D_MODEL * D_FF, D_FF, D_MODEL, e); }
              { NEpiRes e{X, nullptr, nullptr, 0, 0};
                k_ngemm<NEpiRes, false><<<dim3(1024 / 128, NTOK / 128), 256, 0, stream>>>(H, D_FF, ffn_w2 + (size_t)i * D_FF * D_MODEL, nullptr, D_MODEL, D_FF, e); }
            }
        } else {
            if (o_norm) launch_mk(a, pb + P_NORM2, pb + P_NORM2 + 1, o_moe ? 8 : 0, grid, stream);
            else k_norm<<<NTOK / 4, 256, 0, stream>>>(X, norm_ffn + layer * D_MODEL, XN, moe_router + (size_t)i * D_MODEL * N_EXP, asg_e, asg_g);
            if (o_moe) { launch_mk(a, pb + P_ASSIGN, pb + P_ASSIGN + 1, 0, grid, stream); launch_mk(a, pb + P_UP, pb + P_UP + 1, 0, grid, stream); launch_mk(a, pb + P_DOWN, pb + P_DOWN + 1, 0, grid, stream); }
            else for (int ex = 0; ex < N_EXP; ++ex) {
                const size_t wo = ((size_t)i * N_EXP + ex) * D_MODEL * D_FF;
                { NEpiSwiglu e{H};
                  k_ngemm<NEpiSwiglu, true><<<dim3(D_FF / 128, NTOK / 128), 256, 0, stream>>>(XN, D_MODEL, moe_w1 + wo, moe_w3 + wo, D_FF, D_MODEL, e); }
                { NEpiRes e{X, asg_e, asg_g, ex, 0};
                  k_ngemm<NEpiRes, false><<<dim3(1024 / 128, NTOK / 128), 256, 0, stream>>>(H, D_FF, moe_w2 + wo, nullptr, D_MODEL, D_FF, e); }
            }
        }
    }
    if (o_norm) launch_mk(a, PH_FINAL, PH_FINAL + 1, sub_c, grid, stream);
    else k_final_norm<<<NTOK / 4, 256, 0, stream>>>(X, norm_final);
}
```

```cpp
#include <hip/hip_runtime.h>
#include <cstdio>
#include <cstdint>
#include <cmath>

constexpr int D_MODEL = 1024, BATCH = 2, SEQ = 8192, DEPTH = 4, NTOK = BATCH * SEQ;
constexpr int NHEAD = 4, HD = 64, VD = 128;
constexpr int SSM_G = 32, SSM_CH = 16, SSM_P = 64, SSM_W = 512;
constexpr int IN_W = 4096, OFF_K = 512, OFF_V = 1024, OFF_U = 1536, OFF_G = 2048;
constexpr int D_FF = 2816, N_EXP = 8;
constexpr float RMS_EPS = 1e-6f;
constexpr int CHL = 16;
constexpr int NCH = SEQ / CHL;

typedef unsigned short bf16;
typedef float f32x4 __attribute__((ext_vector_type(4)));

constexpr size_t MiB = 1u << 20;
constexpr size_t WS_CTL = 0;
constexpr size_t WS_WEIGHTS = 1 * MiB;
constexpr size_t WS_XN = 267 * MiB;
constexpr size_t WS_R1 = WS_XN + 32 * MiB;
constexpr size_t WS_Q = WS_R1, WS_K = WS_Q + 16 * MiB, WS_V = WS_K + 16 * MiB, WS_G = WS_V + 16 * MiB;
constexpr size_t WS_AY = WS_G + 64 * MiB, WS_XLOC = WS_AY + 32 * MiB, WS_AS2 = WS_XLOC + 32 * MiB;
constexpr size_t WS_H = WS_R1;
constexpr size_t WS_R2 = WS_R1 + 208 * MiB;
constexpr size_t WS_SACT = WS_R2, WS_MERGED = WS_SACT + 16 * MiB, WS_O1 = WS_MERGED + 32 * MiB;
constexpr size_t WS_ROUTE = WS_R2 + 80 * MiB;
constexpr size_t WS_PART = WS_ROUTE + 1 * MiB;
constexpr size_t WS_PS = WS_PART + 48 * MiB;
constexpr size_t WS_XR = WS_PS + 1 * MiB;
constexpr size_t WS_END = WS_XR + 32 * MiB;

__device__ __forceinline__ float bf2f(bf16 v) { return __uint_as_float(((unsigned)v) << 16); }
__device__ __forceinline__ bf16 f2bf(float f) { unsigned u = __float_as_uint(f); return (bf16)((u + 0x7fffu + ((u >> 16) & 1u)) >> 16); }
__device__ __forceinline__ float wave_sum(float v) {
#pragma unroll
    for (int o = 1; o < 64; o <<= 1) v += __shfl_xor(v, o);
    return v;
}
__device__ __forceinline__ float sigmoidf_(float x) { return 1.f / (1.f + __expf(-x)); }
__host__ __device__ __forceinline__ int qk_pos(int d) { const int j = d & 31, n = d >> 5; return 32 * (j >> 4) + 8 * ((j & 15) >> 2) + 4 * n + (j & 3); }
__device__ __forceinline__ size_t q_index(int b, int h, int c, int s, int d) { return ((((size_t)b * NHEAD + h) * 2 + c) * SEQ + s) * HD + qk_pos(d); }
__device__ __forceinline__ size_t v_index(int b, int h, int s, int e) { return (((size_t)b * NHEAD + h) * SEQ + s) * VD + e; }
__device__ __forceinline__ size_t ay_index(int g, int b, int s, int hh) { return (((size_t)g * (BATCH * NCH)) + b * NCH + (s / CHL)) * 512 + (s % CHL) * SSM_CH + hh; }

__global__ __launch_bounds__(256) void k_norm(const float* __restrict__ x, const float* __restrict__ g, bf16* __restrict__ xn,
                                             const float* __restrict__ wr, int* __restrict__ top_e, float* __restrict__ top_g) {
    const int lane = threadIdx.x & 63, row = blockIdx.x * 4 + (threadIdx.x >> 6);
    const f32x4* xr = (const f32x4*)(x + (size_t)row * D_MODEL) + lane;
    f32x4 v[4]; float s = 0.f;
#pragma unroll
    for (int j = 0; j < 4; ++j) { v[j] = xr[64 * j]; s += (v[j].x * v[j].x + v[j].y * v[j].y) + (v[j].z * v[j].z + v[j].w * v[j].w); }
    const float rstd = rsqrtf(wave_sum(s) * (1.f / D_MODEL) + RMS_EPS);
    float lg[N_EXP];
#pragma unroll
    for (int e = 0; e < N_EXP; ++e) lg[e] = 0.f;
#pragma unroll
    for (int j = 0; j < 4; ++j) {
        const f32x4 gg = ((const f32x4*)g)[64 * j + lane];
        v[j].x *= rstd * gg.x; v[j].y *= rstd * gg.y; v[j].z *= rstd * gg.z; v[j].w *= rstd * gg.w;
        unsigned long long o = (unsigned long long)f2bf(v[j].x) | ((unsigned long long)f2bf(v[j].y) << 16) | ((unsigned long long)f2bf(v[j].z) << 32) | ((unsigned long long)f2bf(v[j].w) << 48);
        ((unsigned long long*)(xn + (size_t)row * D_MODEL))[64 * j + lane] = o;
        if (wr) {
            const int k0 = (64 * j + lane) * 4;
#pragma unroll
            for (int e = 0; e < N_EXP; ++e) lg[e] += v[j].x * wr[(k0 + 0) * N_EXP + e] + v[j].y * wr[(k0 + 1) * N_EXP + e] + v[j].z * wr[(k0 + 2) * N_EXP + e] + v[j].w * wr[(k0 + 3) * N_EXP + e];
        }
    }
    if (wr) {
#pragma unroll
        for (int e = 0; e < N_EXP; ++e) lg[e] = wave_sum(lg[e]);
        int e0 = 0; float l0 = lg[0];
#pragma unroll
        for (int e = 1; e < N_EXP; ++e) if (lg[e] > l0) { l0 = lg[e]; e0 = e; }
        int e1 = -1; float l1 = -3.4e38f;
#pragma unroll
        for (int e = 0; e < N_EXP; ++e) if (e != e0 && lg[e] > l1) { l1 = lg[e]; e1 = e; }
        const float p1 = __expf(l1 - l0), inv = 1.f / (1.f + p1);
        if (lane == 0) { top_e[row * 2] = e0; top_e[row * 2 + 1] = e1; top_g[row * 2] = inv; top_g[row * 2 + 1] = p1 * inv; }
    }
}

__global__ __launch_bounds__(256) void k_final_norm(float* __restrict__ x, const float* __restrict__ g) {
    const int lane = threadIdx.x & 63, row = blockIdx.x * 4 + (threadIdx.x >> 6);
    f32x4* xr = (f32x4*)(x + (size_t)row * D_MODEL) + lane;
    f32x4 v[4]; float s = 0.f;
#pragma unroll
    for (int j = 0; j < 4; ++j) { v[j] = xr[64 * j]; s += (v[j].x * v[j].x + v[j].y * v[j].y) + (v[j].z * v[j].z + v[j].w * v[j].w); }
    const float rstd = rsqrtf(wave_sum(s) * (1.f / D_MODEL) + RMS_EPS);
#pragma unroll
    for (int j = 0; j < 4; ++j) { const f32x4 gg = ((const f32x4*)g)[64 * j + lane]; f32x4 o = {v[j].x * rstd * gg.x, v[j].y * rstd * gg.y, v[j].z * rstd * gg.z, v[j].w * rstd * gg.w}; xr[64 * j] = o; }
}

template <class Epi, bool DUAL>
__global__ __launch_bounds__(256) void k_ngemm(const bf16* __restrict__ A, int lda, const float* __restrict__ W, const float* __restrict__ W2, int ldw, int K, Epi epi) {
    __shared__ float As[16][132];
    __shared__ float Bs[16][128];
    __shared__ float Bs2[DUAL ? 16 : 1][128];
    const int tid = threadIdx.x, tx = tid & 15, ty = tid >> 4;
    const int m0 = blockIdx.y * 128, n0 = blockIdx.x * 128;
    float acc[8][8], acc2[DUAL ? 8 : 1][8];
#pragma unroll
    for (int i = 0; i < 8; ++i)
#pragma unroll
        for (int j = 0; j < 8; ++j) { acc[i][j] = 0.f; if (DUAL) acc2[i][j] = 0.f; }
    const int ar = tid >> 1, ak = (tid & 1) * 8;
    const int bk = tid >> 4, bn = (tid & 15) * 8;
    for (int k0 = 0; k0 < K; k0 += 16) {
        const uint4 av = *(const uint4*)(A + (size_t)(m0 + ar) * lda + k0 + ak);
        const unsigned aw[4] = {av.x, av.y, av.z, av.w};
#pragma unroll
        for (int q = 0; q < 4; ++q) { As[ak + 2 * q][ar] = __uint_as_float(aw[q] << 16); As[ak + 2 * q + 1][ar] = __uint_as_float(aw[q] & 0xffff0000u); }
        const f32x4 b0 = *(const f32x4*)(W + (size_t)(k0 + bk) * ldw + n0 + bn), b1 = *(const f32x4*)(W + (size_t)(k0 + bk) * ldw + n0 + bn + 4);
        *(f32x4*)&Bs[bk][bn] = b0; *(f32x4*)&Bs[bk][bn + 4] = b1;
        if (DUAL) { const f32x4 c0 = *(const f32x4*)(W2 + (size_t)(k0 + bk) * ldw + n0 + bn), c1 = *(const f32x4*)(W2 + (size_t)(k0 + bk) * ldw + n0 + bn + 4);
            *(f32x4*)&Bs2[bk][bn] = c0; *(f32x4*)&Bs2[bk][bn + 4] = c1; }
        __syncthreads();
#pragma unroll
        for (int k = 0; k < 16; ++k) {
            float a[8], b[8], b2[8];
#pragma unroll
            for (int i = 0; i < 8; ++i) a[i] = As[k][ty * 8 + i];
#pragma unroll
            for (int j = 0; j < 8; ++j) { b[j] = Bs[k][tx * 2 + (j & 1) + 32 * (j >> 1)]; if (DUAL) b2[j] = Bs2[k][tx * 2 + (j & 1) + 32 * (j >> 1)]; }
#pragma unroll
            for (int i = 0; i < 8; ++i)
#pragma unroll
                for (int j = 0; j < 8; ++j) { acc[i][j] += a[i] * b[j]; if (DUAL) acc2[i][j] += a[i] * b2[j]; }
        }
        __syncthreads();
    }
#pragma unroll
    for (int i = 0; i < 8; ++i) { if constexpr (DUAL) epi.row2(m0 + ty * 8 + i, n0, tx, acc[i], acc2[i]); else epi.row(m0 + ty * 8 + i, n0, tx, acc[i]); }
}
#define NG_COL(n0, tx, jj) ((n0) + (tx) * 2 + ((jj) & 1) + 32 * ((jj) >> 1))

struct NEpiInProj {
    bf16 *Q, *Kb, *V, *AY, *G;
    __device__ void row(int m, int n0, int tx, const float (&a)[8]) const {
        const int b = m / SEQ, s = m % SEQ;
        if (n0 < OFF_V) {
            bf16* dst = n0 < OFF_K ? Q : Kb; const int h = (n0 % 512) / 128;
#pragma unroll
            for (int c = 0; c < 2; ++c)
#pragma unroll
                for (int e = 0; e < 2; ++e) {
                    const int j = tx * 2 + e;
                    const float x1 = a[c * 4 + e], x2 = a[c * 4 + 2 + e];
                    const double ang = (double)s * pow(10000.0, -(double)j / 32.0);
                    const float sn = (float)sin(ang), cs = (float)cos(ang);
                    dst[q_index(b, h, c, s, j)] = f2bf(x1 * cs - x2 * sn);
                    dst[q_index(b, h, c, s, j + 32)] = f2bf(x2 * cs + x1 * sn);
                }
        } else {
#pragma unroll
            for (int jj = 0; jj < 8; ++jj) {
                const int n = NG_COL(n0, tx, jj);
                if (n < OFF_U) { const int h = (n - OFF_V) / VD, e = (n - OFF_V) % VD; V[v_index(b, h, s, e)] = f2bf(a[jj]); }
                else if (n < OFF_G) { const int g = (n - OFF_U) / SSM_CH, hh = (n - OFF_U) % SSM_CH; AY[ay_index(g, b, s, hh)] = f2bf(a[jj]); }
                else G[(size_t)m * 2048 + (n - OFF_G)] = f2bf(sigmoidf_(a[jj]));
            }
        }
    }
};
struct NEpiGlu {
    const bf16* SACT; bf16* AS2;
    __device__ void row(int m, int n0, int tx, const float (&a)[8]) const {
#pragma unroll
        for (int jj = 0; jj < 8; ++jj) { const int n = NG_COL(n0, tx, jj); AS2[(size_t)m * 1024 + 512 + n] = f2bf(bf2f(SACT[(size_t)m * 512 + n]) * sigmoidf_(a[jj])); }
    }
};
struct NEpiBranch {
    const bf16* G; float* TMP; bf16* MERGED; int second, pad;
    __device__ void row(int m, int n0, int tx, const float (&a)[8]) const {
#pragma unroll
        for (int jj = 0; jj < 8; ++jj) { const int n = NG_COL(n0, tx, jj);
            if (!second) TMP[(size_t)m * 1024 + n] = bf2f(G[(size_t)m * 2048 + n]) * a[jj];
            else MERGED[(size_t)m * 1024 + n] = f2bf(TMP[(size_t)m * 1024 + n] + bf2f(G[(size_t)m * 2048 + 1024 + n]) * a[jj]); }
    }
};
struct NEpiRes {
    float* X; const int* top_e; const float* top_g; int e, pad;
    __device__ void row(int m, int n0, int tx, const float (&a)[8]) const {
        float gt = 1.f;
        if (top_e) { gt = 0.f; if (top_e[m * 2] == e) gt = top_g[m * 2]; else if (top_e[m * 2 + 1] == e) gt = top_g[m * 2 + 1]; if (gt == 0.f) return; }
#pragma unroll
        for (int jj = 0; jj < 8; ++jj) { const int n = NG_COL(n0, tx, jj); X[(size_t)m * 1024 + n] += gt * a[jj]; }
    }
};
struct NEpiSwiglu {
    bf16* H;
    __device__ void row2(int m, int n0, int tx, const float (&a)[8], const float (&b)[8]) const {
#pragma unroll
        for (int jj = 0; jj < 8; ++jj) { const int n = NG_COL(n0, tx, jj); H[(size_t)m * D_FF + n] = f2bf(a[jj] * sigmoidf_(a[jj]) * b[jj]); }
    }
};

__global__ __launch_bounds__(128) void k_nattn(const bf16* __restrict__ Q, const bf16* __restrict__ Kb, const bf16* __restrict__ V, bf16* __restrict__ AS2,
                                              const float* __restrict__ lam_p, const float* __restrict__ subln, float lam_init) {
    __shared__ float Ks[32][64];
    __shared__ float Vs[32][128];
    __shared__ float ssq[2][64];
    const int tid = threadIdx.x, r = tid & 63, vh = tid >> 6;
    const int b = blockIdx.z, h = blockIdx.y, s = blockIdx.x * 64 + r;
    float d01 = 0.f, d23 = 0.f;
    for (int i = 0; i < HD; ++i) { d01 += lam_p[i] * lam_p[HD + i]; d23 += lam_p[2 * HD + i] * lam_p[3 * HD + i]; }
    const float lam = __expf(d01) - __expf(d23) + lam_init;
    float res[64];
#pragma unroll
    for (int e = 0; e < 64; ++e) res[e] = 0.f;
    for (int c = 0; c < 2; ++c) {
        float q[64], o[64];
        const bf16* qp = Q + ((((size_t)b * NHEAD + h) * 2 + c) * SEQ + s) * HD;
#pragma unroll
        for (int d = 0; d < 64; ++d) { q[d] = bf2f(qp[d]) * 0.125f; o[d] = 0.f; }
        float mx = -1e30f, l = 0.f;
        const bf16* kp = Kb + ((((size_t)b * NHEAD + h) * 2 + c) * SEQ) * HD;
        const bf16* vp = V + (((size_t)b * NHEAD + h) * SEQ) * VD;
        for (int k0 = 0; k0 < SEQ; k0 += 32) {
            __syncthreads();
            for (int i = tid; i < 32 * 64; i += 128) Ks[i / 64][i % 64] = bf2f(kp[(size_t)k0 * HD + i]);
            for (int i = tid; i < 32 * 128; i += 128) Vs[i / 128][i % 128] = bf2f(vp[(size_t)k0 * VD + i]);
            __syncthreads();
            float sc[32]; float tm = mx;
#pragma unroll
            for (int j = 0; j < 32; ++j) { float a = 0.f;
#pragma unroll
                for (int d = 0; d < 64; ++d) a += q[d] * Ks[j][d];
                sc[j] = a; tm = fmaxf(tm, a); }
            const float alpha = __expf(mx - tm); mx = tm; l *= alpha;
#pragma unroll
            for (int e = 0; e < 64; ++e) o[e] *= alpha;
#pragma unroll
            for (int j = 0; j < 32; ++j) { const float p = __expf(sc[j] - mx); l += p;
#pragma unroll
                for (int e = 0; e < 64; ++e) o[e] += p * Vs[j][vh * 64 + e]; }
        }
        const float il = (c == 0 ? 1.f : -lam) / l;
#pragma unroll
        for (int e = 0; e < 64; ++e) res[e] += o[e] * il;
    }
    float sq = 0.f;
#pragma unroll
    for (int e = 0; e < 64; ++e) sq += res[e] * res[e];
    ssq[vh][r] = sq;
    __syncthreads();
    const float rstd = rsqrtf((ssq[0][r] + ssq[1][r]) * (1.f / VD) + RMS_EPS) * (1.f - lam_init);
    bf16* op = AS2 + (size_t)(b * SEQ + s) * 1024 + h * VD + vh * 64;
#pragma unroll
    for (int e = 0; e < 64; ++e) op[e] = f2bf(res[e] * rstd * subln[vh * 64 + e]);
}

__global__ __launch_bounds__(64) void k_nssm(const bf16* __restrict__ AY, float* __restrict__ Y, bf16* __restrict__ SACT,
                                            const float* __restrict__ lam_re, const float* __restrict__ lam_im, const float* __restrict__ log_dt,
                                            const float* __restrict__ b_re, const float* __restrict__ b_im, const float* __restrict__ c_re, const float* __restrict__ c_im,
                                            const float* __restrict__ dsk) {
    const int p = threadIdx.x, g = blockIdx.x % SSM_G, b = blockIdx.x / SSM_G;
    for (int dir = 0; dir < 2; ++dir) {
        const size_t pi = ((size_t)dir * SSM_G + g) * SSM_P + p;
        const float lr = lam_re[pi], li = lam_im[pi], dt = __expf(log_dt[dir * SSM_G + g]);
        const float er = expf(lr * dt); float sn, cs; sincosf(li * dt, &sn, &cs);
        const float ar = er * cs, ai = er * sn;
        const float nr = ar - 1.f, ni = ai, den = lr * lr + li * li;
        const float fr = (nr * lr + ni * li) / den, fi = (ni * lr - nr * li) / den;
        float bbr[16], bbi[16], cr[16], ci[16];
#pragma unroll
        for (int hh = 0; hh < 16; ++hh) { const float br = b_re[pi * 16 + hh], bi = b_im[pi * 16 + hh]; bbr[hh] = fr * br - fi * bi; bbi[hh] = fr * bi + fi * br;
            const size_t cidx = (((size_t)dir * SSM_G + g) * SSM_CH + hh) * SSM_P + p; cr[hh] = c_re[cidx]; ci[hh] = c_im[cidx]; }
        float xr = 0.f, xi = 0.f;
        for (int step = 0; step < SEQ; ++step) {
            const int s = dir == 0 ? step : SEQ - 1 - step;
            const bf16* up = AY + ay_index(g, b, s, 0);
            float u[16];
#pragma unroll
            for (int hh = 0; hh < 16; ++hh) u[hh] = bf2f(up[hh]);
            float br = 0.f, bi = 0.f;
#pragma unroll
            for (int hh = 0; hh < 16; ++hh) { br += bbr[hh] * u[hh]; bi += bbi[hh] * u[hh]; }
            const float nxr = ar * xr - ai * xi + br, nxi = ar * xi + ai * xr + bi; xr = nxr; xi = nxi;
            float mine = 0.f;
#pragma unroll
            for (int hh = 0; hh < 16; ++hh) { const float t = wave_sum(cr[hh] * xr - ci[hh] * xi); if (p == hh) mine = t; }
            if (p < 16) {
                const size_t yi = (size_t)(b * SEQ + s) * SSM_W + g * SSM_CH + p;
                if (dir == 0) Y[yi] = u[p] * dsk[g * SSM_CH + p] + mine;
                else { const float y = Y[yi] + mine; SACT[yi] = f2bf(0.5f * y * (1.f + erff(y * 0.70710678118654752f))); }
            }
        }
    }
}


#define GAS __attribute__((address_space(1)))
#define LAS __attribute__((address_space(3)))
namespace pg8 {
#define PG8_LAS __attribute__((address_space(3)))
typedef unsigned short bf16_t;
typedef short bf16x8 __attribute__((ext_vector_type(8)));
typedef float f32x4 __attribute__((ext_vector_type(4)));
typedef unsigned u32x4 __attribute__((ext_vector_type(4)));
constexpr int BM = 256, BK = 64, HALF = 128, HTB = HALF * BK * 2  , STAGE_BYTES = 8 * HTB, NXCD = 8, WGM = 8;

__host__ __device__ __forceinline__ int lds_byte(int r, int c) { const int st = (r >> 4) * 2 + (c >> 5), rr = r & 15, cc = c & 31, ob = rr * 64 + cc * 2; return st * 1024 + (ob ^ (((ob >> 9) & 1) << 5)); }
__host__ __device__ __forceinline__ void stage_rc(int b, int& R, int& C) { const int st = b / 1024, sb = b % 1024, swz = sb ^ (((sb >> 9) & 1) << 5); R = (st >> 1) * 16 + swz / 64; C = (st & 1) * 32 + (swz % 64) / 2; }
__host__ __device__ __forceinline__ int perm32(int rho) { const int n = rho >> 4, i = rho & 15; return 8 * (i >> 2) + 4 * n + (i & 3); }

struct Unit { int pm, pn; int ko = 0, aux = 0, nk = 0; };
struct Gemm { const bf16_t* A; const bf16_t* Bt; };

struct StaticOrder {
    int nM, nN, nwg, G, c;
    __host__ __device__ void init(int M, int N, int G_, int c_) { nM = M / BM; nN = N / BM; nwg = nM * nN; G = G_; c = c_; }
    __host__ __device__ void map(int L, Unit& u) const {
        int wgid = L; { const int q = nwg / NXCD, r = nwg % NXCD, xcd = wgid % NXCD, off = wgid / NXCD; wgid = (xcd < r ? xcd * (q + 1) : r * (q + 1) + (xcd - r) * q) + off; }
        const int nig = WGM * nN, gid = wgid / nig, fm = gid * WGM, gsz = (nM - fm) < WGM ? (nM - fm) : WGM;
        u.pm = fm + ((wgid % nig) % gsz); u.pn = (wgid % nig) / gsz;
    }
    __host__ __device__ bool next(int i, Unit& u) const {
        const long L = (long)i * G + c; if (L >= nwg) return false;
        map((int)L, u); return true;
    }
    __device__ __forceinline__ void a_ready(const Unit&) const {}
    __device__ __forceinline__ void done(const Unit&) const {}
};


template <int NM, int NN> struct StaticOrderT {
    int c;
    __device__ __forceinline__ bool next(int i, Unit& u) const {
        constexpr int nwg = NM * NN, q = nwg / NXCD, r = nwg % NXCD; const int L = i * 256 + c; if (L >= nwg) return false;
        int wgid = L; { const int xcd = wgid % NXCD, off = wgid / NXCD; wgid = (xcd < r ? xcd * (q + 1) : r * (q + 1) + (xcd - r) * q) + off; }
        constexpr int nig = WGM * NN; const int gid = wgid / nig, fm = gid * WGM, gsz = (NM - fm) < WGM ? (NM - fm) : WGM;
        u.pm = fm + ((wgid % nig) % gsz); u.pn = (wgid % nig) / gsz; return true;
    }
    __device__ __forceinline__ void a_ready(const Unit&) const {}
    __device__ __forceinline__ void done(const Unit&) const {}
};
typedef __bf16 bf16x2_cv __attribute__((ext_vector_type(2))); typedef float f32x2_cv __attribute__((ext_vector_type(2)));
__device__ __forceinline__ unsigned cvt_pk_bf16(float lo, float hi) { const bf16x2_cv r = __builtin_convertvector((f32x2_cv){lo, hi}, bf16x2_cv); return __builtin_bit_cast(unsigned, r); }
typedef float f32x2 __attribute__((ext_vector_type(2)));
__device__ __forceinline__ f32x2 gelu_pk(f32x2 v) {
    const f32x2 av = __builtin_elementwise_abs(v), d = av * 0.2316418882f + 1.0f;
    f32x2 t; t.x = __builtin_amdgcn_rcpf(d.x); t.y = __builtin_amdgcn_rcpf(d.y);
    f32x2 q = t * 0.5307027145f + (-0.7265760135f); q = q * t + 0.7107068705f; q = q * t + (-0.142248368f); q = q * t + 0.127414796f; q = q * t;
    const f32x2 s = (v * v) * (-0.72134752044f);
    f32x2 e; e.x = __builtin_amdgcn_exp2f(s.x); e.y = __builtin_amdgcn_exp2f(s.y);
    const f32x2 m = v * (q * e), r = v - m;
    f32x2 o; o.x = v.x < 0.f ? m.x : r.x; o.y = v.y < 0.f ? m.y : r.y; return o;
}

template <class Epi, class Sched, int LDA, int LDB, int KK, bool ALIGN_EPI = true, bool SP2 = true>
__device__ __forceinline__ void gemm_phase(PG8_LAS unsigned char* lds, const Gemm g, const Sched& S, const Epi& E) {
    int tid_l = threadIdx.x; asm volatile("" : "+v"(tid_l));
    const int tid = tid_l, wid = __builtin_amdgcn_readfirstlane(tid >> 6), lane = tid & 63, wr = wid >> 2, wc = wid & 3, fr = lane & 15, fq = lane >> 4;
    static_assert(KK % 128 == 0, "K multiple of 128");
    unsigned voffA[2], voffB[2];
#pragma unroll
    for (int i = 0; i < 2; ++i) { int R, C; stage_rc(tid * 16 + i * 8192, R, C); const int Rb = Epi::PERM ? ((R & ~31) + perm32(R & 31)) : R;
        voffA[i] = (unsigned)(R * LDA + C) * 2u; voffB[i] = (unsigned)(Rb * LDB + C) * 2u; }
    constexpr size_t kstep = (size_t)(BK * 2);
    constexpr size_t hstepA = (size_t)HALF * LDA * 2, hstepB = (size_t)HALF * LDB * 2;
    constexpr size_t tstepA = 2 * hstepA, tstepB = 2 * hstepB;
    const unsigned ldsw = (unsigned)wid * 1024u;
    const int aoff = lds_byte(wr * 64 + fr, fq * 8), boff = lds_byte(wc * 32 + fr, fq * 8);
#define PG8_SA(b, h) (((b) * 2 + (h)) * HTB)
#define PG8_SB(b, h) ((4 + (b) * 2 + (h)) * HTB)
#define PG8_STAGE(bufoff, gbase, voff) do { _Pragma("unroll") for (int _i = 0; _i < 2; ++_i) \
        __builtin_amdgcn_global_load_lds((const unsigned*)((const char*)(gbase) + (voff)[_i]), (PG8_LAS unsigned*)(lds + (bufoff) + ldsw + _i * 8192), 16, 0, 0); } while (0)
#define PG8_LDA(dst, b, h) do { _Pragma("unroll") for (int m = 0; m < 4; ++m) _Pragma("unroll") for (int k = 0; k < 2; ++k) dst[m][k] = *(const PG8_LAS bf16x8*)(lds + PG8_SA(b, h) + aoff + m * 2048 + k * 1024); } while (0)
#define PG8_LDB(dst, b, h) do { _Pragma("unroll") for (int n = 0; n < 2; ++n) _Pragma("unroll") for (int k = 0; k < 2; ++k) dst[n][k] = *(const PG8_LAS bf16x8*)(lds + PG8_SB(b, h) + boff + n * 2048 + k * 1024); } while (0)
#define PG8_MMA(ai, bj, At, Bt) do { __builtin_amdgcn_s_setprio(1); _Pragma("unroll") for (int m = 0; m < 4; ++m) _Pragma("unroll") for (int n = 0; n < 2; ++n) _Pragma("unroll") for (int k = 0; k < 2; ++k) \
        acc[ai][bj][m][n] = __builtin_amdgcn_mfma_f32_16x16x32_bf16(Bt[n][k], At[m][k], acc[ai][bj][m][n], 0, 0, 0); __builtin_amdgcn_s_setprio(0); } while (0)
#define PG8_WAIT_V(n) asm volatile("s_waitcnt vmcnt(" #n ")" ::: "memory")
#define PG8_WAIT_L(n) asm volatile("s_waitcnt lgkmcnt(" #n ")" ::: "memory")
#define PG8_BAR __builtin_amdgcn_s_barrier()
#define PG8_SCHED __builtin_amdgcn_sched_barrier(0)
    Unit cur, nxt; int ui = 0;
    if (!S.next(0, cur)) return;
    f32x4 acc[2][2][4][2];
#pragma unroll
    for (int a = 0; a < 2; ++a)
#pragma unroll
        for (int b = 0; b < 2; ++b)
#pragma unroll
            for (int m = 0; m < 4; ++m)
#pragma unroll
                for (int n = 0; n < 2; ++n) acc[a][b][m][n] = (f32x4){0.f, 0.f, 0.f, 0.f};
    bf16x8 At[4][2], B0[2][2], B1[2][2];
    const char* cA = (const char*)g.A + (size_t)cur.pm * tstepA + cur.ko; const char* cB = (const char*)g.Bt + (size_t)cur.pn * tstepB + cur.ko;
    S.a_ready(cur);
    if constexpr (SP2) {
        PG8_STAGE(PG8_SB(0, 0), cB, voffB); PG8_STAGE(PG8_SB(0, 1), cB + hstepB, voffB); PG8_STAGE(PG8_SA(0, 0), cA, voffA); PG8_STAGE(PG8_SA(0, 1), cA + hstepA, voffA);
        if (wr == 1) PG8_BAR;
        PG8_WAIT_V(2); PG8_BAR;
        PG8_STAGE(PG8_SB(1, 0), cB + kstep, voffB); PG8_STAGE(PG8_SA(1, 0), cA + kstep, voffA); PG8_STAGE(PG8_SB(1, 1), cB + hstepB + kstep, voffB);
        PG8_WAIT_V(6); PG8_BAR;
    } else {
        PG8_STAGE(PG8_SB(0, 0), cB, voffB); PG8_STAGE(PG8_SA(0, 0), cA, voffA); PG8_STAGE(PG8_SB(0, 1), cB + hstepB, voffB); PG8_STAGE(PG8_SA(0, 1), cA + hstepA, voffA);
        if (wr == 1) PG8_BAR;
        PG8_WAIT_V(4); PG8_BAR;
        PG8_STAGE(PG8_SB(1, 0), cB + kstep, voffB); PG8_STAGE(PG8_SA(1, 0), cA + kstep, voffA); PG8_STAGE(PG8_SB(1, 1), cB + hstepB + kstep, voffB);
        PG8_WAIT_V(6); PG8_BAR;
    }
    for (;;) {
        const bool has_next = S.next(ui + 1, nxt);
        const char* nA = has_next ? (const char*)g.A + (size_t)nxt.pm * tstepA + nxt.ko : cA; const char* nB = has_next ? (const char*)g.Bt + (size_t)nxt.pn * tstepB + nxt.ko : cB;
        const int nt = KK > 0 ? KK / BK : cur.nk;
        for (int t = 0; t < nt; t += 2) {
            if constexpr (Epi::MIDHOOK) { if (t == nt / 2) E.mid(acc, cur, wr, wc, fr, fq); }
            const bool last = (t == nt - 2);
            const char* a1 = cA + (size_t)(t + 1) * kstep;
            const char* a2 = last ? nA : cA + (size_t)(t + 2) * kstep; const char* b2 = last ? nB : cB + (size_t)(t + 2) * kstep;
            const char* a3 = a2 + kstep; const char* b3 = b2 + kstep;
            if (last && has_next) S.a_ready(nxt);
            if constexpr (SP2) {
            PG8_LDB(B0, 0, 0); PG8_LDB(B1, 0, 1); PG8_SCHED; PG8_LDA(At, 0, 0); PG8_STAGE(PG8_SA(1, 1), a1 + hstepA, voffA);
            PG8_WAIT_V(8); PG8_WAIT_L(0); PG8_BAR; PG8_MMA(0, 0, At, B0); PG8_MMA(0, 1, At, B1); PG8_BAR; PG8_SCHED;
            PG8_LDA(At, 0, 1); PG8_STAGE(PG8_SB(0, 0), b2, voffB); PG8_STAGE(PG8_SB(0, 1), b2 + hstepB, voffB); PG8_STAGE(PG8_SA(0, 0), a2, voffA);
            PG8_WAIT_V(8); PG8_WAIT_L(0); PG8_BAR; PG8_MMA(1, 0, At, B0); PG8_MMA(1, 1, At, B1); PG8_BAR; PG8_SCHED;
            PG8_LDB(B0, 1, 0); PG8_LDB(B1, 1, 1); PG8_SCHED; PG8_LDA(At, 1, 0); PG8_STAGE(PG8_SA(0, 1), a2 + hstepA, voffA);
            PG8_WAIT_V(8); PG8_WAIT_L(0); PG8_BAR; PG8_MMA(0, 0, At, B0); PG8_MMA(0, 1, At, B1); PG8_BAR; PG8_SCHED;
            PG8_LDA(At, 1, 1); PG8_STAGE(PG8_SB(1, 0), b3, voffB); PG8_STAGE(PG8_SB(1, 1), b3 + hstepB, voffB); PG8_STAGE(PG8_SA(1, 0), a3, voffA);
            PG8_WAIT_V(8); PG8_WAIT_L(0); PG8_BAR; PG8_MMA(1, 0, At, B0); PG8_MMA(1, 1, At, B1); PG8_BAR; PG8_SCHED;
            } else {
            PG8_LDB(B0, 0, 0); PG8_SCHED; PG8_LDA(At, 0, 0); PG8_STAGE(PG8_SA(1, 1), a1 + hstepA, voffA);
            PG8_WAIT_L(8); PG8_BAR; PG8_WAIT_L(0); PG8_MMA(0, 0, At, B0); PG8_BAR; PG8_SCHED;
            PG8_LDB(B1, 0, 1); PG8_STAGE(PG8_SB(0, 0), b2, voffB);
            PG8_BAR; PG8_WAIT_L(0); PG8_MMA(0, 1, At, B1); PG8_BAR;
            PG8_LDA(At, 0, 1); PG8_STAGE(PG8_SA(0, 0), a2, voffA);
            PG8_BAR; PG8_WAIT_L(0); PG8_MMA(1, 0, At, B0); PG8_BAR; PG8_SCHED;
            PG8_STAGE(PG8_SB(0, 1), b2 + hstepB, voffB);
            PG8_WAIT_V(6); PG8_BAR; PG8_MMA(1, 1, At, B1); PG8_BAR;
            PG8_LDB(B0, 1, 0); PG8_SCHED; PG8_LDA(At, 1, 0); PG8_STAGE(PG8_SA(0, 1), a2 + hstepA, voffA);
            PG8_WAIT_L(8); PG8_BAR; PG8_WAIT_L(0); PG8_MMA(0, 0, At, B0); PG8_BAR; PG8_SCHED;
            PG8_LDB(B1, 1, 1); PG8_STAGE(PG8_SB(1, 0), b3, voffB);
            PG8_BAR; PG8_WAIT_L(0); PG8_MMA(0, 1, At, B1); PG8_BAR;
            PG8_LDA(At, 1, 1); PG8_STAGE(PG8_SA(1, 0), a3, voffA);
            PG8_BAR; PG8_WAIT_L(0); PG8_MMA(1, 0, At, B0); PG8_BAR; PG8_SCHED;
            PG8_STAGE(PG8_SB(1, 1), b3 + hstepB, voffB);
            PG8_WAIT_V(6); PG8_BAR; PG8_MMA(1, 1, At, B1); PG8_BAR;
            }
        }
        if constexpr (ALIGN_EPI) { if (wr == 0) PG8_BAR; }
        if constexpr (!Epi::AFTER_DRAIN) { E(acc, cur, wr, wc, fr, fq); S.done(cur); }
        if (!has_next) break;
#pragma unroll
        for (int a = 0; a < 2; ++a)
#pragma unroll
            for (int b = 0; b < 2; ++b)
#pragma unroll
                for (int m = 0; m < 4; ++m)
#pragma unroll
                    for (int n = 0; n < 2; ++n) acc[a][b][m][n] = (f32x4){0.f, 0.f, 0.f, 0.f};
        cur = nxt; cA = nA; cB = nB; ++ui;
        if constexpr (ALIGN_EPI) { if (wr == 1) PG8_BAR; }
    }
    PG8_WAIT_V(0);
    if constexpr (!ALIGN_EPI) { if (wr == 0) PG8_BAR; }
    PG8_BAR;
    if constexpr (Epi::AFTER_DRAIN) { E.fused(acc, cur, wr, wc, fr, fq, lds, wid, lane); S.done(cur); }
#undef PG8_SA
#undef PG8_SB
#undef PG8_STAGE
#undef PG8_LDA
#undef PG8_LDB
#undef PG8_MMA
#undef PG8_WAIT_V
#undef PG8_WAIT_L
#undef PG8_BAR
#undef PG8_SCHED
}
}
namespace pg8 {
__device__ __forceinline__ u32x4 pack8(const f32x4 a, const f32x4 b) { u32x4 w; w.x = cvt_pk_bf16(a[0], a[1]); w.y = cvt_pk_bf16(a[2], a[3]); w.z = cvt_pk_bf16(b[0], b[1]); w.w = cvt_pk_bf16(b[2], b[3]); return w; }
__device__ __forceinline__ void unpack8(const u32x4 w, f32x4& a, f32x4& b) {
    a[0] = __uint_as_float(w.x << 16); a[1] = __uint_as_float(w.x & 0xffff0000u); a[2] = __uint_as_float(w.y << 16); a[3] = __uint_as_float(w.y & 0xffff0000u);
    b[0] = __uint_as_float(w.z << 16); b[1] = __uint_as_float(w.z & 0xffff0000u); b[2] = __uint_as_float(w.w << 16); b[3] = __uint_as_float(w.w & 0xffff0000u); }
__device__ __forceinline__ float fsig(float x) { return __builtin_amdgcn_rcpf(1.f + __builtin_amdgcn_exp2f(-1.4426950408889634f * x)); }
__device__ __forceinline__ f32x4 fsig4(const f32x4 v) { f32x4 r; r[0] = fsig(v[0]); r[1] = fsig(v[1]); r[2] = fsig(v[2]); r[3] = fsig(v[3]); return r; }
__device__ __forceinline__ f32x4 gelu4(const f32x4 v) { const f32x2 a = gelu_pk((f32x2){v[0], v[1]}), b = gelu_pk((f32x2){v[2], v[3]}); return (f32x4){a.x, a.y, b.x, b.y}; }

struct SsmOrder {
    int G, c;
    __device__ bool next(int i, Unit& u) const { const int L = i * G + c; if (L >= 128) return false; u.pm = L; u.pn = L >> 2; return true; }
    __device__ __forceinline__ void a_ready(const Unit&) const {}
    __device__ __forceinline__ void done(const Unit&) const {}
};
struct MoeOrder {
    StaticOrder so; int pe0, pe1, pe2, pe3, pe4, pe5, pe6; int nN; int maxr;
    __device__ bool next(int i, Unit& u) const {
        if (i >= maxr || !so.next(i, u)) return false;
        const int r0 = u.pm * 256; const int e = (pe0 <= r0) + (pe1 <= r0) + (pe2 <= r0) + (pe3 <= r0) + (pe4 <= r0) + (pe5 <= r0) + (pe6 <= r0);
        u.pn += e * nN; return true; }
    __device__ __forceinline__ void a_ready(const Unit&) const {}
    __device__ __forceinline__ void done(const Unit&) const {}
};

struct MoeSplitOrder {
    int c, tile0, nsub, eoff;
    int pe0, pe1, pe2, pe3, pe4, pe5, pe6; int nN;
    __device__ bool next(int i, Unit& u) const {
        const int q = i * 256 + c; if (q >= nsub) return false;
        const int j = q / 6, ks = q - j * 6;
        u.pm = tile0 + (j >> 2);
        const int r0 = u.pm * 256; const int e = (pe0 <= r0) + (pe1 <= r0) + (pe2 <= r0) + (pe3 <= r0) + (pe4 <= r0) + (pe5 <= r0) + (pe6 <= r0);
        u.pn = (j & 3) + e * nN; u.ko = (ks < 4 ? ks * 8 : 32 + (ks - 4) * 6) * 128; u.nk = ks < 4 ? 8 : 6; u.aux = q; return true; }
    __device__ __forceinline__ void a_ready(const Unit&) const {}
    __device__ __forceinline__ void done(const Unit&) const {}
};

#define EPI_ROWS(u) const int rowb = (u).pm * BM + wr * 64 + fr
template <bool RS> struct EpiInProjT {
    static constexpr bool PERM = true, AFTER_DRAIN = false, MIDHOOK = false;
    bf16_t *Q, *Kb, *V, *AY, *G; const float *COS, *SIN; const PG8_LAS float* RSTD;
    __device__ __forceinline__ void operator()(const f32x4 (&acc_)[2][2][4][2], const Unit& u, int wr, int wc, int fr, int fq) const {
        EPI_ROWS(u); const int pn = u.pn;
#pragma unroll
        for (int ai = 0; ai < 2; ++ai)
#pragma unroll
            for (int m = 0; m < 4; ++m) {
                f32x4 c_[2][2];
                { const float rs = RS ? RSTD[ai * HALF + wr * 64 + m * 16 + fr] : 1.f;
#pragma unroll
                  for (int bj = 0; bj < 2; ++bj) { c_[bj][0] = RS ? acc_[ai][bj][m][0] * rs : acc_[ai][bj][m][0]; c_[bj][1] = RS ? acc_[ai][bj][m][1] * rs : acc_[ai][bj][m][1]; } }
                const int row = rowb + ai * HALF + m * 16, b = row >> 13, s = row & 8191;
                if (pn < 4) {
                    bf16_t* dst = pn < 2 ? Q : Kb; const int c = wc >> 1, jb = 16 * (wc & 1) + 4 * fq;
                    const f32x4 cs = *(const f32x4*)(COS + s * 32 + jb), sn = *(const f32x4*)(SIN + s * 32 + jb);
#pragma unroll
                    for (int bj = 0; bj < 2; ++bj) { const int h = 2 * (pn & 1) + bj; const f32x4 x1 = c_[bj][0], x2 = c_[bj][1];
                        *(u32x4*)(dst + ((((size_t)b * 4 + h) * 2 + c) * 8192 + s) * 64 + 32 * (wc & 1) + 8 * fq) = pack8(x1 * cs - x2 * sn, x2 * cs + x1 * sn); }
                } else if (pn < 6) {
#pragma unroll
                    for (int bj = 0; bj < 2; ++bj) { const int h = 2 * (pn - 4) + bj;
                        *(u32x4*)(V + (((size_t)b * 4 + h) * 8192 + s) * 128 + 32 * wc + 8 * fq) = pack8(c_[bj][0], c_[bj][1]); }
                } else if (pn < 8) {
#pragma unroll
                    for (int bj = 0; bj < 2; ++bj) { const int ucol = 256 * (pn - 6) + 128 * bj + 32 * wc + 8 * fq, g = ucol >> 4, hh0 = ucol & 15;
                        *(u32x4*)(AY + ((size_t)g * 1024 + b * 512 + (s >> 4)) * 512 + (s & 15) * 16 + hh0) = pack8(c_[bj][0], c_[bj][1]); }
                } else {
                    const int gcol = 128 * (pn - 8) + 32 * wc + 8 * fq; f32x4 rt[2], g1[2];
#pragma unroll
                    for (int n = 0; n < 2; ++n)
#pragma unroll
                        for (int e = 0; e < 4; ++e) { const float ea = __builtin_amdgcn_exp2f(-1.4426950408889634f * c_[0][n][e]), eb1 = 1.f + __builtin_amdgcn_exp2f(-1.4426950408889634f * c_[1][n][e]);
                            g1[n][e] = __builtin_amdgcn_rcpf(eb1); rt[n][e] = eb1 * __builtin_amdgcn_rcpf(1.f + ea); }
                    *(u32x4*)(G + (size_t)row * 2048 + gcol) = pack8(rt[0], rt[1]); *(u32x4*)(G + (size_t)row * 2048 + 1024 + gcol) = pack8(g1[0], g1[1]);
                }
            }
    }
};
typedef EpiInProjT<false> EpiInProj;
struct EpiXloc {
    static constexpr bool PERM = true, AFTER_DRAIN = false, MIDHOOK = false;
    float* XLOC;
    __device__ __forceinline__ void operator()(const f32x4 (&acc)[2][2][4][2], const Unit& u, int wr, int wc, int fr, int fq) const {
        EPI_ROWS(u);
#pragma unroll
        for (int ai = 0; ai < 2; ++ai)
#pragma unroll
            for (int m = 0; m < 4; ++m)
#pragma unroll
                for (int bj = 0; bj < 2; ++bj) { float* p = XLOC + (size_t)(rowb + ai * HALF + m * 16) * 256 + bj * HALF + 32 * wc + 8 * fq;
                    *(f32x4*)p = acc[ai][bj][m][0]; *(f32x4*)(p + 4) = acc[ai][bj][m][1]; }
    }
};
struct EpiY {
    static constexpr bool PERM = true, AFTER_DRAIN = false, MIDHOOK = false;
    bf16_t* SACT;
    __device__ __forceinline__ void operator()(const f32x4 (&acc)[2][2][4][2], const Unit& u, int wr, int wc, int fr, int fq) const {
        EPI_ROWS(u);
#pragma unroll
        for (int ai = 0; ai < 2; ++ai)
#pragma unroll
            for (int m = 0; m < 4; ++m) { const int R = rowb + ai * HALF + m * 16, g = R >> 10, bc = R & 1023;
#pragma unroll
                for (int bj = 0; bj < 2; ++bj) { const int col0 = bj * HALF + 32 * wc + 8 * fq, i = col0 >> 4, hh0 = col0 & 15;
                    *(u32x4*)(SACT + (size_t)(bc * 16 + i) * 512 + g * 16 + hh0) = pack8(gelu4(acc[ai][bj][m][0]), gelu4(acc[ai][bj][m][1])); } }
    }
};
struct EpiGlu {
    static constexpr bool PERM = true, AFTER_DRAIN = false, MIDHOOK = false;
    const bf16_t* SACT; bf16_t* AS2;
    __device__ __forceinline__ void operator()(const f32x4 (&acc)[2][2][4][2], const Unit& u, int wr, int wc, int fr, int fq) const {
        EPI_ROWS(u);
#pragma unroll
        for (int ai = 0; ai < 2; ++ai)
#pragma unroll
            for (int m = 0; m < 4; ++m) { const int row = rowb + ai * HALF + m * 16;
#pragma unroll
                for (int bj = 0; bj < 2; ++bj) { const int col0 = u.pn * BM + bj * HALF + 32 * wc + 8 * fq;
                    f32x4 s0, s1; unpack8(*(const u32x4*)(SACT + (size_t)row * 512 + col0), s0, s1);
                    *(u32x4*)(AS2 + (size_t)row * 1024 + 512 + col0) = pack8(s0 * fsig4(acc[ai][bj][m][0]), s1 * fsig4(acc[ai][bj][m][1])); } }
    }
};
struct EpiBranch {
    static constexpr bool PERM = true, AFTER_DRAIN = false, MIDHOOK = true;
    const bf16_t* G; bf16_t* MERGED;
    __device__ __forceinline__ void mid(f32x4 (&acc)[2][2][4][2], const Unit& u, int wr, int wc, int fr, int fq) const {
        asm volatile("" : "+v"(fr), "+v"(fq));
        EPI_ROWS(u);
#pragma unroll
        for (int ai = 0; ai < 2; ++ai)
#pragma unroll
            for (int m = 0; m < 4; ++m) { const int row = rowb + ai * HALF + m * 16;
#pragma unroll
                for (int bj = 0; bj < 2; ++bj) { const int col0 = u.pn * BM + bj * HALF + 32 * wc + 8 * fq;
                    f32x4 a0, a1; unpack8(*(const u32x4*)(G + (size_t)row * 2048 + col0), a0, a1);
#pragma unroll
                    for (int e = 0; e < 4; ++e) { acc[ai][bj][m][0][e] *= a0[e]; acc[ai][bj][m][1][e] *= a1[e]; } }
                asm volatile("" ::: "memory"); }
    }
    __device__ __forceinline__ void operator()(const f32x4 (&acc)[2][2][4][2], const Unit& u, int wr, int wc, int fr, int fq) const {
        EPI_ROWS(u);
#pragma unroll
        for (int ai = 0; ai < 2; ++ai)
#pragma unroll
            for (int m = 0; m < 4; ++m) { const int row = rowb + ai * HALF + m * 16;
#pragma unroll
                for (int bj = 0; bj < 2; ++bj) { const int col0 = u.pn * BM + bj * HALF + 32 * wc + 8 * fq;
                    f32x4 b0, b1; unpack8(*(const u32x4*)(G + (size_t)row * 2048 + 1024 + col0), b0, b1);
                    *(u32x4*)(MERGED + (size_t)row * 1024 + col0) = pack8(acc[ai][bj][m][0] * b0, acc[ai][bj][m][1] * b1); } }
    }
};
struct EpiRes {
    static constexpr bool PERM = true, AFTER_DRAIN = false, MIDHOOK = false;
    const float* SRC; float* X;
    __device__ __forceinline__ void operator()(const f32x4 (&acc)[2][2][4][2], const Unit& u, int wr, int wc, int fr, int fq) const {
        EPI_ROWS(u);
#pragma unroll
        for (int ai = 0; ai < 2; ++ai)
#pragma unroll
            for (int m = 0; m < 4; ++m) { const int row = rowb + ai * HALF + m * 16;
#pragma unroll
                for (int bj = 0; bj < 2; ++bj) { const size_t o = (size_t)row * 1024 + u.pn * BM + bj * HALF + 32 * wc + 8 * fq;
                    const f32x4 s0 = *(const f32x4*)(SRC + o), s1 = *(const f32x4*)(SRC + o + 4);
                    *(f32x4*)(X + o) = s0 + acc[ai][bj][m][0]; *(f32x4*)(X + o + 4) = s1 + acc[ai][bj][m][1]; } }
    }
};
template <bool RS> struct EpiSwigluT {
    static constexpr bool PERM = true, AFTER_DRAIN = false, MIDHOOK = false;
    bf16_t* H; int nN; const PG8_LAS float* RSTD;
    __device__ __forceinline__ void operator()(const f32x4 (&acc)[2][2][4][2], const Unit& u, int wr, int wc, int fr, int fq) const {
        EPI_ROWS(u); const int col0 = 128 * (u.pn % nN) + 32 * wc + 8 * fq;
#pragma unroll
        for (int ai = 0; ai < 2; ++ai)
#pragma unroll
            for (int m = 0; m < 4; ++m) { const int row = rowb + ai * HALF + m * 16;
                const float rs = RS ? RSTD[ai * HALF + wr * 64 + m * 16 + fr] : 1.f;
                const f32x4 a0 = RS ? acc[ai][0][m][0] * rs : acc[ai][0][m][0], a1 = RS ? acc[ai][0][m][1] * rs : acc[ai][0][m][1];
                const f32x4 b0 = RS ? acc[ai][1][m][0] * rs : acc[ai][1][m][0], b1 = RS ? acc[ai][1][m][1] * rs : acc[ai][1][m][1];
                *(u32x4*)(H + (size_t)row * 2816 + col0) = pack8(a0 * fsig4(a0) * b0, a1 * fsig4(a1) * b1); }
    }
};
typedef EpiSwigluT<false> EpiSwiglu;
struct EpiResB {
    static constexpr bool PERM = true, AFTER_DRAIN = false, MIDHOOK = false;
    const bf16_t* XN; float* X;
    __device__ __forceinline__ void operator()(const f32x4 (&acc)[2][2][4][2], const Unit& u, int wr, int wc, int fr, int fq) const {
        EPI_ROWS(u);
#pragma unroll
        for (int ai = 0; ai < 2; ++ai)
#pragma unroll
            for (int m = 0; m < 4; ++m) { const int row = rowb + ai * HALF + m * 16;
#pragma unroll
                for (int bj = 0; bj < 2; ++bj) { const size_t o = (size_t)row * 1024 + u.pn * BM + bj * HALF + 32 * wc + 8 * fq;
                    f32x4 s0, s1; unpack8(*(const u32x4*)(XN + o), s0, s1);
                    *(f32x4*)(X + o) = s0 + acc[ai][bj][m][0]; *(f32x4*)(X + o + 4) = s1 + acc[ai][bj][m][1]; } }
    }
};
template <bool WX, bool RB> struct EpiResNT {
    static constexpr bool PERM = true, AFTER_DRAIN = false, MIDHOOK = false;
    const float* SRC; float* X; bf16_t* XN; float* PS; const bf16_t* R16;
    __device__ __forceinline__ void operator()(const f32x4 (&acc)[2][2][4][2], const Unit& u, int wr, int wc, int fr, int fq) const {
        EPI_ROWS(u);
#pragma unroll
        for (int ai = 0; ai < 2; ++ai)
#pragma unroll
            for (int m = 0; m < 4; ++m) { const int row = rowb + ai * HALF + m * 16; float ss = 0.f;
#pragma unroll
                for (int bj = 0; bj < 2; ++bj) { const size_t o = (size_t)row * 1024 + u.pn * BM + bj * HALF + 32 * wc + 8 * fq;
                    f32x4 s0, s1;
                    if (RB) unpack8(*(const u32x4*)(R16 + o), s0, s1); else { s0 = *(const f32x4*)(SRC + o); s1 = *(const f32x4*)(SRC + o + 4); }
                    const f32x4 y0 = s0 + acc[ai][bj][m][0], y1 = s1 + acc[ai][bj][m][1];
                    if (WX) { *(f32x4*)(X + o) = y0; *(f32x4*)(X + o + 4) = y1; }
                    *(u32x4*)(XN + o) = pack8(y0, y1);
                    ss += (y0[0] * y0[0] + y0[1] * y0[1]) + (y0[2] * y0[2] + y0[3] * y0[3]) + (y1[0] * y1[0] + y1[1] * y1[1]) + (y1[2] * y1[2] + y1[3] * y1[3]); }
                { auto r = __builtin_amdgcn_permlane16_swap(__float_as_uint(ss), __float_as_uint(ss), false, false); ss = __uint_as_float(r[0]) + __uint_as_float(r[1]); }
                { auto r = __builtin_amdgcn_permlane32_swap(__float_as_uint(ss), __float_as_uint(ss), false, false); ss = __uint_as_float(r[0]) + __uint_as_float(r[1]); }
                if (fq == 0) PS[(size_t)(u.pn * 4 + wc) * 16384 + row] = ss; }
    }
};
struct EpiMoeDown {
    static constexpr bool PERM = true, AFTER_DRAIN = false, MIDHOOK = false;
    bf16_t* YS;
    __device__ __forceinline__ void operator()(const f32x4 (&acc)[2][2][4][2], const Unit& u, int wr, int wc, int fr, int fq) const {
        EPI_ROWS(u);
#pragma unroll
        for (int ai = 0; ai < 2; ++ai)
#pragma unroll
            for (int m = 0; m < 4; ++m) { const int row = rowb + ai * HALF + m * 16;
#pragma unroll
                for (int bj = 0; bj < 2; ++bj)
                    *(u32x4*)(YS + (size_t)row * 1024 + (u.pn & 3) * BM + bj * HALF + 32 * wc + 8 * fq) = pack8(acc[ai][bj][m][0], acc[ai][bj][m][1]); }
    }
};
struct EpiMoeDownPart {
    static constexpr bool PERM = true, AFTER_DRAIN = false, MIDHOOK = false;
    float* P;
    __device__ __forceinline__ void operator()(const f32x4 (&acc)[2][2][4][2], const Unit& u, int wr, int wc, int fr, int fq) const {
        float* base = P + (size_t)u.aux * 65536 + (size_t)(wr * 64 + fr) * 256 + 32 * wc + 8 * fq;
#pragma unroll
        for (int ai = 0; ai < 2; ++ai)
#pragma unroll
            for (int m = 0; m < 4; ++m)
#pragma unroll
                for (int bj = 0; bj < 2; ++bj) { float* d = base + (ai * HALF + m * 16) * 256 + bj * HALF;
                    *(f32x4*)d = acc[ai][bj][m][0]; *(f32x4*)(d + 4) = acc[ai][bj][m][1]; }
    }
};
#undef EPI_ROWS
}
#define XB_TMO      128
#define XB_XCNT(j)  (256  + 64 * (j))
#define XB_XSUB(j)  (1280 + 64 * (j))
#define XB_XGEN(j)  (2304 + 64 * (j))
#define XB_TOP      3328
#define XB_TOPGEN   3392
#define XCD_BAR_WORDS 3456
#define XB_SPIN_CAP (1u << 18)

__device__ __forceinline__ unsigned xb_ld(unsigned* p)              { return __hip_atomic_load(p, __ATOMIC_RELAXED, __HIP_MEMORY_SCOPE_AGENT); }
__device__ __forceinline__ unsigned xb_add(unsigned* p, unsigned v) { return __hip_atomic_fetch_add(p, v, __ATOMIC_RELAXED, __HIP_MEMORY_SCOPE_AGENT); }
__device__ __forceinline__ unsigned xb_xcc_id() { return (unsigned)__builtin_amdgcn_s_getreg((3 << 11) | 20) & 0xFu; }
#define XB_SPIN(cond, bar) do { unsigned _sp = 0; while (cond) { __builtin_amdgcn_s_sleep(1); \
    if ((++_sp & 255u) == 0u) { if (xb_ld(&(bar)[XB_TMO])) break; if (_sp > XB_SPIN_CAP) { atomicAdd(&(bar)[XB_TMO], 1u); break; } } } } while (0)

struct XcdBarrier {
    unsigned* bar; unsigned x;
    volatile LAS unsigned* st;
};

__device__ __forceinline__ XcdBarrier xcd_barrier_post(unsigned* bar, volatile LAS unsigned* st) {
    XcdBarrier b; b.bar = bar; b.x = xb_xcc_id(); b.st = st;
    if (threadIdx.x == 0) (void)xb_add(&bar[XB_XCNT(b.x)], 1u);
    return b;
}
__device__ __forceinline__ void xcd_barrier_complete(unsigned* bar, unsigned x, unsigned& nloc, unsigned& nx) {
    const unsigned G = gridDim.x * gridDim.y * gridDim.z;
    unsigned sum, cnt, mine, sp = 0u;
    for (;;) {
        sum = 0u; cnt = 0u; mine = 0u;
#pragma unroll
        for (unsigned j = 0; j < 16; ++j) { const unsigned c = xb_ld(&bar[XB_XCNT(j)]); sum += c; cnt += (c > 0u) ? 1u : 0u; mine = (j == x) ? c : mine; }
        if (sum == G) break;
        __builtin_amdgcn_s_sleep(1);
        if ((++sp & 255u) == 0u) { if (xb_ld(&bar[XB_TMO])) break; if (sp > XB_SPIN_CAP) { atomicAdd(&bar[XB_TMO], 1u); break; } }
    }
    nloc = mine > 0u ? mine : 1u; nx = cnt > 0u ? cnt : 1u;
}

__device__ __forceinline__ void xcd_barrier(const XcdBarrier& b) {
    asm volatile("s_waitcnt vmcnt(0)" ::: "memory");
    __syncthreads();
    if (threadIdx.x == 0) {
        unsigned* bar = b.bar;
        __builtin_amdgcn_s_waitcnt(0);
        unsigned nloc = b.st[0], nx = b.st[1];
        if (nloc == 0u) { xcd_barrier_complete(bar, b.x, nloc, nx); b.st[0] = nloc; b.st[1] = nx; }
        const unsigned old = xb_add(&bar[XB_XSUB(b.x)], 1u);
        const unsigned gen = old / nloc;
        if (old + 1u == (gen + 1u) * nloc) {
            __builtin_amdgcn_fence(__ATOMIC_RELEASE, "agent");
            asm volatile("s_waitcnt vmcnt(0)" ::: "memory");
            const unsigned og = xb_add(&bar[XB_TOP], 1u);
            const unsigned tg = og / nx;
            if (og + 1u == (tg + 1u) * nx) xb_add(&bar[XB_TOPGEN], 1u);
            else XB_SPIN(xb_ld(&bar[XB_TOPGEN]) == tg, bar);
            __builtin_amdgcn_fence(__ATOMIC_ACQUIRE, "agent");
            xb_add(&bar[XB_XGEN(b.x)], 1u);
            asm volatile("s_waitcnt vmcnt(0)" ::: "memory");
        } else {
            XB_SPIN(xb_ld(&bar[XB_XGEN(b.x)]) == gen, bar);
            __builtin_amdgcn_fence(__ATOMIC_ACQUIRE, "agent");
            asm volatile("s_waitcnt vmcnt(0)" ::: "memory");
        }
    }
    __syncthreads();
}

namespace att {
using bf16x8 = __attribute__((ext_vector_type(8))) short;
using s16x4  = __attribute__((ext_vector_type(4))) short;
using f32x16 = __attribute__((ext_vector_type(16))) float;
using u32x4  = __attribute__((ext_vector_type(4))) unsigned;
constexpr int NW = 8, QBLK = 32, KVBLK = 64;
constexpr float SCALE = 0.125f;
constexpr int SHM_V = KVBLK * 128 * 2, SHM_K = KVBLK * 64 * 2, SHM_ATTN = 4 * SHM_V + 4 * SHM_K + NW * 64 * 4;
#define KSWZ64(row, colB) ((row) * 128 + ((colB) ^ ((((row) >> 1) & 7) << 4)))
#define SBAR() __builtin_amdgcn_sched_barrier(0)
__device__ __forceinline__ int crow(int r, int hi) { return (r & 3) + 8 * (r >> 2) + 4 * hi; }
typedef __bf16 bf16x2_cv __attribute__((ext_vector_type(2))); typedef float f32x2_cv __attribute__((ext_vector_type(2)));
__device__ __forceinline__ unsigned cvtpk(float lo, float hi) { const bf16x2_cv r = __builtin_convertvector((f32x2_cv){lo, hi}, bf16x2_cv); return __builtin_bit_cast(unsigned, r); }
__device__ __forceinline__ void partialSM(f32x16& p0, f32x16& p1, float mb) {
  constexpr float C = SCALE * 1.4426950408889634f;
#pragma unroll
  for (int r = 0; r < 16; ++r) p0[r] = fmaf(p0[r], C, -mb);
#pragma unroll
  for (int r = 0; r < 16; ++r) p1[r] = fmaf(p1[r], C, -mb);
#pragma unroll
  for (int r = 0; r < 16; ++r) p0[r] = __builtin_amdgcn_exp2f(p0[r]);
}
__device__ __forceinline__ void finishSM(f32x16& p0, f32x16& p1, float& l_reg, bf16x8& pa0, bf16x8& pa1, bf16x8& pa2, bf16x8& pa3) {
#pragma unroll
  for (int r = 0; r < 16; ++r) p1[r] = __builtin_amdgcn_exp2f(p1[r]);
  typedef __bf16 bf2_t __attribute__((ext_vector_type(2)));
  const bf2_t one2 = {(__bf16)1.0f, (__bf16)1.0f};
  float ps0 = 0.f, ps1 = 0.f;
#define DOT1(acc, w) acc = __builtin_amdgcn_fdot2_f32_bf16(__builtin_bit_cast(bf2_t, (unsigned)(w)), one2, acc, false)
#define PK4(P, BASE, OUT) do { unsigned a0 = cvtpk(P[BASE + 0], P[BASE + 1]), a1 = cvtpk(P[BASE + 2], P[BASE + 3]);   \
    unsigned b0 = cvtpk(P[BASE + 4], P[BASE + 5]), b1 = cvtpk(P[BASE + 6], P[BASE + 7]);                              \
    DOT1(ps0, a0); DOT1(ps1, a1); DOT1(ps0, b0); DOT1(ps1, b1);                                                       \
    u32x4 w = {a0, a1, b0, b1}; OUT = *reinterpret_cast<bf16x8*>(&w); } while (0)
  PK4(p0, 0, pa0); PK4(p0, 8, pa1); PK4(p1, 0, pa2); PK4(p1, 8, pa3);
  l_reg += ps0 + ps1;
#undef DOT1
#undef PK4
}
template <int OFF> __device__ __forceinline__ bf16x8 k_read(int ka) { bf16x8 r; asm volatile("ds_read_b128 %0, %1 offset:%2" : "=&v"(r) : "v"(ka), "i"(OFF) : "memory"); return r; }
__device__ __forceinline__ void qkt(f32x16& p0, f32x16& p1, const char* Ks, const bf16x8* qr, int r32, int hi) {
  p0 = f32x16{}; p1 = f32x16{};
  const int sw = (r32 >> 1) & 7, base = (int)(uintptr_t)Ks + r32 * 128;
  const int a0 = base + (((0 + hi) ^ sw) << 4), a1 = base + (((2 + hi) ^ sw) << 4), a2 = base + (((4 + hi) ^ sw) << 4), a3 = base + (((6 + hi) ^ sw) << 4);
  const bf16x8 k00 = k_read<0>(a0), k01 = k_read<4096>(a0), k10 = k_read<0>(a1), k11 = k_read<4096>(a1), k20 = k_read<0>(a2), k21 = k_read<4096>(a2), k30 = k_read<0>(a3), k31 = k_read<4096>(a3);
  asm volatile("s_waitcnt lgkmcnt(0)" ::: "memory"); SBAR();
  p0 = __builtin_amdgcn_mfma_f32_32x32x16_bf16(k00, qr[0], p0, 0, 0, 0); p1 = __builtin_amdgcn_mfma_f32_32x32x16_bf16(k01, qr[0], p1, 0, 0, 0);
  p0 = __builtin_amdgcn_mfma_f32_32x32x16_bf16(k10, qr[1], p0, 0, 0, 0); p1 = __builtin_amdgcn_mfma_f32_32x32x16_bf16(k11, qr[1], p1, 0, 0, 0);
  p0 = __builtin_amdgcn_mfma_f32_32x32x16_bf16(k20, qr[2], p0, 0, 0, 0); p1 = __builtin_amdgcn_mfma_f32_32x32x16_bf16(k21, qr[2], p1, 0, 0, 0);
  p0 = __builtin_amdgcn_mfma_f32_32x32x16_bf16(k30, qr[3], p0, 0, 0, 0); p1 = __builtin_amdgcn_mfma_f32_32x32x16_bf16(k31, qr[3], p1, 0, 0, 0);
}
__device__ __forceinline__ int v_st(int k, int c) { const int kk = k; return ((kk >> 3) * 4 + (c >> 5)) * 512 + ((kk & 7) * 32 + (c & 31)) * 2; }
__device__ __forceinline__ int v_rd_base(int lane) { return ((lane & 3) << 3) | (((lane >> 2) & 3) << 6) | (((lane >> 4) & 1) << 5) | (((lane >> 5) & 1) << 8); }
constexpr int v_rd_off(int d0, int ks, int half) { return d0 * 512 + ks * 4096 + half * 2048; }
template <int OFF> __device__ __forceinline__ s16x4 tr_read(int vb) {
  s16x4 r; asm volatile("ds_read_b64_tr_b16 %0, %1 offset:%2" : "=&v"(r) : "v"(vb), "i"(OFF) : "memory"); return r;
}
template <int D0> __device__ __forceinline__ void pv_one(f32x16& od, int vb, bf16x8 pa0, bf16x8 pa1, bf16x8 pa2, bf16x8 pa3) {
  const s16x4 l0 = tr_read<v_rd_off(D0, 0, 0)>(vb), h0 = tr_read<v_rd_off(D0, 0, 1)>(vb), l1 = tr_read<v_rd_off(D0, 1, 0)>(vb), h1 = tr_read<v_rd_off(D0, 1, 1)>(vb);
  const s16x4 l2 = tr_read<v_rd_off(D0, 2, 0)>(vb), h2 = tr_read<v_rd_off(D0, 2, 1)>(vb), l3 = tr_read<v_rd_off(D0, 3, 0)>(vb), h3 = tr_read<v_rd_off(D0, 3, 1)>(vb);
  asm volatile("s_waitcnt lgkmcnt(0)" ::: "memory"); SBAR();
#define PK(L, H) (bf16x8){L[0], L[1], L[2], L[3], H[0], H[1], H[2], H[3]}
  od = __builtin_amdgcn_mfma_f32_32x32x16_bf16(pa0, PK(l0, h0), od, 0, 0, 0);
  od = __builtin_amdgcn_mfma_f32_32x32x16_bf16(pa1, PK(l1, h1), od, 0, 0, 0);
  od = __builtin_amdgcn_mfma_f32_32x32x16_bf16(pa2, PK(l2, h2), od, 0, 0, 0);
  od = __builtin_amdgcn_mfma_f32_32x32x16_bf16(pa3, PK(l3, h3), od, 0, 0, 0);
#undef PK
}
__device__ __forceinline__ void pv_d0(f32x16* o, int vb, bf16x8 pa0, bf16x8 pa1, bf16x8 pa2, bf16x8 pa3) {
  pv_one<0>(o[0], vb, pa0, pa1, pa2, pa3); pv_one<1>(o[1], vb, pa0, pa1, pa2, pa3); pv_one<2>(o[2], vb, pa0, pa1, pa2, pa3); pv_one<3>(o[3], vb, pa0, pa1, pa2, pa3);
}

__device__ __forceinline__ void diff_attn_unit(const unsigned short* __restrict__ Qh, const unsigned short* __restrict__ Kh, const unsigned short* __restrict__ Vh, int i0,
                                               const unsigned* __restrict__ kmax2, float* __restrict__ O1s, unsigned short* __restrict__ OUT, const float* __restrict__ subln, float lam, float oml, char* lds) {
  constexpr int SEQL = 8192, NT = SEQL / KVBLK;
  char* V_lds = lds; char* K_lds = lds + 4 * SHM_V;
  for (int c = 0; c < 2; ++c) {
    int tid_l = threadIdx.x; asm volatile("" : "+v"(tid_l));
    const int tid = tid_l, wid = __builtin_amdgcn_readfirstlane(tid >> 6), lane = tid & 63, r32 = lane & 31, hi = lane >> 5;
    const int sr = tid >> 4, sc = (tid & 15) * 8, vst0 = v_st(sr, sc), vst1 = v_st(32 + sr, sc);
    const int kr = tid >> 3, kcb = (tid & 7) * 16, kst = KSWZ64(kr, kcb);
    const int vb0 = (int)(uintptr_t)V_lds + v_rd_base(lane);
    const unsigned short* Kc = Kh + (size_t)c * SEQL * 64;
    float l_reg = 0; f32x16 o[4] = {}; bf16x8 qr[4];
    const unsigned short* Qw = Qh + (size_t)c * SEQL * 64 + (size_t)(i0 + wid * QBLK + r32) * 64 + hi * 8;
#pragma unroll
    for (int d0 = 0; d0 < 4; ++d0) qr[d0] = *reinterpret_cast<const bf16x8*>(Qw + d0 * 16);
    float mb;
    { float q2 = 0.f;
#pragma unroll
      for (int d0 = 0; d0 < 4; ++d0)
#pragma unroll
        for (int e = 0; e < 8; ++e) { const float qv = __uint_as_float(((unsigned)(unsigned short)qr[d0][e]) << 16); q2 = fmaf(qv, qv, q2); }
      { auto rr = __builtin_amdgcn_permlane32_swap(__float_as_uint(q2), __float_as_uint(q2), false, false); q2 = __uint_as_float(rr[0]) + __uint_as_float(rr[1]); }
      mb = sqrtf(q2 * __uint_as_float(kmax2[c])) * (SCALE * 1.4426950408889634f); }
    struct { bf16x8 vs0, vs1, ks0; } sr_[3];
    const unsigned voV = (unsigned)(sr * 128 + sc) * 2u, voV1 = voV + 8192u, voK = (unsigned)(kr * 64 + (tid & 7) * 8) * 2u;
    const __amdgpu_buffer_rsrc_t rV = __builtin_amdgcn_make_buffer_rsrc((void*)Vh, 0, 0x7fffffff, 0x00020000), rK = __builtin_amdgcn_make_buffer_rsrc((void*)Kc, 0, 0x7fffffff, 0x00020000);
#define SLOAD(i, k0) do { const u32x4 a_ = __builtin_amdgcn_raw_buffer_load_b128(rV, voV, (k0) * 256, 0), b_ = __builtin_amdgcn_raw_buffer_load_b128(rV, voV1, (k0) * 256, 0), \
        c_ = __builtin_amdgcn_raw_buffer_load_b128(rK, voK, (k0) * 128, 0); \
    sr_[i].vs0 = __builtin_bit_cast(bf16x8, a_); sr_[i].vs1 = __builtin_bit_cast(bf16x8, b_); sr_[i].ks0 = __builtin_bit_cast(bf16x8, c_); } while (0)
#define SWRITE(b, i) do { *(bf16x8*)(V_lds + (b) * SHM_V + vst0) = sr_[i].vs0; *(bf16x8*)(V_lds + (b) * SHM_V + vst1) = sr_[i].vs1; \
    *(bf16x8*)(K_lds + (b) * SHM_K + kst) = sr_[i].ks0; } while (0)
#define LBAR() do { asm volatile("s_waitcnt lgkmcnt(0)" ::: "memory"); __builtin_amdgcn_s_barrier(); asm volatile("" ::: "memory"); } while (0)
    f32x16 pA0, pA1, pB0, pB1; bf16x8 pa0, pa1, pa2, pa3;
    __syncthreads();
    SLOAD(0, 0); SLOAD(1, KVBLK); SLOAD(2, 2 * KVBLK); SWRITE(0, 0); SWRITE(1, 1); SWRITE(2, 2); __syncthreads();
    qkt(pA0, pA1, K_lds, qr, r32, hi); partialSM(pA0, pA1, mb);
    if (wid >= 4) { __builtin_amdgcn_s_setprio(1); LBAR(); }
    for (int j = 1; j + 1 < NT; j += 2) {
      SLOAD(0, (j + 2) * KVBLK);
      SBAR(); qkt(pB0, pB1, K_lds + (j & 3) * SHM_K, qr, r32, hi);
      finishSM(pA0, pA1, l_reg, pa0, pa1, pa2, pa3); SBAR();
      LBAR();
      pv_d0(o, vb0 + ((j - 1) & 3) * SHM_V, pa0, pa1, pa2, pa3); SBAR(); partialSM(pB0, pB1, mb); SBAR();
      SWRITE((j + 2) & 3, 0);
      LBAR();
      if (j + 3 < NT) SLOAD(0, (j + 3) * KVBLK);
      SBAR(); qkt(pA0, pA1, K_lds + ((j + 1) & 3) * SHM_K, qr, r32, hi);
      finishSM(pB0, pB1, l_reg, pa0, pa1, pa2, pa3); SBAR();
      LBAR();
      pv_d0(o, vb0 + (j & 3) * SHM_V, pa0, pa1, pa2, pa3); SBAR(); partialSM(pA0, pA1, mb); SBAR();
      if (j + 3 < NT) SWRITE((j + 3) & 3, 0);
      LBAR();
    }
    SBAR(); qkt(pB0, pB1, K_lds + ((NT - 1) & 3) * SHM_K, qr, r32, hi);
    finishSM(pA0, pA1, l_reg, pa0, pa1, pa2, pa3); SBAR();
    pv_d0(o, vb0 + ((NT - 2) & 3) * SHM_V, pa0, pa1, pa2, pa3); partialSM(pB0, pB1, mb);
    finishSM(pB0, pB1, l_reg, pa0, pa1, pa2, pa3); SBAR();
    pv_d0(o, vb0 + ((NT - 1) & 3) * SHM_V, pa0, pa1, pa2, pa3);
    if (wid < 4) LBAR();
    __builtin_amdgcn_s_setprio(0);
    { auto rr = __builtin_amdgcn_permlane32_swap(__float_as_uint(l_reg), __float_as_uint(l_reg), false, false); l_reg = __uint_as_float(rr[0]) + __uint_as_float(rr[1]); }
    { int t2 = threadIdx.x; asm volatile("" : "+v"(t2));
      const int wid2 = __builtin_amdgcn_readfirstlane(t2 >> 6), lane2 = t2 & 63, r322 = lane2 & 31, hi2 = lane2 >> 5;
      float* li_l = (float*)(lds + 4 * SHM_V + 4 * SHM_K) + wid2 * 64;
      if (hi2 == 0) li_l[r322] = l_reg; asm volatile("s_waitcnt lgkmcnt(0)" ::: "memory");
      float* O1w = O1s + (size_t)c * 32768 + (size_t)wid2 * 4096 + lane2;
#pragma unroll
      for (int r = 0; r < 16; ++r) { const float rl = __builtin_amdgcn_rcpf(li_l[crow(r, hi2)]);
#pragma unroll
        for (int d0 = 0; d0 < 4; ++d0) O1w[(d0 * 16 + r) * 64] = o[d0][r] * rl; } }
#undef SLOAD
#undef SWRITE
#undef LBAR
  }
  {
    int t3 = threadIdx.x; asm volatile("" : "+v"(t3));
    const int wid = __builtin_amdgcn_readfirstlane(t3 >> 6), lane = t3 & 63, r32 = lane & 31, hi = lane >> 5;
    const float* Ow = O1s + (size_t)wid * 4096 + lane;
    float sg[4];
#pragma unroll
    for (int d0 = 0; d0 < 4; ++d0) sg[d0] = subln[d0 * 32 + r32] * oml;
#pragma unroll 4
    for (int r = 0; r < 16; ++r) {
      float v[4], ss = 0.f;
#pragma unroll
      for (int d0 = 0; d0 < 4; ++d0) { v[d0] = Ow[(d0 * 16 + r) * 64] - lam * Ow[32768 + (d0 * 16 + r) * 64]; ss += v[d0] * v[d0]; }
#pragma unroll
      for (int of = 1; of < 32; of <<= 1) ss += __int_as_float(__builtin_amdgcn_ds_bpermute((lane ^ of) << 2, __float_as_int(ss)));
      const float rstd = rsqrtf(ss * (1.f / 128.f) + 1e-6f);
      unsigned short* op = OUT + (size_t)(wid * QBLK + crow(r, hi)) * 1024 + r32;
#pragma unroll
      for (int d0 = 0; d0 < 4; ++d0) { const float y = v[d0] * rstd * sg[d0]; unsigned u = __float_as_uint(y); op[d0 * 32] = (unsigned short)((u + 0x7fffu + ((u >> 16) & 1u)) >> 16); }
    }
  }
}
}
constexpr int NWAVES = 8;
constexpr int RING_OFF = 0, RING_BYTES = 131072;
constexpr int LDSCTL_OFF = RING_BYTES, MISC_OFF = LDSCTL_OFF + 320;
constexpr int LDS_BYTES = 147456;
constexpr int RSTD_OFF = LDSCTL_OFF + 8192;
constexpr int CW_BAR = 4096;
constexpr int CW_KMAX = 8448;
constexpr int CW_CNT = 8192;
constexpr int CW_BLKCNT = 10240;
constexpr int CW_SPLT = 9216;
constexpr size_t CTL_ZERO_BYTES = 64 * 1024;
constexpr int PH_PRO = 0, PH_L0 = 1, PH_PER_LAYER = 12, PH_FINAL = PH_L0 + DEPTH * PH_PER_LAYER, PH_END = PH_FINAL + 1;
enum { P_NORM1 = 0, P_INPROJ, P_XLOC, P_SCAN, P_MIX, P_GLU, P_BRANCH, P_OUT, P_NORM2, P_ASSIGN, P_UP, P_DOWN };

struct Args {
    const float* in[25]; float* out; unsigned char* ws;
    double inv_freq[32];
    int ph_lo, ph_hi, sub, pad;
};

typedef const __attribute__((address_space(4))) Args* ArgsP;
__device__ __forceinline__ ArgsP get_args() { ArgsP p = (ArgsP)__builtin_amdgcn_kernarg_segment_ptr(); asm volatile("" : "+s"(p)); return p; }
#define LDS_WAIT() asm volatile("s_waitcnt lgkmcnt(0)" ::: "memory")
#define VM_WAIT() asm volatile("s_waitcnt vmcnt(0)" ::: "memory")
typedef unsigned v4u __attribute__((ext_vector_type(4)));
__device__ __forceinline__ unsigned pk2(float lo, float hi) { return (unsigned)f2bf(lo) | ((unsigned)f2bf(hi) << 16); }

template <class RowMap>
__device__ __forceinline__ void transpose_item(const float* __restrict__ W, int N, bf16* __restrict__ WT, int ldt, int koff, LAS float* scr, int item, int lane, const RowMap& rm, const float* __restrict__ gk = nullptr) {
    const int nblk = N / 32, kb = item / nblk, nb = item % nblk, k0 = 64 * kb, n0 = 32 * nb;
    float wv[32];
    const float* wp = W + (size_t)(k0 + (lane >> 5)) * N + n0 + (lane & 31);
#pragma unroll
    for (int i = 0; i < 32; ++i) wv[i] = wp[(size_t)(2 * i) * N];
#pragma unroll
    for (int i = 0; i < 32; ++i) scr[(2 * i + (lane >> 5)) * 33 + (lane & 31)] = wv[i];
    LDS_WAIT(); asm volatile("" ::: "memory");
    const int c = lane & 7;
    f32x4 g0 = {1.f, 1.f, 1.f, 1.f}, g1 = g0;
    if (gk) { g0 = *(const f32x4*)(gk + k0 + 8 * c); g1 = *(const f32x4*)(gk + k0 + 8 * c + 4); }
#pragma unroll
    for (int j = 0; j < 4; ++j) { const int n = (lane >> 3) + 8 * j; const LAS float* s = scr + (8 * c) * 33 + n;
        v4u o; o.x = pk2(s[0 * 33] * g0.x, s[1 * 33] * g0.y); o.y = pk2(s[2 * 33] * g0.z, s[3 * 33] * g0.w); o.z = pk2(s[4 * 33] * g1.x, s[5 * 33] * g1.y); o.w = pk2(s[6 * 33] * g1.z, s[7 * 33] * g1.w);
        *(v4u*)(WT + (size_t)rm(n0 + n) * ldt + koff + k0 + 8 * c) = o; }
    LDS_WAIT(); asm volatile("" ::: "memory");
}
struct RmId { __device__ __forceinline__ int operator()(int n) const { return n; } };
struct RmInProj { __device__ __forceinline__ int operator()(int n) const {
    if (n < 1024) return (n & ~63) + qk_pos(n & 63);
    if (n < 2048) return n;
    const int j = n - 2048, k = j & 1023; return 2048 + (k >> 7) * 256 + (j >= 1024 ? 128 : 0) + (k & 127); } };
struct RmGlu13 { int half; __device__ __forceinline__ int operator()(int n) const { return (n >> 7) * 256 + half * 128 + (n & 127); } };
struct TItem { const float* src; bf16* dst; int N, ldt, koff, map, k0, n0; };
__device__ __forceinline__ void t_setkn(TItem& t, int item) { const int nblk = t.N / 32; t.k0 = 64 * (item / nblk); t.n0 = 32 * (item % nblk); }
__device__ __forceinline__ void t_load(const TItem& t, int lane, float (&wv)[32]) {
    const float* wp = t.src + (size_t)(t.k0 + (lane >> 5)) * t.N + t.n0 + (lane & 31);
#pragma unroll
    for (int i = 0; i < 32; ++i) wv[i] = wp[(size_t)(2 * i) * t.N];
}
__device__ __forceinline__ void t_store(const TItem& t, int lane, const float (&wv)[32], LAS float* scr) {
#pragma unroll
    for (int i = 0; i < 32; ++i) scr[(2 * i + (lane >> 5)) * 33 + (lane & 31)] = wv[i];
    LDS_WAIT(); asm volatile("" ::: "memory");
    const int c = lane & 7;
#pragma unroll
    for (int j = 0; j < 4; ++j) { const int n = (lane >> 3) + 8 * j; const LAS float* q = scr + (8 * c) * 33 + n; const int nn = t.n0 + n;
        const int row = t.map == 0 ? nn : (t.map == 1 ? (nn < 1024 ? (nn & ~63) + qk_pos(nn & 63) : nn) : (nn >> 7) * 256 + (t.map - 2) * 128 + (nn & 127));
        v4u o; o.x = pk2(q[0 * 33], q[1 * 33]); o.y = pk2(q[2 * 33], q[3 * 33]); o.z = pk2(q[4 * 33], q[5 * 33]); o.w = pk2(q[6 * 33], q[7 * 33]);
        *(v4u*)(t.dst + (size_t)row * t.ldt + t.koff + t.k0 + 8 * c) = o; }
    LDS_WAIT(); asm volatile("" ::: "memory");
}
#define T_SWEEP(first, step, total, DEC) do { int it_ = (first); if (it_ < (total)) { TItem ta_, tb_; float va_[32], vb_[32]; DEC(it_, ta_); t_load(ta_, lane, va_); \
    for (;;) { const int i2_ = it_ + (step); const bool h2_ = i2_ < (total); if (h2_) { DEC(i2_, tb_); t_load(tb_, lane, vb_); } t_store(ta_, lane, va_, scr); if (!h2_) break; \
               it_ = i2_ + (step); const bool h3_ = it_ < (total); if (h3_) { DEC(it_, ta_); t_load(ta_, lane, va_); } t_store(tb_, lane, vb_, scr); if (!h3_) break; } } } while (0)

constexpr size_t WO_IN = 0, WO_GLU = WO_IN + 32 * MiB, WO_BR = WO_GLU + 2 * MiB, WO_OUT = WO_BR + 8 * MiB, WO_F13 = WO_OUT + 8 * MiB, WO_F2 = WO_F13 + 22 * MiB,
                 WO_M13 = WO_F2 + 11 * MiB, WO_M2 = WO_M13 + 88 * MiB, WO_BY = WO_M2 + 44 * MiB, WO_BX = WO_BY + 32 * MiB, WO_ROT = WO_BX + 16 * MiB, WO_END = WO_ROT + 2 * MiB;
static_assert(WS_WEIGHTS + WO_END <= WS_XN, "weights region");

__device__ __forceinline__ int ltid() { int t = threadIdx.x; asm volatile("" : "+v"(t)); return t; }
#define PHASE_IDS const int tid = ltid(), lane = tid & 63, wave = __builtin_amdgcn_readfirstlane(tid >> 6); (void)lane; (void)wave
struct Frame {
    LAS unsigned char* lds; int vcu, G, bx;
};
__device__ __forceinline__ Frame make_frame(LAS unsigned char* lds) {
    Frame F; F.lds = lds; int G = gridDim.x, bx = blockIdx.x; asm volatile("" : "+s"(G), "+s"(bx));
    F.G = G; F.bx = bx; F.vcu = (G % 8 == 0) ? (bx % 8) * (G / 8) + bx / 8 : bx; return F;
}
__device__ __forceinline__ float shx(float v, int o, int lane) { return __int_as_float(__builtin_amdgcn_ds_bpermute((lane ^ o) << 2, __float_as_int(v))); }
#define WS_DPP(v, ctrl) ((v) + __int_as_float(__builtin_amdgcn_mov_dpp(__float_as_int(v), (ctrl), 0xf, 0xf, true)))
__device__ __forceinline__ float wave_sum_l(float v, int lane) {
    (void)lane;
    v = WS_DPP(v, 0xB1);
    v = WS_DPP(v, 0x4E);
    v = WS_DPP(v, 0x141);
    v = WS_DPP(v, 0x140);
    { auto r = __builtin_amdgcn_permlane16_swap(__float_as_uint(v), __float_as_uint(v), false, false); v = __uint_as_float(r[0]) + __uint_as_float(r[1]); }
    { auto r = __builtin_amdgcn_permlane32_swap(__float_as_uint(v), __float_as_uint(v), false, false); v = __uint_as_float(r[0]) + __uint_as_float(r[1]); }
    return v;
}

__device__ __forceinline__ void ssm_gen_item(const Frame& F, ArgsP A, int item) {
    unsigned char* ws = A->ws;
    PHASE_IDS; const int layer = item >> 5, g = item & 31;
    LAS float* L = (LAS float*)(F.lds);
    LAS float* apr = L;
    LAS float* api = apr + 2 * 17 * 64;
    LAS float* bbr = api + 2 * 17 * 64;
    LAS float* bbi = bbr + 2 * 64 * 16;
    LAS float* cr = bbi + 2 * 64 * 16;
    LAS float* ci = cr + 2 * 16 * 64;
    LAS float* Kt = ci + 2 * 16 * 64;
    LAS float* ff = Kt + 2 * 16 * 256;
    LAS float* apj = ff + 2 * 64 * 2;
    const float* lam_re = A->in[5] + (size_t)layer * 2 * SSM_G * SSM_P; const float* lam_im = A->in[6] + (size_t)layer * 2 * SSM_G * SSM_P; const float* log_dt = A->in[7] + layer * 2 * SSM_G;
    const float* b_re = A->in[8] + (size_t)layer * 2 * SSM_G * SSM_P * 16; const float* b_im = A->in[9] + (size_t)layer * 2 * SSM_G * SSM_P * 16;
    const float* c_re = A->in[10] + (size_t)layer * 2 * SSM_G * 16 * SSM_P; const float* c_im = A->in[11] + (size_t)layer * 2 * SSM_G * 16 * SSM_P;
    const float* dsk = A->in[12] + layer * SSM_W + g * 16;
    {
        const int d = (tid >> 6) & 1, p = tid & 63, jq = tid >> 7; const size_t pi = ((size_t)d * SSM_G + g) * SSM_P + p;
        const float lr = lam_re[pi], li = lam_im[pi], dt = expf(log_dt[d * SSM_G + g]);
        for (int j = jq; j <= 16; j += 4) { const float er = expf((float)j * lr * dt); float sn, cs; sincosf((float)j * li * dt, &sn, &cs); const float ar_ = er * cs, ai_ = er * sn;
            apr[(d * 17 + j) * 64 + p] = ar_; api[(d * 17 + j) * 64 + p] = ai_;
            if (j < 16) { apj[((d * 64 + p) * 16 + j) * 2] = ar_; apj[((d * 64 + p) * 16 + j) * 2 + 1] = ai_; }
            if (j == 1) { const float nr = ar_ - 1.f, ni = ai_, den = lr * lr + li * li;
                ff[(d * 64 + p) * 2] = (nr * lr + ni * li) / den; ff[(d * 64 + p) * 2 + 1] = (ni * lr - nr * li) / den; } }
    }
    __syncthreads();
    for (int e = tid; e < 2048; e += 512) {
        const int d = e >> 10, p = (e >> 4) & 63, hh = e & 15; const size_t bi_ = (((size_t)d * SSM_G + g) * SSM_P + p) * 16 + hh;
        const float br = b_re[bi_], bi = b_im[bi_], fr = ff[(d * 64 + p) * 2], fi = ff[(d * 64 + p) * 2 + 1];
        bbr[e] = fr * br - fi * bi; bbi[e] = fr * bi + fi * br;
        const int h2 = (e >> 6) & 15, p2 = e & 63; const size_t ci_ = (((size_t)d * SSM_G + g) * 16 + h2) * SSM_P + p2;
        cr[e] = c_re[ci_]; ci[e] = c_im[ci_];
    }
    __syncthreads();
    {
        const int d = tid >> 8, h = (tid >> 4) & 15, h2 = tid & 15;
        float sj[16];
#pragma unroll
        for (int j = 0; j < 16; ++j) sj[j] = 0.f;
        for (int p = 0; p < 64; ++p) {
            const float c_r = cr[(d * 16 + h) * 64 + p], c_i = ci[(d * 16 + h) * 64 + p], b_r = bbr[(d * 64 + p) * 16 + h2], b_i = bbi[(d * 64 + p) * 16 + h2];
            const float t_r = c_r * b_r - c_i * b_i, t_i = c_r * b_i + c_i * b_r;
            const LAS f32x4* ap = (const LAS f32x4*)(apj + (d * 64 + p) * 32);
#pragma unroll
            for (int q = 0; q < 8; ++q) { const f32x4 a = ap[q]; sj[2 * q] += t_r * a.x - t_i * a.y; sj[2 * q + 1] += t_r * a.z - t_i * a.w; }
        }
#pragma unroll
        for (int j = 0; j < 16; ++j) Kt[(d * 16 + j) * 256 + h * 16 + h2] = sj[j];
    }
    __syncthreads();
    bf16* BY = (bf16*)(ws + WS_WEIGHTS + WO_BY) + ((size_t)layer * 32 + g) * 256 * 512;
    bf16* BX = (bf16*)(ws + WS_WEIGHTS + WO_BX) + ((size_t)layer * 32 + g) * 256 * 256;
    for (int e8 = tid; e8 < 256 * 64; e8 += 512) {
        const int n = e8 >> 6, k0 = (e8 & 63) * 8, i = n >> 4, h = n & 15; float v[8];
        if (k0 < 256) { const int i2 = k0 >> 4, h20 = k0 & 15;
#pragma unroll
            for (int q = 0; q < 8; ++q) { const int h2 = h20 + q; float t = 0.f;
                if (i >= i2) t += Kt[(0 * 16 + (i - i2)) * 256 + h * 16 + h2];
                if (i2 >= i) t += Kt[(1 * 16 + (i2 - i)) * 256 + h * 16 + h2];
                if (i == i2 && h == h2) t += dsk[h];
                v[q] = t; }
        } else { const int kk = k0 - 256, d = kk >> 7, im = (kk >> 6) & 1, p0 = kk & 63, j = d == 0 ? i + 1 : 16 - i;
#pragma unroll
            for (int q = 0; q < 8; ++q) { const int p = p0 + q; const float c_r = cr[(d * 16 + h) * 64 + p], c_i = ci[(d * 16 + h) * 64 + p], a_r = apr[(d * 17 + j) * 64 + p], a_i = api[(d * 17 + j) * 64 + p];
                v[q] = im ? -(c_r * a_i + c_i * a_r) : (c_r * a_r - c_i * a_i); } }
        v4u o; o.x = pk2(v[0], v[1]); o.y = pk2(v[2], v[3]); o.z = pk2(v[4], v[5]); o.w = pk2(v[6], v[7]);
        *(v4u*)(BY + (size_t)n * 512 + k0) = o;
    }
    for (int e8 = tid; e8 < 256 * 32; e8 += 512) {
        const int n = e8 >> 5, k0 = (e8 & 31) * 8, d = n >> 7, im = (n >> 6) & 1, p = n & 63, i2 = k0 >> 4, h20 = k0 & 15, j = d == 0 ? 15 - i2 : i2;
        const float a_r = apr[(d * 17 + j) * 64 + p], a_i = api[(d * 17 + j) * 64 + p]; float v[8];
#pragma unroll
        for (int q = 0; q < 8; ++q) { const float b_r = bbr[(d * 64 + p) * 16 + h20 + q], b_i = bbi[(d * 64 + p) * 16 + h20 + q]; v[q] = im ? (a_r * b_i + a_i * b_r) : (a_r * b_r - a_i * b_i); }
        v4u o; o.x = pk2(v[0], v[1]); o.y = pk2(v[2], v[3]); o.z = pk2(v[4], v[5]); o.w = pk2(v[6], v[7]);
        *(v4u*)(BX + (size_t)n * 256 + k0) = o;
    }
    __syncthreads();
}

__device__ __forceinline__ void prologue_phase(const Frame& F, ArgsP A) {
    unsigned char* ws = A->ws;
    PHASE_IDS;
    __syncthreads();
    for (int it = F.bx; it < DEPTH * SSM_G; it += F.G) ssm_gen_item(F, A, it);
    { float* COS = (float*)(ws + WS_WEIGHTS + WO_ROT); float* SIN = COS + SEQ * 32;
      for (int e = F.bx * 512 + tid; e < SEQ * 32; e += F.G * 512) { const int s = e >> 5, j = e & 31;
          double r = (double)s * A->inv_freq[j] * 0.15915494309189533577; r -= floor(r); const float th = (float)(r * 6.283185307179586477);
          float sn, cs; sincosf(th, &sn, &cs); COS[e] = cs; SIN[e] = sn; } }
    LAS float* scr = (LAS float*)(F.lds + wave * 16384);
    const int gw = F.vcu * NWAVES + wave, NGW = F.G * NWAVES;
    unsigned char* wb = ws + WS_WEIGHTS;
    constexpr int I_IN = 16 * 128, I_GLU = 8 * 16, I_BR = 8 * 32, I_OUT = 16 * 32, I_LAYER = I_IN + I_GLU + 2 * I_BR + I_OUT;
    constexpr int I_13 = 16 * 88, I_2 = 44 * 32, I_FFN = 2 * I_13 + I_2;
    constexpr int N_ITEMS = DEPTH * I_LAYER + 2 * I_FFN, POOL_A = (N_ITEMS * 99 / 100) & ~7;
    const bool split = F.G == 256; const int hw = (F.bx - 128) * NWAVES + wave;
    for (int k = 0;; ++k) {
        int it;
        if (!split) { it = gw + k * NGW; if (it >= N_ITEMS) break; }
        else if (F.bx >= 128) { const int a = hw + k * 128 * NWAVES; if (a < POOL_A) it = a; else { const int nA = (POOL_A - hw + 128 * NWAVES - 1) / (128 * NWAVES); it = POOL_A + gw + (k - nA) * NGW; if (it >= N_ITEMS) break; } }
        else { it = POOL_A + gw + k * NGW; if (it >= N_ITEMS) break; }
        int r = it;
        if (r < DEPTH * I_LAYER) {
            const int l = r / I_LAYER; r -= l * I_LAYER;
            if (r < I_IN) { transpose_item(A->in[2] + (size_t)l * 1024 * 4096, 4096, (bf16*)(wb + WO_IN) + (size_t)l * 4096 * 1024, 1024, 0, scr, r, lane, RmInProj{}, (l & 1) ? A->in[1] + l * D_MODEL : nullptr); continue; } r -= I_IN;
            if (r < I_GLU) { transpose_item(A->in[13] + (size_t)l * 512 * 512, 512, (bf16*)(wb + WO_GLU) + (size_t)l * 512 * 512, 512, 0, scr, r, lane, RmId{}); continue; } r -= I_GLU;
            if (r < 2 * I_BR) { const int br = r / I_BR; r -= br * I_BR;
                transpose_item(A->in[14] + ((size_t)l * 2 + br) * 512 * 1024, 1024, (bf16*)(wb + WO_BR) + (size_t)l * 1024 * 1024, 1024, br * 512, scr, r, lane, RmId{}); continue; } r -= 2 * I_BR;
            transpose_item(A->in[15] + (size_t)l * 1024 * 1024, 1024, (bf16*)(wb + WO_OUT) + (size_t)l * 1024 * 1024, 1024, 0, scr, r, lane, RmId{});
        } else {
            r -= DEPTH * I_LAYER; const int i = r / I_FFN; r -= i * I_FFN;
            bf16* F13 = (bf16*)(wb + WO_F13) + (size_t)i * 5632 * 1024; bf16* F2 = (bf16*)(wb + WO_F2) + (size_t)i * 1024 * 2816;
            if (r < I_13) { transpose_item(A->in[17] + (size_t)i * 1024 * 2816, 2816, F13, 1024, 0, scr, r, lane, RmGlu13{0}, A->in[16] + (2 * i) * D_MODEL); continue; } r -= I_13;
            if (r < I_13) { transpose_item(A->in[18] + (size_t)i * 1024 * 2816, 2816, F13, 1024, 0, scr, r, lane, RmGlu13{1}, A->in[16] + (2 * i) * D_MODEL); continue; } r -= I_13;
            transpose_item(A->in[19] + (size_t)i * 2816 * 1024, 1024, F2, 2816, 0, scr, r, lane, RmId{});
        }
    }
}
constexpr int MOE_EARLY = 4864;
__device__ __forceinline__ void moe_cvt(const Frame& F, ArgsP A, int i, int part) {
    unsigned char* ws = A->ws;
    PHASE_IDS;
    LAS float* scr = (LAS float*)(F.lds + 40960 + wave * 8704);
    const bool early = part < 2 && F.G == 256;
    if (part < 2 && !early) return;
    const int gw = early ? part * MOE_EARLY + (F.bx - 128) * NWAVES + wave : (F.G == 256 ? 2 * MOE_EARLY : 0) + F.vcu * NWAVES + wave, NGW = early ? 128 * NWAVES : F.G * NWAVES;
    const int itend = early ? (part + 1) * MOE_EARLY : 8 * (2 * 16 * 88 + 44 * 32);
    unsigned char* wb = ws + WS_WEIGHTS;
    constexpr int I_13 = 16 * 88, I_2 = 44 * 32, I_E = 2 * I_13 + I_2;
#define MOE_DEC(it, t) do { const int e_ = (it) / I_E; int r_ = (it) - e_ * I_E; const size_t wo_ = ((size_t)i * N_EXP + e_); \
        if (r_ < 2 * I_13) { const int h_ = r_ >= I_13; r_ -= h_ * I_13; (t).src = A->in[21 + h_] + wo_ * 1024 * 2816; (t).N = 2816; (t).dst = (bf16*)(wb + WO_M13) + (size_t)e_ * 5632 * 1024; (t).ldt = 1024; (t).koff = 0; (t).map = 2 + h_; } \
        else { r_ -= 2 * I_13; (t).src = A->in[23] + wo_ * 2816 * 1024; (t).N = 1024; (t).dst = (bf16*)(wb + WO_M2) + (size_t)e_ * 1024 * 2816; (t).ldt = 2816; (t).koff = 0; (t).map = 0; } \
        t_setkn((t), r_); } while (0)
    T_SWEEP(gw, NGW, itend, MOE_DEC);
#undef MOE_DEC
}

template <bool COMBINE, bool ROUTER, bool FINAL>
__device__ __forceinline__ void norm_phase(const Frame& F, const float* __restrict__ SRC, float* __restrict__ X, const float* __restrict__ gain, bf16* __restrict__ XN,
                                           const bf16* __restrict__ YS, const int* __restrict__ slot_prev, const float* __restrict__ gate_prev, const unsigned* __restrict__ SPLT, const float* __restrict__ PART,
                                           const float* __restrict__ wr, unsigned* __restrict__ cnt, int* __restrict__ asg_e, int* __restrict__ asg_pos, float* __restrict__ asg_g) {
    PHASE_IDS;
    LAS float* wrl = (LAS float*)F.lds;
    LAS int* rinfo = (LAS int*)(F.lds + 32768 + 64);
    LAS int* lcnt = (LAS int*)(F.lds + 32768 + 64 + 512);
    LAS float* rg = (LAS float*)(F.lds + 32768 + 64 + 1024);
    if (ROUTER) { for (int e = tid; e < 8192; e += 512) wrl[(e & 7) * 1024 + (e >> 3)] = wr[e]; __syncthreads(); }
    const int rpb = NTOK / F.G;
    f32x4 gg4[4], vn[4];
#pragma unroll
    for (int j = 0; j < 4; ++j) gg4[j] = ((const f32x4*)gain)[64 * j + lane];
    if (wave < rpb) { const f32x4* xr = (const f32x4*)(SRC + (size_t)(F.vcu * rpb + wave) * D_MODEL) + lane;
#pragma unroll
        for (int j = 0; j < 4; ++j) vn[j] = xr[64 * j]; }
    for (int rr = wave; rr < rpb; rr += NWAVES) {
        const int row = F.vcu * rpb + rr;
        f32x4 v[4]; float s = 0.f;
#pragma unroll
        for (int j = 0; j < 4; ++j) v[j] = vn[j];
        if (rr + NWAVES < rpb) { const f32x4* xr = (const f32x4*)(SRC + (size_t)(row + NWAVES) * D_MODEL) + lane;
#pragma unroll
            for (int j = 0; j < 4; ++j) vn[j] = xr[64 * j]; }
        if (COMBINE) {
            const int s0 = slot_prev[row * 2], s1 = slot_prev[row * 2 + 1]; const float g0 = gate_prev[row * 2], g1 = gate_prev[row * 2 + 1];
            const unsigned long long* y0 = (const unsigned long long*)(YS + (size_t)s0 * 1024) + lane; const unsigned long long* y1 = (const unsigned long long*)(YS + (size_t)s1 * 1024) + lane;
            const unsigned t0 = SPLT[s0 >> 8], t1 = SPLT[s1 >> 8];
            f32x4 ta[4] = {{0.f, 0.f, 0.f, 0.f}, {0.f, 0.f, 0.f, 0.f}, {0.f, 0.f, 0.f, 0.f}, {0.f, 0.f, 0.f, 0.f}}, tb[4] = {{0.f, 0.f, 0.f, 0.f}, {0.f, 0.f, 0.f, 0.f}, {0.f, 0.f, 0.f, 0.f}, {0.f, 0.f, 0.f, 0.f}};
            if (t0 != 0u) { const f32x4* pp = (const f32x4*)(PART + (size_t)(t0 - 1) * 24 * 65536 + (size_t)(s0 & 255) * 256) + lane;
#pragma unroll
                for (int j = 0; j < 4; ++j) { ta[j] = pp[(size_t)(j * 6) * 16384];
#pragma unroll
                    for (int ks = 1; ks < 6; ++ks) ta[j] += pp[(size_t)(j * 6 + ks) * 16384]; } }
            if (t1 != 0u) { const f32x4* pp = (const f32x4*)(PART + (size_t)(t1 - 1) * 24 * 65536 + (size_t)(s1 & 255) * 256) + lane;
#pragma unroll
                for (int j = 0; j < 4; ++j) { tb[j] = pp[(size_t)(j * 6) * 16384];
#pragma unroll
                    for (int ks = 1; ks < 6; ++ks) tb[j] += pp[(size_t)(j * 6 + ks) * 16384]; } }
#pragma unroll
            for (int j = 0; j < 4; ++j) { const unsigned long long a = y0[64 * j], b = y1[64 * j];
                f32x4 ya = {__uint_as_float((unsigned)(a << 16)), __uint_as_float((unsigned)a & 0xffff0000u), __uint_as_float((unsigned)(a >> 32) << 16), __uint_as_float((unsigned)(a >> 32) & 0xffff0000u)};
                f32x4 yb = {__uint_as_float((unsigned)(b << 16)), __uint_as_float((unsigned)b & 0xffff0000u), __uint_as_float((unsigned)(b >> 32) << 16), __uint_as_float((unsigned)(b >> 32) & 0xffff0000u)};
                if (t0 != 0u) ya = ta[j];
                if (t1 != 0u) yb = tb[j];
                v[j] += g0 * ya + g1 * yb;
                if (!FINAL) ((unsigned long long*)((bf16*)X + (size_t)row * D_MODEL))[64 * j + lane] = (unsigned long long)pk2(v[j].x, v[j].y) | ((unsigned long long)pk2(v[j].z, v[j].w) << 32); }
        }
#pragma unroll
        for (int j = 0; j < 4; ++j) s += (v[j].x * v[j].x + v[j].y * v[j].y) + (v[j].z * v[j].z + v[j].w * v[j].w);
        const float rstd = rsqrtf(wave_sum_l(s, lane) * (1.f / D_MODEL) + RMS_EPS);
        float lg[8];
#pragma unroll
        for (int e = 0; e < 8; ++e) lg[e] = 0.f;
#pragma unroll
        for (int j = 0; j < 4; ++j) {
            const f32x4 gg = gg4[j];
            v[j].x *= rstd * gg.x; v[j].y *= rstd * gg.y; v[j].z *= rstd * gg.z; v[j].w *= rstd * gg.w;
            if (FINAL) ((f32x4*)(X + (size_t)row * D_MODEL) + lane)[64 * j] = v[j];
            else ((unsigned long long*)(XN + (size_t)row * D_MODEL))[64 * j + lane] = (unsigned long long)pk2(v[j].x, v[j].y) | ((unsigned long long)pk2(v[j].z, v[j].w) << 32);
            if (ROUTER) {
#pragma unroll
                for (int e = 0; e < 8; ++e) { const f32x4 w = *(const LAS f32x4*)(wrl + e * 1024 + (64 * j + lane) * 4); lg[e] += (v[j].x * w.x + v[j].y * w.y) + (v[j].z * w.z + v[j].w * w.w); } }
        }
        if (ROUTER) {
#pragma unroll
            for (int e = 0; e < 8; ++e) lg[e] = wave_sum_l(lg[e], lane);
            int e0 = 0; float l0 = lg[0];
#pragma unroll
            for (int e = 1; e < 8; ++e) if (lg[e] > l0) { l0 = lg[e]; e0 = e; }
            int e1 = -1; float l1 = -3.4e38f;
#pragma unroll
            for (int e = 0; e < 8; ++e) if (e != e0 && lg[e] > l1) { l1 = lg[e]; e1 = e; }
            const float p1 = __expf(l1 - l0), inv = 1.f / (1.f + p1);
            if (lane == 0) { rinfo[rr * 2] = e0; rinfo[rr * 2 + 1] = e1; rg[rr * 2] = inv; rg[rr * 2 + 1] = p1 * inv; }
        }
    }
    if (ROUTER) {
        __syncthreads();
        const int nW = (rpb * 2) >> 6;
        int e_my = 0, lp = 0;
        if (wave < nW) { e_my = rinfo[wave * 64 + lane]; unsigned long long mine = 0ull;
#pragma unroll
            for (int q = 0; q < 8; ++q) { const unsigned long long m = __ballot(e_my == q); mine = (e_my == q) ? m : mine; if (lane == 0) lcnt[wave * 8 + q] = __popcll(m); }
            lp = (int)__builtin_amdgcn_mbcnt_hi((unsigned)(mine >> 32), __builtin_amdgcn_mbcnt_lo((unsigned)mine, 0u)); }
        __syncthreads();
        if (wave < nW) { for (int w2 = 0; w2 < wave; ++w2) lp += lcnt[w2 * 8 + e_my];
            const int a = wave * 64 + lane, row2 = F.vcu * rpb * 2 + a; asg_e[row2] = e_my; asg_pos[row2] = lp; asg_g[row2] = rg[a]; }
        if (tid >= 256 && tid < 264) { const int e = tid - 256; int c = 0; for (int w2 = 0; w2 < nW; ++w2) c += lcnt[w2 * 8 + e]; cnt[F.vcu * 8 + e] = (unsigned)c; }
    }
}

__device__ __forceinline__ void rstd_prep(const Frame& F, const float* __restrict__ PS, int pm) {
    PHASE_IDS;
    LAS float* rs = (LAS float*)(F.lds + RSTD_OFF);
    if (tid < 256) { const float* q = PS + pm * 256 + tid; float s = 0.f;
#pragma unroll
        for (int i = 0; i < 16; ++i) s += q[(size_t)i * NTOK];
        rs[tid] = rsqrtf(s * (1.f / D_MODEL) + RMS_EPS); }
    __syncthreads();
}
struct MoeLayout { int ps[8]; int pe[8]; int nblk; };
template <class P> __device__ __forceinline__ MoeLayout moe_layout(P cnt) {
    MoeLayout L; int acc = 0;
#pragma unroll
    for (int e = 0; e < 8; ++e) { const int c = (int)cnt[e]; L.ps[e] = acc; acc += (c + 255) & ~255; L.pe[e] = acc; }
    L.nblk = acc >> 8; return L;
}
__device__ __forceinline__ void assign_phase(const Frame& F, const unsigned* blkcnt, unsigned* cnt, const int* asg_e, const int* asg_pos, int* slot_of, const bf16* XN, bf16* XB, unsigned* splt) {
    PHASE_IDS;
    LAS int* lt = (LAS int*)F.lds;
    if (tid < 16) lt[tid] = 0;
    __syncthreads();
    int tot = 0, pre = 0;
    if (tid < 128) { const int e = tid & 7, h = tid >> 3;
#pragma unroll
        for (int k = 0; k < 16; ++k) { const int b = h * 16 + k; const int c = b < F.G ? (int)blkcnt[b * 8 + e] : 0; tot += c; pre += (b < F.vcu) ? c : 0; } }
    const int rpb = NTOK / F.G;
    if (rpb == 64) {
        int ee[16], pp[16]; v4u d0[16], d1[16];
#pragma unroll
        for (int k = 0; k < 16; ++k) { const int ga = F.vcu * 128 + wave + 8 * k; ee[k] = asg_e[ga]; pp[k] = asg_pos[ga];
            const v4u* src = (const v4u*)(XN + (size_t)(ga >> 1) * 1024) + lane; d0[k] = src[0]; d1[k] = src[64]; }
        if (tid < 128) { const int e = tid & 7; __hip_atomic_fetch_add(&lt[e], tot, __ATOMIC_RELAXED, __HIP_MEMORY_SCOPE_WORKGROUP); __hip_atomic_fetch_add(&lt[8 + e], pre, __ATOMIC_RELAXED, __HIP_MEMORY_SCOPE_WORKGROUP); }
        __syncthreads();
        const MoeLayout L = moe_layout(lt);
        if (F.bx == 0) {
            if (tid < 8) cnt[tid] = (unsigned)lt[tid];
            const int tile0 = ((L.nblk * 4) >> 8) * 64;
            if (tid < L.nblk - tile0) splt[tile0 + tid] = (unsigned)(tid + 1);
        }
#pragma unroll
        for (int k = 0; k < 16; ++k) { const int ga = F.vcu * 128 + wave + 8 * k, e = ee[k];
            int ps = L.ps[0], pr = lt[8];
#pragma unroll
            for (int q = 1; q < 8; ++q) { ps = (e == q) ? L.ps[q] : ps; pr = (e == q) ? lt[8 + q] : pr; }
            const int dest = ps + pr + pp[k];
            if (lane == 0) slot_of[ga] = dest;
            v4u* dst = (v4u*)(XB + (size_t)dest * 1024) + lane; dst[0] = d0[k]; dst[64] = d1[k]; }
        return;
    }
    if (tid < 128) { const int e = tid & 7; __hip_atomic_fetch_add(&lt[e], tot, __ATOMIC_RELAXED, __HIP_MEMORY_SCOPE_WORKGROUP); __hip_atomic_fetch_add(&lt[8 + e], pre, __ATOMIC_RELAXED, __HIP_MEMORY_SCOPE_WORKGROUP); }
    __syncthreads();
    if (F.bx == 0 && tid < 8) cnt[tid] = (unsigned)lt[tid];
    const MoeLayout L = moe_layout(lt);
    if (F.bx == 0) {
        const int tile0 = ((L.nblk * 4) >> 8) * 64;
        if (tid < L.nblk - tile0) splt[tile0 + tid] = (unsigned)(tid + 1);
    }
    for (int a = wave; a < rpb * 2; a += NWAVES) {
        const int ga = F.vcu * rpb * 2 + a, tok = ga >> 1, e = asg_e[ga];
        int ps = L.ps[0];
#pragma unroll
        for (int q = 1; q < 8; ++q) ps = (e == q) ? L.ps[q] : ps;
        int pr = lt[8];
#pragma unroll
        for (int q = 1; q < 8; ++q) pr = (e == q) ? lt[8 + q] : pr;
        const int dest = ps + pr + asg_pos[ga];
        if (lane == 0) slot_of[ga] = dest;
        const v4u* src = (const v4u*)(XN + (size_t)tok * 1024) + lane; v4u* dst = (v4u*)(XB + (size_t)dest * 1024) + lane;
        dst[0] = src[0]; dst[64] = src[64];
    }
}

__device__ __forceinline__ void scan_phase(const Frame& F, ArgsP A, int layer, const float* __restrict__ XLOC, bf16* __restrict__ AY) {
    PHASE_IDS;
    LAS float* S = (LAS float*)F.lds;
    for (int it = F.vcu; it < 256; it += F.G) {
        const int b = it >> 7, g = (it >> 2) & 31, d = (it >> 1) & 1, ph = it & 1, pp = tid & 31, seg = tid >> 5, p = ph * 32 + pp;
        const size_t pi = ((size_t)layer * 2 + d) * SSM_G * SSM_P + (size_t)g * SSM_P + p;
        const float lr = A->in[5][pi], li = A->in[6][pi], dt = expf(A->in[7][(layer * 2 + d) * SSM_G + g]);
        const float er = expf(16.f * lr * dt); float sn, cs; sincosf(16.f * li * dt, &sn, &cs);
        const float ar = er * cs, ai = er * sn;
        float Ar = ar, Ai = ai;
#pragma unroll
        for (int q = 0; q < 5; ++q) { const float t = Ar * Ar - Ai * Ai; Ai = 2.f * Ar * Ai; Ar = t; }
        const int c0 = d == 0 ? seg * 32 : 511 - seg * 32, cstep = d == 0 ? 1 : -1;
        const float* xl = XLOC + ((size_t)g * 1024 + b * 512 + c0) * 256 + d * 128 + p; const long xs = (long)cstep * 256;
        float sr = 0.f, si = 0.f;
        float xrv[32], xiv[32];
#pragma unroll
        for (int k = 0; k < 32; ++k) { xrv[k] = xl[k * xs]; xiv[k] = xl[k * xs + 64]; }
#pragma unroll
        for (int k = 0; k < 32; ++k) { const float t = ar * sr - ai * si + xrv[k]; si = ar * si + ai * sr + xiv[k]; sr = t; }
        S[(seg * 32 + pp) * 2] = sr; S[(seg * 32 + pp) * 2 + 1] = si;
        __syncthreads();
        float cr_ = 0.f, ci_ = 0.f;
        for (int s2 = 0; s2 < seg; ++s2) { const float t = Ar * cr_ - Ai * ci_ + S[(s2 * 32 + pp) * 2]; ci_ = Ar * ci_ + Ai * cr_ + S[(s2 * 32 + pp) * 2 + 1]; cr_ = t; }
        bf16* ay = AY + ((size_t)g * 1024 + b * 512 + c0) * 512 + 256 + d * 128 + p; const long ys = (long)cstep * 512;
#pragma unroll
        for (int k = 0; k < 32; ++k) { const float xr = xrv[k], xi = xiv[k];
            {
              const float pr = __int_as_float(__builtin_amdgcn_mov_dpp(__float_as_int(cr_), 0xB1, 0xf, 0xf, true)), pi = __int_as_float(__builtin_amdgcn_mov_dpp(__float_as_int(ci_), 0xB1, 0xf, 0xf, true));
              const bool odd = (pp & 1) != 0;
              *(unsigned*)(ay + k * ys + (odd ? 63 : 0)) = odd ? pk2(pi, ci_) : pk2(cr_, pr); }
            const float t = ar * cr_ - ai * ci_ + xr; ci_ = ar * ci_ + ai * cr_ + xi; cr_ = t; }
        __syncthreads();
    }
}

__device__ __forceinline__ void kmax_phase(const Frame& F, const bf16* __restrict__ Kb, unsigned* __restrict__ KMAX) {
    PHASE_IDS;
    const int nw = F.G > 128 ? F.G - 128 : F.G, w0 = F.G > 128 ? F.bx - 128 : F.bx;
    if (w0 < 0) return;
    for (int it = w0; it < 128; it += nw) {
        const int slab = it >> 3; const bf16* base = Kb + ((size_t)slab * 8192 + (size_t)(it & 7) * 1024 + wave * 128) * 64;
        float mx = 0.f;
#pragma unroll 4
        for (int i = 0; i < 16; ++i) { const v4u v = *(const v4u*)(base + (size_t)(i * 8 + (lane >> 3)) * 64 + (lane & 7) * 8); float q = 0.f;
            const unsigned w[4] = {v.x, v.y, v.z, v.w};
#pragma unroll
            for (int e = 0; e < 4; ++e) { const float a = __uint_as_float(w[e] << 16), b2 = __uint_as_float(w[e] & 0xffff0000u); q = fmaf(a, a, q); q = fmaf(b2, b2, q); }
            q += shx(q, 1, lane); q += shx(q, 2, lane); q += shx(q, 4, lane); mx = fmaxf(mx, q); }
#pragma unroll
        for (int o = 8; o < 64; o <<= 1) mx = fmaxf(mx, shx(mx, o, lane));
        if (lane == 0) __hip_atomic_fetch_max(KMAX + slab, __float_as_uint(mx), __ATOMIC_RELAXED, __HIP_MEMORY_SCOPE_AGENT);
    }
}
#ifndef PHASE_MASK
#define PHASE_MASK 0xffffffu
#endif
#define PMB(b) ((PHASE_MASK >> (b)) & 1u)
#ifndef REP_MASK
#define REP_MASK 0u
#endif
#ifndef REP_N
#define REP_N 1
#endif
#define RPT(b, cond) for (int rep_ = 0; rep_ < 1 + (((REP_MASK >> (b)) & 1u) && (cond) ? REP_N : 0); ++rep_)
#define SITE ArgsP ap = get_args(); unsigned char* ws = ap->ws; unsigned char* wb = ws + WS_WEIGHTS; (void)wb; const Frame F = make_frame((LAS unsigned char*)lds); (void)F
__device__ __forceinline__ bool in_range(int k) { ArgsP a = get_args(); const int lo = a->ph_lo, hi = a->ph_hi; return lo <= k && k < hi; }
__global__ void __launch_bounds__(NWAVES * 64, 2) mk_fwd(Args args_unused) {
    extern __shared__ __attribute__((aligned(16))) unsigned char lds[];
    volatile LAS unsigned* MISC = (volatile LAS unsigned*)((LAS unsigned char*)lds + MISC_OFF);
    for (int u = threadIdx.x; u < (LDS_BYTES - LDSCTL_OFF) / 4; u += NWAVES * 64) ((LAS unsigned*)((LAS unsigned char*)lds + LDSCTL_OFF))[u] = 0u;
    __syncthreads();
    { SITE; if ((ap->ph_hi - ap->ph_lo) > 1) (void)xcd_barrier_post((unsigned*)(ws + WS_CTL) + CW_BAR, MISC + 8); }
#define IN(k) in_range((k))
#define SUB() (get_args()->sub)
#define SEAM(k) do { if (IN(k) && IN((k) + 1)) { ArgsP ap_ = get_args(); XcdBarrier b_; b_.bar = (unsigned*)(ap_->ws + WS_CTL) + CW_BAR; b_.x = xb_xcc_id(); \
        b_.st = (volatile LAS unsigned*)((LAS unsigned char*)lds + MISC_OFF) + 8; xcd_barrier(b_); } } while (0)

    RPT(0, true) if (PMB(0) && IN(PH_PRO)) { SITE; prologue_phase(F, ap); }
    SEAM(PH_PRO);

    for (int l = 0; l < DEPTH; ++l) {
        const int pb = PH_L0 + l * PH_PER_LAYER, moe = l & 1, i = l >> 1;
        const bool fold1 = (l & 1) != 0;
        RPT(1, l != 2) if (!fold1 && PMB(1) && IN(pb + P_NORM1)) {
            SITE; float* X = ap->out; bf16* XN = (bf16*)(ws + WS_XN);
            const float* gain = ap->in[1] + l * D_MODEL;
            if (l == 0) norm_phase<false, false, false>(F, ap->in[0], X, gain, XN, nullptr, nullptr, nullptr, nullptr, nullptr, nullptr, nullptr, nullptr, nullptr, nullptr);
            else if (l == 2 && ((SUB() & 4) != 0)) { const int* sp = (const int*)(ws + WS_ROUTE) + 3 * 32768; const float* gp = (const float*)(ws + WS_ROUTE) + 2 * 32768;
                norm_phase<true, false, false>(F, X, (float*)(ws + WS_XR), gain, XN, (const bf16*)(ws + WS_R2), sp, gp, (const unsigned*)(ws + WS_CTL) + CW_SPLT, (const float*)(ws + WS_PART), nullptr, nullptr, nullptr, nullptr, nullptr); }
            else norm_phase<false, false, false>(F, X, X, gain, XN, nullptr, nullptr, nullptr, nullptr, nullptr, nullptr, nullptr, nullptr, nullptr, nullptr);
        }
        if (!fold1) SEAM(pb + P_NORM1);
        RPT(2, true) if (PMB(2) && IN(pb + P_INPROJ)) {
            SITE;
            pg8::Gemm g{(const bf16*)(ws + WS_XN), (const bf16*)(wb + WO_IN) + (size_t)l * 4096 * 1024}; pg8::StaticOrderT<64, 16> S{F.bx};
            const float* COS = (const float*)(wb + WO_ROT);
            if (fold1) { pg8::Unit u0; S.next(0, u0); rstd_prep(F, (const float*)(ws + WS_PS), u0.pm);
                pg8::EpiInProjT<true> E{(bf16*)(ws + WS_Q), (bf16*)(ws + WS_K), (bf16*)(ws + WS_V), (bf16*)(ws + WS_AY), (bf16*)(ws + WS_G), COS, COS + SEQ * 32, (const LAS float*)(F.lds + RSTD_OFF)};
                pg8::gemm_phase<pg8::EpiInProjT<true>, pg8::StaticOrderT<64, 16>, 1024, 1024, 1024>(F.lds + RING_OFF, g, S, E); }
            else { pg8::EpiInProj E{(bf16*)(ws + WS_Q), (bf16*)(ws + WS_K), (bf16*)(ws + WS_V), (bf16*)(ws + WS_AY), (bf16*)(ws + WS_G), COS, COS + SEQ * 32, nullptr};
                pg8::gemm_phase<pg8::EpiInProj, pg8::StaticOrderT<64, 16>, 1024, 1024, 1024>(F.lds + RING_OFF, g, S, E); }
        }
        SEAM(pb + P_INPROJ);
        RPT(3, true) if (PMB(3) && IN(pb + P_XLOC)) {
            SITE;
            pg8::Gemm g{(const bf16*)(ws + WS_AY), (const bf16*)(wb + WO_BX) + (size_t)l * 32 * 256 * 256}; pg8::SsmOrder S{F.G, F.bx};
            pg8::EpiXloc E{(float*)(ws + WS_XLOC)};
            pg8::gemm_phase<pg8::EpiXloc, pg8::SsmOrder, 512, 256, 256>(F.lds + RING_OFF, g, S, E);
            kmax_phase(F, (const bf16*)(ws + WS_K), (unsigned*)(ws + WS_CTL) + CW_KMAX + 16 * l);
        }
        SEAM(pb + P_XLOC);
        RPT(4, true) if (PMB(4) && IN(pb + P_SCAN)) { SITE; scan_phase(F, ap, l, (const float*)(ws + WS_XLOC), (bf16*)(ws + WS_AY)); }
        SEAM(pb + P_SCAN);
        if (IN(pb + P_MIX)) {
            RPT(5, true) if (PMB(5) && (SUB() & 1)) {
                SITE;
                pg8::Gemm g{(const bf16*)(ws + WS_AY), (const bf16*)(wb + WO_BY) + (size_t)l * 32 * 256 * 512}; pg8::SsmOrder S{F.G, F.bx};
                pg8::EpiY E{(bf16*)(ws + WS_SACT)};
                pg8::gemm_phase<pg8::EpiY, pg8::SsmOrder, 512, 512, 512>(F.lds + RING_OFF, g, S, E);
            }
            if ((SUB() & 8) && (SUB() & 2)) { SITE; if (F.bx >= 128) moe_cvt(F, ap, i, l & 1); }
            RPT(6, true) if (PMB(6) && (SUB() & 2)) {
                SITE;
                const float* lp = ap->in[3] + l * 4 * HD; float d01 = 0.f, d23 = 0.f;
                for (int q = 0; q < HD; ++q) { d01 += lp[q] * lp[HD + q]; d23 += lp[2 * HD + q] * lp[3 * HD + q]; }
                const float lam_init = 0.8f - 0.6f * __expf(-0.3f * (float)l), lam = __expf(d01) - __expf(d23) + lam_init;
                const bf16* Q = (const bf16*)(ws + WS_Q); const bf16* Kb = (const bf16*)(ws + WS_K); const bf16* V = (const bf16*)(ws + WS_V);
                float* O1 = (float*)(ws + WS_MERGED);
                bf16* AS2 = (bf16*)(ws + WS_AS2);
                for (int u = F.vcu; u < 256; u += F.G) {
                    const int bh = u >> 5, qb = u & 31, b = bh >> 2, h = bh & 3;
                    att::diff_attn_unit(Q + (size_t)bh * 2 * SEQ * 64, Kb + (size_t)bh * 2 * SEQ * 64, V + (size_t)bh * SEQ * 128, qb * 256,
                                        (const unsigned*)(ws + WS_CTL) + CW_KMAX + 16 * l + bh * 2, O1 + (size_t)u * 65536, AS2 + ((size_t)b * SEQ + qb * 256) * 1024 + h * 128, ap->in[4] + l * VD, lam, 1.f - lam_init, (char*)lds + RING_OFF);
                    __syncthreads();
                }
            }
        }
        SEAM(pb + P_MIX);
        RPT(7, true) if (PMB(7) && IN(pb + P_GLU)) {
            SITE;
            pg8::Gemm g{(const bf16*)(ws + WS_SACT), (const bf16*)(wb + WO_GLU) + (size_t)l * 512 * 512}; pg8::StaticOrderT<64, 2> S{F.bx};
            pg8::EpiGlu E{(const bf16*)(ws + WS_SACT), (bf16*)(ws + WS_AS2)};
            pg8::gemm_phase<pg8::EpiGlu, pg8::StaticOrderT<64, 2>, 512, 512, 512>(F.lds + RING_OFF, g, S, E);
        }
        SEAM(pb + P_GLU);
        RPT(8, true) if (PMB(8) && IN(pb + P_BRANCH)) {
            SITE;
            pg8::Gemm g{(const bf16*)(ws + WS_AS2), (const bf16*)(wb + WO_BR) + (size_t)l * 1024 * 1024}; pg8::StaticOrderT<64, 4> S{F.bx};
            pg8::EpiBranch E{(const bf16*)(ws + WS_G), (bf16*)(ws + WS_MERGED)};
            pg8::gemm_phase<pg8::EpiBranch, pg8::StaticOrderT<64, 4>, 1024, 1024, 1024>(F.lds + RING_OFF, g, S, E);
        }
        SEAM(pb + P_BRANCH);
        RPT(9, l == 0) if (PMB(9) && IN(pb + P_OUT)) {
            SITE; float* X = ap->out;
            pg8::Gemm g{(const bf16*)(ws + WS_MERGED), (const bf16*)(wb + WO_OUT) + (size_t)l * 1024 * 1024}; pg8::StaticOrderT<64, 4> S{F.bx};
            if (!moe && l == 0) { pg8::EpiResNT<false, false> E{ap->in[0], X, (bf16*)(ws + WS_XN), (float*)(ws + WS_PS), nullptr};
                pg8::gemm_phase<pg8::EpiResNT<false, false>, pg8::StaticOrderT<64, 4>, 1024, 1024, 1024>(F.lds + RING_OFF, g, S, E); }
            else if (!moe) { pg8::EpiResNT<false, true> E{X, X, (bf16*)(ws + WS_XN), (float*)(ws + WS_PS), (const bf16*)(ws + WS_XR)};
                pg8::gemm_phase<pg8::EpiResNT<false, true>, pg8::StaticOrderT<64, 4>, 1024, 1024, 1024>(F.lds + RING_OFF, g, S, E); }
            else { pg8::EpiResB E{(const bf16*)(ws + WS_XN), X};
                pg8::gemm_phase<pg8::EpiResB, pg8::StaticOrderT<64, 4>, 1024, 1024, 1024>(F.lds + RING_OFF, g, S, E); }
        }
        SEAM(pb + P_OUT);
        RPT(10, false) if (moe && PMB(10) && IN(pb + P_NORM2)) {
            SITE; float* X = ap->out; bf16* XN = (bf16*)(ws + WS_XN);
            const float* gain = ap->in[16] + l * D_MODEL;
            if (moe) { int* asg_e = (int*)(ws + WS_ROUTE + (size_t)i * 512 * 1024); int* asg_pos = asg_e + 32768; float* asg_g = (float*)(asg_pos + 32768);
                       norm_phase<false, true, false>(F, X, X, gain, XN, nullptr, nullptr, nullptr, nullptr, nullptr, ap->in[20] + (size_t)i * D_MODEL * N_EXP, (unsigned*)(ws + WS_CTL) + CW_BLKCNT + 2048 * i, asg_e, asg_pos, asg_g);
                       RPT(17, true) { if (SUB() & 8) moe_cvt(F, ap, i, 2); } }
            else norm_phase<false, false, false>(F, X, X, gain, XN, nullptr, nullptr, nullptr, nullptr, nullptr, nullptr, nullptr, nullptr, nullptr, nullptr);
        }
        if (moe) SEAM(pb + P_NORM2);
        if (!moe) {
            RPT(11, true) if (PMB(11) && IN(pb + P_UP)) {
                SITE;
                pg8::Gemm g{(const bf16*)(ws + WS_XN), (const bf16*)(wb + WO_F13) + (size_t)i * 5632 * 1024}; pg8::StaticOrderT<64, 22> S{F.bx};
                { pg8::Unit u0; S.next(0, u0); rstd_prep(F, (const float*)(ws + WS_PS), u0.pm); }
                pg8::EpiSwigluT<true> E{(bf16*)(ws + WS_H), 22, (const LAS float*)(F.lds + RSTD_OFF)};
                pg8::gemm_phase<pg8::EpiSwigluT<true>, pg8::StaticOrderT<64, 22>, 1024, 1024, 1024>(F.lds + RING_OFF, g, S, E);
            }
            SEAM(pb + P_UP);
            if (PMB(12) && IN(pb + P_DOWN)) {
                SITE; float* X = ap->out;
                pg8::Gemm g{(const bf16*)(ws + WS_H), (const bf16*)(wb + WO_F2) + (size_t)i * 1024 * 2816}; pg8::StaticOrderT<64, 4> S{F.bx};
                pg8::EpiResNT<false, true> E{X, X, (bf16*)(ws + WS_XN), (float*)(ws + WS_PS), (const bf16*)(ws + WS_XN)};
                pg8::gemm_phase<pg8::EpiResNT<false, true>, pg8::StaticOrderT<64, 4>, 2816, 2816, 2816>(F.lds + RING_OFF, g, S, E);
            }
            SEAM(pb + P_DOWN);
        } else {
            RPT(13, true) if (PMB(13) && IN(pb + P_ASSIGN)) {
                SITE; int* asg_e = (int*)(ws + WS_ROUTE + (size_t)i * 512 * 1024);
                assign_phase(F, (const unsigned*)(ws + WS_CTL) + CW_BLKCNT + 2048 * i, (unsigned*)(ws + WS_CTL) + CW_CNT + 64 * i, asg_e, asg_e + 32768, asg_e + 3 * 32768, (const bf16*)(ws + WS_XN), (bf16*)(ws + WS_R2), (unsigned*)(ws + WS_CTL) + CW_SPLT + 256 * i);
            }
            SEAM(pb + P_ASSIGN);
            RPT(14, true) if (PMB(14) && IN(pb + P_UP)) {
                SITE;
                const MoeLayout L = moe_layout((const unsigned*)(ws + WS_CTL) + CW_CNT + 64 * i);
                pg8::Gemm g{(const bf16*)(ws + WS_R2), (const bf16*)(wb + WO_M13)};
                pg8::MoeOrder S; S.so.init(L.nblk * 256, 5632, F.G, F.bx); S.pe0 = L.pe[0]; S.pe1 = L.pe[1]; S.pe2 = L.pe[2]; S.pe3 = L.pe[3]; S.pe4 = L.pe[4]; S.pe5 = L.pe[5]; S.pe6 = L.pe[6]; S.nN = 22; S.maxr = 1 << 20;
                pg8::EpiSwiglu E{(bf16*)(ws + WS_H), 22, nullptr};
                pg8::gemm_phase<pg8::EpiSwiglu, pg8::MoeOrder, 1024, 1024, 1024>(F.lds + RING_OFF, g, S, E);
            }
            SEAM(pb + P_UP);
            RPT(15, true) if (PMB(15) && IN(pb + P_DOWN)) {
                SITE;
                const MoeLayout L = moe_layout((const unsigned*)(ws + WS_CTL) + CW_CNT + 64 * i);
                pg8::Gemm g{(const bf16*)(ws + WS_H), (const bf16*)(wb + WO_M2)};
                const int tile0 = ((L.nblk * 4) >> 8) * 64;
                pg8::MoeOrder S; S.so.init(tile0 * 256, 1024, F.G, F.bx); S.pe0 = L.pe[0]; S.pe1 = L.pe[1]; S.pe2 = L.pe[2]; S.pe3 = L.pe[3]; S.pe4 = L.pe[4]; S.pe5 = L.pe[5]; S.pe6 = L.pe[6]; S.nN = 4; S.maxr = 1 << 20;
                pg8::EpiMoeDown E{(bf16*)(ws + WS_R2)};
                pg8::gemm_phase<pg8::EpiMoeDown, pg8::MoeOrder, 2816, 2816, 2816>(F.lds + RING_OFF, g, S, E);
                pg8::MoeSplitOrder T; T.c = F.bx; T.tile0 = tile0; T.nsub = (L.nblk - tile0) * 24; T.eoff = 0; T.pe0 = S.pe0; T.pe1 = S.pe1; T.pe2 = S.pe2; T.pe3 = S.pe3; T.pe4 = S.pe4; T.pe5 = S.pe5; T.pe6 = S.pe6; T.nN = 4;
                pg8::EpiMoeDownPart EP{(float*)(ws + WS_PART)};
                pg8::gemm_phase<pg8::EpiMoeDownPart, pg8::MoeSplitOrder, 2816, 2816, 0>(F.lds + RING_OFF, g, T, EP);
            }
            SEAM(pb + P_DOWN);
        }
    }
    if (PMB(16) && IN(PH_FINAL)) {
        SITE; float* X = ap->out;
        if (((SUB() & 4) != 0)) { const int* sp = (const int*)(ws + WS_ROUTE + 512 * 1024) + 3 * 32768; const float* gp = (const float*)(ws + WS_ROUTE + 512 * 1024) + 2 * 32768;
            norm_phase<true, false, true>(F, X, X, ap->in[24], nullptr, (const bf16*)(ws + WS_R2), sp, gp, (const unsigned*)(ws + WS_CTL) + CW_SPLT + 256, (const float*)(ws + WS_PART), nullptr, nullptr, nullptr, nullptr, nullptr); }
        else norm_phase<false, false, true>(F, X, X, ap->in[24], nullptr, nullptr, nullptr, nullptr, nullptr, nullptr, nullptr, nullptr, nullptr, nullptr, nullptr);
    }
#undef IN
#undef SEAM
}
#ifndef OPT_MASK
#define OPT_MASK 0x37f
#endif
#ifndef ONE_LAUNCH
#define ONE_LAUNCH 1
#endif
static void launch_mk(Args& a, int lo, int hi, int sub, int grid, hipStream_t stream) {
    a.ph_lo = lo; a.ph_hi = hi; a.sub = sub;
    hipLaunchKernelGGL(mk_fwd, dim3(grid), dim3(NWAVES * 64), LDS_BYTES, stream, a);
}
extern "C" void kernel_launch(void* const* d_in, const int* in_sizes, int n_in, void* d_out, int out_size, void* d_ws, size_t ws_size, hipStream_t stream) {
    static int grid = 0;
    if (grid == 0) {
        if (n_in != 25 || out_size != NTOK * D_MODEL || ws_size < WS_END + 64 * MiB) { fprintf(stderr, "kernel_launch: unexpected shapes n_in %d out %d ws %zu (need %zu)\n", n_in, out_size, ws_size, (size_t)(WS_END + 64 * MiB)); grid = -1; return; }
        int dev = 0, cus = 0;
        if (hipGetDevice(&dev) != hipSuccess || hipDeviceGetAttribute(&cus, hipDeviceAttributeMultiprocessorCount, dev) != hipSuccess) { grid = -1; return; }
        if (hipFuncSetAttribute((const void*)mk_fwd, hipFuncAttributeMaxDynamicSharedMemorySize, LDS_BYTES) != hipSuccess) { fprintf(stderr, "kernel_launch: hipFuncSetAttribute failed\n"); grid = -1; return; }
        int per_cu = 0;
        if (hipOccupancyMaxActiveBlocksPerMultiprocessor(&per_cu, (const void*)mk_fwd, NWAVES * 64, LDS_BYTES) != hipSuccess || per_cu < 1) fprintf(stderr, "kernel_launch: occupancy query reports %d\n", per_cu);
        (void)hipGetLastError();
        grid = cus;
        if (grid != 256) fprintf(stderr, "kernel_launch: %d CUs (built for 256)\n", grid);
    }
    if (grid < 0) return;
    const float* x_in = (const float*)d_in[0]; const float* norm_mix = (const float*)d_in[1]; const float* w_in = (const float*)d_in[2];
    const float* attn_lambda = (const float*)d_in[3]; const float* attn_subln = (const float*)d_in[4];
    const float* ssm_lam_re = (const float*)d_in[5]; const float* ssm_lam_im = (const float*)d_in[6]; const float* ssm_log_dt = (const float*)d_in[7];
    const float* ssm_b_re = (const float*)d_in[8]; const float* ssm_b_im = (const float*)d_in[9]; const float* ssm_c_re = (const float*)d_in[10]; const float* ssm_c_im = (const float*)d_in[11];
    const float* ssm_d = (const float*)d_in[12]; const float* w_glu = (const float*)d_in[13]; const float* w_branch = (const float*)d_in[14]; const float* w_out = (const float*)d_in[15];
    const float* norm_ffn = (const float*)d_in[16]; const float* ffn_w1 = (const float*)d_in[17]; const float* ffn_w3 = (const float*)d_in[18]; const float* ffn_w2 = (const float*)d_in[19];
    const float* moe_router = (const float*)d_in[20]; const float* moe_w1 = (const float*)d_in[21]; const float* moe_w3 = (const float*)d_in[22]; const float* moe_w2 = (const float*)d_in[23];
    const float* norm_final = (const float*)d_in[24];
    unsigned char* ws = (unsigned char*)d_ws; float* X = (float*)d_out;
    bf16* XN = (bf16*)(ws + WS_XN); bf16* Q = (bf16*)(ws + WS_Q); bf16* Kb = (bf16*)(ws + WS_K); bf16* V = (bf16*)(ws + WS_V); bf16* G = (bf16*)(ws + WS_G);
    bf16* AY = (bf16*)(ws + WS_AY); float* XLOC = (float*)(ws + WS_XLOC); bf16* AS2 = (bf16*)(ws + WS_AS2); bf16* H = (bf16*)(ws + WS_H);
    bf16* SACT = (bf16*)(ws + WS_SACT); bf16* MERGED = (bf16*)(ws + WS_MERGED);
    float* TMP = (float*)(ws + WS_END);
    if (hipMemsetAsync(ws + WS_CTL, 0, CTL_ZERO_BYTES, stream) != hipSuccess) { fprintf(stderr, "kernel_launch: memset failed\n"); return; }
    Args a{};
    for (int i = 0; i < 25; ++i) a.in[i] = (const float*)d_in[i];
    a.out = X; a.ws = ws;
    for (int j = 0; j < 32; ++j) a.inv_freq[j] = pow(10000.0, -(double)j / 32.0);
    constexpr int OM = OPT_MASK;
    if (ONE_LAUNCH) { launch_mk(a, 0, PH_END, 1 | 2 | 4 | 8, grid, stream); return; }
    constexpr bool o_norm = OM & 1, o_inproj = OM & 2, o_ssm = OM & 4, o_attn = OM & 8, o_glu = OM & 16, o_branch = OM & 32, o_out = OM & 64, o_ffn = OM & 256, o_moe = OM & 512;
    static_assert(!o_moe || o_norm, "optimized MoE needs the optimized norms");
    const int sub_c = o_moe ? 4 : 0;
    (void)hipMemcpyAsync(X, x_in, (size_t)NTOK * D_MODEL * 4, hipMemcpyDeviceToDevice, stream);
    if (OM & ~1) launch_mk(a, PH_PRO, PH_PRO + 1, 0, grid, stream);
    for (int layer = 0; layer < DEPTH; ++layer) {
        const int pb = PH_L0 + layer * PH_PER_LAYER, i = layer / 2;
        const float lam_init = 0.8f - 0.6f * expf(-0.3f * (float)layer);
        if (o_norm) launch_mk(a, pb + P_NORM1, pb + P_NORM1 + 1, sub_c, grid, stream);
        else k_norm<<<NTOK / 4, 256, 0, stream>>>(X, norm_mix + layer * D_MODEL, XN, nullptr, nullptr, nullptr);
        if (o_inproj) launch_mk(a, pb + P_INPROJ, pb + P_INPROJ + 1, 0, grid, stream);
        else { NEpiInProj e{Q, Kb, V, AY, G};
          k_ngemm<NEpiInProj, false><<<dim3(IN_W / 128, NTOK / 128), 256, 0, stream>>>(XN, D_MODEL, w_in + (size_t)layer * D_MODEL * IN_W, nullptr, IN_W, D_MODEL, e); }
        if (o_ssm) { launch_mk(a, pb + P_XLOC, pb + P_XLOC + 1, 0, grid, stream); launch_mk(a, pb + P_SCAN, pb + P_SCAN + 1, 0, grid, stream); launch_mk(a, pb + P_MIX, pb + P_MIX + 1, 1, grid, stream); }
        else { const size_t po = (size_t)layer * 2 * SSM_G * SSM_P;
          k_nssm<<<BATCH * SSM_G, 64, 0, stream>>>(AY, XLOC, SACT, ssm_lam_re + po, ssm_lam_im + po, ssm_log_dt + layer * 2 * SSM_G,
                                                   ssm_b_re + po * 16, ssm_b_im + po * 16, ssm_c_re + po * 16, ssm_c_im + po * 16, ssm_d + layer * SSM_W); }
        if (o_attn) launch_mk(a, pb + P_MIX, pb + P_MIX + 1, 2, grid, stream);
        else k_nattn<<<dim3(SEQ / 64, NHEAD, BATCH), 128, 0, stream>>>(Q, Kb, V, AS2, attn_lambda + layer * 4 * HD, attn_subln + layer * VD, lam_init);
        if (o_glu) launch_mk(a, pb + P_GLU, pb + P_GLU + 1, 0, grid, stream);
        else { NEpiGlu e{SACT, AS2};
          k_ngemm<NEpiGlu, false><<<dim3(SSM_W / 128, NTOK / 128), 256, 0, stream>>>(SACT, SSM_W, w_glu + (size_t)layer * SSM_W * SSM_W, nullptr, SSM_W, SSM_W, e); }
        if (o_branch) launch_mk(a, pb + P_BRANCH, pb + P_BRANCH + 1, 0, grid, stream);
        else { NEpiBranch e0{G, TMP, MERGED, 0, 0}, e1{G, TMP, MERGED, 1, 0};
            const float* wbp = w_branch + (size_t)layer * 2 * 512 * 1024;
            k_ngemm<NEpiBranch, false><<<dim3(1024 / 128, NTOK / 128), 256, 0, stream>>>(AS2, 1024, wbp, nullptr, 1024, 512, e0);
            k_ngemm<NEpiBranch, false><<<dim3(1024 / 128, NTOK / 128), 256, 0, stream>>>(AS2 + 512, 1024, wbp + 512 * 1024, nullptr, 1024, 512, e1); }
        if (o_out) launch_mk(a, pb + P_OUT, pb + P_OUT + 1, 0, grid, stream);
        else { NEpiRes e{X, nullptr, nullptr, 0, 0};
          k_ngemm<NEpiRes, false><<<dim3(1024 / 128, NTOK / 128), 256, 0, stream>>>(MERGED, 1024, w_out + (size_t)layer * 1024 * 1024, nullptr, 1024, 1024, e); }
        int* asg_e = (int*)(ws + WS_ROUTE + (size_t)i * 512 * 1024); float* asg_g = (float*)(asg_e + 2 * 32768);
        if (layer % 2 == 0) {
            if (o_norm) launch_mk(a, pb + P_NORM2, pb + P_NORM2 + 1, 0, grid, stream);
            else k_norm<<<NTOK / 4, 256, 0, stream>>>(X, norm_ffn + layer * D_MODEL, XN, nullptr, nullptr, nullptr);
            if (o_ffn) { launch_mk(a, pb + P_UP, pb + P_UP + 1, 0, grid, stream); launch_mk(a, pb + P_DOWN, pb + P_DOWN + 1, 0, grid, stream); }
            else {
              { NEpiSwiglu e{H};
                k_ngemm<NEpiSwiglu, true><<<dim3(D_FF / 128, NTOK / 128), 256, 0, stream>>>(XN, D_MODEL, ffn_w1 + (size_t)i * D_MODEL * D_FF, ffn_w3 + (size_t)i * D_MODEL * D_FF, D_FF, D_MODEL, e); }
              { NEpiRes e{X, nullptr, nullptr, 0, 0};
                k_ngemm<NEpiRes, false><<<dim3(1024 / 128, NTOK / 128), 256, 0, stream>>>(H, D_FF, ffn_w2 + (size_t)i * D_FF * D_MODEL, nullptr, D_MODEL, D_FF, e); }
            }
        } else {
            if (o_norm) launch_mk(a, pb + P_NORM2, pb + P_NORM2 + 1, o_moe ? 8 : 0, grid, stream);
            else k_norm<<<NTOK / 4, 256, 0, stream>>>(X, norm_ffn + layer * D_MODEL, XN, moe_router + (size_t)i * D_MODEL * N_EXP, asg_e, asg_g);
            if (o_moe) { launch_mk(a, pb + P_ASSIGN, pb + P_ASSIGN + 1, 0, grid, stream); launch_mk(a, pb + P_UP, pb + P_UP + 1, 0, grid, stream); launch_mk(a, pb + P_DOWN, pb + P_DOWN + 1, 0, grid, stream); }
            else for (int ex = 0; ex < N_EXP; ++ex) {
                const size_t wo = ((size_t)i * N_EXP + ex) * D_MODEL * D_FF;
                { NEpiSwiglu e{H};
                  k_ngemm<NEpiSwiglu, true><<<dim3(D_FF / 128, NTOK / 128), 256, 0, stream>>>(XN, D_MODEL, moe_w1 + wo, moe_w3 + wo, D_FF, D_MODEL, e); }
                { NEpiRes e{X, asg_e, asg_g, ex, 0};
                  k_ngemm<NEpiRes, false><<<dim3(1024 / 128, NTOK / 128), 256, 0, stream>>>(H, D_FF, moe_w2 + wo, nullptr, D_MODEL, D_FF, e); }
            }
        }
    }
    if (o_norm) launch_mk(a, PH_FINAL, PH_FINAL + 1, sub_c, grid, stream);
    else k_final_norm<<<NTOK / 4, 256, 0, stream>>>(X, norm_final);
}
```
